# Optimizing an MI355X kernel written in HIP

```python
import math
import jax, jax.numpy as jnp
from jax import lax
import numpy as np


D_MODEL = 1024
BATCH = 4
SEQ = 8192
DEPTH = 1

GRID_W = 64
CTX_LEN = 256
N_DIFF_HEADS = 8
HEAD_DIM = 64
V_HEAD_DIM = 2 * HEAD_DIM
QK_W = 2 * N_DIFF_HEADS * HEAD_DIM
ATTN_W = N_DIFF_HEADS * V_HEAD_DIM
CONV_W = D_MODEL
CONV_K = 31
D_FF = 2816
N_MOD = 9
ROPE_BASE = 10000.0
AXIS_DIM = HEAD_DIM // 2
Q_BLOCK = 128
EPS = 1e-6
IN_SPLITS = (QK_W, 2 * QK_W, 2 * QK_W + ATTN_W, 2 * QK_W + ATTN_W + 2 * CONV_W,
             2 * QK_W + ATTN_W + 2 * CONV_W + D_MODEL)
IN_W = 2 * QK_W + ATTN_W + 2 * CONV_W + 2 * D_MODEL

kernel_name = 'hybrid_diffattn_conformer_macaron_dit_block'


def _rms(x, g):
    xf = x.astype(jnp.float32)
    y = xf * lax.rsqrt(jnp.mean(xf * xf, axis=-1, keepdims=True) + EPS)
    return (y * g.astype(jnp.float32)).astype(x.dtype)


def _layernorm(x, g, b):
    xf = x.astype(jnp.float32)
    mu = jnp.mean(xf, axis=-1, keepdims=True)
    xc = xf - mu
    var = jnp.mean(xc * xc, axis=-1, keepdims=True)
    y = xc * lax.rsqrt(var + EPS) * g.astype(jnp.float32) + b.astype(jnp.float32)
    return y.astype(x.dtype)


def _sub_in(x, g_pre, m, k):
    return _rms(x, g_pre) * (1 + m[k + 1]) + m[k]


def _sub_out(x, y, g_post, m, k, mult):
    return x + mult * m[k + 2] * _rms(y, g_post)


def _swiglu(h, w13, w2):
    gate, up = jnp.split(h @ w13, 2, axis=-1)
    return (jax.nn.silu(gate) * up) @ w2


def _rope2d(x, cos, sin):
    xs = x.reshape(x.shape[:-1] + (2, 2, AXIS_DIM // 2))
    x1, x2 = xs[..., 0, :], xs[..., 1, :]
    c = cos[None, :, None]
    s = sin[None, :, None]
    out = jnp.stack([x1 * c - x2 * s, x2 * c + x1 * s], axis=-2)
    return out.reshape(x.shape).astype(x.dtype)


def _diff_attn(q, k, v, lam):
    s = jnp.einsum('bqgd,bkgd->bgqk', q, k).astype(jnp.float32) * (HEAD_DIM ** -0.5)
    p = jax.nn.softmax(s, axis=-1)
    bsz, _, nq, nk = p.shape
    p = p.reshape(bsz, N_DIFF_HEADS, 2, nq, nk)
    a = p[:, :, 0] - lam * p[:, :, 1]
    return jnp.einsum('bhqk,bkhe->bqhe', a.astype(v.dtype), v)


def _diff_attn_blocked(q, k, v, lam):
    bsz, n, g, d = q.shape
    nb = n // Q_BLOCK
    qb = q.reshape(bsz, nb, Q_BLOCK, g, d).transpose(1, 0, 2, 3, 4)
    ob = lax.map(lambda blk: _diff_attn(blk, k, v, lam), qb)
    return ob.transpose(1, 0, 2, 3, 4).reshape(bsz, n, N_DIFF_HEADS, V_HEAD_DIM)


def _diff_heads_out(o, subln_g, lam_init):
    o = _rms(o, subln_g) * (1 - lam_init)
    return o.reshape(o.shape[:2] + (ATTN_W,))


def _conformer_conv(glu_in, w, b, ln_g, ln_b, w_proj):
    a, gt = jnp.split(glu_in, 2, axis=-1)
    u = a * jax.nn.sigmoid(gt)
    u = lax.conv_general_dilated(u, w[:, None, :].astype(u.dtype), window_strides=(1,),
                                 padding=[(CONV_K // 2, CONV_K // 2)],
                                 dimension_numbers=('NWC', 'WIO', 'NWC'),
                                 feature_group_count=CONV_W) + b
    u = jax.nn.silu(_layernorm(u, ln_g, ln_b))
    return u @ w_proj


def _merge(o_attn, glu_in, ga, gb, p):
    y_attn = o_attn @ p['w_attn_proj']
    y_conv = _conformer_conv(glu_in, p['conv_w'], p['conv_b'], p['conv_ln_g'], p['conv_ln_b'],
                             p['w_conv_proj'])
    return (jax.nn.sigmoid(ga) * y_attn + jax.nn.sigmoid(gb) * y_conv) @ p['w_out']


def _layer(x, xc, m_lat, m_ctx, cos, sin, p, lam_init, ctx_out):
    g = p['norm_g']
    bsz, n = x.shape[:2]
    nc = xc.shape[1]
    H2 = 2 * N_DIFF_HEADS

    def ffn_step(xx, m, k, w13, w2, gi):
        y = _swiglu(_sub_in(xx, g[gi], m, k), w13, w2)
        return _sub_out(xx, y, g[gi + 1], m, k, 0.5)

    x = ffn_step(x, m_lat, 0, p['ffn1_w13'], p['ffn1_w2'], 0)
    xc = ffn_step(xc, m_ctx, 0, p['ffn1_w13'], p['ffn1_w2'], 0)

    lq = p['lambda_qk'].astype(jnp.float32)
    lam = jnp.exp(jnp.sum(lq[0] * lq[1])) - jnp.exp(jnp.sum(lq[2] * lq[3])) + lam_init

    h = _sub_in(x, g[2], m_lat, 3)
    q, k, v, glu_in, ga, gb = jnp.split(h @ p['w_in'], IN_SPLITS, axis=-1)
    hc = _sub_in(xc, g[2], m_ctx, 3)
    if ctx_out:
        qc, kc, vc, glu_c, gac, gbc = jnp.split(hc @ p['w_in'], IN_SPLITS, axis=-1)
    else:
        kc, vc = jnp.split(hc @ p['w_in'][:, QK_W:IN_SPLITS[2]], [QK_W], axis=-1)
    kc = kc.reshape(bsz, nc, H2, HEAD_DIM)
    vc = vc.reshape(bsz, nc, N_DIFF_HEADS, V_HEAD_DIM)

    q = _rope2d(q.reshape(bsz, n, H2, HEAD_DIM), cos, sin)
    k = _rope2d(k.reshape(bsz, n, H2, HEAD_DIM), cos, sin)
    v = v.reshape(bsz, n, N_DIFF_HEADS, V_HEAD_DIM)
    k_all = jnp.concatenate([kc, k], axis=1)
    v_all = jnp.concatenate([vc, v], axis=1)
    o_attn = _diff_heads_out(_diff_attn_blocked(q, k_all, v_all, lam), p['subln_g'], lam_init)
    y = _merge(o_attn, glu_in, ga, gb, p)
    x = _sub_out(x, y, g[3], m_lat, 3, 1.0)

    x = ffn_step(x, m_lat, 6, p['ffn2_w13'], p['ffn2_w2'], 4)

    if ctx_out:
        qc = qc.reshape(bsz, nc, H2, HEAD_DIM)
        oc_attn = _diff_heads_out(_diff_attn(qc, kc, vc, lam), p['subln_g'], lam_init)
        yc = _merge(oc_attn, glu_c, gac, gbc, p)
        xc = _sub_out(xc, yc, g[3], m_ctx, 3, 1.0)
        xc = ffn_step(xc, m_ctx, 6, p['ffn2_w13'], p['ffn2_w2'], 4)
    return x, xc


def setup_inputs(seed: int = 0) -> dict:
    key = jax.random.key(seed)
    ks = jax.random.split(key, 21)
    f32 = jnp.float32
    D = D_MODEL

    def nrm(k, shape, scale):
        return jax.random.normal(k, shape, f32) * scale

    return {
        'x': nrm(ks[0], (BATCH, SEQ, D), 1.0),
        'c': nrm(ks[1], (BATCH, D), 1.0),
        'ctx': nrm(ks[2], (BATCH, CTX_LEN, D), 1.0),
        'c_ctx': nrm(ks[3], (D,), 1.0),
        'w_ada': nrm(ks[4], (DEPTH, D, N_MOD * D), D ** -0.5),
        'b_ada': nrm(ks[5], (DEPTH, N_MOD * D), 0.02),
        'norm_g': 1.0 + nrm(ks[6], (DEPTH, 6, D), 0.05),
        'ffn1_w13': nrm(ks[7], (DEPTH, D, 2 * D_FF), D ** -0.5),
        'ffn1_w2': nrm(ks[8], (DEPTH, D_FF, D), D_FF ** -0.5),
        'ffn2_w13': nrm(ks[9], (DEPTH, D, 2 * D_FF), D ** -0.5),
        'ffn2_w2': nrm(ks[10], (DEPTH, D_FF, D), D_FF ** -0.5),
        'w_in': nrm(ks[11], (DEPTH, D, IN_W), D ** -0.5),
        'lambda_qk': nrm(ks[12], (DEPTH, 4, HEAD_DIM), 0.1),
        'subln_g': 1.0 + nrm(ks[13], (DEPTH, V_HEAD_DIM), 0.05),
        'w_attn_proj': nrm(ks[14], (DEPTH, ATTN_W, D), ATTN_W ** -0.5),
        'conv_w': nrm(ks[15], (DEPTH, CONV_K, CONV_W), CONV_K ** -0.5),
        'conv_b': nrm(ks[16], (DEPTH, CONV_W), 0.02),
        'conv_ln_g': 1.0 + nrm(ks[17], (DEPTH, CONV_W), 0.05),
        'conv_ln_b': nrm(ks[18], (DEPTH, CONV_W), 0.02),
        'w_conv_proj': nrm(ks[19], (DEPTH, CONV_W, D), CONV_W ** -0.5),
        'w_out': nrm(ks[20], (DEPTH, D, D), D ** -0.5),
    }


def reference(x, c, ctx, c_ctx, w_ada, b_ada, norm_g, ffn1_w13, ffn1_w2, ffn2_w13, ffn2_w2,
              w_in, lambda_qk, subln_g, w_attn_proj, conv_w, conv_b, conv_ln_g, conv_ln_b,
              w_conv_proj, w_out):
    bsz, n_lat, d = x.shape
    n_rows = n_lat // GRID_W
    row = jnp.repeat(jnp.arange(n_rows, dtype=jnp.int32), GRID_W)
    col = jnp.tile(jnp.arange(GRID_W, dtype=jnp.int32), n_rows)
    inv_freq = ROPE_BASE ** (-jnp.arange(0, AXIS_DIM, 2, dtype=jnp.float32) / AXIS_DIM)
    ang = jnp.stack([row, col], axis=-1).astype(jnp.float32)[..., None] * inv_freq
    cos, sin = jnp.cos(ang), jnp.sin(ang)

    xc = ctx
    for i in range(DEPTH):
        m_lat = (jax.nn.silu(c) @ w_ada[i] + b_ada[i]).reshape(bsz, N_MOD, 1, d).transpose(1, 0, 2, 3)
        m_ctx = (jax.nn.silu(c_ctx) @ w_ada[i] + b_ada[i]).reshape(N_MOD, 1, 1, d)
        p = {'norm_g': norm_g[i], 'ffn1_w13': ffn1_w13[i], 'ffn1_w2': ffn1_w2[i],
             'ffn2_w13': ffn2_w13[i], 'ffn2_w2': ffn2_w2[i], 'w_in': w_in[i],
             'lambda_qk': lambda_qk[i], 'subln_g': subln_g[i], 'w_attn_proj': w_attn_proj[i],
             'conv_w': conv_w[i], 'conv_b': conv_b[i], 'conv_ln_g': conv_ln_g[i],
             'conv_ln_b': conv_ln_b[i], 'w_conv_proj': w_conv_proj[i], 'w_out': w_out[i]}
        lam_init = 0.8 - 0.6 * math.exp(-0.3 * i)
        x, xc = _layer(x, xc, m_lat, m_ctx, cos, sin, p, lam_init, i < DEPTH - 1)
    return x
```

```cpp
#include <hip/hip_runtime.h>
#include <hip/hip_cooperative_groups.h>
#include <cstdio>
#include <cstdint>
namespace cg = cooperative_groups;
namespace pg8 {
#define PG8_LAS __attribute__((address_space(3)))
typedef unsigned short bf16_t;
typedef short bf16x8 __attribute__((ext_vector_type(8)));
typedef float f32x4 __attribute__((ext_vector_type(4)));
typedef unsigned u32x4 __attribute__((ext_vector_type(4)));
constexpr int BM = 256, BK = 64, HALF = 128, HTB = HALF * BK * 2  , STAGE_BYTES = 8 * HTB, NXCD = 8, WGM = 8;

__host__ __device__ __forceinline__ int lds_byte(int r, int c) { const int st = (r >> 4) * 2 + (c >> 5), rr = r & 15, cc = c & 31, ob = rr * 64 + cc * 2; return st * 1024 + (ob ^ (((ob >> 9) & 1) << 5)); }
__host__ __device__ __forceinline__ void stage_rc(int b, int& R, int& C) { const int st = b / 1024, sb = b % 1024, swz = sb ^ (((sb >> 9) & 1) << 5); R = (st >> 1) * 16 + swz / 64; C = (st & 1) * 32 + (swz % 64) / 2; }
__host__ __device__ __forceinline__ int perm32(int rho) { const int n = rho >> 4, i = rho & 15; return 8 * (i >> 2) + 4 * n + (i & 3); }

struct Unit { int pm, pn; };
struct Gemm { const bf16_t* A; const bf16_t* Bt; int M, N, K; };

struct StaticOrder {
    int nM, nN, nwg, G, c;
    __host__ __device__ void init(int M, int N, int G_, int c_) { nM = M / BM; nN = N / BM; nwg = nM * nN; G = G_; c = c_; }
    __host__ __device__ bool next(int i, Unit& u) const {
        const long L = (long)i * G + c; if (L >= nwg) return false;
        int wgid = (int)L; { const int q = nwg / NXCD, r = nwg % NXCD, xcd = wgid % NXCD, off = wgid / NXCD; wgid = (xcd < r ? xcd * (q + 1) : r * (q + 1) + (xcd - r) * q) + off; }
        const int nig = WGM * nN, gid = wgid / nig, fm = gid * WGM, gsz = (nM - fm) < WGM ? (nM - fm) : WGM;
        u.pm = fm + ((wgid % nig) % gsz); u.pn = (wgid % nig) / gsz; return true;
    }
    __device__ __forceinline__ void a_ready(const Unit&) const {}
    __device__ __forceinline__ void done(const Unit&) const {}
};

typedef float f32x2c_t __attribute__((ext_vector_type(2))); typedef __bf16 bf16x2c_t __attribute__((ext_vector_type(2)));
__device__ __forceinline__ unsigned cvt_pk_bf16(float lo, float hi) { f32x2c_t v = {lo, hi}; bf16x2c_t b = __builtin_convertvector(v, bf16x2c_t); return __builtin_bit_cast(unsigned, b); }
typedef float f32x2 __attribute__((ext_vector_type(2)));
__device__ __forceinline__ f32x2 gelu_pk(f32x2 v) {
    const f32x2 av = __builtin_elementwise_abs(v), d = av * 0.2316418882f + 1.0f;
    f32x2 t; t.x = __builtin_amdgcn_rcpf(d.x); t.y = __builtin_amdgcn_rcpf(d.y);
    f32x2 q = t * 0.5307027145f + (-0.7265760135f); q = q * t + 0.7107068705f; q = q * t + (-0.142248368f); q = q * t + 0.127414796f; q = q * t;
    const f32x2 s = (v * v) * (-0.72134752044f);
    f32x2 e; e.x = __builtin_amdgcn_exp2f(s.x); e.y = __builtin_amdgcn_exp2f(s.y);
    const f32x2 m = v * (q * e), r = v - m;
    f32x2 o; o.x = v.x < 0.f ? m.x : r.x; o.y = v.y < 0.f ? m.y : r.y; return o;
}

template <int ACT  > struct EpiBf16 {
    static constexpr bool PERM = true, AFTER_DRAIN = false; static_assert(ACT == 0 || ACT == 1, "EpiBf16: ACT is 0 (none) or 1 (gelu_pk)");
    bf16_t* O; int ldc; const float* bias; int split_cols; size_t split_stride; float scale0;
    __device__ __forceinline__ void operator()(const f32x4 (&acc)[2][2][4][2], const Unit& u, int wr, int wc, int fr, int fq) const {
        const int row0 = u.pm * BM + wr * 64 + fr; int colt = u.pn * BM; bf16_t* base = O;
        float sc = 1.f; if (split_cols) { const int t = colt / split_cols; base += (size_t)t * split_stride; colt -= t * split_cols; if (t == 0) sc = scale0; }
        const int col0 = colt + wc * 32 + 8 * fq, bcol0 = u.pn * BM + wc * 32 + 8 * fq;
        f32x4 bv[2][2];
#pragma unroll
        for (int bj = 0; bj < 2; ++bj)
#pragma unroll
            for (int n = 0; n < 2; ++n) bv[bj][n] = bias ? *(const f32x4*)(bias + bcol0 + bj * HALF + 4 * n) : (f32x4){0.f, 0.f, 0.f, 0.f};
#pragma unroll
        for (int ai = 0; ai < 2; ++ai)
#pragma unroll
            for (int m = 0; m < 4; ++m) { bf16_t* rowp = base + (size_t)(row0 + ai * HALF + m * 16) * ldc + col0;
#pragma unroll
                for (int bj = 0; bj < 2; ++bj) { f32x4 v0 = acc[ai][bj][m][0] + bv[bj][0], v1 = acc[ai][bj][m][1] + bv[bj][1];
                    if (ACT == 1) { f32x2 a = gelu_pk((f32x2){v0[0], v0[1]}), b = gelu_pk((f32x2){v0[2], v0[3]}), c = gelu_pk((f32x2){v1[0], v1[1]}), d = gelu_pk((f32x2){v1[2], v1[3]});
                        v0 = (f32x4){a.x, a.y, b.x, b.y}; v1 = (f32x4){c.x, c.y, d.x, d.y}; }
                    v0 = v0 * sc; v1 = v1 * sc; u32x4 w; w.x = cvt_pk_bf16(v0[0], v0[1]); w.y = cvt_pk_bf16(v0[2], v0[3]); w.z = cvt_pk_bf16(v1[0], v1[1]); w.w = cvt_pk_bf16(v1[2], v1[3]);
                    *(u32x4*)(rowp + bj * HALF) = w; } }
    }
};
template <class Epi, class Sched, bool ALIGN_EPI = false, bool SP2 = false>
__device__ __forceinline__ void gemm_phase(PG8_LAS unsigned char* lds, const Gemm g, const Sched& S, const Epi& E) {
    int tid_ = threadIdx.x; asm volatile("" : "+v"(tid_));
    const int tid = tid_, wid = __builtin_amdgcn_readfirstlane(tid >> 6), lane = tid & 63, wr = wid >> 2, wc = wid & 3, fr = lane & 15, fq = lane >> 4;
    const int K = g.K, nt = K / BK;
    unsigned voffA[2], voffB[2];
#pragma unroll
    for (int i = 0; i < 2; ++i) { int R, C; stage_rc(tid * 16 + i * 8192, R, C); const int Rb = Epi::PERM ? ((R & ~31) + perm32(R & 31)) : R;
        voffA[i] = (unsigned)(R * K + C) * 2u; voffB[i] = (unsigned)(Rb * K + C) * 2u; }
    const size_t kstep = (size_t)(BK * 2);
    const size_t hstep = (size_t)HALF * K * 2;
    const size_t tstep = 2 * hstep;
    const unsigned ldsw = (unsigned)wid * 1024u;
    const int aoff = lds_byte(wr * 64 + fr, fq * 8), boff = lds_byte(wc * 32 + fr, fq * 8);
#define PG8_SA(b, h) (((b) * 2 + (h)) * HTB)
#define PG8_SB(b, h) ((4 + (b) * 2 + (h)) * HTB)
#define PG8_STAGE(bufoff, gbase, voff) do { _Pragma("unroll") for (int _i = 0; _i < 2; ++_i) \
        __builtin_amdgcn_global_load_lds((const unsigned*)((const char*)(gbase) + (voff)[_i]), (PG8_LAS unsigned*)(lds + (bufoff) + ldsw + _i * 8192), 16, 0, 0); } while (0)
#define PG8_LDA(dst, b, h) do { _Pragma("unroll") for (int m = 0; m < 4; ++m) _Pragma("unroll") for (int k = 0; k < 2; ++k) dst[m][k] = *(const PG8_LAS bf16x8*)(lds + PG8_SA(b, h) + aoff + m * 2048 + k * 1024); } while (0)
#define PG8_LDB(dst, b, h) do { _Pragma("unroll") for (int n = 0; n < 2; ++n) _Pragma("unroll") for (int k = 0; k < 2; ++k) dst[n][k] = *(const PG8_LAS bf16x8*)(lds + PG8_SB(b, h) + boff + n * 2048 + k * 1024); } while (0)
#define PG8_MMA(ai, bj, At, Bt) do { __builtin_amdgcn_s_setprio(1); _Pragma("unroll") for (int m = 0; m < 4; ++m) _Pragma("unroll") for (int n = 0; n < 2; ++n) _Pragma("unroll") for (int k = 0; k < 2; ++k) \
        acc[ai][bj][m][n] = __builtin_amdgcn_mfma_f32_16x16x32_bf16(Bt[n][k], At[m][k], acc[ai][bj][m][n], 0, 0, 0); __builtin_amdgcn_s_setprio(0); } while (0)
#define PG8_WAIT_V(n) asm volatile("s_waitcnt vmcnt(" #n ")" ::: "memory")
#define PG8_WAIT_L(n) asm volatile("s_waitcnt lgkmcnt(" #n ")" ::: "memory")
#define PG8_BAR __builtin_amdgcn_s_barrier()
#define PG8_SCHED __builtin_amdgcn_sched_barrier(0)
    Unit cur, nxt; int ui = 0;
    if (!S.next(0, cur)) return;
    f32x4 acc[2][2][4][2];
#pragma unroll
    for (int a = 0; a < 2; ++a)
#pragma unroll
        for (int b = 0; b < 2; ++b)
#pragma unroll
            for (int m = 0; m < 4; ++m)
#pragma unroll
                for (int n = 0; n < 2; ++n) acc[a][b][m][n] = (f32x4){0.f, 0.f, 0.f, 0.f};
    bf16x8 At[4][2], B0[2][2], B1[2][2];
    const char* cA = (const char*)g.A + (size_t)cur.pm * tstep; const char* cB = (const char*)g.Bt + (size_t)cur.pn * tstep;
    S.a_ready(cur);
    if constexpr (SP2) {
        PG8_STAGE(PG8_SB(0, 0), cB, voffB); PG8_STAGE(PG8_SB(0, 1), cB + hstep, voffB); PG8_STAGE(PG8_SA(0, 0), cA, voffA); PG8_STAGE(PG8_SA(0, 1), cA + hstep, voffA);
        if (wr == 1) PG8_BAR;
        PG8_WAIT_V(2); PG8_BAR;
        PG8_STAGE(PG8_SB(1, 0), cB + kstep, voffB); PG8_STAGE(PG8_SA(1, 0), cA + kstep, voffA); PG8_STAGE(PG8_SB(1, 1), cB + hstep + kstep, voffB);
        PG8_WAIT_V(6); PG8_BAR;
    } else {
        PG8_STAGE(PG8_SB(0, 0), cB, voffB); PG8_STAGE(PG8_SA(0, 0), cA, voffA); PG8_STAGE(PG8_SB(0, 1), cB + hstep, voffB); PG8_STAGE(PG8_SA(0, 1), cA + hstep, voffA);
        if (wr == 1) PG8_BAR;
        PG8_WAIT_V(4); PG8_BAR;
        PG8_STAGE(PG8_SB(1, 0), cB + kstep, voffB); PG8_STAGE(PG8_SA(1, 0), cA + kstep, voffA); PG8_STAGE(PG8_SB(1, 1), cB + hstep + kstep, voffB);
        PG8_WAIT_V(6); PG8_BAR;
    }
    for (;;) {
        const bool has_next = S.next(ui + 1, nxt);
        const char* nA = has_next ? (const char*)g.A + (size_t)nxt.pm * tstep : cA; const char* nB = has_next ? (const char*)g.Bt + (size_t)nxt.pn * tstep : cB;
        for (int t = 0; t < nt; t += 2) {
            const bool last = (t == nt - 2);
            const char* a1 = cA + (size_t)(t + 1) * kstep;
            const char* a2 = last ? nA : cA + (size_t)(t + 2) * kstep; const char* b2 = last ? nB : cB + (size_t)(t + 2) * kstep;
            const char* a3 = a2 + kstep; const char* b3 = b2 + kstep;
            if (last && has_next) S.a_ready(nxt);
            if constexpr (SP2) {
            PG8_LDB(B0, 0, 0); PG8_LDB(B1, 0, 1); PG8_SCHED; PG8_LDA(At, 0, 0); PG8_STAGE(PG8_SA(1, 1), a1 + hstep, voffA);
            PG8_WAIT_V(8); PG8_WAIT_L(0); PG8_BAR; PG8_MMA(0, 0, At, B0); PG8_MMA(0, 1, At, B1); PG8_BAR; PG8_SCHED;
            PG8_LDA(At, 0, 1); PG8_STAGE(PG8_SB(0, 0), b2, voffB); PG8_STAGE(PG8_SB(0, 1), b2 + hstep, voffB); PG8_STAGE(PG8_SA(0, 0), a2, voffA);
            PG8_WAIT_V(8); PG8_WAIT_L(0); PG8_BAR; PG8_MMA(1, 0, At, B0); PG8_MMA(1, 1, At, B1); PG8_BAR; PG8_SCHED;
            PG8_LDB(B0, 1, 0); PG8_LDB(B1, 1, 1); PG8_SCHED; PG8_LDA(At, 1, 0); PG8_STAGE(PG8_SA(0, 1), a2 + hstep, voffA);
            PG8_WAIT_V(8); PG8_WAIT_L(0); PG8_BAR; PG8_MMA(0, 0, At, B0); PG8_MMA(0, 1, At, B1); PG8_BAR; PG8_SCHED;
            PG8_LDA(At, 1, 1); PG8_STAGE(PG8_SB(1, 0), b3, voffB); PG8_STAGE(PG8_SB(1, 1), b3 + hstep, voffB); PG8_STAGE(PG8_SA(1, 0), a3, voffA);
            PG8_WAIT_V(8); PG8_WAIT_L(0); PG8_BAR; PG8_MMA(1, 0, At, B0); PG8_MMA(1, 1, At, B1); PG8_BAR; PG8_SCHED;
            } else {
            PG8_LDB(B0, 0, 0); PG8_SCHED; PG8_LDA(At, 0, 0); PG8_STAGE(PG8_SA(1, 1), a1 + hstep, voffA);
            PG8_WAIT_L(8); PG8_BAR; PG8_WAIT_L(0); PG8_MMA(0, 0, At, B0); PG8_BAR; PG8_SCHED;
            PG8_LDB(B1, 0, 1); PG8_STAGE(PG8_SB(0, 0), b2, voffB);
            PG8_BAR; PG8_WAIT_L(0); PG8_MMA(0, 1, At, B1); PG8_BAR;
            PG8_LDA(At, 0, 1); PG8_STAGE(PG8_SA(0, 0), a2, voffA);
            PG8_BAR; PG8_WAIT_L(0); PG8_MMA(1, 0, At, B0); PG8_BAR; PG8_SCHED;
            PG8_STAGE(PG8_SB(0, 1), b2 + hstep, voffB);
            PG8_WAIT_V(6); PG8_BAR; PG8_MMA(1, 1, At, B1); PG8_BAR;
            PG8_LDB(B0, 1, 0); PG8_SCHED; PG8_LDA(At, 1, 0); PG8_STAGE(PG8_SA(0, 1), a2 + hstep, voffA);
            PG8_WAIT_L(8); PG8_BAR; PG8_WAIT_L(0); PG8_MMA(0, 0, At, B0); PG8_BAR; PG8_SCHED;
            PG8_LDB(B1, 1, 1); PG8_STAGE(PG8_SB(1, 0), b3, voffB);
            PG8_BAR; PG8_WAIT_L(0); PG8_MMA(0, 1, At, B1); PG8_BAR;
            PG8_LDA(At, 1, 1); PG8_STAGE(PG8_SA(1, 0), a3, voffA);
            PG8_BAR; PG8_WAIT_L(0); PG8_MMA(1, 0, At, B0); PG8_BAR; PG8_SCHED;
            PG8_STAGE(PG8_SB(1, 1), b3 + hstep, voffB);
            PG8_WAIT_V(6); PG8_BAR; PG8_MMA(1, 1, At, B1); PG8_BAR;
            }
        }
        if constexpr (ALIGN_EPI) { if (wr == 0) PG8_BAR; }
        if constexpr (!Epi::AFTER_DRAIN) { E(acc, cur, wr, wc, fr, fq); S.done(cur); }
        if (!has_next) break;
#pragma unroll
        for (int a = 0; a < 2; ++a)
#pragma unroll
            for (int b = 0; b < 2; ++b)
#pragma unroll
                for (int m = 0; m < 4; ++m)
#pragma unroll
                    for (int n = 0; n < 2; ++n) acc[a][b][m][n] = (f32x4){0.f, 0.f, 0.f, 0.f};
        cur = nxt; cA = nA; cB = nB; ++ui;
        if constexpr (ALIGN_EPI) { if (wr == 1) PG8_BAR; }
    }
    PG8_WAIT_V(0);
    if constexpr (!ALIGN_EPI) { if (wr == 0) PG8_BAR; }
    PG8_BAR;
    if constexpr (Epi::AFTER_DRAIN) { E.fused(acc, cur, wr, wc, fr, fq, lds, wid, lane); S.done(cur); }
#undef PG8_SA
#undef PG8_SB
#undef PG8_STAGE
#undef PG8_LDA
#undef PG8_LDB
#undef PG8_MMA
#undef PG8_WAIT_V
#undef PG8_WAIT_L
#undef PG8_BAR
#undef PG8_SCHED
}
}

#ifndef PG8_SP2
#define PG8_SP2 true
#endif
#ifndef PG8_ALIGN
#define PG8_ALIGN true
#endif
#include <hip/hip_bf16.h>
#include <cmath>
namespace attn2 {
using bf16x8 = __attribute__((ext_vector_type(8))) short;
using s16x4  = __attribute__((ext_vector_type(4))) short;
using f32x16 = __attribute__((ext_vector_type(16))) float;
using u32x4  = __attribute__((ext_vector_type(4))) unsigned;
typedef unsigned short bf16r;
constexpr int DQ = 64, DV = 128, NW = 8, QBLK = 32, KVBLK = 64, LD = 1024;
constexpr float SCALE = 0.125f, THR = 8.f;
constexpr size_t SHM_V = KVBLK * DV * 2, SHM_K = KVBLK * DQ * 2, SHM_ATTN = 3 * SHM_V + 3 * SHM_K + NW * 64 * 4;
constexpr size_t PARK_OFF = SHM_ATTN, PARK_BYTES = NW * 2048 * 4;
#define A2_KSWZ(row, colB) ((row) * 128 + ((colB) ^ ((((row) >> 1) & 7) << 4)))
#define A2_SBAR() __builtin_amdgcn_sched_barrier(0)
__device__ __forceinline__ int crow(int r, int hi) { return (r & 3) + 8 * (r >> 2) + 4 * hi; }
typedef float f32x2_t __attribute__((ext_vector_type(2))); typedef __bf16 bf16x2_t __attribute__((ext_vector_type(2)));
__device__ __forceinline__ unsigned cvtpk(float lo, float hi) { f32x2_t v = {lo, hi}; bf16x2_t b = __builtin_convertvector(v, bf16x2_t); return __builtin_bit_cast(unsigned, b); }

__device__ __forceinline__ void partialSM(f32x16& p0, f32x16& p1, float& m_reg, float& mn, float& alpha) {
  constexpr float C = SCALE * 1.4426950408889634f;
  float pmax = p0[0];
#pragma unroll
  for (int r = 1; r < 16; ++r) pmax = fmaxf(pmax, p0[r]);
#pragma unroll
  for (int r = 0; r < 16; ++r) pmax = fmaxf(pmax, p1[r]);
  { auto rr = __builtin_amdgcn_permlane32_swap(__float_as_uint(pmax), __float_as_uint(pmax), false, false);
    pmax = fmaxf(__uint_as_float(rr[0]), __uint_as_float(rr[1])); }
  if (__builtin_expect(__all(pmax - m_reg <= THR / SCALE), 1)) { mn = m_reg; alpha = 1.f; }
  else { mn = fmaxf(m_reg, pmax); alpha = __builtin_amdgcn_exp2f((m_reg - mn) * C); m_reg = mn; }
  const float mnC = -mn * C;
  { const f32x2_t cv = {C, C}, mv = {mnC, mnC};
#pragma unroll
    for (int i = 0; i < 8; ++i) { f32x2_t t = {p0[2 * i], p0[2 * i + 1]}; t = t * cv + mv; p0[2 * i] = t.x; p0[2 * i + 1] = t.y; }
#pragma unroll
    for (int i = 0; i < 8; ++i) { f32x2_t t = {p1[2 * i], p1[2 * i + 1]}; t = t * cv + mv; p1[2 * i] = t.x; p1[2 * i + 1] = t.y; } }
#pragma unroll
  for (int r = 0; r < 16; ++r) p0[r] = __builtin_amdgcn_exp2f(p0[r]);
}
__device__ __forceinline__ void finishSM(f32x16& p0, f32x16& p1, float alpha, float& l_reg, bf16x8& pa0, bf16x8& pa1, bf16x8& pa2, bf16x8& pa3) {
#pragma unroll
  for (int r = 0; r < 16; ++r) p1[r] = __builtin_amdgcn_exp2f(p1[r]);
  f32x2_t sv = {p0[0], p0[1]};
#pragma unroll
  for (int i = 1; i < 8; ++i) sv += (f32x2_t){p0[2 * i], p0[2 * i + 1]};
#pragma unroll
  for (int i = 0; i < 8; ++i) sv += (f32x2_t){p1[2 * i], p1[2 * i + 1]};
  float ps = sv.x + sv.y;
  { auto rr = __builtin_amdgcn_permlane32_swap(__float_as_uint(ps), __float_as_uint(ps), false, false);
    ps = __uint_as_float(rr[0]) + __uint_as_float(rr[1]); }
  l_reg = l_reg * alpha + ps;
#define A2_PK4(P, BASE, OUT) do { unsigned a0 = cvtpk(P[BASE + 0], P[BASE + 1]), a1 = cvtpk(P[BASE + 2], P[BASE + 3]);   \
    unsigned b0 = cvtpk(P[BASE + 4], P[BASE + 5]), b1 = cvtpk(P[BASE + 6], P[BASE + 7]);                              \
    auto r0 = __builtin_amdgcn_permlane32_swap(a0, b0, false, false); auto r1 = __builtin_amdgcn_permlane32_swap(a1, b1, false, false); \
    u32x4 w = {r0[0], r1[0], r0[1], r1[1]}; OUT = *reinterpret_cast<bf16x8*>(&w); } while (0)
  A2_PK4(p0, 0, pa0); A2_PK4(p0, 8, pa1); A2_PK4(p1, 0, pa2); A2_PK4(p1, 8, pa3);
#undef A2_PK4
}
__device__ __forceinline__ void qkt(f32x16& p0, f32x16& p1, const char* Ks, const bf16x8* qr, int r32, int hi) {
  p0 = f32x16{}; p1 = f32x16{};
#pragma unroll
  for (int d0 = 0; d0 < 4; ++d0) { const int cb = (d0 * 16 + hi * 8) * 2;
    const bf16x8 b0 = *reinterpret_cast<const bf16x8*>(Ks + A2_KSWZ(r32, cb));
    const bf16x8 b1 = *reinterpret_cast<const bf16x8*>(Ks + A2_KSWZ(32 + r32, cb));
    p0 = __builtin_amdgcn_mfma_f32_32x32x16_bf16(b0, qr[d0], p0, 0, 0, 0);
    p1 = __builtin_amdgcn_mfma_f32_32x32x16_bf16(b1, qr[d0], p1, 0, 0, 0); }
}
__device__ __forceinline__ int v_st(int k, int c) { const int kk = (k & ~0xC) | ((k & 4) << 1) | ((k & 8) >> 1); return ((kk >> 3) * 4 + (c >> 5)) * 512 + ((kk & 7) * 32 + (c & 31)) * 2; }
__device__ __forceinline__ int v_rd_base(int lane) { return ((lane & 3) << 3) | (((lane >> 2) & 3) << 6) | (((lane >> 4) & 1) << 5) | (((lane >> 5) & 1) << 8); }
constexpr int v_rd_off(int d0, int ks, int half) { return d0 * 512 + ks * 4096 + half * 2048; }
template <int OFF> __device__ __forceinline__ s16x4 tr_read(int vb) {
  s16x4 r; asm volatile("ds_read_b64_tr_b16 %0, %1 offset:%2" : "=&v"(r) : "v"(vb), "i"(OFF) : "memory"); return r;
}
template <int D0> __device__ __forceinline__ void pv_one(f32x16& od, int vb, bf16x8 pa0, bf16x8 pa1, bf16x8 pa2, bf16x8 pa3) {
  const s16x4 l0 = tr_read<v_rd_off(D0, 0, 0)>(vb), h0 = tr_read<v_rd_off(D0, 0, 1)>(vb), l1 = tr_read<v_rd_off(D0, 1, 0)>(vb), h1 = tr_read<v_rd_off(D0, 1, 1)>(vb);
  const s16x4 l2 = tr_read<v_rd_off(D0, 2, 0)>(vb), h2 = tr_read<v_rd_off(D0, 2, 1)>(vb), l3 = tr_read<v_rd_off(D0, 3, 0)>(vb), h3 = tr_read<v_rd_off(D0, 3, 1)>(vb);
  asm volatile("s_waitcnt lgkmcnt(0)" ::: "memory"); A2_SBAR();
#define A2_PK(L, H) (bf16x8){L[0], L[1], L[2], L[3], H[0], H[1], H[2], H[3]}
  od = __builtin_amdgcn_mfma_f32_32x32x16_bf16(pa0, A2_PK(l0, h0), od, 0, 0, 0);
  od = __builtin_amdgcn_mfma_f32_32x32x16_bf16(pa1, A2_PK(l1, h1), od, 0, 0, 0);
  od = __builtin_amdgcn_mfma_f32_32x32x16_bf16(pa2, A2_PK(l2, h2), od, 0, 0, 0);
  od = __builtin_amdgcn_mfma_f32_32x32x16_bf16(pa3, A2_PK(l3, h3), od, 0, 0, 0);
#undef A2_PK
}
__device__ __forceinline__ void pv_d0(f32x16* o, int vb, bf16x8 pa0, bf16x8 pa1, bf16x8 pa2, bf16x8 pa3) {
  pv_one<0>(o[0], vb, pa0, pa1, pa2, pa3); pv_one<1>(o[1], vb, pa0, pa1, pa2, pa3); pv_one<2>(o[2], vb, pa0, pa1, pa2, pa3); pv_one<3>(o[3], vb, pa0, pa1, pa2, pa3);
}

struct VF { s16x4 l0, h0, l1, h1, l2, h2, l3, h3; };
template <int D0> __device__ __forceinline__ VF vread(int vb) { VF f;
  f.l0 = tr_read<v_rd_off(D0, 0, 0)>(vb); f.h0 = tr_read<v_rd_off(D0, 0, 1)>(vb); f.l1 = tr_read<v_rd_off(D0, 1, 0)>(vb); f.h1 = tr_read<v_rd_off(D0, 1, 1)>(vb);
  f.l2 = tr_read<v_rd_off(D0, 2, 0)>(vb); f.h2 = tr_read<v_rd_off(D0, 2, 1)>(vb); f.l3 = tr_read<v_rd_off(D0, 3, 0)>(vb); f.h3 = tr_read<v_rd_off(D0, 3, 1)>(vb); return f; }
__device__ __forceinline__ void mfma4(f32x16& od, const VF& f, bf16x8 pa0, bf16x8 pa1, bf16x8 pa2, bf16x8 pa3) {
#define A2_PK(L, H) (bf16x8){L[0], L[1], L[2], L[3], H[0], H[1], H[2], H[3]}
  od = __builtin_amdgcn_mfma_f32_32x32x16_bf16(pa0, A2_PK(f.l0, f.h0), od, 0, 0, 0);
  od = __builtin_amdgcn_mfma_f32_32x32x16_bf16(pa1, A2_PK(f.l1, f.h1), od, 0, 0, 0);
  od = __builtin_amdgcn_mfma_f32_32x32x16_bf16(pa2, A2_PK(f.l2, f.h2), od, 0, 0, 0);
  od = __builtin_amdgcn_mfma_f32_32x32x16_bf16(pa3, A2_PK(f.l3, f.h3), od, 0, 0, 0);
#undef A2_PK
}
#define A2_LWAIT(n) do { asm volatile("s_waitcnt lgkmcnt(" #n ")" ::: "memory"); A2_SBAR(); } while (0)
__device__ __forceinline__ void pv_psm(f32x16* o, int vb, bf16x8 pa0, bf16x8 pa1, bf16x8 pa2, bf16x8 pa3, f32x16& p0, f32x16& p1, float& m_reg, float& mn, float& alpha) {
  constexpr float C = SCALE * 1.4426950408889634f;
  const VF f0 = vread<0>(vb);
  const VF f1 = vread<1>(vb); A2_LWAIT(8); mfma4(o[0], f0, pa0, pa1, pa2, pa3);
  float pmax = p0[0];
#pragma unroll
  for (int r = 1; r < 16; ++r) pmax = fmaxf(pmax, p0[r]);
#pragma unroll
  for (int r = 0; r < 16; ++r) pmax = fmaxf(pmax, p1[r]);
  { auto rr = __builtin_amdgcn_permlane32_swap(__float_as_uint(pmax), __float_as_uint(pmax), false, false);
    pmax = fmaxf(__uint_as_float(rr[0]), __uint_as_float(rr[1])); }
  asm volatile("" : "+v"(pmax));
  const VF f2 = vread<2>(vb); A2_LWAIT(8); mfma4(o[1], f1, pa0, pa1, pa2, pa3);
  if (__builtin_expect(__all(pmax - m_reg <= THR / SCALE), 1)) { mn = m_reg; alpha = 1.f; }
  else { mn = fmaxf(m_reg, pmax); alpha = __builtin_amdgcn_exp2f((m_reg - mn) * C); m_reg = mn; }
  const float mnC = -mn * C; const f32x2_t cv = {C, C}, mv = {mnC, mnC};
#pragma unroll
  for (int i = 0; i < 8; ++i) { f32x2_t t = {p0[2 * i], p0[2 * i + 1]}; t = t * cv + mv; p0[2 * i] = t.x; p0[2 * i + 1] = t.y; }
  asm volatile("" : "+v"(p0));
  const VF f3 = vread<3>(vb); A2_LWAIT(8); mfma4(o[2], f2, pa0, pa1, pa2, pa3);
#pragma unroll
  for (int i = 0; i < 8; ++i) { f32x2_t t = {p1[2 * i], p1[2 * i + 1]}; t = t * cv + mv; p1[2 * i] = t.x; p1[2 * i + 1] = t.y; }
  asm volatile("" : "+v"(p1));
  A2_LWAIT(0); mfma4(o[3], f3, pa0, pa1, pa2, pa3);
#pragma unroll
  for (int r = 0; r < 16; ++r) p0[r] = __builtin_amdgcn_exp2f(p0[r]);
  asm volatile("" : "+v"(p0)); A2_SBAR();
}
template <int PASS>
__device__ __forceinline__ void body(const bf16r* Qb, const bf16r* Kh, const bf16r* Vh, int seq, char* lds, float lam, const float* subln, bf16r* Ob) {
  int tid_ = threadIdx.x; asm volatile("" : "+v"(tid_));
  const int tid = tid_, wid = tid >> 6, lane = tid & 63, r32 = lane & 31, hi = lane >> 5;
  char* V_lds = lds; char* K_lds = lds + 3 * SHM_V;
  float* ws = (float*)(lds + 3 * SHM_V + 3 * SHM_K) + wid * 64; float* li_l = ws; float* al_l = ws + 32;
  float m_reg = -1e30f, l_reg = 0; f32x16 o[4] = {}; bf16x8 qr[4];
  const bf16r* Qw = Qb + (long)(wid * QBLK + r32) * LD + hi * 8;
#pragma unroll
  for (int d0 = 0; d0 < 4; ++d0) qr[d0] = *reinterpret_cast<const bf16x8*>(Qw + d0 * 16);
  const int sr = tid >> 4, sc = (tid & 15) * 8, vst0 = v_st(sr, sc), vst1 = v_st(32 + sr, sc);
  const int kr = tid >> 3, kc = (tid & 7) * 8, kst = A2_KSWZ(kr, kc * 2);
  const int vb0 = (int)(uintptr_t)V_lds + v_rd_base(lane);
  struct { bf16x8 vs0, vs1, ks0; } sr_[2];
#define A2_SLOAD(i, k0) do { sr_[i].vs0 = *reinterpret_cast<const bf16x8*>(&Vh[(long)((k0) + sr) * LD + sc]); sr_[i].vs1 = *reinterpret_cast<const bf16x8*>(&Vh[(long)((k0) + 32 + sr) * LD + sc]); \
    sr_[i].ks0 = *reinterpret_cast<const bf16x8*>(&Kh[(long)((k0) + kr) * LD + kc]); } while (0)
#define A2_SWRITE(b, i) do { *(bf16x8*)(V_lds + (b) * SHM_V + vst0) = sr_[i].vs0; *(bf16x8*)(V_lds + (b) * SHM_V + vst1) = sr_[i].vs1; *(bf16x8*)(K_lds + (b) * SHM_K + kst) = sr_[i].ks0; } while (0)
#define A2_SWAIT() asm volatile("s_waitcnt vmcnt(3)" ::: "memory")
#define A2_RESC(a) do { if (__any((a) < 1.f)) { if (hi == 0) al_l[r32] = (a); asm volatile("s_waitcnt lgkmcnt(0)" ::: "memory"); \
    _Pragma("unroll") for (int d = 0; d < 4; ++d) _Pragma("unroll") for (int r = 0; r < 16; ++r) o[d][r] *= al_l[crow(r, hi)]; } } while (0)
  f32x16 pA0, pA1, pB0, pB1; float mnA, mnB, alA, alB; bf16x8 pa0, pa1, pa2, pa3; const int NT = seq / KVBLK;
  A2_SLOAD(0, 0); asm volatile("s_waitcnt vmcnt(0)" ::: "memory"); A2_SWRITE(0, 0);
  A2_SLOAD(1, KVBLK); A2_SLOAD(0, 2 * KVBLK);
  __syncthreads();
  qkt(pA0, pA1, K_lds, qr, r32, hi); partialSM(pA0, pA1, m_reg, mnA, alA);
  A2_SWAIT(); A2_SWRITE(1, 1); A2_SLOAD(1, 3 * KVBLK);
  int bp = 0, bc = 1, bn = 2;
#define A2_STEP(PC0, PC1, mnC_, alC_, PP0, PP1, alP_, j_, SL) do { \
    __syncthreads(); \
    if ((j_) + 1 < NT) { A2_SWAIT(); A2_SWRITE(bn, SL); } \
    A2_SBAR(); qkt(PC0, PC1, K_lds + bc * SHM_K, qr, r32, hi); \
    finishSM(PP0, PP1, alP_, l_reg, pa0, pa1, pa2, pa3); A2_SBAR(); \
    if ((j_) + 3 < NT) A2_SLOAD(SL, ((j_) + 3) * KVBLK); A2_SBAR(); \
    pv_psm(o, vb0 + bp * (int)SHM_V, pa0, pa1, pa2, pa3, PC0, PC1, m_reg, mnC_, alC_); \
    A2_RESC(alC_); \
    { const int t_ = bp; bp = bc; bc = bn; bn = t_; } } while (0)
  for (int j = 1; j + 1 < NT; j += 2) {
    A2_STEP(pB0, pB1, mnB, alB, pA0, pA1, alA, j, 0);
    A2_STEP(pA0, pA1, mnA, alA, pB0, pB1, alB, j + 1, 1);
  }
  A2_STEP(pB0, pB1, mnB, alB, pA0, pA1, alA, NT - 1, 0);
#undef A2_STEP
  finishSM(pB0, pB1, alB, l_reg, pa0, pa1, pa2, pa3); A2_SBAR();
  pv_d0(o, vb0 + bp * (int)SHM_V, pa0, pa1, pa2, pa3);
  if (hi == 0) li_l[r32] = l_reg; asm volatile("s_waitcnt lgkmcnt(0)" ::: "memory");
  float rli[16];
#pragma unroll
  for (int r = 0; r < 16; ++r) rli[r] = __builtin_amdgcn_rcpf(li_l[crow(r, hi)]);
  unsigned* sw = (unsigned*)(lds + PARK_OFF) + wid * 2048 + lane;
  if (PASS == 0) {
#pragma unroll
    for (int r = 0; r < 16; ++r)
#pragma unroll
      for (int dp = 0; dp < 2; ++dp) sw[(r * 2 + dp) * 64] = cvtpk(o[2 * dp][r] * rli[r], o[2 * dp + 1][r] * rli[r]);
  } else {
    float sg[4];
#pragma unroll
    for (int d0 = 0; d0 < 4; ++d0) sg[d0] = subln[d0 * 32 + r32];
    bf16r* Ow = Ob + (long)(wid * QBLK) * LD + r32;
#pragma unroll
    for (int r = 0; r < 16; ++r) {
      float d[4]; float ss = 0.f;
#pragma unroll
      for (int dp = 0; dp < 2; ++dp) { const unsigned w = sw[(r * 2 + dp) * 64];
        d[2 * dp] = __uint_as_float(w << 16) - lam * (o[2 * dp][r] * rli[r]); d[2 * dp + 1] = __uint_as_float(w & 0xffff0000u) - lam * (o[2 * dp + 1][r] * rli[r]); }
#pragma unroll
      for (int d0 = 0; d0 < 4; ++d0) ss += d[d0] * d[d0];
      ss += __shfl_xor(ss, 1); ss += __shfl_xor(ss, 2); ss += __shfl_xor(ss, 4); ss += __shfl_xor(ss, 8); ss += __shfl_xor(ss, 16);
      const float rstd = 0.8f / sqrtf(ss * (1.f / 128.f) + 1e-6f);
      const int orow = crow(r, hi);
#pragma unroll
      for (int d0 = 0; d0 < 4; ++d0) Ow[(long)orow * LD + d0 * 32] = (bf16r)(cvtpk(d[d0] * rstd * sg[d0], 0.f) & 0xffffu);
    }
  }
  __syncthreads();
#undef A2_SLOAD
#undef A2_SWRITE
#undef A2_SWAIT
#undef A2_RESC
}
#undef A2_KSWZ
#undef A2_LWAIT
#undef A2_SBAR
}
namespace pg8 {
typedef unsigned u32x2 __attribute__((ext_vector_type(2)));
__device__ __forceinline__ float fsigmoid(float x) { return __builtin_amdgcn_rcpf(1.0f + __builtin_amdgcn_exp2f(-1.4426950408889634f * x)); }
__device__ __forceinline__ float fsilu(float x) { return x * fsigmoid(x); }
__device__ __forceinline__ float bflo(unsigned w) { return __uint_as_float(w << 16); }
__device__ __forceinline__ float bfhi(unsigned w) { return __uint_as_float(w & 0xffff0000u); }

struct EpiSwiglu {
    static constexpr bool PERM = true, AFTER_DRAIN = false;
    bf16_t* O; int ldc;
    __device__ __forceinline__ void operator()(const f32x4 (&acc)[2][2][4][2], const Unit& u, int wr, int wc, int fr, int fq) const {
        const int row0 = u.pm * BM + wr * 64 + fr, col0 = u.pn * HALF + wc * 32 + 8 * fq;
#pragma unroll
        for (int ai = 0; ai < 2; ++ai)
#pragma unroll
            for (int m = 0; m < 4; ++m) {
                bf16_t* rowp = O + (size_t)(row0 + ai * HALF + m * 16) * ldc + col0;
                const f32x4 g0 = acc[ai][0][m][0], g1 = acc[ai][0][m][1], u0 = acc[ai][1][m][0], u1 = acc[ai][1][m][1];
                u32x4 w;
                w.x = cvt_pk_bf16(fsilu(g0[0]) * u0[0], fsilu(g0[1]) * u0[1]); w.y = cvt_pk_bf16(fsilu(g0[2]) * u0[2], fsilu(g0[3]) * u0[3]);
                w.z = cvt_pk_bf16(fsilu(g1[0]) * u1[0], fsilu(g1[1]) * u1[1]); w.w = cvt_pk_bf16(fsilu(g1[2]) * u1[2], fsilu(g1[3]) * u1[3]);
                *(u32x4*)rowp = w;
            }
    }
};

struct EpiWin {
    static constexpr bool PERM = true, AFTER_DRAIN = false;
    bf16_t *q, *k, *v, *u, *ga, *gb; const float* rope; float qscale;
    __device__ __forceinline__ void operator()(const f32x4 (&acc)[2][2][4][2], const Unit& un, int wr, int wc, int fr, int fq) const {
        const int pn = un.pn, rowt = un.pm * BM + wr * 64 + fr, bidx = un.pm >> 5;
        if (pn < 8) {
            const bool isq = pn < 4; const float sc = isq ? qscale : 1.f; bf16_t* base = isq ? q : k;
            const int colt = (pn & 3) * 256 + wc * 32 + 8 * fq, axis = wc & 1, f0 = 8 * (fq & 1);
            const float sgn = (fq < 2) ? -sc : sc;
#pragma unroll
            for (int ai = 0; ai < 2; ++ai)
#pragma unroll
                for (int m = 0; m < 4; ++m) {
                    const int r = rowt + ai * HALF + m * 16, t = r & 8191, pos = axis ? (t & 63) : (t >> 6);
                    const f32x4 cs0 = *(const f32x4*)(rope + pos * 16 + f0), cs1 = *(const f32x4*)(rope + pos * 16 + f0 + 4);
                    const f32x4 sn0 = *(const f32x4*)(rope + 2048 + pos * 16 + f0), sn1 = *(const f32x4*)(rope + 2048 + pos * 16 + f0 + 4);
                    const size_t orow = isq ? (size_t)r : (size_t)bidx * 8448 + 256 + t;
                    bf16_t* rowp = base + orow * 1024 + colt;
#pragma unroll
                    for (int bj = 0; bj < 2; ++bj) {
                        const f32x4 s0 = acc[ai][bj][m][0], s1 = acc[ai][bj][m][1]; f32x4 o0, o1;
#pragma unroll
                        for (int jj = 0; jj < 4; ++jj) { const float p0 = __shfl_xor(s0[jj], 32), p1 = __shfl_xor(s1[jj], 32);
                            o0[jj] = s0[jj] * (cs0[jj] * sc) + p0 * (sn0[jj] * sgn); o1[jj] = s1[jj] * (cs1[jj] * sc) + p1 * (sn1[jj] * sgn); }
                        u32x4 w; w.x = cvt_pk_bf16(o0[0], o0[1]); w.y = cvt_pk_bf16(o0[2], o0[3]); w.z = cvt_pk_bf16(o1[0], o1[1]); w.w = cvt_pk_bf16(o1[2], o1[3]);
                        *(u32x4*)(rowp + bj * HALF) = w;
                    }
                }
        } else if (pn < 12) {
            const int colt = (pn - 8) * 256 + wc * 32 + 8 * fq;
#pragma unroll
            for (int ai = 0; ai < 2; ++ai)
#pragma unroll
                for (int m = 0; m < 4; ++m) {
                    const int r = rowt + ai * HALF + m * 16, t = r & 8191;
                    bf16_t* rowp = v + ((size_t)bidx * 8448 + 256 + t) * 1024 + colt;
#pragma unroll
                    for (int bj = 0; bj < 2; ++bj) { const f32x4 v0 = acc[ai][bj][m][0], v1 = acc[ai][bj][m][1]; u32x4 w;
                        w.x = cvt_pk_bf16(v0[0], v0[1]); w.y = cvt_pk_bf16(v0[2], v0[3]); w.z = cvt_pk_bf16(v1[0], v1[1]); w.w = cvt_pk_bf16(v1[2], v1[3]); *(u32x4*)(rowp + bj * HALF) = w; }
                }
        } else if (pn < 20) {
            const int colt = (pn - 12) * HALF + wc * 32 + 8 * fq;
#pragma unroll
            for (int ai = 0; ai < 2; ++ai)
#pragma unroll
                for (int m = 0; m < 4; ++m) {
                    bf16_t* rowp = u + (size_t)(rowt + ai * HALF + m * 16) * 1024 + colt;
                    const f32x4 a0 = acc[ai][0][m][0], a1 = acc[ai][0][m][1], g0 = acc[ai][1][m][0], g1 = acc[ai][1][m][1]; u32x4 w;
                    w.x = cvt_pk_bf16(a0[0] * fsigmoid(g0[0]), a0[1] * fsigmoid(g0[1])); w.y = cvt_pk_bf16(a0[2] * fsigmoid(g0[2]), a0[3] * fsigmoid(g0[3]));
                    w.z = cvt_pk_bf16(a1[0] * fsigmoid(g1[0]), a1[1] * fsigmoid(g1[1])); w.w = cvt_pk_bf16(a1[2] * fsigmoid(g1[2]), a1[3] * fsigmoid(g1[3]));
                    *(u32x4*)rowp = w;
                }
        } else {
            bf16_t* base = pn < 24 ? ga : gb; const int colt = (pn & 3) * 256 + wc * 32 + 8 * fq;
#pragma unroll
            for (int ai = 0; ai < 2; ++ai)
#pragma unroll
                for (int m = 0; m < 4; ++m) {
                    bf16_t* rowp = base + (size_t)(rowt + ai * HALF + m * 16) * 1024 + colt;
#pragma unroll
                    for (int bj = 0; bj < 2; ++bj) { const f32x4 v0 = acc[ai][bj][m][0], v1 = acc[ai][bj][m][1]; u32x4 w;
                        w.x = cvt_pk_bf16(fsigmoid(v0[0]), fsigmoid(v0[1])); w.y = cvt_pk_bf16(fsigmoid(v0[2]), fsigmoid(v0[3]));
                        w.z = cvt_pk_bf16(fsigmoid(v1[0]), fsigmoid(v1[1])); w.w = cvt_pk_bf16(fsigmoid(v1[2]), fsigmoid(v1[3])); *(u32x4*)(rowp + bj * HALF) = w; }
                }
        }
    }
};

struct EpiKVc {
    static constexpr bool PERM = true, AFTER_DRAIN = false;
    bf16_t *k, *v;
    __device__ __forceinline__ void operator()(const f32x4 (&acc)[2][2][4][2], const Unit& un, int wr, int wc, int fr, int fq) const {
        bf16_t* base = un.pn < 4 ? k : v; const int colt = (un.pn & 3) * 256 + wc * 32 + 8 * fq;
#pragma unroll
        for (int ai = 0; ai < 2; ++ai)
#pragma unroll
            for (int m = 0; m < 4; ++m) {
                bf16_t* rowp = base + ((size_t)un.pm * 8448 + wr * 64 + fr + ai * HALF + m * 16) * 1024 + colt;
#pragma unroll
                for (int bj = 0; bj < 2; ++bj) { const f32x4 v0 = acc[ai][bj][m][0], v1 = acc[ai][bj][m][1]; u32x4 w;
                    w.x = cvt_pk_bf16(v0[0], v0[1]); w.y = cvt_pk_bf16(v0[2], v0[3]); w.z = cvt_pk_bf16(v1[0], v1[1]); w.w = cvt_pk_bf16(v1[2], v1[3]); *(u32x4*)(rowp + bj * HALF) = w; }
            }
    }
};

template <bool ADD> struct EpiGate {
    static constexpr bool PERM = true, AFTER_DRAIN = false;
    bf16_t* Z; const bf16_t* G;
    __device__ __forceinline__ void operator()(const f32x4 (&acc)[2][2][4][2], const Unit& un, int wr, int wc, int fr, int fq) const {
        const int row0 = un.pm * BM + wr * 64 + fr, col0 = un.pn * BM + wc * 32 + 8 * fq;
#pragma unroll
        for (int ai = 0; ai < 2; ++ai)
#pragma unroll
            for (int m = 0; m < 4; ++m) {
                const size_t off = (size_t)(row0 + ai * HALF + m * 16) * 1024 + col0;
#pragma unroll
                for (int bj = 0; bj < 2; ++bj) {
                    const u32x4 g = *(const u32x4*)(G + off + bj * HALF);
                    const f32x4 v0 = acc[ai][bj][m][0], v1 = acc[ai][bj][m][1];
                    float o[8];
                    o[0] = v0[0] * bflo(g.x); o[1] = v0[1] * bfhi(g.x); o[2] = v0[2] * bflo(g.y); o[3] = v0[3] * bfhi(g.y);
                    o[4] = v1[0] * bflo(g.z); o[5] = v1[1] * bfhi(g.z); o[6] = v1[2] * bflo(g.w); o[7] = v1[3] * bfhi(g.w);
                    if (ADD) { const u32x4 z = *(const u32x4*)(Z + off + bj * HALF);
                        o[0] += bflo(z.x); o[1] += bfhi(z.x); o[2] += bflo(z.y); o[3] += bfhi(z.y); o[4] += bflo(z.z); o[5] += bfhi(z.z); o[6] += bflo(z.w); o[7] += bfhi(z.w); }
                    u32x4 w; w.x = cvt_pk_bf16(o[0], o[1]); w.y = cvt_pk_bf16(o[2], o[3]); w.z = cvt_pk_bf16(o[4], o[5]); w.w = cvt_pk_bf16(o[6], o[7]);
                    *(u32x4*)(Z + off + bj * HALF) = w;
                }
            }
    }
};
}

constexpr int NWAVES = 8, NTHR = 512;
constexpr int DM = 1024, NB = 4, SEQ = 8192, NLAT = NB * SEQ, NCTX = 256, NCTXR = NB * NCTX, NROWS = NLAT + NCTXR, NKEYS = SEQ + NCTX;
constexpr int DFF = 2816, INW = 7168, NMOD = 9;
constexpr float EPS = 1e-6f;
constexpr size_t MiB = 1u << 20;
constexpr size_t WS_MOD = 1 * MiB, WS_ROPE = 1 * MiB + 256 * 1024, WS_LAM = 1 * MiB + 512 * 1024;
constexpr size_t WS_W13A = 2 * MiB, WS_W2A = 13 * MiB, WS_W13B = WS_W2A + 11 * MiB / 2, WS_W2B = WS_W13B + 11 * MiB, WS_WIN = 35 * MiB, WS_WAP = 49 * MiB, WS_WCP = 51 * MiB, WS_WOUT = 53 * MiB;
constexpr size_t WS_H = 56 * MiB, WS_Y = 122 * MiB, WS_BIG = 188 * MiB;
constexpr size_t WS_ACT = WS_BIG, WS_Q = WS_BIG, WS_K = WS_BIG + 64 * MiB, WS_V = WS_K + 66 * MiB, WS_U = WS_V + 66 * MiB, WS_GB = WS_U + 64 * MiB, WS_END = WS_GB + 64 * MiB;
constexpr size_t WS_GA = WS_Y, WS_UC = WS_H, WS_OSCR = WS_U, WS_Z = WS_U;
static_assert(WS_END == 512 * MiB, "ws map");
static_assert(WS_W2B + 11 * MiB / 2 <= WS_WIN, "ws map weights");
constexpr int LDS_BYTES = 147456;

#define LAS __attribute__((address_space(3)))
typedef unsigned short bf16;
typedef unsigned v4u __attribute__((ext_vector_type(4)));
typedef unsigned v2u __attribute__((ext_vector_type(2)));
typedef float f32x4 __attribute__((ext_vector_type(4)));
#define LDS_WAIT() asm volatile("s_waitcnt lgkmcnt(0)" ::: "memory")
__device__ __forceinline__ unsigned f2bf(float f) { unsigned u = __builtin_bit_cast(unsigned, f); return (u + 0x7fffu + ((u >> 16) & 1u)) >> 16; }
__device__ __forceinline__ unsigned pk2(float lo, float hi) { return f2bf(lo) | (f2bf(hi) << 16); }
__device__ __forceinline__ float wave_sum(float v) {
#pragma unroll
    for (int o = 1; o < 64; o <<= 1) v += __shfl_xor(v, o);
    return v;
}

struct Args { const float* in[21]; float* out; unsigned char* ws; int pad0, pad1; };
enum { I_X = 0, I_C, I_CTX, I_CCTX, I_WADA, I_BADA, I_NORMG, I_F1W13, I_F1W2, I_F2W13, I_F2W2, I_WIN, I_LAMQK, I_SUBLN, I_WAP, I_CONVW, I_CONVB, I_CLNG, I_CLNB, I_WCP, I_WOUT };

template <int MODE> __device__ __forceinline__ int drow(int n0) {
    if (MODE == 1) { const int bj = n0 / DFF, j = n0 % DFF; return 256 * (j / 128) + 128 * bj + (j % 128); }
    if (MODE == 2) { if (n0 >= 3072 && n0 < 5120) { const int c = n0 - 3072, bj = c / 1024, j = c % 1024; return 3072 + 256 * (j / 128) + 128 * bj + (j % 128); } return n0; }
    return n0;
}
template <int MODE> __device__ __forceinline__ void transpose_item(const float* W, int K, int N, bf16* WT, LAS float* scr, int item, int lane) {
    const int nblk = N / 32, kb = item / nblk, nb = item % nblk, k0 = 64 * kb, n0 = 32 * nb, d0 = drow<MODE>(n0);
    float tv[32];
#pragma unroll
    for (int i = 0; i < 32; ++i) tv[i] = W[(size_t)(k0 + 2 * i + (lane >> 5)) * N + n0 + (lane & 31)];
#pragma unroll
    for (int i = 0; i < 32; ++i) scr[(2 * i + (lane >> 5)) * 33 + (lane & 31)] = tv[i];
    LDS_WAIT(); asm volatile("" ::: "memory");
    const int c = lane & 7;
#pragma unroll
    for (int j = 0; j < 4; ++j) { const int n = (lane >> 3) + 8 * j; const LAS float* s = scr + (8 * c) * 33 + n;
        v4u o; o.x = pk2(s[0 * 33], s[1 * 33]); o.y = pk2(s[2 * 33], s[3 * 33]); o.z = pk2(s[4 * 33], s[5 * 33]); o.w = pk2(s[6 * 33], s[7 * 33]);
        *(v4u*)(WT + (size_t)(d0 + n) * K + k0 + 8 * c) = o; }
    LDS_WAIT(); asm volatile("" ::: "memory");
}

template <bool HAS_Y, bool WRITE_X, bool WRITE_H>
__device__ __forceinline__ void norm_rows(int gw, int NGW, int lane, int row_lo, int nrows, const float* xlat, const float* xctx, const bf16* Y, float* xout, bf16* hout, const float* mod,
                                          float mult, const float* g_post, int k_gate, const float* g_pre, int k_in) {
    for (int row0 = row_lo + gw; row0 < nrows; row0 += 2 * NGW) {
        int rows[2]; rows[0] = row0; rows[1] = (row0 + NGW < nrows) ? row0 + NGW : row0;
        f32x4 v[2][4]; v2u yw[2][4]; const float* mp[2]; bool isctx[2];
#pragma unroll
        for (int r = 0; r < 2; ++r) {
            const int row = rows[r]; isctx[r] = row >= NLAT; const int mv = isctx[r] ? 4 : (row >> 13);
            const float* xr = isctx[r] ? xctx + (size_t)(row - NLAT) * DM : xlat + (size_t)row * DM;
            mp[r] = mod + (size_t)mv * (NMOD * DM);
#pragma unroll
            for (int j = 0; j < 4; ++j) v[r][j] = ((const f32x4*)xr)[lane + 64 * j];
            if (HAS_Y) {
#pragma unroll
                for (int j = 0; j < 4; ++j) yw[r][j] = ((const v2u*)(Y + (size_t)row * DM))[lane + 64 * j];
            }
        }
        if (HAS_Y) {
            f32x4 y[2][4]; float ss[2];
#pragma unroll
            for (int r = 0; r < 2; ++r) { ss[r] = 0.f;
#pragma unroll
                for (int j = 0; j < 4; ++j) { const v2u w = yw[r][j]; y[r][j] = (f32x4){pg8::bflo(w.x), pg8::bfhi(w.x), pg8::bflo(w.y), pg8::bfhi(w.y)};
                    ss[r] += (y[r][j].x * y[r][j].x + y[r][j].y * y[r][j].y) + (y[r][j].z * y[r][j].z + y[r][j].w * y[r][j].w); } }
#pragma unroll
            for (int o = 1; o < 64; o <<= 1) { ss[0] += __shfl_xor(ss[0], o); ss[1] += __shfl_xor(ss[1], o); }
#pragma unroll
            for (int r = 0; r < 2; ++r) { const float rstd = 1.0f / sqrtf(ss[r] * (1.f / DM) + EPS);
#pragma unroll
                for (int j = 0; j < 4; ++j) { const f32x4 gp = ((const f32x4*)g_post)[lane + 64 * j], gt = ((const f32x4*)(mp[r] + k_gate * DM))[lane + 64 * j];
                    v[r][j] = v[r][j] + (mult * gt) * ((y[r][j] * rstd) * gp); }
                if (WRITE_X && !isctx[r]) {
#pragma unroll
                    for (int j = 0; j < 4; ++j) ((f32x4*)(xout + (size_t)rows[r] * DM))[lane + 64 * j] = v[r][j];
                } }
        }
        if (WRITE_H) {
            float ss[2];
#pragma unroll
            for (int r = 0; r < 2; ++r) { ss[r] = 0.f;
#pragma unroll
                for (int j = 0; j < 4; ++j) ss[r] += (v[r][j].x * v[r][j].x + v[r][j].y * v[r][j].y) + (v[r][j].z * v[r][j].z + v[r][j].w * v[r][j].w); }
#pragma unroll
            for (int o = 1; o < 64; o <<= 1) { ss[0] += __shfl_xor(ss[0], o); ss[1] += __shfl_xor(ss[1], o); }
#pragma unroll
            for (int r = 0; r < 2; ++r) { const float rstd = 1.0f / sqrtf(ss[r] * (1.f / DM) + EPS);
#pragma unroll
                for (int j = 0; j < 4; ++j) { const f32x4 gp = ((const f32x4*)g_pre)[lane + 64 * j], sh = ((const f32x4*)(mp[r] + k_in * DM))[lane + 64 * j], sc = ((const f32x4*)(mp[r] + (k_in + 1) * DM))[lane + 64 * j];
                    const f32x4 h = ((v[r][j] * rstd) * gp) * (1.0f + sc) + sh;
                    v2u w; w.x = pk2(h.x, h.y); w.y = pk2(h.z, h.w); ((v2u*)(hout + (size_t)rows[r] * DM))[lane + 64 * j] = w; } }
        }
    }
}

#define RLX_AGENT __ATOMIC_RELAXED, __HIP_MEMORY_SCOPE_AGENT
#define XB_TMO      128
#define XB_XCNT(j)  (256  + 64 * (j))
#define XB_XSUB(j)  (1280 + 64 * (j))
#define XB_XGEN(j)  (2304 + 64 * (j))
#define XB_TOP      3328
#define XB_TOPGEN   3392
#define XCD_BAR_WORDS 3456
#define XB_SPIN_CAP (1u << 22)

__device__ __forceinline__ unsigned xb_ld(unsigned* p)              { return __hip_atomic_load(p, __ATOMIC_RELAXED, __HIP_MEMORY_SCOPE_AGENT); }
__device__ __forceinline__ unsigned xb_add(unsigned* p, unsigned v) { return __hip_atomic_fetch_add(p, v, __ATOMIC_RELAXED, __HIP_MEMORY_SCOPE_AGENT); }
__device__ __forceinline__ unsigned xb_xcc_id() { return (unsigned)__builtin_amdgcn_s_getreg((3 << 11) | 20) & 0xFu; }
#define XB_SPIN(cond, bar) do { unsigned _sp = 0; while (cond) { __builtin_amdgcn_s_sleep(1); \
    if ((++_sp & 255u) == 0u) { if (xb_ld(&(bar)[XB_TMO])) break; if (_sp > XB_SPIN_CAP) { atomicAdd(&(bar)[XB_TMO], 1u); break; } } } } while (0)

struct XcdBarrier {
    unsigned* bar; unsigned x;
    volatile LAS unsigned* st;
};

__device__ __forceinline__ XcdBarrier xcd_barrier_post(unsigned* bar, volatile LAS unsigned* st) {
    XcdBarrier b; b.bar = bar; b.x = xb_xcc_id(); b.st = st;
    if (threadIdx.x == 0) (void)xb_add(&bar[XB_XCNT(b.x)], 1u);
    return b;
}
__device__ __forceinline__ void xcd_barrier_complete(unsigned* bar, unsigned x, unsigned& nloc, unsigned& nx) {
    const unsigned G = gridDim.x * gridDim.y * gridDim.z;
    unsigned sum, cnt, mine, sp = 0u;
    for (;;) {
        sum = 0u; cnt = 0u; mine = 0u;
#pragma unroll
        for (unsigned j = 0; j < 16; ++j) { const unsigned c = xb_ld(&bar[XB_XCNT(j)]); sum += c; cnt += (c > 0u) ? 1u : 0u; mine = (j == x) ? c : mine; }
        if (sum == G) break;
        __builtin_amdgcn_s_sleep(1);
        if ((++sp & 255u) == 0u) { if (xb_ld(&bar[XB_TMO])) break; if (sp > XB_SPIN_CAP) { atomicAdd(&bar[XB_TMO], 1u); break; } }
    }
    nloc = mine > 0u ? mine : 1u; nx = cnt > 0u ? cnt : 1u;
}

__device__ __forceinline__ void xcd_barrier(const XcdBarrier& b) {
    asm volatile("s_waitcnt vmcnt(0)" ::: "memory");
    __syncthreads();
    if (threadIdx.x == 0) {
        unsigned* bar = b.bar;
        __builtin_amdgcn_s_waitcnt(0);
        unsigned nloc = b.st[0], nx = b.st[1];
        if (nloc == 0u) { xcd_barrier_complete(bar, b.x, nloc, nx); b.st[0] = nloc; b.st[1] = nx; }
        const unsigned old = xb_add(&bar[XB_XSUB(b.x)], 1u);
        const unsigned gen = old / nloc;
        if (old + 1u == (gen + 1u) * nloc) {
            __builtin_amdgcn_fence(__ATOMIC_RELEASE, "agent");
            asm volatile("s_waitcnt vmcnt(0)" ::: "memory");
            const unsigned og = xb_add(&bar[XB_TOP], 1u);
            const unsigned tg = og / nx;
            if (og + 1u == (tg + 1u) * nx) xb_add(&bar[XB_TOPGEN], 1u);
            else XB_SPIN(xb_ld(&bar[XB_TOPGEN]) == tg, bar);
            __builtin_amdgcn_fence(__ATOMIC_ACQUIRE, "agent");
            xb_add(&bar[XB_XGEN(b.x)], 1u);
            asm volatile("s_waitcnt vmcnt(0)" ::: "memory");
        } else {
            XB_SPIN(xb_ld(&bar[XB_XGEN(b.x)]) == gen, bar);
            __builtin_amdgcn_fence(__ATOMIC_ACQUIRE, "agent");
            asm volatile("s_waitcnt vmcnt(0)" ::: "memory");
        }
    }
    __syncthreads();
}

__global__ void __launch_bounds__(NTHR, 2) fwd_mega(Args args) {
    extern __shared__ __attribute__((aligned(16))) unsigned char lds[];
    cg::grid_group grid = cg::this_grid();
#define GSYNC_CG() do { asm volatile("s_waitcnt vmcnt(0) lgkmcnt(0)" ::: "memory"); grid.sync(); __builtin_amdgcn_fence(__ATOMIC_ACQUIRE, "agent"); asm volatile("s_waitcnt vmcnt(0)" ::: "memory"); } while (0)
#define GSYNC() xcd_barrier(xbar)
    LAS unsigned char* L = (LAS unsigned char*)lds;
    const int tid = threadIdx.x, lane = tid & 63, wave = __builtin_amdgcn_readfirstlane(tid >> 6);
    const int G = gridDim.x, bx = blockIdx.x, vcu = (G % 8 == 0) ? (bx % 8) * (G / 8) + bx / 8 : bx;
    const int gw = vcu * NWAVES + wave, NGW = G * NWAVES;
    unsigned char* ws = args.ws;
    volatile LAS unsigned* xst = (volatile LAS unsigned*)(L + LDS_BYTES - 64);
    static_assert(attn2::PARK_OFF + attn2::PARK_BYTES <= LDS_BYTES - 64, "LDS map");
    if (tid < 2) xst[tid] = 0u;
    __syncthreads();
    XcdBarrier xbar = xcd_barrier_post((unsigned*)ws, xst);
    float* mod = (float*)(ws + WS_MOD); float* rope = (float*)(ws + WS_ROPE); float* lamp = (float*)(ws + WS_LAM);
    bf16 *W13A = (bf16*)(ws + WS_W13A), *W2A = (bf16*)(ws + WS_W2A), *W13B = (bf16*)(ws + WS_W13B), *W2B = (bf16*)(ws + WS_W2B), *WIN = (bf16*)(ws + WS_WIN), *WAP = (bf16*)(ws + WS_WAP), *WCP = (bf16*)(ws + WS_WCP), *WOUT = (bf16*)(ws + WS_WOUT);
    bf16 *H = (bf16*)(ws + WS_H), *Y = (bf16*)(ws + WS_Y), *ACT = (bf16*)(ws + WS_ACT), *Qb = (bf16*)(ws + WS_Q), *Kb = (bf16*)(ws + WS_K), *Vb = (bf16*)(ws + WS_V), *Ub = (bf16*)(ws + WS_U), *GA = (bf16*)(ws + WS_GA), *GB = (bf16*)(ws + WS_GB);
    bf16 *UC = (bf16*)(ws + WS_UC), *OSCR = (bf16*)(ws + WS_OSCR), *Zb = (bf16*)(ws + WS_Z);
    const float* x = args.in[I_X]; const float* ctx = args.in[I_CTX]; const float* normg = args.in[I_NORMG]; float* out = args.out;

    {
        LAS float* sc = (LAS float*)L;
        LAS float* red = (LAS float*)(L + 20480);
        if (bx < 144) {
            for (int i = tid; i < 5 * DM; i += NTHR) { const float c = i < 4 * DM ? args.in[I_C][i] : args.in[I_CCTX][i - 4 * DM]; sc[i] = c / (1.0f + expf(-c)); }
            __syncthreads();
            for (int it = bx; it < 144; it += G) {
                const int col = it * 64 + lane; const float* wp = args.in[I_WADA] + (size_t)(wave * 128) * (NMOD * DM) + col;
                float a0 = 0.f, a1 = 0.f, a2 = 0.f, a3 = 0.f, a4 = 0.f;
#pragma unroll 32
                for (int kk = 0; kk < 128; ++kk) { const float w = wp[(size_t)kk * (NMOD * DM)]; const int k = wave * 128 + kk;
                    a0 += sc[k] * w; a1 += sc[DM + k] * w; a2 += sc[2 * DM + k] * w; a3 += sc[3 * DM + k] * w; a4 += sc[4 * DM + k] * w; }
                red[(wave * 5 + 0) * 64 + lane] = a0; red[(wave * 5 + 1) * 64 + lane] = a1; red[(wave * 5 + 2) * 64 + lane] = a2; red[(wave * 5 + 3) * 64 + lane] = a3; red[(wave * 5 + 4) * 64 + lane] = a4;
                __syncthreads();
                if (tid < 320) { const int v = tid >> 6, cl = tid & 63; float s = 0.f;
#pragma unroll
                    for (int w8 = 0; w8 < 8; ++w8) s += red[(w8 * 5 + v) * 64 + cl];
                    mod[(size_t)v * (NMOD * DM) + it * 64 + cl] = s + args.in[I_BADA][it * 64 + cl]; }
                __syncthreads();
            }
        }
        if (bx == G - 1) {
            for (int i = tid; i < 2048; i += NTHR) { const int pos = i >> 4, f = i & 15; double inv = 1.0; for (int j = 0; j < f; ++j) inv *= 0.56234132519034908; const double ang = (double)pos * inv; rope[i] = (float)cos(ang); rope[2048 + i] = (float)sin(ang); }
        }
        if (bx == G - 2 && tid < 64) {
            const float* lq = args.in[I_LAMQK];
            const float s01 = wave_sum(lq[tid] * lq[64 + tid]), s23 = wave_sum(lq[128 + tid] * lq[192 + tid]);
            if (tid == 0) lamp[0] = expf(s01) - expf(s23) + 0.2f;
        }
        __syncthreads();
        LAS float* scr = (LAS float*)(L + wave * 16384);
        constexpr int I_13 = (DM / 64) * (2 * DFF / 32), I_2 = (DFF / 64) * (DM / 32);
        for (int it = gw; it < I_13 + I_2; it += NGW) {
            if (it < I_13) transpose_item<1>(args.in[I_F1W13], DM, 2 * DFF, W13A, scr, it, lane);
            else transpose_item<0>(args.in[I_F1W2], DFF, DM, W2A, scr, it - I_13, lane);
        }
    }
    if (args.pad0 != 0) GSYNC_CG();
    GSYNC();
    norm_rows<false, false, true>(gw, NGW, lane, 0, NROWS, x, ctx, nullptr, nullptr, H, mod, 0.f, nullptr, 0, normg + 0 * DM, 0);
    GSYNC();
    { pg8::Gemm g{H, W13A, NROWS, 2 * DFF, DM}; pg8::StaticOrder S; S.init(NROWS, 2 * DFF, G, bx); pg8::EpiSwiglu E{ACT, DFF};
      pg8::gemm_phase<pg8::EpiSwiglu, pg8::StaticOrder, PG8_ALIGN, PG8_SP2>(L, g, S, E); }
    {
        constexpr int NU = (NROWS / 256) * (2 * DFF / 256), NFULL = NU / 256, NREM = NU - NFULL * 256;
        static_assert(NREM > 0 && NREM < 256, "partial round");
        if (G == 256 ? bx >= NREM : true) {
            const int nhelp = (G == 256) ? (256 - NREM) : G, hid = (G == 256) ? bx - NREM : bx;
            LAS float* scr = (LAS float*)(L + wave * 16384);
            constexpr int I_13 = (DM / 64) * (2 * DFF / 32), I_2 = (DFF / 64) * (DM / 32), I_IN = (DM / 64) * (INW / 32), I_SQ = (DM / 64) * (DM / 32);
            constexpr int NITEMS = I_13 + I_2 + I_IN + 3 * I_SQ;
            for (int it = hid * NWAVES + wave; it < NITEMS; it += nhelp * NWAVES) {
                int r = it;
                if (r < I_IN) { transpose_item<2>(args.in[I_WIN], DM, INW, WIN, scr, r, lane); continue; } r -= I_IN;
                if (r < I_SQ) { transpose_item<0>(args.in[I_WAP], DM, DM, WAP, scr, r, lane); continue; } r -= I_SQ;
                if (r < I_SQ) { transpose_item<0>(args.in[I_WCP], DM, DM, WCP, scr, r, lane); continue; } r -= I_SQ;
                if (r < I_SQ) { transpose_item<0>(args.in[I_WOUT], DM, DM, WOUT, scr, r, lane); continue; } r -= I_SQ;
                if (r < I_13) { transpose_item<1>(args.in[I_F2W13], DM, 2 * DFF, W13B, scr, r, lane); continue; } r -= I_13;
                transpose_item<0>(args.in[I_F2W2], DFF, DM, W2B, scr, r, lane);
            }
        }
    }
    GSYNC();
    { pg8::Gemm g{ACT, W2A, NLAT, DM, DFF}; pg8::StaticOrder S; S.init(NLAT, DM, G, bx); pg8::EpiBf16<0> E{Y, DM, nullptr, 0, 0, 1.f};
      pg8::gemm_phase<pg8::EpiBf16<0>, pg8::StaticOrder, PG8_ALIGN, PG8_SP2>(L, g, S, E); }
    GSYNC();
    if (G == 256) {
        if (bx < 16) { pg8::Gemm g{ACT + (size_t)NLAT * DFF, W2A, NCTXR, DM, DFF}; pg8::StaticOrder S; S.init(NCTXR, DM, G, bx); pg8::EpiBf16<0> E{Y + (size_t)NLAT * DM, DM, nullptr, 0, 0, 1.f};
            pg8::gemm_phase<pg8::EpiBf16<0>, pg8::StaticOrder, PG8_ALIGN, PG8_SP2>(L, g, S, E); }
        else norm_rows<true, true, true>((bx - 16) * NWAVES + wave, (G - 16) * NWAVES, lane, 0, NLAT, x, ctx, Y, out, H, mod, 0.5f, normg + 1 * DM, 2, normg + 2 * DM, 3);
    } else {
        { pg8::Gemm g{ACT + (size_t)NLAT * DFF, W2A, NCTXR, DM, DFF}; pg8::StaticOrder S; S.init(NCTXR, DM, G, bx); pg8::EpiBf16<0> E{Y + (size_t)NLAT * DM, DM, nullptr, 0, 0, 1.f};
          pg8::gemm_phase<pg8::EpiBf16<0>, pg8::StaticOrder, PG8_ALIGN, PG8_SP2>(L, g, S, E); }
        norm_rows<true, true, true>(gw, NGW, lane, 0, NLAT, x, ctx, Y, out, H, mod, 0.5f, normg + 1 * DM, 2, normg + 2 * DM, 3);
    }
    GSYNC();
    norm_rows<true, true, true>(gw, NGW, lane, NLAT, NROWS, x, ctx, Y, out, H, mod, 0.5f, normg + 1 * DM, 2, normg + 2 * DM, 3);
    GSYNC();
    { pg8::Gemm g{H, WIN, NLAT, INW, DM}; pg8::StaticOrder S; S.init(NLAT, INW, G, bx);
      pg8::EpiWin E{Qb, Kb, Vb, Ub, GA, GB, rope, 1.0f};

      pg8::gemm_phase<pg8::EpiWin, pg8::StaticOrder, PG8_ALIGN, PG8_SP2>(L, g, S, E);
    }
    { pg8::Gemm g{H + (size_t)NLAT * DM, WIN + (size_t)1024 * DM, NCTXR, 2048, DM}; pg8::StaticOrder S; S.init(NCTXR, 2048, G, bx); pg8::EpiKVc E{Kb, Vb};
      pg8::gemm_phase<pg8::EpiKVc, pg8::StaticOrder, PG8_ALIGN, PG8_SP2>(L, g, S, E); }
    GSYNC();
    {
        const int c0 = 2 * tid;
        float w0[31], w1[31];
#pragma unroll
        for (int k = 0; k < 31; ++k) { const float2 w = *(const float2*)(args.in[I_CONVW] + k * DM + c0); w0[k] = w.x; w1[k] = w.y; }
        const float2 cb = *(const float2*)(args.in[I_CONVB] + c0), lg = *(const float2*)(args.in[I_CLNG] + c0), lb = *(const float2*)(args.in[I_CLNB] + c0);
        LAS float* red = (LAS float*)L;
        LAS float* stat = (LAS float*)(L + 2048);
        for (int item = vcu; item < NLAT / 16; item += G) {
            const int tg = item * 16, b = tg >> 13, t0 = tg & 8191;
            float a0[16], a1[16];
#pragma unroll
            for (int o = 0; o < 16; ++o) { a0[o] = 0.f; a1[o] = 0.f; }
#pragma unroll
            for (int i = 0; i < 46; ++i) {
                const int t = t0 - 15 + i; const bool valid = (t >= 0) && (t < SEQ); const int tt = valid ? t : t0;
                const unsigned wv = *(const unsigned*)(Ub + ((size_t)(b * SEQ + tt)) * DM + c0);
                const float x0 = valid ? pg8::bflo(wv) : 0.f, x1 = valid ? pg8::bfhi(wv) : 0.f;
#pragma unroll
                for (int o = 0; o < 16; ++o) { if (i - o >= 0 && i - o <= 30) { a0[o] += w0[i - o] * x0; a1[o] += w1[i - o] * x1; } }
            }
#pragma unroll
            for (int o = 0; o < 16; ++o) { a0[o] += cb.x; a1[o] += cb.y; const float s = wave_sum(a0[o] + a1[o]), ss = wave_sum(a0[o] * a0[o] + a1[o] * a1[o]);
                if (lane == 0) { red[wave * 32 + 2 * o] = s; red[wave * 32 + 2 * o + 1] = ss; } }
            __syncthreads();
            if (tid < 32) { float s = 0.f;
#pragma unroll
                for (int w8 = 0; w8 < 8; ++w8) s += red[w8 * 32 + tid];
                stat[tid] = s; }
            __syncthreads();
#pragma unroll
            for (int o = 0; o < 16; ++o) { const float mean = stat[2 * o] * (1.f / DM), var = stat[2 * o + 1] * (1.f / DM) - mean * mean, rstd = 1.0f / sqrtf(fmaxf(var, 0.f) + EPS);
                const float y0 = (a0[o] - mean) * rstd * lg.x + lb.x, y1 = (a1[o] - mean) * rstd * lg.y + lb.y;
                *(unsigned*)(UC + ((size_t)(tg + o)) * DM + c0) = pk2(pg8::fsilu(y0), pg8::fsilu(y1)); }
        }
    }
    __syncthreads();
    {
        const float lam = lamp[0];
#pragma unroll 1
        for (int un = vcu; un < NB * 8 * (SEQ / 256); un += G) {
            const int qb = un & 31, bh = (un >> 8) * 8 + ((un & 255) >> 5), b = bh >> 3, h = bh & 7;
            const size_t qrow0 = (size_t)b * SEQ + (size_t)qb * 256;
            const bf16* kbase = Kb + (size_t)b * NKEYS * DM; const bf16* vbase = Vb + (size_t)b * NKEYS * DM + h * 128;
            attn2::body<0>(Qb + qrow0 * DM + (2 * h) * 64, kbase + (2 * h) * 64, vbase, NKEYS, (char*)lds, lam, args.in[I_SUBLN], nullptr);
            attn2::body<1>(Qb + qrow0 * DM + (2 * h + 1) * 64, kbase + (2 * h + 1) * 64, vbase, NKEYS, (char*)lds, lam, args.in[I_SUBLN], Qb + qrow0 * DM + h * 128);
        }
    }
    GSYNC();
    { pg8::Gemm g{Qb, WAP, NLAT, DM, DM}; pg8::StaticOrder S; S.init(NLAT, DM, G, bx); pg8::EpiGate<false> E{Zb, GA};
      pg8::gemm_phase<pg8::EpiGate<false>, pg8::StaticOrder, PG8_ALIGN, PG8_SP2>(L, g, S, E); }
    asm volatile("s_waitcnt vmcnt(0)" ::: "memory");
    { pg8::Gemm g{UC, WCP, NLAT, DM, DM}; pg8::StaticOrder S; S.init(NLAT, DM, G, bx); pg8::EpiGate<true> E{Zb, GB};
      pg8::gemm_phase<pg8::EpiGate<true>, pg8::StaticOrder, PG8_ALIGN, PG8_SP2>(L, g, S, E); }
    GSYNC();
    { pg8::Gemm g{Zb, WOUT, NLAT, DM, DM}; pg8::StaticOrder S; S.init(NLAT, DM, G, bx); pg8::EpiBf16<0> E{Y, DM, nullptr, 0, 0, 1.f};
      pg8::gemm_phase<pg8::EpiBf16<0>, pg8::StaticOrder, PG8_ALIGN, PG8_SP2>(L, g, S, E);
    }
    GSYNC();
    norm_rows<true, true, true>(gw, NGW, lane, 0, NLAT, out, ctx, Y, out, H, mod, 1.0f, normg + 3 * DM, 5, normg + 4 * DM, 6);
    GSYNC();
    { pg8::Gemm g{H, W13B, NLAT, 2 * DFF, DM}; pg8::StaticOrder S; S.init(NLAT, 2 * DFF, G, bx); pg8::EpiSwiglu E{ACT, DFF};
      pg8::gemm_phase<pg8::EpiSwiglu, pg8::StaticOrder, PG8_ALIGN, PG8_SP2>(L, g, S, E);
    }
    GSYNC();
    { pg8::Gemm g{ACT, W2B, NLAT, DM, DFF}; pg8::StaticOrder S; S.init(NLAT, DM, G, bx); pg8::EpiBf16<0> E{Y, DM, nullptr, 0, 0, 1.f};
      pg8::gemm_phase<pg8::EpiBf16<0>, pg8::StaticOrder, PG8_ALIGN, PG8_SP2>(L, g, S, E);
    }
    GSYNC();
    norm_rows<true, true, false>(gw, NGW, lane, 0, NLAT, out, ctx, Y, out, nullptr, mod, 0.5f, normg + 5 * DM, 8, nullptr, 0);
}

extern "C" void kernel_launch(void* const* d_in, const int* in_sizes, int n_in, void* d_out, int out_size, void* d_ws, size_t ws_size, hipStream_t stream) {
    static int grid = 0;
    if (grid == 0) {
        if (n_in != 21 || ws_size < WS_END || out_size != NLAT * DM) { fprintf(stderr, "kernel_launch: unexpected shapes (n_in %d, out %d, ws %zu)\n", n_in, out_size, ws_size); grid = -1; return; }
        int dev = 0, cus = 0, per_cu = 0;
        if (hipGetDevice(&dev) != hipSuccess || hipDeviceGetAttribute(&cus, hipDeviceAttributeMultiprocessorCount, dev) != hipSuccess) { grid = -1; return; }
        if (hipFuncSetAttribute((const void*)fwd_mega, hipFuncAttributeMaxDynamicSharedMemorySize, LDS_BYTES) != hipSuccess) { fprintf(stderr, "kernel_launch: hipFuncSetAttribute failed\n"); grid = -1; return; }
        if (hipOccupancyMaxActiveBlocksPerMultiprocessor(&per_cu, (const void*)fwd_mega, NTHR, LDS_BYTES) != hipSuccess || per_cu < 1) fprintf(stderr, "kernel_launch: occupancy query says %d\n", per_cu);
        (void)hipGetLastError();
        grid = cus;
    }
    if (grid < 0) return;
    if (hipMemsetAsync(d_ws, 0, 16384, stream) != hipSuccess) { fprintf(stderr, "kernel_launch: memset of the barrier words failed\n"); return; }
    Args a{};
    for (int i = 0; i < 21; ++i) a.in[i] = (const float*)d_in[i];
    a.out = (float*)d_out; a.ws = (unsigned char*)d_ws;
    void* kargs[] = {&a};
    const hipError_t e = hipLaunchCooperativeKernel((const void*)fwd_mega, dim3(grid), dim3(NTHR), kargs, LDS_BYTES, stream);
    if (e != hipSuccess) fprintf(stderr, "cooperative launch failed: %s (grid %d)\n", hipGetErrorString(e), grid);
}
```

```cpp
#include <hip/hip_runtime.h>
#include <hip/hip_cooperative_groups.h>
#include <cstdio>
#include <cstdint>
namespace cg = cooperative_groups;
namespace pg8 {
#define PG8_LAS __attribute__((address_space(3)))
typedef unsigned short bf16_t;
typedef short bf16x8 __attribute__((ext_vector_type(8)));
typedef float f32x4 __attribute__((ext_vector_type(4)));
typedef unsigned u32x4 __attribute__((ext_vector_type(4)));
constexpr int BM = 256, BK = 64, HALF = 128, HTB = HALF * BK * 2  , STAGE_BYTES = 8 * HTB, NXCD = 8, WGM = 8;

__host__ __device__ __forceinline__ int lds_byte(int r, int c) { const int st = (r >> 4) * 2 + (c >> 5), rr = r & 15, cc = c & 31, ob = rr * 64 + cc * 2; return st * 1024 + (ob ^ (((ob >> 9) & 1) << 5)); }
__host__ __device__ __forceinline__ void stage_rc(int b, int& R, int& C) { const int st = b / 1024, sb = b % 1024, swz = sb ^ (((sb >> 9) & 1) << 5); R = (st >> 1) * 16 + swz / 64; C = (st & 1) * 32 + (swz % 64) / 2; }
__host__ __device__ __forceinline__ int perm32(int rho) { const int n = rho >> 4, i = rho & 15; return 8 * (i >> 2) + 4 * n + (i & 3); }

struct Unit { int pm, pn; };
struct Gemm { const bf16_t* A; const bf16_t* Bt; int M, N, K; };

struct StaticOrder {
    int nM, nN, nwg, G, c;
    __host__ __device__ void init(int M, int N, int G_, int c_) { nM = M / BM; nN = N / BM; nwg = nM * nN; G = G_; c = c_; }
    __host__ __device__ bool next(int i, Unit& u) const {
        const long L = (long)i * G + c; if (L >= nwg) return false;
        int wgid = (int)L; { const int q = nwg / NXCD, r = nwg % NXCD, xcd = wgid % NXCD, off = wgid / NXCD; wgid = (xcd < r ? xcd * (q + 1) : r * (q + 1) + (xcd - r) * q) + off; }
        const int nig = WGM * nN, gid = wgid / nig, fm = gid * WGM, gsz = (nM - fm) < WGM ? (nM - fm) : WGM;
        u.pm = fm + ((wgid % nig) % gsz); u.pn = (wgid % nig) / gsz; return true;
    }
    __device__ __forceinline__ void a_ready(const Unit&) const {}
    __device__ __forceinline__ void done(const Unit&) const {}
};

typedef float f32x2c_t __attribute__((ext_vector_type(2))); typedef __bf16 bf16x2c_t __attribute__((ext_vector_type(2)));
__device__ __forceinline__ unsigned cvt_pk_bf16(float lo, float hi) { f32x2c_t v = {lo, hi}; bf16x2c_t b = __builtin_convertvector(v, bf16x2c_t); return __builtin_bit_cast(unsigned, b); }
typedef float f32x2 __attribute__((ext_vector_type(2)));
__device__ __forceinline__ f32x2 gelu_pk(f32x2 v) {
    const f32x2 av = __builtin_elementwise_abs(v), d = av * 0.2316418882f + 1.0f;
    f32x2 t; t.x = __builtin_amdgcn_rcpf(d.x); t.y = __builtin_amdgcn_rcpf(d.y);
    f32x2 q = t * 0.5307027145f + (-0.7265760135f); q = q * t + 0.7107068705f; q = q * t + (-0.142248368f); q = q * t + 0.127414796f; q = q * t;
    const f32x2 s = (v * v) * (-0.72134752044f);
    f32x2 e; e.x = __builtin_amdgcn_exp2f(s.x); e.y = __builtin_amdgcn_exp2f(s.y);
    const f32x2 m = v * (q * e), r = v - m;
    f32x2 o; o.x = v.x < 0.f ? m.x : r.x; o.y = v.y < 0.f ? m.y : r.y; return o;
}

template <int ACT  > struct EpiBf16 {
    static constexpr bool PERM = true, AFTER_DRAIN = false; static_assert(ACT == 0 || ACT == 1, "EpiBf16: ACT is 0 (none) or 1 (gelu_pk)");
    bf16_t* O; int ldc; const float* bias; int split_cols; size_t split_stride; float scale0;
    __device__ __forceinline__ void operator()(const f32x4 (&acc)[2][2][4][2], const Unit& u, int wr, int wc, int fr, int fq) const {
        const int row0 = u.pm * BM + wr * 64 + fr; int colt = u.pn * BM; bf16_t* base = O;
        float sc = 1.f; if (split_cols) { const int t = colt / split_cols; base += (size_t)t * split_stride; colt -= t * split_cols; if (t == 0) sc = scale0; }
        const int col0 = colt + wc * 32 + 8 * fq, bcol0 = u.pn * BM + wc * 32 + 8 * fq;
        f32x4 bv[2][2];
#pragma unroll
        for (int bj = 0; bj < 2; ++bj)
#pragma unroll
            for (int n = 0; n < 2; ++n) bv[bj][n] = bias ? *(const f32x4*)(bias + bcol0 + bj * HALF + 4 * n) : (f32x4){0.f, 0.f, 0.f, 0.f};
#pragma unroll
        for (int ai = 0; ai < 2; ++ai)
#pragma unroll
            for (int m = 0; m < 4; ++m) { bf16_t* rowp = base + (size_t)(row0 + ai * HALF + m * 16) * ldc + col0;
#pragma unroll
                for (int bj = 0; bj < 2; ++bj) { f32x4 v0 = acc[ai][bj][m][0] + bv[bj][0], v1 = acc[ai][bj][m][1] + bv[bj][1];
                    if (ACT == 1) { f32x2 a = gelu_pk((f32x2){v0[0], v0[1]}), b = gelu_pk((f32x2){v0[2], v0[3]}), c = gelu_pk((f32x2){v1[0], v1[1]}), d = gelu_pk((f32x2){v1[2], v1[3]});
                        v0 = (f32x4){a.x, a.y, b.x, b.y}; v1 = (f32x4){c.x, c.y, d.x, d.y}; }
                    v0 = v0 * sc; v1 = v1 * sc; u32x4 w; w.x = cvt_pk_bf16(v0[0], v0[1]); w.y = cvt_pk_bf16(v0[2], v0[3]); w.z = cvt_pk_bf16(v1[0], v1[1]); w.w = cvt_pk_bf16(v1[2], v1[3]);
                    *(u32x4*)(rowp + bj * HALF) = w; } }
    }
};
template <class Epi, class Sched, bool ALIGN_EPI = false, bool SP2 = false>
__device__ __forceinline__ void gemm_phase(PG8_LAS unsigned char* lds, const Gemm g, const Sched& S, const Epi& E) {
    int tid_ = threadIdx.x; asm volatile("" : "+v"(tid_));
    const int tid = tid_, wid = __builtin_amdgcn_readfirstlane(tid >> 6), lane = tid & 63, wr = wid >> 2, wc = wid & 3, fr = lane & 15, fq = lane >> 4;
    const int K = g.K, nt = K / BK;
    unsigned voffA[2], voffB[2];
#pragma unroll
    for (int i = 0; i < 2; ++i) { int R, C; stage_rc(tid * 16 + i * 8192, R, C); const int Rb = Epi::PERM ? ((R & ~31) + perm32(R & 31)) : R;
        voffA[i] = (unsigned)(R * K + C) * 2u; voffB[i] = (unsigned)(Rb * K + C) * 2u; }
    const size_t kstep = (size_t)(BK * 2);
    const size_t hstep = (size_t)HALF * K * 2;
    const size_t tstep = 2 * hstep;
    const unsigned ldsw = (unsigned)wid * 1024u;
    const int aoff = lds_byte(wr * 64 + fr, fq * 8), boff = lds_byte(wc * 32 + fr, fq * 8);
#define PG8_SA(b, h) (((b) * 2 + (h)) * HTB)
#define PG8_SB(b, h) ((4 + (b) * 2 + (h)) * HTB)
#define PG8_STAGE(bufoff, gbase, voff) do { _Pragma("unroll") for (int _i = 0; _i < 2; ++_i) \
        __builtin_amdgcn_global_load_lds((const unsigned*)((const char*)(gbase) + (voff)[_i]), (PG8_LAS unsigned*)(lds + (bufoff) + ldsw + _i * 8192), 16, 0, 0); } while (0)
#define PG8_LDA(dst, b, h) do { _Pragma("unroll") for (int m = 0; m < 4; ++m) _Pragma("unroll") for (int k = 0; k < 2; ++k) dst[m][k] = *(const PG8_LAS bf16x8*)(lds + PG8_SA(b, h) + aoff + m * 2048 + k * 1024); } while (0)
#define PG8_LDB(dst, b, h) do { _Pragma("unroll") for (int n = 0; n < 2; ++n) _Pragma("unroll") for (int k = 0; k < 2; ++k) dst[n][k] = *(const PG8_LAS bf16x8*)(lds + PG8_SB(b, h) + boff + n * 2048 + k * 1024); } while (0)
#define PG8_MMA(ai, bj, At, Bt) do { __builtin_amdgcn_s_setprio(1); _Pragma("unroll") for (int m = 0; m < 4; ++m) _Pragma("unroll") for (int n = 0; n < 2; ++n) _Pragma("unroll") for (int k = 0; k < 2; ++k) \
        acc[ai][bj][m][n] = __builtin_amdgcn_mfma_f32_16x16x32_bf16(Bt[n][k], At[m][k], acc[ai][bj][m][n], 0, 0, 0); __builtin_amdgcn_s_setprio(0); } while (0)
#define PG8_WAIT_V(n) asm volatile("s_waitcnt vmcnt(" #n ")" ::: "memory")
#define PG8_WAIT_L(n) asm volatile("s_waitcnt lgkmcnt(" #n ")" ::: "memory")
#define PG8_BAR __builtin_amdgcn_s_barrier()
#define PG8_SCHED __builtin_amdgcn_sched_barrier(0)
    Unit cur, nxt; int ui = 0;
    if (!S.next(0, cur)) return;
    f32x4 acc[2][2][4][2];
#pragma unroll
    for (int a = 0; a < 2; ++a)
#pragma unroll
        for (int b = 0; b < 2; ++b)
#pragma unroll
            for (int m = 0; m < 4; ++m)
#pragma unroll
                for (int n = 0; n < 2; ++n) acc[a][b][m][n] = (f32x4){0.f, 0.f, 0.f, 0.f};
    bf16x8 At[4][2], B0[2][2], B1[2][2];
    const char* cA = (const char*)g.A + (size_t)cur.pm * tstep; const char* cB = (const char*)g.Bt + (size_t)cur.pn * tstep;
    S.a_ready(cur);
    if constexpr (SP2) {
        PG8_STAGE(PG8_SB(0, 0), cB, voffB); PG8_STAGE(PG8_SB(0, 1), cB + hstep, voffB); PG8_STAGE(PG8_SA(0, 0), cA, voffA); PG8_STAGE(PG8_SA(0, 1), cA + hstep, voffA);
        if (wr == 1) PG8_BAR;
        PG8_WAIT_V(2); PG8_BAR;
        PG8_STAGE(PG8_SB(1, 0), cB + kstep, voffB); PG8_STAGE(PG8_SA(1, 0), cA + kstep, voffA); PG8_STAGE(PG8_SB(1, 1), cB + hstep + kstep, voffB);
        PG8_WAIT_V(6); PG8_BAR;
    } else {
        PG8_STAGE(PG8_SB(0, 0), cB, voffB); PG8_STAGE(PG8_SA(0, 0), cA, voffA); PG8_STAGE(PG8_SB(0, 1), cB + hstep, voffB); PG8_STAGE(PG8_SA(0, 1), cA + hstep, voffA);
        if (wr == 1) PG8_BAR;
        PG8_WAIT_V(4); PG8_BAR;
        PG8_STAGE(PG8_SB(1, 0), cB + kstep, voffB); PG8_STAGE(PG8_SA(1, 0), cA + kstep, voffA); PG8_STAGE(PG8_SB(1, 1), cB + hstep + kstep, voffB);
        PG8_WAIT_V(6); PG8_BAR;
    }
    for (;;) {
        const bool has_next = S.next(ui + 1, nxt);
        const char* nA = has_next ? (const char*)g.A + (size_t)nxt.pm * tstep : cA; const char* nB = has_next ? (const char*)g.Bt + (size_t)nxt.pn * tstep : cB;
        for (int t = 0; t < nt; t += 2) {
            const bool last = (t == nt - 2);
            const char* a1 = cA + (size_t)(t + 1) * kstep;
            const char* a2 = last ? nA : cA + (size_t)(t + 2) * kstep; const char* b2 = last ? nB : cB + (size_t)(t + 2) * kstep;
            const char* a3 = a2 + kstep; const char* b3 = b2 + kstep;
            if (last && has_next) S.a_ready(nxt);
            if constexpr (SP2) {
            PG8_LDB(B0, 0, 0); PG8_LDB(B1, 0, 1); PG8_SCHED; PG8_LDA(At, 0, 0); PG8_STAGE(PG8_SA(1, 1), a1 + hstep, voffA);
            PG8_WAIT_V(8); PG8_WAIT_L(0); PG8_BAR; PG8_MMA(0, 0, At, B0); PG8_MMA(0, 1, At, B1); PG8_BAR; PG8_SCHED;
            PG8_LDA(At, 0, 1); PG8_STAGE(PG8_SB(0, 0), b2, voffB); PG8_STAGE(PG8_SB(0, 1), b2 + hstep, voffB); PG8_STAGE(PG8_SA(0, 0), a2, voffA);
            PG8_WAIT_V(8); PG8_WAIT_L(0); PG8_BAR; PG8_MMA(1, 0, At, B0); PG8_MMA(1, 1, At, B1); PG8_BAR; PG8_SCHED;
            PG8_LDB(B0, 1, 0); PG8_LDB(B1, 1, 1); PG8_SCHED; PG8_LDA(At, 1, 0); PG8_STAGE(PG8_SA(0, 1), a2 + hstep, voffA);
            PG8_WAIT_V(8); PG8_WAIT_L(0); PG8_BAR; PG8_MMA(0, 0, At, B0); PG8_MMA(0, 1, At, B1); PG8_BAR; PG8_SCHED;
            PG8_LDA(At, 1, 1); PG8_STAGE(PG8_SB(1, 0), b3, voffB); PG8_STAGE(PG8_SB(1, 1), b3 + hstep, voffB); PG8_STAGE(PG8_SA(1, 0), a3, voffA);
            PG8_WAIT_V(8); PG8_WAIT_L(0); PG8_BAR; PG8_MMA(1, 0, At, B0); PG8_MMA(1, 1, At, B1); PG8_BAR; PG8_SCHED;
            } else {
            PG8_LDB(B0, 0, 0); PG8_SCHED; PG8_LDA(At, 0, 0); PG8_STAGE(PG8_SA(1, 1), a1 + hstep, voffA);
            PG8_WAIT_L(8); PG8_BAR; PG8_WAIT_L(0); PG8_MMA(0, 0, At, B0); PG8_BAR; PG8_SCHED;
            PG8_LDB(B1, 0, 1); PG8_STAGE(PG8_SB(0, 0), b2, voffB);
            PG8_BAR; PG8_WAIT_L(0); PG8_MMA(0, 1, At, B1); PG8_BAR;
            PG8_LDA(At, 0, 1); PG8_STAGE(PG8_SA(0, 0), a2, voffA);
            PG8_BAR; PG8_WAIT_L(0); PG8_MMA(1, 0, At, B0); PG8_BAR; PG8_SCHED;
            PG8_STAGE(PG8_SB(0, 1), b2 + hstep, voffB);
            PG8_WAIT_V(6); PG8_BAR; PG8_MMA(1, 1, At, B1); PG8_BAR;
            PG8_LDB(B0, 1, 0); PG8_SCHED; PG8_LDA(At, 1, 0); PG8_STAGE(PG8_SA(0, 1), a2 + hstep, voffA);
            PG8_WAIT_L(8); PG8_BAR; PG8_WAIT_L(0); PG8_MMA(0, 0, At, B0); PG8_BAR; PG8_SCHED;
            PG8_LDB(B1, 1, 1); PG8_STAGE(PG8_SB(1, 0), b3, voffB);
            PG8_BAR; PG8_WAIT_L(0); PG8_MMA(0, 1, At, B1); PG8_BAR;
            PG8_LDA(At, 1, 1); PG8_STAGE(PG8_SA(1, 0), a3, voffA);
            PG8_BAR; PG8_WAIT_L(0); PG8_MMA(1, 0, At, B0); PG8_BAR; PG8_SCHED;
            PG8_STAGE(PG8_SB(1, 1), b3 + hstep, voffB);
            PG8_WAIT_V(6); PG8_BAR; PG8_MMA(1, 1, At, B1); PG8_BAR;
            }
        }
        if constexpr (ALIGN_EPI) { if (wr == 0) PG8_BAR; }
        if constexpr (!Epi::AFTER_DRAIN) { E(acc, cur, wr, wc, fr, fq); S.done(cur); }
        if (!has_next) break;
#pragma unroll
        for (int a = 0; a < 2; ++a)
#pragma unroll
            for (int b = 0; b < 2; ++b)
#pragma unroll
                for (int m = 0; m < 4; ++m)
#pragma unroll
                    for (int n = 0; n < 2; ++n) acc[a][b][m][n] = (f32x4){0.f, 0.f, 0.f, 0.f};
        cur = nxt; cA = nA; cB = nB; ++ui;
        if constexpr (ALIGN_EPI) { if (wr == 1) PG8_BAR; }
    }
    PG8_WAIT_V(0);
    if constexpr (!ALIGN_EPI) { if (wr == 0) PG8_BAR; }
    PG8_BAR;
    if constexpr (Epi::AFTER_DRAIN) { E.fused(acc, cur, wr, wc, fr, fq, lds, wid, lane); S.done(cur); }
#undef PG8_SA
#undef PG8_SB
#undef PG8_STAGE
#undef PG8_LDA
#undef PG8_LDB
#undef PG8_MMA
#undef PG8_WAIT_V
#undef PG8_WAIT_L
#undef PG8_BAR
#undef PG8_SCHED
}
}

#ifndef PG8_SP2
#define PG8_SP2 true
#endif
#ifndef PG8_ALIGN
#define PG8_ALIGN true
#endif
#include <hip/hip_bf16.h>
#include <cmath>
namespace attn2 {
using bf16x8 = __attribute__((ext_vector_type(8))) short;
using s16x4  = __attribute__((ext_vector_type(4))) short;
using f32x16 = __attribute__((ext_vector_type(16))) float;
using u32x4  = __attribute__((ext_vector_type(4))) unsigned;
typedef unsigned short bf16r;
constexpr int DQ = 64, DV = 128, NW = 8, QBLK = 32, KVBLK = 64, LD = 1024;
constexpr float SCALE = 0.125f, THR = 8.f;
constexpr size_t SHM_V = KVBLK * DV * 2, SHM_K = KVBLK * DQ * 2, SHM_ATTN = 3 * SHM_V + 3 * SHM_K + NW * 64 * 4;
constexpr size_t PARK_OFF = SHM_ATTN, PARK_BYTES = NW * 2048 * 4;
#define A2_KSWZ(row, colB) ((row) * 128 + ((colB) ^ ((((row) >> 1) & 7) << 4)))
#define A2_SBAR() __builtin_amdgcn_sched_barrier(0)
__device__ __forceinline__ int crow(int r, int hi) { return (r & 3) + 8 * (r >> 2) + 4 * hi; }
typedef float f32x2_t __attribute__((ext_vector_type(2))); typedef __bf16 bf16x2_t __attribute__((ext_vector_type(2)));
__device__ __forceinline__ unsigned cvtpk(float lo, float hi) { f32x2_t v = {lo, hi}; bf16x2_t b = __builtin_convertvector(v, bf16x2_t); return __builtin_bit_cast(unsigned, b); }

__device__ __forceinline__ void partialSM(f32x16& p0, f32x16& p1, float& m_reg, float& mn, float& alpha) {
  constexpr float C = SCALE * 1.4426950408889634f;
  float pmax = p0[0];
#pragma unroll
  for (int r = 1; r < 16; ++r) pmax = fmaxf(pmax, p0[r]);
#pragma unroll
  for (int r = 0; r < 16; ++r) pmax = fmaxf(pmax, p1[r]);
  { auto rr = __builtin_amdgcn_permlane32_swap(__float_as_uint(pmax), __float_as_uint(pmax), false, false);
    pmax = fmaxf(__uint_as_float(rr[0]), __uint_as_float(rr[1])); }
  if (__builtin_expect(__all(pmax - m_reg <= THR / SCALE), 1)) { mn = m_reg; alpha = 1.f; }
  else { mn = fmaxf(m_reg, pmax); alpha = __builtin_amdgcn_exp2f((m_reg - mn) * C); m_reg = mn; }
  const float mnC = -mn * C;
  { const f32x2_t cv = {C, C}, mv = {mnC, mnC};
#pragma unroll
    for (int i = 0; i < 8; ++i) { f32x2_t t = {p0[2 * i], p0[2 * i + 1]}; t = t * cv + mv; p0[2 * i] = t.x; p0[2 * i + 1] = t.y; }
#pragma unroll
    for (int i = 0; i < 8; ++i) { f32x2_t t = {p1[2 * i], p1[2 * i + 1]}; t = t * cv + mv; p1[2 * i] = t.x; p1[2 * i + 1] = t.y; } }
#pragma unroll
  for (int r = 0; r < 16; ++r) p0[r] = __builtin_amdgcn_exp2f(p0[r]);
}
__device__ __forceinline__ void finishSM(f32x16& p0, f32x16& p1, float alpha, float& l_reg, bf16x8& pa0, bf16x8& pa1, bf16x8& pa2, bf16x8& pa3) {
#pragma unroll
  for (int r = 0; r < 16; ++r) p1[r] = __builtin_amdgcn_exp2f(p1[r]);
  f32x2_t sv = {p0[0], p0[1]};
#pragma unroll
  for (int i = 1; i < 8; ++i) sv += (f32x2_t){p0[2 * i], p0[2 * i + 1]};
#pragma unroll
  for (int i = 0; i < 8; ++i) sv += (f32x2_t){p1[2 * i], p1[2 * i + 1]};
  float ps = sv.x + sv.y;
  { auto rr = __builtin_amdgcn_permlane32_swap(__float_as_uint(ps), __float_as_uint(ps), false, false);
    ps = __uint_as_float(rr[0]) + __uint_as_float(rr[1]); }
  l_reg = l_reg * alpha + ps;
#define A2_PK4(P, BASE, OUT) do { unsigned a0 = cvtpk(P[BASE + 0], P[BASE + 1]), a1 = cvtpk(P[BASE + 2], P[BASE + 3]);   \
    unsigned b0 = cvtpk(P[BASE + 4], P[BASE + 5]), b1 = cvtpk(P[BASE + 6], P[BASE + 7]);                              \
    auto r0 = __builtin_amdgcn_permlane32_swap(a0, b0, false, false); auto r1 = __builtin_amdgcn_permlane32_swap(a1, b1, false, false); \
    u32x4 w = {r0[0], r1[0], r0[1], r1[1]}; OUT = *reinterpret_cast<bf16x8*>(&w); } while (0)
  A2_PK4(p0, 0, pa0); A2_PK4(p0, 8, pa1); A2_PK4(p1, 0, pa2); A2_PK4(p1, 8, pa3);
#undef A2_PK4
}
__device__ __forceinline__ void qkt(f32x16& p0, f32x16& p1, const char* Ks, const bf16x8* qr, int r32, int hi) {
  p0 = f32x16{}; p1 = f32x16{};
#pragma unroll
  for (int d0 = 0; d0 < 4; ++d0) { const int cb = (d0 * 16 + hi * 8) * 2;
    const bf16x8 b0 = *reinterpret_cast<const bf16x8*>(Ks + A2_KSWZ(r32, cb));
    const bf16x8 b1 = *reinterpret_cast<const bf16x8*>(Ks + A2_KSWZ(32 + r32, cb));
    p0 = __builtin_amdgcn_mfma_f32_32x32x16_bf16(b0, qr[d0], p0, 0, 0, 0);
    p1 = __builtin_amdgcn_mfma_f32_32x32x16_bf16(b1, qr[d0], p1, 0, 0, 0); }
}
__device__ __forceinline__ int v_st(int k, int c) { const int kk = (k & ~0xC) | ((k & 4) << 1) | ((k & 8) >> 1); return ((kk >> 3) * 4 + (c >> 5)) * 512 + ((kk & 7) * 32 + (c & 31)) * 2; }
__device__ __forceinline__ int v_rd_base(int lane) { return ((lane & 3) << 3) | (((lane >> 2) & 3) << 6) | (((lane >> 4) & 1) << 5) | (((lane >> 5) & 1) << 8); }
constexpr int v_rd_off(int d0, int ks, int half) { return d0 * 512 + ks * 4096 + half * 2048; }
template <int OFF> __device__ __forceinline__ s16x4 tr_read(int vb) {
  s16x4 r; asm volatile("ds_read_b64_tr_b16 %0, %1 offset:%2" : "=&v"(r) : "v"(vb), "i"(OFF) : "memory"); return r;
}
template <int D0> __device__ __forceinline__ void pv_one(f32x16& od, int vb, bf16x8 pa0, bf16x8 pa1, bf16x8 pa2, bf16x8 pa3) {
  const s16x4 l0 = tr_read<v_rd_off(D0, 0, 0)>(vb), h0 = tr_read<v_rd_off(D0, 0, 1)>(vb), l1 = tr_read<v_rd_off(D0, 1, 0)>(vb), h1 = tr_read<v_rd_off(D0, 1, 1)>(vb);
  const s16x4 l2 = tr_read<v_rd_off(D0, 2, 0)>(vb), h2 = tr_read<v_rd_off(D0, 2, 1)>(vb), l3 = tr_read<v_rd_off(D0, 3, 0)>(vb), h3 = tr_read<v_rd_off(D0, 3, 1)>(vb);
  asm volatile("s_waitcnt lgkmcnt(0)" ::: "memory"); A2_SBAR();
#define A2_PK(L, H) (bf16x8){L[0], L[1], L[2], L[3], H[0], H[1], H[2], H[3]}
  od = __builtin_amdgcn_mfma_f32_32x32x16_bf16(pa0, A2_PK(l0, h0), od, 0, 0, 0);
  od = __builtin_amdgcn_mfma_f32_32x32x16_bf16(pa1, A2_PK(l1, h1), od, 0, 0, 0);
  od = __builtin_amdgcn_mfma_f32_32x32x16_bf16(pa2, A2_PK(l2, h2), od, 0, 0, 0);
  od = __builtin_amdgcn_mfma_f32_32x32x16_bf16(pa3, A2_PK(l3, h3), od, 0, 0, 0);
#undef A2_PK
}
__device__ __forceinline__ void pv_d0(f32x16* o, int vb, bf16x8 pa0, bf16x8 pa1, bf16x8 pa2, bf16x8 pa3) {
  pv_one<0>(o[0], vb, pa0, pa1, pa2, pa3); pv_one<1>(o[1], vb, pa0, pa1, pa2, pa3); pv_one<2>(o[2], vb, pa0, pa1, pa2, pa3); pv_one<3>(o[3], vb, pa0, pa1, pa2, pa3);
}

struct VF { s16x4 l0, h0, l1, h1, l2, h2, l3, h3; };
template <int D0> __device__ __forceinline__ VF vread(int vb) { VF f;
  f.l0 = tr_read<v_rd_off(D0, 0, 0)>(vb); f.h0 = tr_read<v_rd_off(D0, 0, 1)>(vb); f.l1 = tr_read<v_rd_off(D0, 1, 0)>(vb); f.h1 = tr_read<v_rd_off(D0, 1, 1)>(vb);
  f.l2 = tr_read<v_rd_off(D0, 2, 0)>(vb); f.h2 = tr_read<v_rd_off(D0, 2, 1)>(vb); f.l3 = tr_read<v_rd_off(D0, 3, 0)>(vb); f.h3 = tr_read<v_rd_off(D0, 3, 1)>(vb); return f; }
__device__ __forceinline__ void mfma4(f32x16& od, const VF& f, bf16x8 pa0, bf16x8 pa1, bf16x8 pa2, bf16x8 pa3) {
#define A2_PK(L, H) (bf16x8){L[0], L[1], L[2], L[3], H[0], H[1], H[2], H[3]}
  od = __builtin_amdgcn_mfma_f32_32x32x16_bf16(pa0, A2_PK(f.l0, f.h0), od, 0, 0, 0);
  od = __builtin_amdgcn_mfma_f32_32x32x16_bf16(pa1, A2_PK(f.l1, f.h1), od, 0, 0, 0);
  od = __builtin_amdgcn_mfma_f32_32x32x16_bf16(pa2, A2_PK(f.l2, f.h2), od, 0, 0, 0);
  od = __builtin_amdgcn_mfma_f32_32x32x16_bf16(pa3, A2_PK(f.l3, f.h3), od, 0, 0, 0);
#undef A2_PK
}
#define A2_LWAIT(n) do { asm volatile("s_waitcnt lgkmcnt(" #n ")" ::: "memory"); A2_SBAR(); } while (0)
__device__ __forceinline__ void pv_psm(f32x16* o, int vb, bf16x8 pa0, bf16x8 pa1, bf16x8 pa2, bf16x8 pa3, f32x16& p0, f32x16& p1, float& m_reg, float& mn, float& alpha) {
  constexpr float C = SCALE * 1.4426950408889634f;
  const VF f0 = vread<0>(vb);
  const VF f1 = vread<1>(vb); A2_LWAIT(8); mfma4(o[0], f0, pa0, pa1, pa2, pa3);
  float pmax = p0[0];
#pragma unroll
  for (int r = 1; r < 16; ++r) pmax = fmaxf(pmax, p0[r]);
#pragma unroll
  for (int r = 0; r < 16; ++r) pmax = fmaxf(pmax, p1[r]);
  { auto rr = __builtin_amdgcn_permlane32_swap(__float_as_uint(pmax), __float_as_uint(pmax), false, false);
    pmax = fmaxf(__uint_as_float(rr[0]), __uint_as_float(rr[1])); }
  asm volatile("" : "+v"(pmax));
  const VF f2 = vread<2>(vb); A2_LWAIT(8); mfma4(o[1], f1, pa0, pa1, pa2, pa3);
  if (__builtin_expect(__all(pmax - m_reg <= THR / SCALE), 1)) { mn = m_reg; alpha = 1.f; }
  else { mn = fmaxf(m_reg, pmax); alpha = __builtin_amdgcn_exp2f((m_reg - mn) * C); m_reg = mn; }
  const float mnC = -mn * C; const f32x2_t cv = {C, C}, mv = {mnC, mnC};
#pragma unroll
  for (int i = 0; i < 8; ++i) { f32x2_t t = {p0[2 * i], p0[2 * i + 1]}; t = t * cv + mv; p0[2 * i] = t.x; p0[2 * i + 1] = t.y; }
  asm volatile("" : "+v"(p0));
  const VF f3 = vread<3>(vb); A2_LWAIT(8); mfma4(o[2], f2, pa0, pa1, pa2, pa3);
#pragma unroll
  for (int i = 0; i < 8; ++i) { f32x2_t t = {p1[2 * i], p1[2 * i + 1]}; t = t * cv + mv; p1[2 * i] = t.x; p1[2 * i + 1] = t.y; }
  asm volatile("" : "+v"(p1));
  A2_LWAIT(0); mfma4(o[3], f3, pa0, pa1, pa2, pa3);
#pragma unroll
  for (int r = 0; r < 16; ++r) p0[r] = __builtin_amdgcn_exp2f(p0[r]);
  asm volatile("" : "+v"(p0)); A2_SBAR();
}
template <int PASS>
__device__ __forceinline__ void body(const bf16r* Qb, const bf16r* Kh, const bf16r* Vh, int seq, char* lds, float lam, const float* subln, bf16r* Ob) {
  int tid_ = threadIdx.x; asm volatile("" : "+v"(tid_));
  const int tid = tid_, wid = tid >> 6, lane = tid & 63, r32 = lane & 31, hi = lane >> 5;
  char* V_lds = lds; char* K_lds = lds + 3 * SHM_V;
  float* ws = (float*)(lds + 3 * SHM_V + 3 * SHM_K) + wid * 64; float* li_l = ws; float* al_l = ws + 32;
  float m_reg = -1e30f, l_reg = 0; f32x16 o[4] = {}; bf16x8 qr[4];
  const bf16r* Qw = Qb + (long)(wid * QBLK + r32) * LD + hi * 8;
#pragma unroll
  for (int d0 = 0; d0 < 4; ++d0) qr[d0] = *reinterpret_cast<const bf16x8*>(Qw + d0 * 16);
  const int sr = tid >> 4, sc = (tid & 15) * 8, vst0 = v_st(sr, sc), vst1 = v_st(32 + sr, sc);
  const int kr = tid >> 3, kc = (tid & 7) * 8, kst = A2_KSWZ(kr, kc * 2);
  const int vb0 = (int)(uintptr_t)V_lds + v_rd_base(lane);
  struct { bf16x8 vs0, vs1, ks0; } sr_[2];
#define A2_SLOAD(i, k0) do { sr_[i].vs0 = *reinterpret_cast<const bf16x8*>(&Vh[(long)((k0) + sr) * LD + sc]); sr_[i].vs1 = *reinterpret_cast<const bf16x8*>(&Vh[(long)((k0) + 32 + sr) * LD + sc]); \
    sr_[i].ks0 = *reinterpret_cast<const bf16x8*>(&Kh[(long)((k0) + kr) * LD + kc]); } while (0)
#define A2_SWRITE(b, i) do { *(bf16x8*)(V_lds + (b) * SHM_V + vst0) = sr_[i].vs0; *(bf16x8*)(V_lds + (b) * SHM_V + vst1) = sr_[i].vs1; *(bf16x8*)(K_lds + (b) * SHM_K + kst) = sr_[i].ks0; } while (0)
#define A2_SWAIT() asm volatile("s_waitcnt vmcnt(3)" ::: "memory")
#define A2_RESC(a) do { if (__any((a) < 1.f)) { if (hi == 0) al_l[r32] = (a); asm volatile("s_waitcnt lgkmcnt(0)" ::: "memory"); \
    _Pragma("unroll") for (int d = 0; d < 4; ++d) _Pragma("unroll") for (int r = 0; r < 16; ++r) o[d][r] *= al_l[crow(r, hi)]; } } while (0)
  if (wid >= 4) __builtin_amdgcn_s_setprio(1);
  f32x16 pA0, pA1, pB0, pB1; float mnA, mnB, alA, alB; bf16x8 pa0, pa1, pa2, pa3; const int NT = seq / KVBLK;
  A2_SLOAD(0, 0); asm volatile("s_waitcnt vmcnt(0)" ::: "memory"); A2_SWRITE(0, 0);
  A2_SLOAD(1, KVBLK); A2_SLOAD(0, 2 * KVBLK);
  __syncthreads();
  qkt(pA0, pA1, K_lds, qr, r32, hi); partialSM(pA0, pA1, m_reg, mnA, alA);
  A2_SWAIT(); A2_SWRITE(1, 1); A2_SLOAD(1, 3 * KVBLK);
  int bp = 0, bc = 1, bn = 2;
#define A2_STEP(PC0, PC1, mnC_, alC_, PP0, PP1, alP_, j_, SL) do { \
    __syncthreads(); \
    if ((j_) + 1 < NT) { A2_SWAIT(); A2_SWRITE(bn, SL); } \
    A2_SBAR(); qkt(PC0, PC1, K_lds + bc * SHM_K, qr, r32, hi); \
    finishSM(PP0, PP1, alP_, l_reg, pa0, pa1, pa2, pa3); A2_SBAR(); \
    if ((j_) + 3 < NT) A2_SLOAD(SL, ((j_) + 3) * KVBLK); A2_SBAR(); \
    pv_psm(o, vb0 + bp * (int)SHM_V, pa0, pa1, pa2, pa3, PC0, PC1, m_reg, mnC_, alC_); \
    A2_RESC(alC_); \
    { const int t_ = bp; bp = bc; bc = bn; bn = t_; } } while (0)
  for (int j = 1; j + 1 < NT; j += 2) {
    A2_STEP(pB0, pB1, mnB, alB, pA0, pA1, alA, j, 0);
    A2_STEP(pA0, pA1, mnA, alA, pB0, pB1, alB, j + 1, 1);
  }
  A2_STEP(pB0, pB1, mnB, alB, pA0, pA1, alA, NT - 1, 0);
#undef A2_STEP
  finishSM(pB0, pB1, alB, l_reg, pa0, pa1, pa2, pa3); A2_SBAR();
  pv_d0(o, vb0 + bp * (int)SHM_V, pa0, pa1, pa2, pa3);
  __builtin_amdgcn_s_setprio(0);
  if (hi == 0) li_l[r32] = l_reg; asm volatile("s_waitcnt lgkmcnt(0)" ::: "memory");
  float rli[16];
#pragma unroll
  for (int r = 0; r < 16; ++r) rli[r] = __builtin_amdgcn_rcpf(li_l[crow(r, hi)]);
  unsigned* sw = (unsigned*)(lds + PARK_OFF) + wid * 2048 + lane;
  if (PASS == 0) {
#pragma unroll
    for (int r = 0; r < 16; ++r)
#pragma unroll
      for (int dp = 0; dp < 2; ++dp) sw[(r * 2 + dp) * 64] = cvtpk(o[2 * dp][r] * rli[r], o[2 * dp + 1][r] * rli[r]);
  } else {
    float sg[4];
#pragma unroll
    for (int d0 = 0; d0 < 4; ++d0) sg[d0] = subln[d0 * 32 + r32];
    bf16r* Ow = Ob + (long)(wid * QBLK) * LD + r32;
#pragma unroll
    for (int r = 0; r < 16; ++r) {
      float d[4]; float ss = 0.f;
#pragma unroll
      for (int dp = 0; dp < 2; ++dp) { const unsigned w = sw[(r * 2 + dp) * 64];
        d[2 * dp] = __uint_as_float(w << 16) - lam * (o[2 * dp][r] * rli[r]); d[2 * dp + 1] = __uint_as_float(w & 0xffff0000u) - lam * (o[2 * dp + 1][r] * rli[r]); }
#pragma unroll
      for (int d0 = 0; d0 < 4; ++d0) ss += d[d0] * d[d0];
      ss += __shfl_xor(ss, 1); ss += __shfl_xor(ss, 2); ss += __shfl_xor(ss, 4); ss += __shfl_xor(ss, 8); ss += __shfl_xor(ss, 16);
      const float rstd = 0.8f / sqrtf(ss * (1.f / 128.f) + 1e-6f);
      const int orow = crow(r, hi);
#pragma unroll
      for (int d0 = 0; d0 < 4; ++d0) Ow[(long)orow * LD + d0 * 32] = (bf16r)(cvtpk(d[d0] * rstd * sg[d0], 0.f) & 0xffffu);
    }
  }
  __syncthreads();
#undef A2_SLOAD
#undef A2_SWRITE
#undef A2_SWAIT
#undef A2_RESC
}
#undef A2_KSWZ
#undef A2_LWAIT
#undef A2_SBAR
}
namespace pg8 {
typedef unsigned u32x2 __attribute__((ext_vector_type(2)));
__device__ __forceinline__ float fsigmoid(float x) { return __builtin_amdgcn_rcpf(1.0f + __builtin_amdgcn_exp2f(-1.4426950408889634f * x)); }
__device__ __forceinline__ float fsilu(float x) { return x * fsigmoid(x); }
__device__ __forceinline__ float bflo(unsigned w) { return __uint_as_float(w << 16); }
__device__ __forceinline__ float bfhi(unsigned w) { return __uint_as_float(w & 0xffff0000u); }

struct EpiSwiglu {
    static constexpr bool PERM = true, AFTER_DRAIN = false;
    bf16_t* O; int ldc;
    __device__ __forceinline__ void operator()(const f32x4 (&acc)[2][2][4][2], const Unit& u, int wr, int wc, int fr, int fq) const {
        const int row0 = u.pm * BM + wr * 64 + fr, col0 = u.pn * HALF + wc * 32 + 8 * fq;
#pragma unroll
        for (int ai = 0; ai < 2; ++ai)
#pragma unroll
            for (int m = 0; m < 4; ++m) {
                bf16_t* rowp = O + (size_t)(row0 + ai * HALF + m * 16) * ldc + col0;
                const f32x4 g0 = acc[ai][0][m][0], g1 = acc[ai][0][m][1], u0 = acc[ai][1][m][0], u1 = acc[ai][1][m][1];
                u32x4 w;
                w.x = cvt_pk_bf16(fsilu(g0[0]) * u0[0], fsilu(g0[1]) * u0[1]); w.y = cvt_pk_bf16(fsilu(g0[2]) * u0[2], fsilu(g0[3]) * u0[3]);
                w.z = cvt_pk_bf16(fsilu(g1[0]) * u1[0], fsilu(g1[1]) * u1[1]); w.w = cvt_pk_bf16(fsilu(g1[2]) * u1[2], fsilu(g1[3]) * u1[3]);
                *(u32x4*)rowp = w;
            }
    }
};

struct EpiWin {
    static constexpr bool PERM = true, AFTER_DRAIN = false;
    bf16_t *q, *k, *v, *u, *ga, *gb; const float* rope; float qscale;
    __device__ __forceinline__ void operator()(const f32x4 (&acc)[2][2][4][2], const Unit& un, int wr, int wc, int fr, int fq) const {
        const int pn = un.pn, rowt = un.pm * BM + wr * 64 + fr, bidx = un.pm >> 5;
        if (pn < 8) {
            const bool isq = pn < 4; const float sc = isq ? qscale : 1.f; bf16_t* base = isq ? q : k;
            const int colt = (pn & 3) * 256 + wc * 32 + 8 * fq, axis = wc & 1, f0 = 8 * (fq & 1);
            const float sgn = (fq < 2) ? -sc : sc;
#pragma unroll
            for (int ai = 0; ai < 2; ++ai)
#pragma unroll
                for (int m = 0; m < 4; ++m) {
                    const int r = rowt + ai * HALF + m * 16, t = r & 8191, pos = axis ? (t & 63) : (t >> 6);
                    const f32x4 cs0 = *(const f32x4*)(rope + pos * 16 + f0), cs1 = *(const f32x4*)(rope + pos * 16 + f0 + 4);
                    const f32x4 sn0 = *(const f32x4*)(rope + 2048 + pos * 16 + f0), sn1 = *(const f32x4*)(rope + 2048 + pos * 16 + f0 + 4);
                    const size_t orow = isq ? (size_t)r : (size_t)bidx * 8448 + 256 + t;
                    bf16_t* rowp = base + orow * 1024 + colt;
#pragma unroll
                    for (int bj = 0; bj < 2; ++bj) {
                        const f32x4 s0 = acc[ai][bj][m][0], s1 = acc[ai][bj][m][1]; f32x4 o0, o1;
#pragma unroll
                        for (int jj = 0; jj < 4; ++jj) { const float p0 = __shfl_xor(s0[jj], 32), p1 = __shfl_xor(s1[jj], 32);
                            o0[jj] = s0[jj] * (cs0[jj] * sc) + p0 * (sn0[jj] * sgn); o1[jj] = s1[jj] * (cs1[jj] * sc) + p1 * (sn1[jj] * sgn); }
                        u32x4 w; w.x = cvt_pk_bf16(o0[0], o0[1]); w.y = cvt_pk_bf16(o0[2], o0[3]); w.z = cvt_pk_bf16(o1[0], o1[1]); w.w = cvt_pk_bf16(o1[2], o1[3]);
                        *(u32x4*)(rowp + bj * HALF) = w;
                    }
                }
        } else if (pn < 12) {
            const int colt = (pn - 8) * 256 + wc * 32 + 8 * fq;
#pragma unroll
            for (int ai = 0; ai < 2; ++ai)
#pragma unroll
                for (int m = 0; m < 4; ++m) {
                    const int r = rowt + ai * HALF + m * 16, t = r & 8191;
                    bf16_t* rowp = v + ((size_t)bidx * 8448 + 256 + t) * 1024 + colt;
#pragma unroll
                    for (int bj = 0; bj < 2; ++bj) { const f32x4 v0 = acc[ai][bj][m][0], v1 = acc[ai][bj][m][1]; u32x4 w;
                        w.x = cvt_pk_bf16(v0[0], v0[1]); w.y = cvt_pk_bf16(v0[2], v0[3]); w.z = cvt_pk_bf16(v1[0], v1[1]); w.w = cvt_pk_bf16(v1[2], v1[3]); *(u32x4*)(rowp + bj * HALF) = w; }
                }
        } else if (pn < 20) {
            const int colt = (pn - 12) * HALF + wc * 32 + 8 * fq;
#pragma unroll
            for (int ai = 0; ai < 2; ++ai)
#pragma unroll
                for (int m = 0; m < 4; ++m) {
                    bf16_t* rowp = u + (size_t)(rowt + ai * HALF + m * 16) * 1024 + colt;
                    const f32x4 a0 = acc[ai][0][m][0], a1 = acc[ai][0][m][1], g0 = acc[ai][1][m][0], g1 = acc[ai][1][m][1]; u32x4 w;
                    w.x = cvt_pk_bf16(a0[0] * fsigmoid(g0[0]), a0[1] * fsigmoid(g0[1])); w.y = cvt_pk_bf16(a0[2] * fsigmoid(g0[2]), a0[3] * fsigmoid(g0[3]));
                    w.z = cvt_pk_bf16(a1[0] * fsigmoid(g1[0]), a1[1] * fsigmoid(g1[1])); w.w = cvt_pk_bf16(a1[2] * fsigmoid(g1[2]), a1[3] * fsigmoid(g1[3]));
                    *(u32x4*)rowp = w;
                }
        } else {
            bf16_t* base = pn < 24 ? ga : gb; const int colt = (pn & 3) * 256 + wc * 32 + 8 * fq;
#pragma unroll
            for (int ai = 0; ai < 2; ++ai)
#pragma unroll
                for (int m = 0; m < 4; ++m) {
                    bf16_t* rowp = base + (size_t)(rowt + ai * HALF + m * 16) * 1024 + colt;
#pragma unroll
                    for (int bj = 0; bj < 2; ++bj) { const f32x4 v0 = acc[ai][bj][m][0], v1 = acc[ai][bj][m][1]; u32x4 w;
                        w.x = cvt_pk_bf16(fsigmoid(v0[0]), fsigmoid(v0[1])); w.y = cvt_pk_bf16(fsigmoid(v0[2]), fsigmoid(v0[3]));
                        w.z = cvt_pk_bf16(fsigmoid(v1[0]), fsigmoid(v1[1])); w.w = cvt_pk_bf16(fsigmoid(v1[2]), fsigmoid(v1[3])); *(u32x4*)(rowp + bj * HALF) = w; }
                }
        }
    }
};

struct EpiKVc {
    static constexpr bool PERM = true, AFTER_DRAIN = false;
    bf16_t *k, *v;
    __device__ __forceinline__ void operator()(const f32x4 (&acc)[2][2][4][2], const Unit& un, int wr, int wc, int fr, int fq) const {
        bf16_t* base = un.pn < 4 ? k : v; const int colt = (un.pn & 3) * 256 + wc * 32 + 8 * fq;
#pragma unroll
        for (int ai = 0; ai < 2; ++ai)
#pragma unroll
            for (int m = 0; m < 4; ++m) {
                bf16_t* rowp = base + ((size_t)un.pm * 8448 + wr * 64 + fr + ai * HALF + m * 16) * 1024 + colt;
#pragma unroll
                for (int bj = 0; bj < 2; ++bj) { const f32x4 v0 = acc[ai][bj][m][0], v1 = acc[ai][bj][m][1]; u32x4 w;
                    w.x = cvt_pk_bf16(v0[0], v0[1]); w.y = cvt_pk_bf16(v0[2], v0[3]); w.z = cvt_pk_bf16(v1[0], v1[1]); w.w = cvt_pk_bf16(v1[2], v1[3]); *(u32x4*)(rowp + bj * HALF) = w; }
            }
    }
};

template <bool ADD> struct EpiGate {
    static constexpr bool PERM = true, AFTER_DRAIN = false;
    bf16_t* Z; const bf16_t* G;
    __device__ __forceinline__ void operator()(const f32x4 (&acc)[2][2][4][2], const Unit& un, int wr, int wc, int fr, int fq) const {
        const int row0 = un.pm * BM + wr * 64 + fr, col0 = un.pn * BM + wc * 32 + 8 * fq;
#pragma unroll
        for (int ai = 0; ai < 2; ++ai)
#pragma unroll
            for (int m = 0; m < 4; ++m) {
                const size_t off = (size_t)(row0 + ai * HALF + m * 16) * 1024 + col0;
#pragma unroll
                for (int bj = 0; bj < 2; ++bj) {
                    const u32x4 g = *(const u32x4*)(G + off + bj * HALF);
                    const f32x4 v0 = acc[ai][bj][m][0], v1 = acc[ai][bj][m][1];
                    float o[8];
                    o[0] = v0[0] * bflo(g.x); o[1] = v0[1] * bfhi(g.x); o[2] = v0[2] * bflo(g.y); o[3] = v0[3] * bfhi(g.y);
                    o[4] = v1[0] * bflo(g.z); o[5] = v1[1] * bfhi(g.z); o[6] = v1[2] * bflo(g.w); o[7] = v1[3] * bfhi(g.w);
                    if (ADD) { const u32x4 z = *(const u32x4*)(Z + off + bj * HALF);
                        o[0] += bflo(z.x); o[1] += bfhi(z.x); o[2] += bflo(z.y); o[3] += bfhi(z.y); o[4] += bflo(z.z); o[5] += bfhi(z.z); o[6] += bflo(z.w); o[7] += bfhi(z.w); }
                    u32x4 w; w.x = cvt_pk_bf16(o[0], o[1]); w.y = cvt_pk_bf16(o[2], o[3]); w.z = cvt_pk_bf16(o[4], o[5]); w.w = cvt_pk_bf16(o[6], o[7]);
                    *(u32x4*)(Z + off + bj * HALF) = w;
                }
            }
    }
};
}

constexpr int NWAVES = 8, NTHR = 512;
constexpr int DM = 1024, NB = 4, SEQ = 8192, NLAT = NB * SEQ, NCTX = 256, NCTXR = NB * NCTX, NROWS = NLAT + NCTXR, NKEYS = SEQ + NCTX;
constexpr int DFF = 2816, INW = 7168, NMOD = 9;
constexpr float EPS = 1e-6f;
constexpr size_t MiB = 1u << 20;
constexpr size_t WS_MOD = 1 * MiB, WS_ROPE = 1 * MiB + 256 * 1024, WS_LAM = 1 * MiB + 512 * 1024;
constexpr size_t WS_W13A = 2 * MiB, WS_W2A = 13 * MiB, WS_W13B = WS_W2A + 11 * MiB / 2, WS_W2B = WS_W13B + 11 * MiB, WS_WIN = 35 * MiB, WS_WAP = 49 * MiB, WS_WCP = 51 * MiB, WS_WOUT = 53 * MiB;
constexpr size_t WS_H = 56 * MiB, WS_Y = 122 * MiB, WS_BIG = 188 * MiB;
constexpr size_t WS_ACT = WS_BIG, WS_Q = WS_BIG, WS_K = WS_BIG + 64 * MiB, WS_V = WS_K + 66 * MiB, WS_U = WS_V + 66 * MiB, WS_GB = WS_U + 64 * MiB, WS_END = WS_GB + 64 * MiB;
constexpr size_t WS_GA = WS_Y, WS_UC = WS_H, WS_OSCR = WS_U, WS_Z = WS_U;
static_assert(WS_END == 512 * MiB, "ws map");
static_assert(WS_W2B + 11 * MiB / 2 <= WS_WIN, "ws map weights");
constexpr int LDS_BYTES = 147456;

#define LAS __attribute__((address_space(3)))
typedef unsigned short bf16;
typedef unsigned v4u __attribute__((ext_vector_type(4)));
typedef unsigned v2u __attribute__((ext_vector_type(2)));
typedef float f32x4 __attribute__((ext_vector_type(4)));
#define LDS_WAIT() asm volatile("s_waitcnt lgkmcnt(0)" ::: "memory")
__device__ __forceinline__ unsigned f2bf(float f) { unsigned u = __builtin_bit_cast(unsigned, f); return (u + 0x7fffu + ((u >> 16) & 1u)) >> 16; }
__device__ __forceinline__ unsigned pk2(float lo, float hi) { return f2bf(lo) | (f2bf(hi) << 16); }
__device__ __forceinline__ float wave_sum(float v) {
#pragma unroll
    for (int o = 1; o < 64; o <<= 1) v += __shfl_xor(v, o);
    return v;
}

struct Args { const float* in[21]; float* out; unsigned char* ws; int pad0, pad1; };
enum { I_X = 0, I_C, I_CTX, I_CCTX, I_WADA, I_BADA, I_NORMG, I_F1W13, I_F1W2, I_F2W13, I_F2W2, I_WIN, I_LAMQK, I_SUBLN, I_WAP, I_CONVW, I_CONVB, I_CLNG, I_CLNB, I_WCP, I_WOUT };

template <int MODE> __device__ __forceinline__ int drow(int n0) {
    if (MODE == 1) { const int bj = n0 / DFF, j = n0 % DFF; return 256 * (j / 128) + 128 * bj + (j % 128); }
    if (MODE == 2) { if (n0 >= 3072 && n0 < 5120) { const int c = n0 - 3072, bj = c / 1024, j = c % 1024; return 3072 + 256 * (j / 128) + 128 * bj + (j % 128); } return n0; }
    return n0;
}
template <int MODE> __device__ __forceinline__ void transpose_item(const float* W, int K, int N, bf16* WT, LAS float* scr, int item, int lane) {
    const int nblk = N / 32, kb = item / nblk, nb = item % nblk, k0 = 64 * kb, n0 = 32 * nb, d0 = drow<MODE>(n0);
    float tv[32];
#pragma unroll
    for (int i = 0; i < 32; ++i) tv[i] = W[(size_t)(k0 + 2 * i + (lane >> 5)) * N + n0 + (lane & 31)];
#pragma unroll
    for (int i = 0; i < 32; ++i) scr[(2 * i + (lane >> 5)) * 33 + (lane & 31)] = tv[i];
    LDS_WAIT(); asm volatile("" ::: "memory");
    const int c = lane & 7;
#pragma unroll
    for (int j = 0; j < 4; ++j) { const int n = (lane >> 3) + 8 * j; const LAS float* s = scr + (8 * c) * 33 + n;
        v4u o; o.x = pk2(s[0 * 33], s[1 * 33]); o.y = pk2(s[2 * 33], s[3 * 33]); o.z = pk2(s[4 * 33], s[5 * 33]); o.w = pk2(s[6 * 33], s[7 * 33]);
        *(v4u*)(WT + (size_t)(d0 + n) * K + k0 + 8 * c) = o; }
    LDS_WAIT(); asm volatile("" ::: "memory");
}

template <bool HAS_Y, bool WRITE_X, bool WRITE_H>
__device__ __forceinline__ void norm_rows(int gw, int NGW, int lane, int row_lo, int nrows, const float* xlat, const float* xctx, const bf16* Y, float* xout, bf16* hout, const float* mod,
                                          float mult, const float* g_post, int k_gate, const float* g_pre, int k_in) {
    for (int row0 = row_lo + gw; row0 < nrows; row0 += 2 * NGW) {
        int rows[2]; rows[0] = row0; rows[1] = (row0 + NGW < nrows) ? row0 + NGW : row0;
        f32x4 v[2][4]; v2u yw[2][4]; const float* mp[2]; bool isctx[2];
#pragma unroll
        for (int r = 0; r < 2; ++r) {
            const int row = rows[r]; isctx[r] = row >= NLAT; const int mv = isctx[r] ? 4 : (row >> 13);
            const float* xr = isctx[r] ? xctx + (size_t)(row - NLAT) * DM : xlat + (size_t)row * DM;
            mp[r] = mod + (size_t)mv * (NMOD * DM);
#pragma unroll
            for (int j = 0; j < 4; ++j) v[r][j] = ((const f32x4*)xr)[lane + 64 * j];
            if (HAS_Y) {
#pragma unroll
                for (int j = 0; j < 4; ++j) yw[r][j] = ((const v2u*)(Y + (size_t)row * DM))[lane + 64 * j];
            }
        }
        if (HAS_Y) {
            f32x4 y[2][4]; float ss[2];
#pragma unroll
            for (int r = 0; r < 2; ++r) { ss[r] = 0.f;
#pragma unroll
                for (int j = 0; j < 4; ++j) { const v2u w = yw[r][j]; y[r][j] = (f32x4){pg8::bflo(w.x), pg8::bfhi(w.x), pg8::bflo(w.y), pg8::bfhi(w.y)};
                    ss[r] += (y[r][j].x * y[r][j].x + y[r][j].y * y[r][j].y) + (y[r][j].z * y[r][j].z + y[r][j].w * y[r][j].w); } }
#pragma unroll
            for (int o = 1; o < 64; o <<= 1) { ss[0] += __shfl_xor(ss[0], o); ss[1] += __shfl_xor(ss[1], o); }
#pragma unroll
            for (int r = 0; r < 2; ++r) { const float rstd = 1.0f / sqrtf(ss[r] * (1.f / DM) + EPS);
#pragma unroll
                for (int j = 0; j < 4; ++j) { const f32x4 gp = ((const f32x4*)g_post)[lane + 64 * j], gt = ((const f32x4*)(mp[r] + k_gate * DM))[lane + 64 * j];
                    v[r][j] = v[r][j] + (mult * gt) * ((y[r][j] * rstd) * gp); }
                if (WRITE_X && !isctx[r]) {
#pragma unroll
                    for (int j = 0; j < 4; ++j) ((f32x4*)(xout + (size_t)rows[r] * DM))[lane + 64 * j] = v[r][j];
                } }
        }
        if (WRITE_H) {
            float ss[2];
#pragma unroll
            for (int r = 0; r < 2; ++r) { ss[r] = 0.f;
#pragma unroll
                for (int j = 0; j < 4; ++j) ss[r] += (v[r][j].x * v[r][j].x + v[r][j].y * v[r][j].y) + (v[r][j].z * v[r][j].z + v[r][j].w * v[r][j].w); }
#pragma unroll
            for (int o = 1; o < 64; o <<= 1) { ss[0] += __shfl_xor(ss[0], o); ss[1] += __shfl_xor(ss[1], o); }
#pragma unroll
            for (int r = 0; r < 2; ++r) { const float rstd = 1.0f / sqrtf(ss[r] * (1.f / DM) + EPS);
#pragma unroll
                for (int j = 0; j < 4; ++j) { const f32x4 gp = ((const f32x4*)g_pre)[lane + 64 * j], sh = ((const f32x4*)(mp[r] + k_in * DM))[lane + 64 * j], sc = ((const f32x4*)(mp[r] + (k_in + 1) * DM))[lane + 64 * j];
                    const f32x4 h = ((v[r][j] * rstd) * gp) * (1.0f + sc) + sh;
                    v2u w; w.x = pk2(h.x, h.y); w.y = pk2(h.z, h.w); ((v2u*)(hout + (size_t)rows[r] * DM))[lane + 64 * j] = w; } }
        }
    }
}

#define RLX_AGENT __ATOMIC_RELAXED, __HIP_MEMORY_SCOPE_AGENT
#define XB_TMO      128
#define XB_XCNT(j)  (256  + 64 * (j))
#define XB_XSUB(j)  (1280 + 64 * (j))
#define XB_XGEN(j)  (2304 + 64 * (j))
#define XB_TOP      3328
#define XB_TOPGEN   3392
#define XCD_BAR_WORDS 3456
#define XB_SPIN_CAP (1u << 22)

__device__ __forceinline__ unsigned xb_ld(unsigned* p)              { return __hip_atomic_load(p, __ATOMIC_RELAXED, __HIP_MEMORY_SCOPE_AGENT); }
__device__ __forceinline__ unsigned xb_add(unsigned* p, unsigned v) { return __hip_atomic_fetch_add(p, v, __ATOMIC_RELAXED, __HIP_MEMORY_SCOPE_AGENT); }
__device__ __forceinline__ unsigned xb_xcc_id() { return (unsigned)__builtin_amdgcn_s_getreg((3 << 11) | 20) & 0xFu; }
#define XB_SPIN(cond, bar) do { unsigned _sp = 0; while (cond) { __builtin_amdgcn_s_sleep(1); \
    if ((++_sp & 255u) == 0u) { if (xb_ld(&(bar)[XB_TMO])) break; if (_sp > XB_SPIN_CAP) { atomicAdd(&(bar)[XB_TMO], 1u); break; } } } } while (0)

struct XcdBarrier {
    unsigned* bar; unsigned x;
    volatile LAS unsigned* st;
};

__device__ __forceinline__ XcdBarrier xcd_barrier_post(unsigned* bar, volatile LAS unsigned* st) {
    XcdBarrier b; b.bar = bar; b.x = xb_xcc_id(); b.st = st;
    if (threadIdx.x == 0) (void)xb_add(&bar[XB_XCNT(b.x)], 1u);
    return b;
}
__device__ __forceinline__ void xcd_barrier_complete(unsigned* bar, unsigned x, unsigned& nloc, unsigned& nx) {
    const unsigned G = gridDim.x * gridDim.y * gridDim.z;
    unsigned sum, cnt, mine, sp = 0u;
    for (;;) {
        sum = 0u; cnt = 0u; mine = 0u;
#pragma unroll
        for (unsigned j = 0; j < 16; ++j) { const unsigned c = xb_ld(&bar[XB_XCNT(j)]); sum += c; cnt += (c > 0u) ? 1u : 0u; mine = (j == x) ? c : mine; }
        if (sum == G) break;
        __builtin_amdgcn_s_sleep(1);
        if ((++sp & 255u) == 0u) { if (xb_ld(&bar[XB_TMO])) break; if (sp > XB_SPIN_CAP) { atomicAdd(&bar[XB_TMO], 1u); break; } }
    }
    nloc = mine > 0u ? mine : 1u; nx = cnt > 0u ? cnt : 1u;
}

__device__ __forceinline__ void xcd_barrier(const XcdBarrier& b) {
    asm volatile("s_waitcnt vmcnt(0)" ::: "memory");
    __syncthreads();
    if (threadIdx.x == 0) {
        unsigned* bar = b.bar;
        __builtin_amdgcn_s_waitcnt(0);
        unsigned nloc = b.st[0], nx = b.st[1];
        if (nloc == 0u) { xcd_barrier_complete(bar, b.x, nloc, nx); b.st[0] = nloc; b.st[1] = nx; }
        const unsigned old = xb_add(&bar[XB_XSUB(b.x)], 1u);
        const unsigned gen = old / nloc;
        if (old + 1u == (gen + 1u) * nloc) {
            __builtin_amdgcn_fence(__ATOMIC_RELEASE, "agent");
            asm volatile("s_waitcnt vmcnt(0)" ::: "memory");
            const unsigned og = xb_add(&bar[XB_TOP], 1u);
            const unsigned tg = og / nx;
            if (og + 1u == (tg + 1u) * nx) xb_add(&bar[XB_TOPGEN], 1u);
            else XB_SPIN(xb_ld(&bar[XB_TOPGEN]) == tg, bar);
            __builtin_amdgcn_fence(__ATOMIC_ACQUIRE, "agent");
            xb_add(&bar[XB_XGEN(b.x)], 1u);
            asm volatile("s_waitcnt vmcnt(0)" ::: "memory");
        } else {
            XB_SPIN(xb_ld(&bar[XB_XGEN(b.x)]) == gen, bar);
            __builtin_amdgcn_fence(__ATOMIC_ACQUIRE, "agent");
            asm volatile("s_waitcnt vmcnt(0)" ::: "memory");
        }
    }
    __syncthreads();
}

__global__ void __launch_bounds__(NTHR, 2) fwd_mega(Args args) {
    extern __shared__ __attribute__((aligned(16))) unsigned char lds[];
    cg::grid_group grid = cg::this_grid();
#define GSYNC_CG() do { asm volatile("s_waitcnt vmcnt(0) lgkmcnt(0)" ::: "memory"); grid.sync(); __builtin_amdgcn_fence(__ATOMIC_ACQUIRE, "agent"); asm volatile("s_waitcnt vmcnt(0)" ::: "memory"); } while (0)
#define GSYNC() xcd_barrier(xbar)
    LAS unsigned char* L = (LAS unsigned char*)lds;
    const int tid = threadIdx.x, lane = tid & 63, wave = __builtin_amdgcn_readfirstlane(tid >> 6);
    const int G = gridDim.x, bx = blockIdx.x, vcu = (G % 8 == 0) ? (bx % 8) * (G / 8) + bx / 8 : bx;
    const int gw = vcu * NWAVES + wave, NGW = G * NWAVES;
    unsigned char* ws = args.ws;
    volatile LAS unsigned* xst = (volatile LAS unsigned*)(L + LDS_BYTES - 64);
    static_assert(attn2::PARK_OFF + attn2::PARK_BYTES <= LDS_BYTES - 64, "LDS map");
    if (tid < 2) xst[tid] = 0u;
    __syncthreads();
    XcdBarrier xbar = xcd_barrier_post((unsigned*)ws, xst);
    float* mod = (float*)(ws + WS_MOD); float* rope = (float*)(ws + WS_ROPE); float* lamp = (float*)(ws + WS_LAM);
    bf16 *W13A = (bf16*)(ws + WS_W13A), *W2A = (bf16*)(ws + WS_W2A), *W13B = (bf16*)(ws + WS_W13B), *W2B = (bf16*)(ws + WS_W2B), *WIN = (bf16*)(ws + WS_WIN), *WAP = (bf16*)(ws + WS_WAP), *WCP = (bf16*)(ws + WS_WCP), *WOUT = (bf16*)(ws + WS_WOUT);
    bf16 *H = (bf16*)(ws + WS_H), *Y = (bf16*)(ws + WS_Y), *ACT = (bf16*)(ws + WS_ACT), *Qb = (bf16*)(ws + WS_Q), *Kb = (bf16*)(ws + WS_K), *Vb = (bf16*)(ws + WS_V), *Ub = (bf16*)(ws + WS_U), *GA = (bf16*)(ws + WS_GA), *GB = (bf16*)(ws + WS_GB);
    bf16 *UC = (bf16*)(ws + WS_UC), *OSCR = (bf16*)(ws + WS_OSCR), *Zb = (bf16*)(ws + WS_Z);
    const float* x = args.in[I_X]; const float* ctx = args.in[I_CTX]; const float* normg = args.in[I_NORMG]; float* out = args.out;

    {
        LAS float* sc = (LAS float*)L;
        LAS float* red = (LAS float*)(L + 20480);
        if (bx < 144) {
            for (int i = tid; i < 5 * DM; i += NTHR) { const float c = i < 4 * DM ? args.in[I_C][i] : args.in[I_CCTX][i - 4 * DM]; sc[i] = c / (1.0f + expf(-c)); }
            __syncthreads();
            for (int it = bx; it < 144; it += G) {
                const int col = it * 64 + lane; const float* wp = args.in[I_WADA] + (size_t)(wave * 128) * (NMOD * DM) + col;
                float a0 = 0.f, a1 = 0.f, a2 = 0.f, a3 = 0.f, a4 = 0.f;
#pragma unroll 32
                for (int kk = 0; kk < 128; ++kk) { const float w = wp[(size_t)kk * (NMOD * DM)]; const int k = wave * 128 + kk;
                    a0 += sc[k] * w; a1 += sc[DM + k] * w; a2 += sc[2 * DM + k] * w; a3 += sc[3 * DM + k] * w; a4 += sc[4 * DM + k] * w; }
                red[(wave * 5 + 0) * 64 + lane] = a0; red[(wave * 5 + 1) * 64 + lane] = a1; red[(wave * 5 + 2) * 64 + lane] = a2; red[(wave * 5 + 3) * 64 + lane] = a3; red[(wave * 5 + 4) * 64 + lane] = a4;
                __syncthreads();
                if (tid < 320) { const int v = tid >> 6, cl = tid & 63; float s = 0.f;
#pragma unroll
                    for (int w8 = 0; w8 < 8; ++w8) s += red[(w8 * 5 + v) * 64 + cl];
                    mod[(size_t)v * (NMOD * DM) + it * 64 + cl] = s + args.in[I_BADA][it * 64 + cl]; }
                __syncthreads();
            }
        }
        if (bx == G - 1) {
            for (int i = tid; i < 2048; i += NTHR) { const int pos = i >> 4, f = i & 15; double inv = 1.0; for (int j = 0; j < f; ++j) inv *= 0.56234132519034908; const double ang = (double)pos * inv; rope[i] = (float)cos(ang); rope[2048 + i] = (float)sin(ang); }
        }
        if (bx == G - 2 && tid < 64) {
            const float* lq = args.in[I_LAMQK];
            const float s01 = wave_sum(lq[tid] * lq[64 + tid]), s23 = wave_sum(lq[128 + tid] * lq[192 + tid]);
            if (tid == 0) lamp[0] = expf(s01) - expf(s23) + 0.2f;
        }
        __syncthreads();
        LAS float* scr = (LAS float*)(L + wave * 16384);
        constexpr int I_13 = (DM / 64) * (2 * DFF / 32), I_2 = (DFF / 64) * (DM / 32);
        for (int it = gw; it < I_13 + I_2; it += NGW) {
            if (it < I_13) transpose_item<1>(args.in[I_F1W13], DM, 2 * DFF, W13A, scr, it, lane);
            else transpose_item<0>(args.in[I_F1W2], DFF, DM, W2A, scr, it - I_13, lane);
        }
    }
    if (args.pad0 != 0) GSYNC_CG();
    GSYNC();
    norm_rows<false, false, true>(gw, NGW, lane, 0, NROWS, x, ctx, nullptr, nullptr, H, mod, 0.f, nullptr, 0, normg + 0 * DM, 0);
    GSYNC();
    { pg8::Gemm g{H, W13A, NROWS, 2 * DFF, DM}; pg8::StaticOrder S; S.init(NROWS, 2 * DFF, G, bx); pg8::EpiSwiglu E{ACT, DFF};
      pg8::gemm_phase<pg8::EpiSwiglu, pg8::StaticOrder, PG8_ALIGN, PG8_SP2>(L, g, S, E); }
    {
        constexpr int NU = (NROWS / 256) * (2 * DFF / 256), NFULL = NU / 256, NREM = NU - NFULL * 256;
        static_assert(NREM > 0 && NREM < 256, "partial round");
        if (G == 256 ? bx >= NREM : true) {
            const int nhelp = (G == 256) ? (256 - NREM) : G, hid = (G == 256) ? bx - NREM : bx;
            LAS float* scr = (LAS float*)(L + wave * 16384);
            constexpr int I_13 = (DM / 64) * (2 * DFF / 32), I_2 = (DFF / 64) * (DM / 32), I_IN = (DM / 64) * (INW / 32), I_SQ = (DM / 64) * (DM / 32);
            constexpr int NITEMS = I_13 + I_2 + I_IN + 3 * I_SQ;
            for (int it = hid * NWAVES + wave; it < NITEMS; it += nhelp * NWAVES) {
                int r = it;
                if (r < I_IN) { transpose_item<2>(args.in[I_WIN], DM, INW, WIN, scr, r, lane); continue; } r -= I_IN;
                if (r < I_SQ) { transpose_item<0>(args.in[I_WAP], DM, DM, WAP, scr, r, lane); continue; } r -= I_SQ;
                if (r < I_SQ) { transpose_item<0>(args.in[I_WCP], DM, DM, WCP, scr, r, lane); continue; } r -= I_SQ;
                if (r < I_SQ) { transpose_item<0>(args.in[I_WOUT], DM, DM, WOUT, scr, r, lane); continue; } r -= I_SQ;
                if (r < I_13) { transpose_item<1>(args.in[I_F2W13], DM, 2 * DFF, W13B, scr, r, lane); continue; } r -= I_13;
                transpose_item<0>(args.in[I_F2W2], DFF, DM, W2B, scr, r, lane);
            }
        }
    }
    GSYNC();
    { pg8::Gemm g{ACT, W2A, NLAT, DM, DFF}; pg8::StaticOrder S; S.init(NLAT, DM, G, bx); pg8::EpiBf16<0> E{Y, DM, nullptr, 0, 0, 1.f};
      pg8::gemm_phase<pg8::EpiBf16<0>, pg8::StaticOrder, PG8_ALIGN, PG8_SP2>(L, g, S, E); }
    GSYNC();
    if (G == 256) {
        if (bx < 16) { pg8::Gemm g{ACT + (size_t)NLAT * DFF, W2A, NCTXR, DM, DFF}; pg8::StaticOrder S; S.init(NCTXR, DM, G, bx); pg8::EpiBf16<0> E{Y + (size_t)NLAT * DM, DM, nullptr, 0, 0, 1.f};
            pg8::gemm_phase<pg8::EpiBf16<0>, pg8::StaticOrder, PG8_ALIGN, PG8_SP2>(L, g, S, E); }
        else norm_rows<true, true, true>((bx - 16) * NWAVES + wave, (G - 16) * NWAVES, lane, 0, NLAT, x, ctx, Y, out, H, mod, 0.5f, normg + 1 * DM, 2, normg + 2 * DM, 3);
    } else {
        { pg8::Gemm g{ACT + (size_t)NLAT * DFF, W2A, NCTXR, DM, DFF}; pg8::StaticOrder S; S.init(NCTXR, DM, G, bx); pg8::EpiBf16<0> E{Y + (size_t)NLAT * DM, DM, nullptr, 0, 0, 1.f};
          pg8::gemm_phase<pg8::EpiBf16<0>, pg8::StaticOrder, PG8_ALIGN, PG8_SP2>(L, g, S, E); }
        norm_rows<true, true, true>(gw, NGW, lane, 0, NLAT, x, ctx, Y, out, H, mod, 0.5f, normg + 1 * DM, 2, normg + 2 * DM, 3);
    }
    GSYNC();
    norm_rows<true, true, true>(gw, NGW, lane, NLAT, NROWS, x, ctx, Y, out, H, mod, 0.5f, normg + 1 * DM, 2, normg + 2 * DM, 3);
    GSYNC();
    { pg8::Gemm g{H, WIN, NLAT, INW, DM}; pg8::StaticOrder S; S.init(NLAT, INW, G, bx);
      pg8::EpiWin E{Qb, Kb, Vb, Ub, GA, GB, rope, 1.0f};

      pg8::gemm_phase<pg8::EpiWin, pg8::StaticOrder, PG8_ALIGN, PG8_SP2>(L, g, S, E);
    }
    { pg8::Gemm g{H + (size_t)NLAT * DM, WIN + (size_t)1024 * DM, NCTXR, 2048, DM}; pg8::StaticOrder S; S.init(NCTXR, 2048, G, bx); pg8::EpiKVc E{Kb, Vb};
      pg8::gemm_phase<pg8::EpiKVc, pg8::StaticOrder, PG8_ALIGN, PG8_SP2>(L, g, S, E); }
    GSYNC();
    {
        const int c0 = 2 * tid;
        float w0[31], w1[31];
#pragma unroll
        for (int k = 0; k < 31; ++k) { const float2 w = *(const float2*)(args.in[I_CONVW] + k * DM + c0); w0[k] = w.x; w1[k] = w.y; }
        const float2 cb = *(const float2*)(args.in[I_CONVB] + c0), lg = *(const float2*)(args.in[I_CLNG] + c0), lb = *(const float2*)(args.in[I_CLNB] + c0);
        LAS float* red = (LAS float*)L;
        LAS float* stat = (LAS float*)(L + 2048);
        for (int item = vcu; item < NLAT / 16; item += G) {
            const int tg = item * 16, b = tg >> 13, t0 = tg & 8191;
            float a0[16], a1[16];
#pragma unroll
            for (int o = 0; o < 16; ++o) { a0[o] = 0.f; a1[o] = 0.f; }
#pragma unroll
            for (int i = 0; i < 46; ++i) {
                const int t = t0 - 15 + i; const bool valid = (t >= 0) && (t < SEQ); const int tt = valid ? t : t0;
                const unsigned wv = *(const unsigned*)(Ub + ((size_t)(b * SEQ + tt)) * DM + c0);
                const float x0 = valid ? pg8::bflo(wv) : 0.f, x1 = valid ? pg8::bfhi(wv) : 0.f;
#pragma unroll
                for (int o = 0; o < 16; ++o) { if (i - o >= 0 && i - o <= 30) { a0[o] += w0[i - o] * x0; a1[o] += w1[i - o] * x1; } }
            }
#pragma unroll
            for (int o = 0; o < 16; ++o) { a0[o] += cb.x; a1[o] += cb.y; const float s = wave_sum(a0[o] + a1[o]), ss = wave_sum(a0[o] * a0[o] + a1[o] * a1[o]);
                if (lane == 0) { red[wave * 32 + 2 * o] = s; red[wave * 32 + 2 * o + 1] = ss; } }
            __syncthreads();
            if (tid < 32) { float s = 0.f;
#pragma unroll
                for (int w8 = 0; w8 < 8; ++w8) s += red[w8 * 32 + tid];
                stat[tid] = s; }
            __syncthreads();
#pragma unroll
            for (int o = 0; o < 16; ++o) { const float mean = stat[2 * o] * (1.f / DM), var = stat[2 * o + 1] * (1.f / DM) - mean * mean, rstd = 1.0f / sqrtf(fmaxf(var, 0.f) + EPS);
                const float y0 = (a0[o] - mean) * rstd * lg.x + lb.x, y1 = (a1[o] - mean) * rstd * lg.y + lb.y;
                *(unsigned*)(UC + ((size_t)(tg + o)) * DM + c0) = pk2(pg8::fsilu(y0), pg8::fsilu(y1)); }
        }
    }
    __syncthreads();
    {
        const float lam = lamp[0];
#pragma unroll 1
        for (int un = vcu; un < NB * 8 * (SEQ / 256); un += G) {
            const int qb = un & 31, bh = (un >> 8) * 8 + ((un & 255) >> 5), b = bh >> 3, h = bh & 7;
            const size_t qrow0 = (size_t)b * SEQ + (size_t)qb * 256;
            const bf16* kbase = Kb + (size_t)b * NKEYS * DM; const bf16* vbase = Vb + (size_t)b * NKEYS * DM + h * 128;
            attn2::body<0>(Qb + qrow0 * DM + (2 * h) * 64, kbase + (2 * h) * 64, vbase, NKEYS, (char*)lds, lam, args.in[I_SUBLN], nullptr);
            attn2::body<1>(Qb + qrow0 * DM + (2 * h + 1) * 64, kbase + (2 * h + 1) * 64, vbase, NKEYS, (char*)lds, lam, args.in[I_SUBLN], Qb + qrow0 * DM + h * 128);
        }
    }
    GSYNC();
    { pg8::Gemm g{Qb, WAP, NLAT, DM, DM}; pg8::StaticOrder S; S.init(NLAT, DM, G, bx); pg8::EpiGate<false> E{Zb, GA};
      pg8::gemm_phase<pg8::EpiGate<false>, pg8::StaticOrder, PG8_ALIGN, PG8_SP2>(L, g, S, E); }
    asm volatile("s_waitcnt vmcnt(0)" ::: "memory");
    { pg8::Gemm g{UC, WCP, NLAT, DM, DM}; pg8::StaticOrder S; S.init(NLAT, DM, G, bx); pg8::EpiGate<true> E{Zb, GB};
      pg8::gemm_phase<pg8::EpiGate<true>, pg8::StaticOrder, PG8_ALIGN, PG8_SP2>(L, g, S, E); }
    GSYNC();
    { pg8::Gemm g{Zb, WOUT, NLAT, DM, DM}; pg8::StaticOrder S; S.init(NLAT, DM, G, bx); pg8::EpiBf16<0> E{Y, DM, nullptr, 0, 0, 1.f};
      pg8::gemm_phase<pg8::EpiBf16<0>, pg8::StaticOrder, PG8_ALIGN, PG8_SP2>(L, g, S, E);
    }
    GSYNC();
    norm_rows<true, true, true>(gw, NGW, lane, 0, NLAT, out, ctx, Y, out, H, mod, 1.0f, normg + 3 * DM, 5, normg + 4 * DM, 6);
    GSYNC();
    { pg8::Gemm g{H, W13B, NLAT, 2 * DFF, DM}; pg8::StaticOrder S; S.init(NLAT, 2 * DFF, G, bx); pg8::EpiSwiglu E{ACT, DFF};
      pg8::gemm_phase<pg8::EpiSwiglu, pg8::StaticOrder, PG8_ALIGN, PG8_SP2>(L, g, S, E);
    }
    GSYNC();
    { pg8::Gemm g{ACT, W2B, NLAT, DM, DFF}; pg8::StaticOrder S; S.init(NLAT, DM, G, bx); pg8::EpiBf16<0> E{Y, DM, nullptr, 0, 0, 1.f};
      pg8::gemm_phase<pg8::EpiBf16<0>, pg8::StaticOrder, PG8_ALIGN, PG8_SP2>(L, g, S, E);
    }
    GSYNC();
    norm_rows<true, true, false>(gw, NGW, lane, 0, NLAT, out, ctx, Y, out, nullptr, mod, 0.5f, normg + 5 * DM, 8, nullptr, 0);
}

extern "C" void kernel_launch(void* const* d_in, const int* in_sizes, int n_in, void* d_out, int out_size, void* d_ws, size_t ws_size, hipStream_t stream) {
    static int grid = 0;
    if (grid == 0) {
        if (n_in != 21 || ws_size < WS_END || out_size != NLAT * DM) { fprintf(stderr, "kernel_launch: unexpected shapes (n_in %d, out %d, ws %zu)\n", n_in, out_size, ws_size); grid = -1; return; }
        int dev = 0, cus = 0, per_cu = 0;
        if (hipGetDevice(&dev) != hipSuccess || hipDeviceGetAttribute(&cus, hipDeviceAttributeMultiprocessorCount, dev) != hipSuccess) { grid = -1; return; }
        if (hipFuncSetAttribute((const void*)fwd_mega, hipFuncAttributeMaxDynamicSharedMemorySize, LDS_BYTES) != hipSuccess) { fprintf(stderr, "kernel_launch: hipFuncSetAttribute failed\n"); grid = -1; return; }
        if (hipOccupancyMaxActiveBlocksPerMultiprocessor(&per_cu, (const void*)fwd_mega, NTHR, LDS_BYTES) != hipSuccess || per_cu < 1) fprintf(stderr, "kernel_launch: occupancy query says %d\n", per_cu);
        (void)hipGetLastError();
        grid = cus;
    }
    if (grid < 0) return;
    if (hipMemsetAsync(d_ws, 0, 16384, stream) != hipSuccess) { fprintf(stderr, "kernel_launch: memset of the barrier words failed\n"); return; }
    Args a{};
    for (int i = 0; i < 21; ++i) a.in[i] = (const float*)d_in[i];
    a.out = (float*)d_out; a.ws = (unsigned char*)d_ws;
    void* kargs[] = {&a};
    const hipError_t e = hipLaunchCooperativeKernel((const void*)fwd_mega, dim3(grid), dim3(NTHR), kargs, LDS_BYTES, stream);
    if (e != hipSuccess) fprintf(stderr, "cooperative launch failed: %s (grid %d)\n", hipGetErrorString(e), grid);
}
```

```cpp
#include <hip/hip_runtime.h>
#include <hip/hip_cooperative_groups.h>
#include <cstdio>
#include <cstdint>
namespace cg = cooperative_groups;
namespace pg8 {
#define PG8_LAS __attribute__((address_space(3)))
typedef unsigned short bf16_t;
typedef short bf16x8 __attribute__((ext_vector_type(8)));
typedef float f32x4 __attribute__((ext_vector_type(4)));
typedef unsigned u32x4 __attribute__((ext_vector_type(4)));
constexpr int BM = 256, BK = 64, HALF = 128, HTB = HALF * BK * 2  , STAGE_BYTES = 8 * HTB, NXCD = 8, WGM = 8;

__host__ __device__ __forceinline__ int lds_byte(int r, int c) { const int st = (r >> 4) * 2 + (c >> 5), rr = r & 15, cc = c & 31, ob = rr * 64 + cc * 2; return st * 1024 + (ob ^ (((ob >> 9) & 1) << 5)); }
__host__ __device__ __forceinline__ void stage_rc(int b, int& R, int& C) { const int st = b / 1024, sb = b % 1024, swz = sb ^ (((sb >> 9) & 1) << 5); R = (st >> 1) * 16 + swz / 64; C = (st & 1) * 32 + (swz % 64) / 2; }
__host__ __device__ __forceinline__ int perm32(int rho) { const int n = rho >> 4, i = rho & 15; return 8 * (i >> 2) + 4 * n + (i & 3); }

struct Unit { int pm, pn; };
struct Gemm { const bf16_t* A; const bf16_t* Bt; int M, N, K; };

struct StaticOrder {
    int nM, nN, nwg, G, c;
    __host__ __device__ void init(int M, int N, int G_, int c_) { nM = M / BM; nN = N / BM; nwg = nM * nN; G = G_; c = c_; }
    __host__ __device__ bool next(int i, Unit& u) const {
        const long L = (long)i * G + c; if (L >= nwg) return false;
        int wgid = (int)L; { const int q = nwg / NXCD, r = nwg % NXCD, xcd = wgid % NXCD, off = wgid / NXCD; wgid = (xcd < r ? xcd * (q + 1) : r * (q + 1) + (xcd - r) * q) + off; }
        const int nig = WGM * nN, gid = wgid / nig, fm = gid * WGM, gsz = (nM - fm) < WGM ? (nM - fm) : WGM;
        u.pm = fm + ((wgid % nig) % gsz); u.pn = (wgid % nig) / gsz; return true;
    }
    __device__ __forceinline__ void a_ready(const Unit&) const {}
    __device__ __forceinline__ void done(const Unit&) const {}
};

typedef float f32x2c_t __attribute__((ext_vector_type(2))); typedef __bf16 bf16x2c_t __attribute__((ext_vector_type(2)));
__device__ __forceinline__ unsigned cvt_pk_bf16(float lo, float hi) { f32x2c_t v = {lo, hi}; bf16x2c_t b = __builtin_convertvector(v, bf16x2c_t); return __builtin_bit_cast(unsigned, b); }
typedef float f32x2 __attribute__((ext_vector_type(2)));
__device__ __forceinline__ f32x2 gelu_pk(f32x2 v) {
    const f32x2 av = __builtin_elementwise_abs(v), d = av * 0.2316418882f + 1.0f;
    f32x2 t; t.x = __builtin_amdgcn_rcpf(d.x); t.y = __builtin_amdgcn_rcpf(d.y);
    f32x2 q = t * 0.5307027145f + (-0.7265760135f); q = q * t + 0.7107068705f; q = q * t + (-0.142248368f); q = q * t + 0.127414796f; q = q * t;
    const f32x2 s = (v * v) * (-0.72134752044f);
    f32x2 e; e.x = __builtin_amdgcn_exp2f(s.x); e.y = __builtin_amdgcn_exp2f(s.y);
    const f32x2 m = v * (q * e), r = v - m;
    f32x2 o; o.x = v.x < 0.f ? m.x : r.x; o.y = v.y < 0.f ? m.y : r.y; return o;
}

template <int ACT  > struct EpiBf16 {
    static constexpr bool PERM = true, AFTER_DRAIN = false; static_assert(ACT == 0 || ACT == 1, "EpiBf16: ACT is 0 (none) or 1 (gelu_pk)");
    bf16_t* O; int ldc; const float* bias; int split_cols; size_t split_stride; float scale0;
    __device__ __forceinline__ void operator()(const f32x4 (&acc)[2][2][4][2], const Unit& u, int wr, int wc, int fr, int fq) const {
        const int row0 = u.pm * BM + wr * 64 + fr; int colt = u.pn * BM; bf16_t* base = O;
        float sc = 1.f; if (split_cols) { const int t = colt / split_cols; base += (size_t)t * split_stride; colt -= t * split_cols; if (t == 0) sc = scale0; }
        const int col0 = colt + wc * 32 + 8 * fq, bcol0 = u.pn * BM + wc * 32 + 8 * fq;
        f32x4 bv[2][2];
#pragma unroll
        for (int bj = 0; bj < 2; ++bj)
#pragma unroll
            for (int n = 0; n < 2; ++n) bv[bj][n] = bias ? *(const f32x4*)(bias + bcol0 + bj * HALF + 4 * n) : (f32x4){0.f, 0.f, 0.f, 0.f};
#pragma unroll
        for (int ai = 0; ai < 2; ++ai)
#pragma unroll
            for (int m = 0; m < 4; ++m) { bf16_t* rowp = base + (size_t)(row0 + ai * HALF + m * 16) * ldc + col0;
#pragma unroll
                for (int bj = 0; bj < 2; ++bj) { f32x4 v0 = acc[ai][bj][m][0] + bv[bj][0], v1 = acc[ai][bj][m][1] + bv[bj][1];
                    if (ACT == 1) { f32x2 a = gelu_pk((f32x2){v0[0], v0[1]}), b = gelu_pk((f32x2){v0[2], v0[3]}), c = gelu_pk((f32x2){v1[0], v1[1]}), d = gelu_pk((f32x2){v1[2], v1[3]});
                        v0 = (f32x4){a.x, a.y, b.x, b.y}; v1 = (f32x4){c.x, c.y, d.x, d.y}; }
                    v0 = v0 * sc; v1 = v1 * sc; u32x4 w; w.x = cvt_pk_bf16(v0[0], v0[1]); w.y = cvt_pk_bf16(v0[2], v0[3]); w.z = cvt_pk_bf16(v1[0], v1[1]); w.w = cvt_pk_bf16(v1[2], v1[3]);
                    *(u32x4*)(rowp + bj * HALF) = w; } }
    }
};
template <class Epi, class Sched, bool ALIGN_EPI = false, bool SP2 = false>
__device__ __forceinline__ void gemm_phase(PG8_LAS unsigned char* lds, const Gemm g, const Sched& S, const Epi& E) {
    int tid_ = threadIdx.x; asm volatile("" : "+v"(tid_));
    const int tid = tid_, wid = __builtin_amdgcn_readfirstlane(tid >> 6), lane = tid & 63, wr = wid >> 2, wc = wid & 3, fr = lane & 15, fq = lane >> 4;
    const int K = g.K, nt = K / BK;
    unsigned voffA[2], voffB[2];
#pragma unroll
    for (int i = 0; i < 2; ++i) { int R, C; stage_rc(tid * 16 + i * 8192, R, C); const int Rb = Epi::PERM ? ((R & ~31) + perm32(R & 31)) : R;
        voffA[i] = (unsigned)(R * K + C) * 2u; voffB[i] = (unsigned)(Rb * K + C) * 2u; }
    const size_t kstep = (size_t)(BK * 2);
    const size_t hstep = (size_t)HALF * K * 2;
    const size_t tstep = 2 * hstep;
    const unsigned ldsw = (unsigned)wid * 1024u;
    const int aoff = lds_byte(wr * 64 + fr, fq * 8), boff = lds_byte(wc * 32 + fr, fq * 8);
#define PG8_SA(b, h) (((b) * 2 + (h)) * HTB)
#define PG8_SB(b, h) ((4 + (b) * 2 + (h)) * HTB)
#define PG8_STAGE(bufoff, gbase, voff) do { _Pragma("unroll") for (int _i = 0; _i < 2; ++_i) \
        __builtin_amdgcn_global_load_lds((const unsigned*)((const char*)(gbase) + (voff)[_i]), (PG8_LAS unsigned*)(lds + (bufoff) + ldsw + _i * 8192), 16, 0, 0); } while (0)
#define PG8_LDA(dst, b, h) do { _Pragma("unroll") for (int m = 0; m < 4; ++m) _Pragma("unroll") for (int k = 0; k < 2; ++k) dst[m][k] = *(const PG8_LAS bf16x8*)(lds + PG8_SA(b, h) + aoff + m * 2048 + k * 1024); } while (0)
#define PG8_LDB(dst, b, h) do { _Pragma("unroll") for (int n = 0; n < 2; ++n) _Pragma("unroll") for (int k = 0; k < 2; ++k) dst[n][k] = *(const PG8_LAS bf16x8*)(lds + PG8_SB(b, h) + boff + n * 2048 + k * 1024); } while (0)
#define PG8_MMA(ai, bj, At, Bt) do { __builtin_amdgcn_s_setprio(1); _Pragma("unroll") for (int m = 0; m < 4; ++m) _Pragma("unroll") for (int n = 0; n < 2; ++n) _Pragma("unroll") for (int k = 0; k < 2; ++k) \
        acc[ai][bj][m][n] = __builtin_amdgcn_mfma_f32_16x16x32_bf16(Bt[n][k], At[m][k], acc[ai][bj][m][n], 0, 0, 0); __builtin_amdgcn_s_setprio(0); } while (0)
#define PG8_WAIT_V(n) asm volatile("s_waitcnt vmcnt(" #n ")" ::: "memory")
#define PG8_WAIT_L(n) asm volatile("s_waitcnt lgkmcnt(" #n ")" ::: "memory")
#define PG8_BAR __builtin_amdgcn_s_barrier()
#define PG8_SCHED __builtin_amdgcn_sched_barrier(0)
    Unit cur, nxt; int ui = 0;
    if (!S.next(0, cur)) return;
    f32x4 acc[2][2][4][2];
#pragma unroll
    for (int a = 0; a < 2; ++a)
#pragma unroll
        for (int b = 0; b < 2; ++b)
#pragma unroll
            for (int m = 0; m < 4; ++m)
#pragma unroll
                for (int n = 0; n < 2; ++n) acc[a][b][m][n] = (f32x4){0.f, 0.f, 0.f, 0.f};
    bf16x8 At[4][2], B0[2][2], B1[2][2];
    const char* cA = (const char*)g.A + (size_t)cur.pm * tstep; const char* cB = (const char*)g.Bt + (size_t)cur.pn * tstep;
    S.a_ready(cur);
    if constexpr (SP2) {
        PG8_STAGE(PG8_SB(0, 0), cB, voffB); PG8_STAGE(PG8_SB(0, 1), cB + hstep, voffB); PG8_STAGE(PG8_SA(0, 0), cA, voffA); PG8_STAGE(PG8_SA(0, 1), cA + hstep, voffA);
        if (wr == 1) PG8_BAR;
        PG8_WAIT_V(2); PG8_BAR;
        PG8_STAGE(PG8_SB(1, 0), cB + kstep, voffB); PG8_STAGE(PG8_SA(1, 0), cA + kstep, voffA); PG8_STAGE(PG8_SB(1, 1), cB + hstep + kstep, voffB);
        PG8_WAIT_V(6); PG8_BAR;
    } else {
        PG8_STAGE(PG8_SB(0, 0), cB, voffB); PG8_STAGE(PG8_SA(0, 0), cA, voffA); PG8_STAGE(PG8_SB(0, 1), cB + hstep, voffB); PG8_STAGE(PG8_SA(0, 1), cA + hstep, voffA);
        if (wr == 1) PG8_BAR;
        PG8_WAIT_V(4); PG8_BAR;
        PG8_STAGE(PG8_SB(1, 0), cB + kstep, voffB); PG8_STAGE(PG8_SA(1, 0), cA + kstep, voffA); PG8_STAGE(PG8_SB(1, 1), cB + hstep + kstep, voffB);
        PG8_WAIT_V(6); PG8_BAR;
    }
    for (;;) {
        const bool has_next = S.next(ui + 1, nxt);
        const char* nA = has_next ? (const char*)g.A + (size_t)nxt.pm * tstep : cA; const char* nB = has_next ? (const char*)g.Bt + (size_t)nxt.pn * tstep : cB;
        for (int t = 0; t < nt; t += 2) {
            const bool last = (t == nt - 2);
            const char* a1 = cA + (size_t)(t + 1) * kstep;
            const char* a2 = last ? nA : cA + (size_t)(t + 2) * kstep; const char* b2 = last ? nB : cB + (size_t)(t + 2) * kstep;
            const char* a3 = a2 + kstep; const char* b3 = b2 + kstep;
            if (last && has_next) S.a_ready(nxt);
            if constexpr (SP2) {
            PG8_LDB(B0, 0, 0); PG8_LDB(B1, 0, 1); PG8_SCHED; PG8_LDA(At, 0, 0); PG8_STAGE(PG8_SA(1, 1), a1 + hstep, voffA);
            PG8_WAIT_V(8); PG8_WAIT_L(0); PG8_BAR; PG8_MMA(0, 0, At, B0); PG8_MMA(0, 1, At, B1); PG8_BAR; PG8_SCHED;
            PG8_LDA(At, 0, 1); PG8_STAGE(PG8_SB(0, 0), b2, voffB); PG8_STAGE(PG8_SB(0, 1), b2 + hstep, voffB); PG8_STAGE(PG8_SA(0, 0), a2, voffA);
            PG8_WAIT_V(8); PG8_WAIT_L(0); PG8_BAR; PG8_MMA(1, 0, At, B0); PG8_MMA(1, 1, At, B1); PG8_BAR; PG8_SCHED;
            PG8_LDB(B0, 1, 0); PG8_LDB(B1, 1, 1); PG8_SCHED; PG8_LDA(At, 1, 0); PG8_STAGE(PG8_SA(0, 1), a2 + hstep, voffA);
            PG8_WAIT_V(8); PG8_WAIT_L(0); PG8_BAR; PG8_MMA(0, 0, At, B0); PG8_MMA(0, 1, At, B1); PG8_BAR; PG8_SCHED;
            PG8_LDA(At, 1, 1); PG8_STAGE(PG8_SB(1, 0), b3, voffB); PG8_STAGE(PG8_SB(1, 1), b3 + hstep, voffB); PG8_STAGE(PG8_SA(1, 0), a3, voffA);
            PG8_WAIT_V(8); PG8_WAIT_L(0); PG8_BAR; PG8_MMA(1, 0, At, B0); PG8_MMA(1, 1, At, B1); PG8_BAR; PG8_SCHED;
            } else {
            PG8_LDB(B0, 0, 0); PG8_SCHED; PG8_LDA(At, 0, 0); PG8_STAGE(PG8_SA(1, 1), a1 + hstep, voffA);
            PG8_WAIT_L(8); PG8_BAR; PG8_WAIT_L(0); PG8_MMA(0, 0, At, B0); PG8_BAR; PG8_SCHED;
            PG8_LDB(B1, 0, 1); PG8_STAGE(PG8_SB(0, 0), b2, voffB);
            PG8_BAR; PG8_WAIT_L(0); PG8_MMA(0, 1, At, B1); PG8_BAR;
            PG8_LDA(At, 0, 1); PG8_STAGE(PG8_SA(0, 0), a2, voffA);
            PG8_BAR; PG8_WAIT_L(0); PG8_MMA(1, 0, At, B0); PG8_BAR; PG8_SCHED;
            PG8_STAGE(PG8_SB(0, 1), b2 + hstep, voffB);
            PG8_WAIT_V(6); PG8_BAR; PG8_MMA(1, 1, At, B1); PG8_BAR;
            PG8_LDB(B0, 1, 0); PG8_SCHED; PG8_LDA(At, 1, 0); PG8_STAGE(PG8_SA(0, 1), a2 + hstep, voffA);
            PG8_WAIT_L(8); PG8_BAR; PG8_WAIT_L(0); PG8_MMA(0, 0, At, B0); PG8_BAR; PG8_SCHED;
            PG8_LDB(B1, 1, 1); PG8_STAGE(PG8_SB(1, 0), b3, voffB);
            PG8_BAR; PG8_WAIT_L(0); PG8_MMA(0, 1, At, B1); PG8_BAR;
            PG8_LDA(At, 1, 1); PG8_STAGE(PG8_SA(1, 0), a3, voffA);
            PG8_BAR; PG8_WAIT_L(0); PG8_MMA(1, 0, At, B0); PG8_BAR; PG8_SCHED;
            PG8_STAGE(PG8_SB(1, 1), b3 + hstep, voffB);
            PG8_WAIT_V(6); PG8_BAR; PG8_MMA(1, 1, At, B1); PG8_BAR;
            }
        }
        if constexpr (ALIGN_EPI) { if (wr == 0) PG8_BAR; }
        if constexpr (!Epi::AFTER_DRAIN) { E(acc, cur, wr, wc, fr, fq); S.done(cur); }
        if (!has_next) break;
#pragma unroll
        for (int a = 0; a < 2; ++a)
#pragma unroll
            for (int b = 0; b < 2; ++b)
#pragma unroll
                for (int m = 0; m < 4; ++m)
#pragma unroll
                    for (int n = 0; n < 2; ++n) acc[a][b][m][n] = (f32x4){0.f, 0.f, 0.f, 0.f};
        cur = nxt; cA = nA; cB = nB; ++ui;
        if constexpr (ALIGN_EPI) { if (wr == 1) PG8_BAR; }
    }
    PG8_WAIT_V(0);
    if constexpr (!ALIGN_EPI) { if (wr == 0) PG8_BAR; }
    PG8_BAR;
    if constexpr (Epi::AFTER_DRAIN) { E.fused(acc, cur, wr, wc, fr, fq, lds, wid, lane); S.done(cur); }
#undef PG8_SA
#undef PG8_SB
#undef PG8_STAGE
#undef PG8_LDA
#undef PG8_LDB
#undef PG8_MMA
#undef PG8_WAIT_V
#undef PG8_WAIT_L
#undef PG8_BAR
#undef PG8_SCHED
}
}

#ifndef PG8_SP2
#define PG8_SP2 true
#endif
#ifndef PG8_ALIGN
#define PG8_ALIGN true
#endif
#include <hip/hip_bf16.h>
#include <cmath>
namespace attn2 {
using bf16x8 = __attribute__((ext_vector_type(8))) short;
using s16x4  = __attribute__((ext_vector_type(4))) short;
using f32x16 = __attribute__((ext_vector_type(16))) float;
using u32x4  = __attribute__((ext_vector_type(4))) unsigned;
typedef unsigned short bf16r;
constexpr int DQ = 64, DV = 128, NW = 8, QBLK = 32, KVBLK = 64, LD = 1024;
constexpr float SCALE = 0.125f, THR = 8.f;
constexpr size_t SHM_V = KVBLK * DV * 2, SHM_K = KVBLK * DQ * 2, SHM_ATTN = 3 * SHM_V + 3 * SHM_K + NW * 64 * 4;
constexpr size_t PARK_OFF = SHM_ATTN, PARK_BYTES = NW * 2048 * 4;
#define A2_KSWZ(row, colB) ((row) * 128 + ((colB) ^ ((((row) >> 1) & 7) << 4)))
#define A2_SBAR() __builtin_amdgcn_sched_barrier(0)
__device__ __forceinline__ int crow(int r, int hi) { return (r & 3) + 8 * (r >> 2) + 4 * hi; }
typedef float f32x2_t __attribute__((ext_vector_type(2))); typedef __bf16 bf16x2_t __attribute__((ext_vector_type(2)));
__device__ __forceinline__ unsigned cvtpk(float lo, float hi) { f32x2_t v = {lo, hi}; bf16x2_t b = __builtin_convertvector(v, bf16x2_t); return __builtin_bit_cast(unsigned, b); }

__device__ __forceinline__ void partialSM(f32x16& p0, f32x16& p1, float& m_reg, float& mn, float& alpha) {
  constexpr float C = SCALE * 1.4426950408889634f;
  float pmax = p0[0];
#pragma unroll
  for (int r = 1; r < 16; ++r) pmax = fmaxf(pmax, p0[r]);
#pragma unroll
  for (int r = 0; r < 16; ++r) pmax = fmaxf(pmax, p1[r]);
  { auto rr = __builtin_amdgcn_permlane32_swap(__float_as_uint(pmax), __float_as_uint(pmax), false, false);
    pmax = fmaxf(__uint_as_float(rr[0]), __uint_as_float(rr[1])); }
  if (__builtin_expect(__all(pmax - m_reg <= THR / SCALE), 1)) { mn = m_reg; alpha = 1.f; }
  else { mn = fmaxf(m_reg, pmax); alpha = __builtin_amdgcn_exp2f((m_reg - mn) * C); m_reg = mn; }
  const float mnC = -mn * C;
  { const f32x2_t cv = {C, C}, mv = {mnC, mnC};
#pragma unroll
    for (int i = 0; i < 8; ++i) { f32x2_t t = {p0[2 * i], p0[2 * i + 1]}; t = t * cv + mv; p0[2 * i] = t.x; p0[2 * i + 1] = t.y; }
#pragma unroll
    for (int i = 0; i < 8; ++i) { f32x2_t t = {p1[2 * i], p1[2 * i + 1]}; t = t * cv + mv; p1[2 * i] = t.x; p1[2 * i + 1] = t.y; } }
#pragma unroll
  for (int r = 0; r < 16; ++r) p0[r] = __builtin_amdgcn_exp2f(p0[r]);
}
__device__ __forceinline__ void finishSM(f32x16& p0, f32x16& p1, float alpha, float& l_reg, bf16x8& pa0, bf16x8& pa1, bf16x8& pa2, bf16x8& pa3) {
#pragma unroll
  for (int r = 0; r < 16; ++r) p1[r] = __builtin_amdgcn_exp2f(p1[r]);
  f32x2_t sv = {p0[0], p0[1]};
#pragma unroll
  for (int i = 1; i < 8; ++i) sv += (f32x2_t){p0[2 * i], p0[2 * i + 1]};
#pragma unroll
  for (int i = 0; i < 8; ++i) sv += (f32x2_t){p1[2 * i], p1[2 * i + 1]};
  float ps = sv.x + sv.y;
  { auto rr = __builtin_amdgcn_permlane32_swap(__float_as_uint(ps), __float_as_uint(ps), false, false);
    ps = __uint_as_float(rr[0]) + __uint_as_float(rr[1]); }
  l_reg = l_reg * alpha + ps;
#define A2_PK8(P, BASE, OUT) do { u32x4 w = {cvtpk(P[BASE + 0], P[BASE + 1]), cvtpk(P[BASE + 2], P[BASE + 3]), cvtpk(P[BASE + 4], P[BASE + 5]), cvtpk(P[BASE + 6], P[BASE + 7])}; OUT = *reinterpret_cast<bf16x8*>(&w); } while (0)
  A2_PK8(p0, 0, pa0); A2_PK8(p0, 8, pa1); A2_PK8(p1, 0, pa2); A2_PK8(p1, 8, pa3);
#undef A2_PK8
}
__device__ __forceinline__ void qkt(f32x16& p0, f32x16& p1, const char* Ks, const bf16x8* qr, int r32, int hi) {
  p0 = f32x16{}; p1 = f32x16{};
#pragma unroll
  for (int d0 = 0; d0 < 4; ++d0) { const int cb = (d0 * 16 + hi * 8) * 2;
    const bf16x8 b0 = *reinterpret_cast<const bf16x8*>(Ks + A2_KSWZ(r32, cb));
    const bf16x8 b1 = *reinterpret_cast<const bf16x8*>(Ks + A2_KSWZ(32 + r32, cb));
    p0 = __builtin_amdgcn_mfma_f32_32x32x16_bf16(b0, qr[d0], p0, 0, 0, 0);
    p1 = __builtin_amdgcn_mfma_f32_32x32x16_bf16(b1, qr[d0], p1, 0, 0, 0); }
}
__device__ __forceinline__ int v_st(int k, int c) { const int kk = k;     return ((kk >> 3) * 4 + (c >> 5)) * 512 + ((kk & 7) * 32 + (c & 31)) * 2; }
__device__ __forceinline__ int v_rd_base(int lane) { return ((lane & 3) << 3) | (((lane >> 2) & 3) << 6) | (((lane >> 4) & 1) << 5) | (((lane >> 5) & 1) << 8); }
constexpr int v_rd_off(int d0, int ks, int half) { return d0 * 512 + ks * 4096 + half * 2048; }
template <int OFF> __device__ __forceinline__ s16x4 tr_read(int vb) {
  s16x4 r; asm volatile("ds_read_b64_tr_b16 %0, %1 offset:%2" : "=&v"(r) : "v"(vb), "i"(OFF) : "memory"); return r;
}
template <int D0> __device__ __forceinline__ void pv_one(f32x16& od, int vb, bf16x8 pa0, bf16x8 pa1, bf16x8 pa2, bf16x8 pa3) {
  const s16x4 l0 = tr_read<v_rd_off(D0, 0, 0)>(vb), h0 = tr_read<v_rd_off(D0, 0, 1)>(vb), l1 = tr_read<v_rd_off(D0, 1, 0)>(vb), h1 = tr_read<v_rd_off(D0, 1, 1)>(vb);
  const s16x4 l2 = tr_read<v_rd_off(D0, 2, 0)>(vb), h2 = tr_read<v_rd_off(D0, 2, 1)>(vb), l3 = tr_read<v_rd_off(D0, 3, 0)>(vb), h3 = tr_read<v_rd_off(D0, 3, 1)>(vb);
  asm volatile("s_waitcnt lgkmcnt(0)" ::: "memory"); A2_SBAR();
#define A2_PK(L, H) (bf16x8){L[0], L[1], L[2], L[3], H[0], H[1], H[2], H[3]}
  od = __builtin_amdgcn_mfma_f32_32x32x16_bf16(pa0, A2_PK(l0, h0), od, 0, 0, 0);
  od = __builtin_amdgcn_mfma_f32_32x32x16_bf16(pa1, A2_PK(l1, h1), od, 0, 0, 0);
  od = __builtin_amdgcn_mfma_f32_32x32x16_bf16(pa2, A2_PK(l2, h2), od, 0, 0, 0);
  od = __builtin_amdgcn_mfma_f32_32x32x16_bf16(pa3, A2_PK(l3, h3), od, 0, 0, 0);
#undef A2_PK
}
__device__ __forceinline__ void pv_d0(f32x16* o, int vb, bf16x8 pa0, bf16x8 pa1, bf16x8 pa2, bf16x8 pa3) {
  pv_one<0>(o[0], vb, pa0, pa1, pa2, pa3); pv_one<1>(o[1], vb, pa0, pa1, pa2, pa3); pv_one<2>(o[2], vb, pa0, pa1, pa2, pa3); pv_one<3>(o[3], vb, pa0, pa1, pa2, pa3);
}

struct VF { s16x4 l0, h0, l1, h1, l2, h2, l3, h3; };
template <int D0> __device__ __forceinline__ VF vread(int vb) { VF f;
  f.l0 = tr_read<v_rd_off(D0, 0, 0)>(vb); f.h0 = tr_read<v_rd_off(D0, 0, 1)>(vb); f.l1 = tr_read<v_rd_off(D0, 1, 0)>(vb); f.h1 = tr_read<v_rd_off(D0, 1, 1)>(vb);
  f.l2 = tr_read<v_rd_off(D0, 2, 0)>(vb); f.h2 = tr_read<v_rd_off(D0, 2, 1)>(vb); f.l3 = tr_read<v_rd_off(D0, 3, 0)>(vb); f.h3 = tr_read<v_rd_off(D0, 3, 1)>(vb); return f; }
__device__ __forceinline__ void mfma4(f32x16& od, const VF& f, bf16x8 pa0, bf16x8 pa1, bf16x8 pa2, bf16x8 pa3) {
#define A2_PK(L, H) (bf16x8){L[0], L[1], L[2], L[3], H[0], H[1], H[2], H[3]}
  od = __builtin_amdgcn_mfma_f32_32x32x16_bf16(pa0, A2_PK(f.l0, f.h0), od, 0, 0, 0);
  od = __builtin_amdgcn_mfma_f32_32x32x16_bf16(pa1, A2_PK(f.l1, f.h1), od, 0, 0, 0);
  od = __builtin_amdgcn_mfma_f32_32x32x16_bf16(pa2, A2_PK(f.l2, f.h2), od, 0, 0, 0);
  od = __builtin_amdgcn_mfma_f32_32x32x16_bf16(pa3, A2_PK(f.l3, f.h3), od, 0, 0, 0);
#undef A2_PK
}
#define A2_LWAIT(n) do { asm volatile("s_waitcnt lgkmcnt(" #n ")" ::: "memory"); A2_SBAR(); } while (0)
__device__ __forceinline__ void pv_psm(f32x16* o, int vb, bf16x8 pa0, bf16x8 pa1, bf16x8 pa2, bf16x8 pa3, f32x16& p0, f32x16& p1, float& m_reg, float& mn, float& alpha) {
  constexpr float C = SCALE * 1.4426950408889634f;
  const VF f0 = vread<0>(vb);
  const VF f1 = vread<1>(vb); A2_LWAIT(8); mfma4(o[0], f0, pa0, pa1, pa2, pa3);
  float pmax = p0[0];
#pragma unroll
  for (int r = 1; r < 16; ++r) pmax = fmaxf(pmax, p0[r]);
#pragma unroll
  for (int r = 0; r < 16; ++r) pmax = fmaxf(pmax, p1[r]);
  { auto rr = __builtin_amdgcn_permlane32_swap(__float_as_uint(pmax), __float_as_uint(pmax), false, false);
    pmax = fmaxf(__uint_as_float(rr[0]), __uint_as_float(rr[1])); }
  asm volatile("" : "+v"(pmax));
  const VF f2 = vread<2>(vb); A2_LWAIT(8); mfma4(o[1], f1, pa0, pa1, pa2, pa3);
  if (__builtin_expect(__all(pmax - m_reg <= THR / SCALE), 1)) { mn = m_reg; alpha = 1.f; }
  else { mn = fmaxf(m_reg, pmax); alpha = __builtin_amdgcn_exp2f((m_reg - mn) * C); m_reg = mn; }
  const float mnC = -mn * C; const f32x2_t cv = {C, C}, mv = {mnC, mnC};
#pragma unroll
  for (int i = 0; i < 8; ++i) { f32x2_t t = {p0[2 * i], p0[2 * i + 1]}; t = t * cv + mv; p0[2 * i] = t.x; p0[2 * i + 1] = t.y; }
  asm volatile("" : "+v"(p0));
  const VF f3 = vread<3>(vb); A2_LWAIT(8); mfma4(o[2], f2, pa0, pa1, pa2, pa3);
#pragma unroll
  for (int i = 0; i < 8; ++i) { f32x2_t t = {p1[2 * i], p1[2 * i + 1]}; t = t * cv + mv; p1[2 * i] = t.x; p1[2 * i + 1] = t.y; }
  asm volatile("" : "+v"(p1));
  A2_LWAIT(0); mfma4(o[3], f3, pa0, pa1, pa2, pa3);
#pragma unroll
  for (int r = 0; r < 16; ++r) p0[r] = __builtin_amdgcn_exp2f(p0[r]);
  asm volatile("" : "+v"(p0)); A2_SBAR();
}
template <int PASS>
__device__ __forceinline__ void body(const bf16r* Qb, const bf16r* Kh, const bf16r* Vh, int seq, char* lds, float lam, const float* subln, bf16r* Ob) {
  int tid_ = threadIdx.x; asm volatile("" : "+v"(tid_));
  const int tid = tid_, wid = tid >> 6, lane = tid & 63, r32 = lane & 31, hi = lane >> 5;
  char* V_lds = lds; char* K_lds = lds + 3 * SHM_V;
  float* ws = (float*)(lds + 3 * SHM_V + 3 * SHM_K) + wid * 64; float* li_l = ws; float* al_l = ws + 32;
  float m_reg = -1e30f, l_reg = 0; f32x16 o[4] = {}; bf16x8 qr[4];
  const bf16r* Qw = Qb + (long)(wid * QBLK + r32) * LD + hi * 8;
#pragma unroll
  for (int d0 = 0; d0 < 4; ++d0) qr[d0] = *reinterpret_cast<const bf16x8*>(Qw + d0 * 16);
  const int sr = tid >> 4, sc = (tid & 15) * 8, vst0 = v_st(sr, sc), vst1 = v_st(32 + sr, sc);
  const int kr = tid >> 3, kc = (tid & 7) * 8, kst = A2_KSWZ(kr, kc * 2);
  const int vb0 = (int)(uintptr_t)V_lds + v_rd_base(lane);
  struct { bf16x8 vs0, vs1, ks0; } sr_[2];
#define A2_SLOAD(i, k0) do { sr_[i].vs0 = *reinterpret_cast<const bf16x8*>(&Vh[(long)((k0) + sr) * LD + sc]); sr_[i].vs1 = *reinterpret_cast<const bf16x8*>(&Vh[(long)((k0) + 32 + sr) * LD + sc]); \
    sr_[i].ks0 = *reinterpret_cast<const bf16x8*>(&Kh[(long)((k0) + kr) * LD + kc]); } while (0)
#define A2_SWRITE(b, i) do { *(bf16x8*)(V_lds + (b) * SHM_V + vst0) = sr_[i].vs0; *(bf16x8*)(V_lds + (b) * SHM_V + vst1) = sr_[i].vs1; *(bf16x8*)(K_lds + (b) * SHM_K + kst) = sr_[i].ks0; } while (0)
#define A2_SWAIT() asm volatile("s_waitcnt vmcnt(3)" ::: "memory")
#define A2_RESC(a) do { if (__any((a) < 1.f)) { if (hi == 0) al_l[r32] = (a); asm volatile("s_waitcnt lgkmcnt(0)" ::: "memory"); \
    _Pragma("unroll") for (int d = 0; d < 4; ++d) _Pragma("unroll") for (int r = 0; r < 16; ++r) o[d][r] *= al_l[crow(r, hi)]; } } while (0)
  if (wid >= 4) __builtin_amdgcn_s_setprio(1);
  f32x16 pA0, pA1, pB0, pB1; float mnA, mnB, alA, alB; bf16x8 pa0, pa1, pa2, pa3; const int NT = seq / KVBLK;
  A2_SLOAD(0, 0); asm volatile("s_waitcnt vmcnt(0)" ::: "memory"); A2_SWRITE(0, 0);
  A2_SLOAD(1, KVBLK); A2_SLOAD(0, 2 * KVBLK);
  __syncthreads();
  qkt(pA0, pA1, K_lds, qr, r32, hi); partialSM(pA0, pA1, m_reg, mnA, alA);
  A2_SWAIT(); A2_SWRITE(1, 1); A2_SLOAD(1, 3 * KVBLK);
  int bp = 0, bc = 1, bn = 2;
#define A2_STEP(PC0, PC1, mnC_, alC_, PP0, PP1, alP_, j_, SL) do { \
    __syncthreads(); \
    if ((j_) + 1 < NT) { A2_SWAIT(); A2_SWRITE(bn, SL); } \
    A2_SBAR(); qkt(PC0, PC1, K_lds + bc * SHM_K, qr, r32, hi); \
    finishSM(PP0, PP1, alP_, l_reg, pa0, pa1, pa2, pa3); A2_SBAR(); \
    if ((j_) + 3 < NT) A2_SLOAD(SL, ((j_) + 3) * KVBLK); A2_SBAR(); \
    pv_psm(o, vb0 + bp * (int)SHM_V, pa0, pa1, pa2, pa3, PC0, PC1, m_reg, mnC_, alC_); \
    A2_RESC(alC_); \
    { const int t_ = bp; bp = bc; bc = bn; bn = t_; } } while (0)
  for (int j = 1; j + 1 < NT; j += 2) {
    A2_STEP(pB0, pB1, mnB, alB, pA0, pA1, alA, j, 0);
    A2_STEP(pA0, pA1, mnA, alA, pB0, pB1, alB, j + 1, 1);
  }
  A2_STEP(pB0, pB1, mnB, alB, pA0, pA1, alA, NT - 1, 0);
#undef A2_STEP
  finishSM(pB0, pB1, alB, l_reg, pa0, pa1, pa2, pa3); A2_SBAR();
  pv_d0(o, vb0 + bp * (int)SHM_V, pa0, pa1, pa2, pa3);
  __builtin_amdgcn_s_setprio(0);
  if (hi == 0) li_l[r32] = l_reg; asm volatile("s_waitcnt lgkmcnt(0)" ::: "memory");
  float rli[16];
#pragma unroll
  for (int r = 0; r < 16; ++r) rli[r] = __builtin_amdgcn_rcpf(li_l[crow(r, hi)]);
  unsigned* sw = (unsigned*)(lds + PARK_OFF) + wid * 2048 + lane;
  if (PASS == 0) {
#pragma unroll
    for (int r = 0; r < 16; ++r)
#pragma unroll
      for (int dp = 0; dp < 2; ++dp) sw[(r * 2 + dp) * 64] = cvtpk(o[2 * dp][r] * rli[r], o[2 * dp + 1][r] * rli[r]);
  } else {
    float sg[4];
#pragma unroll
    for (int d0 = 0; d0 < 4; ++d0) sg[d0] = subln[d0 * 32 + r32];
    bf16r* Ow = Ob + (long)(wid * QBLK) * LD + r32;
#pragma unroll
    for (int r = 0; r < 16; ++r) {
      float d[4]; float ss = 0.f;
#pragma unroll
      for (int dp = 0; dp < 2; ++dp) { const unsigned w = sw[(r * 2 + dp) * 64];
        d[2 * dp] = __uint_as_float(w << 16) - lam * (o[2 * dp][r] * rli[r]); d[2 * dp + 1] = __uint_as_float(w & 0xffff0000u) - lam * (o[2 * dp + 1][r] * rli[r]); }
#pragma unroll
      for (int d0 = 0; d0 < 4; ++d0) ss += d[d0] * d[d0];
      ss += __shfl_xor(ss, 1); ss += __shfl_xor(ss, 2); ss += __shfl_xor(ss, 4); ss += __shfl_xor(ss, 8); ss += __shfl_xor(ss, 16);
      const float rstd = 0.8f / sqrtf(ss * (1.f / 128.f) + 1e-6f);
      const int orow = crow(r, hi);
#pragma unroll
      for (int d0 = 0; d0 < 4; ++d0) Ow[(long)orow * LD + d0 * 32] = (bf16r)(cvtpk(d[d0] * rstd * sg[d0], 0.f) & 0xffffu);
    }
  }
  __syncthreads();
#undef A2_SLOAD
#undef A2_SWRITE
#undef A2_SWAIT
#undef A2_RESC
}
#undef A2_KSWZ
#undef A2_LWAIT
#undef A2_SBAR
}
namespace pg8 {
typedef unsigned u32x2 __attribute__((ext_vector_type(2)));
__device__ __forceinline__ float fsigmoid(float x) { return __builtin_amdgcn_rcpf(1.0f + __builtin_amdgcn_exp2f(-1.4426950408889634f * x)); }
__device__ __forceinline__ float fsilu(float x) { return x * fsigmoid(x); }
__device__ __forceinline__ float bflo(unsigned w) { return __uint_as_float(w << 16); }
__device__ __forceinline__ float bfhi(unsigned w) { return __uint_as_float(w & 0xffff0000u); }

struct EpiSwiglu {
    static constexpr bool PERM = true, AFTER_DRAIN = false;
    bf16_t* O; int ldc;
    __device__ __forceinline__ void operator()(const f32x4 (&acc)[2][2][4][2], const Unit& u, int wr, int wc, int fr, int fq) const {
        const int row0 = u.pm * BM + wr * 64 + fr, col0 = u.pn * HALF + wc * 32 + 8 * fq;
#pragma unroll
        for (int ai = 0; ai < 2; ++ai)
#pragma unroll
            for (int m = 0; m < 4; ++m) {
                bf16_t* rowp = O + (size_t)(row0 + ai * HALF + m * 16) * ldc + col0;
                const f32x4 g0 = acc[ai][0][m][0], g1 = acc[ai][0][m][1], u0 = acc[ai][1][m][0], u1 = acc[ai][1][m][1];
                u32x4 w;
                w.x = cvt_pk_bf16(fsilu(g0[0]) * u0[0], fsilu(g0[1]) * u0[1]); w.y = cvt_pk_bf16(fsilu(g0[2]) * u0[2], fsilu(g0[3]) * u0[3]);
                w.z = cvt_pk_bf16(fsilu(g1[0]) * u1[0], fsilu(g1[1]) * u1[1]); w.w = cvt_pk_bf16(fsilu(g1[2]) * u1[2], fsilu(g1[3]) * u1[3]);
                *(u32x4*)rowp = w;
            }
    }
};

struct EpiWin {
    static constexpr bool PERM = true, AFTER_DRAIN = false;
    bf16_t *q, *k, *v, *u, *ga, *gb; const float* rope; float qscale;
    __device__ __forceinline__ void operator()(const f32x4 (&acc)[2][2][4][2], const Unit& un, int wr, int wc, int fr, int fq) const {
        const int pn = un.pn, rowt = un.pm * BM + wr * 64 + fr, bidx = un.pm >> 5;
        if (pn < 8) {
            const bool isq = pn < 4; const float sc = isq ? qscale : 1.f; bf16_t* base = isq ? q : k;
            const int colt = (pn & 3) * 256 + wc * 32 + 8 * fq, axis = wc & 1, f0 = 8 * (fq & 1);
            const float sgn = (fq < 2) ? -sc : sc;
#pragma unroll
            for (int ai = 0; ai < 2; ++ai)
#pragma unroll
                for (int m = 0; m < 4; ++m) {
                    const int r = rowt + ai * HALF + m * 16, t = r & 8191, pos = axis ? (t & 63) : (t >> 6);
                    const f32x4 cs0 = *(const f32x4*)(rope + pos * 16 + f0), cs1 = *(const f32x4*)(rope + pos * 16 + f0 + 4);
                    const f32x4 sn0 = *(const f32x4*)(rope + 2048 + pos * 16 + f0), sn1 = *(const f32x4*)(rope + 2048 + pos * 16 + f0 + 4);
                    const size_t orow = isq ? (size_t)r : (size_t)bidx * 8448 + 256 + t;
                    bf16_t* rowp = base + orow * 1024 + colt;
#pragma unroll
                    for (int bj = 0; bj < 2; ++bj) {
                        const f32x4 s0 = acc[ai][bj][m][0], s1 = acc[ai][bj][m][1]; f32x4 o0, o1;
#pragma unroll
                        for (int jj = 0; jj < 4; ++jj) { const float p0 = __shfl_xor(s0[jj], 32), p1 = __shfl_xor(s1[jj], 32);
                            o0[jj] = s0[jj] * (cs0[jj] * sc) + p0 * (sn0[jj] * sgn); o1[jj] = s1[jj] * (cs1[jj] * sc) + p1 * (sn1[jj] * sgn); }
                        u32x4 w; w.x = cvt_pk_bf16(o0[0], o0[1]); w.y = cvt_pk_bf16(o0[2], o0[3]); w.z = cvt_pk_bf16(o1[0], o1[1]); w.w = cvt_pk_bf16(o1[2], o1[3]);
                        *(u32x4*)(rowp + bj * HALF) = w;
                    }
                }
        } else if (pn < 12) {
            const int colt = (pn - 8) * 256 + wc * 32 + 8 * fq;
#pragma unroll
            for (int ai = 0; ai < 2; ++ai)
#pragma unroll
                for (int m = 0; m < 4; ++m) {
                    const int r = rowt + ai * HALF + m * 16, t = r & 8191;
                    bf16_t* rowp = v + ((size_t)bidx * 8448 + 256 + t) * 1024 + colt;
#pragma unroll
                    for (int bj = 0; bj < 2; ++bj) { const f32x4 v0 = acc[ai][bj][m][0], v1 = acc[ai][bj][m][1]; u32x4 w;
                        w.x = cvt_pk_bf16(v0[0], v0[1]); w.y = cvt_pk_bf16(v0[2], v0[3]); w.z = cvt_pk_bf16(v1[0], v1[1]); w.w = cvt_pk_bf16(v1[2], v1[3]); *(u32x4*)(rowp + bj * HALF) = w; }
                }
        } else if (pn < 20) {
            const int colt = (pn - 12) * HALF + wc * 32 + 8 * fq;
#pragma unroll
            for (int ai = 0; ai < 2; ++ai)
#pragma unroll
                for (int m = 0; m < 4; ++m) {
                    bf16_t* rowp = u + (size_t)(rowt + ai * HALF + m * 16) * 1024 + colt;
                    const f32x4 a0 = acc[ai][0][m][0], a1 = acc[ai][0][m][1], g0 = acc[ai][1][m][0], g1 = acc[ai][1][m][1]; u32x4 w;
                    w.x = cvt_pk_bf16(a0[0] * fsigmoid(g0[0]), a0[1] * fsigmoid(g0[1])); w.y = cvt_pk_bf16(a0[2] * fsigmoid(g0[2]), a0[3] * fsigmoid(g0[3]));
                    w.z = cvt_pk_bf16(a1[0] * fsigmoid(g1[0]), a1[1] * fsigmoid(g1[1])); w.w = cvt_pk_bf16(a1[2] * fsigmoid(g1[2]), a1[3] * fsigmoid(g1[3]));
                    *(u32x4*)rowp = w;
                }
        } else {
            bf16_t* base = pn < 24 ? ga : gb; const int colt = (pn & 3) * 256 + wc * 32 + 8 * fq;
#pragma unroll
            for (int ai = 0; ai < 2; ++ai)
#pragma unroll
                for (int m = 0; m < 4; ++m) {
                    bf16_t* rowp = base + (size_t)(rowt + ai * HALF + m * 16) * 1024 + colt;
#pragma unroll
                    for (int bj = 0; bj < 2; ++bj) { const f32x4 v0 = acc[ai][bj][m][0], v1 = acc[ai][bj][m][1]; u32x4 w;
                        w.x = cvt_pk_bf16(fsigmoid(v0[0]), fsigmoid(v0[1])); w.y = cvt_pk_bf16(fsigmoid(v0[2]), fsigmoid(v0[3]));
                        w.z = cvt_pk_bf16(fsigmoid(v1[0]), fsigmoid(v1[1])); w.w = cvt_pk_bf16(fsigmoid(v1[2]), fsigmoid(v1[3])); *(u32x4*)(rowp + bj * HALF) = w; }
                }
        }
    }
};

struct EpiKVc {
    static constexpr bool PERM = true, AFTER_DRAIN = false;
    bf16_t *k, *v;
    __device__ __forceinline__ void operator()(const f32x4 (&acc)[2][2][4][2], const Unit& un, int wr, int wc, int fr, int fq) const {
        bf16_t* base = un.pn < 4 ? k : v; const int colt = (un.pn & 3) * 256 + wc * 32 + 8 * fq;
#pragma unroll
        for (int ai = 0; ai < 2; ++ai)
#pragma unroll
            for (int m = 0; m < 4; ++m) {
                bf16_t* rowp = base + ((size_t)un.pm * 8448 + wr * 64 + fr + ai * HALF + m * 16) * 1024 + colt;
#pragma unroll
                for (int bj = 0; bj < 2; ++bj) { const f32x4 v0 = acc[ai][bj][m][0], v1 = acc[ai][bj][m][1]; u32x4 w;
                    w.x = cvt_pk_bf16(v0[0], v0[1]); w.y = cvt_pk_bf16(v0[2], v0[3]); w.z = cvt_pk_bf16(v1[0], v1[1]); w.w = cvt_pk_bf16(v1[2], v1[3]); *(u32x4*)(rowp + bj * HALF) = w; }
            }
    }
};

template <bool ADD> struct EpiGate {
    static constexpr bool PERM = true, AFTER_DRAIN = false;
    bf16_t* Z; const bf16_t* G;
    __device__ __forceinline__ void operator()(const f32x4 (&acc)[2][2][4][2], const Unit& un, int wr, int wc, int fr, int fq) const {
        const int row0 = un.pm * BM + wr * 64 + fr, col0 = un.pn * BM + wc * 32 + 8 * fq;
#pragma unroll
        for (int ai = 0; ai < 2; ++ai)
#pragma unroll
            for (int m = 0; m < 4; ++m) {
                const size_t off = (size_t)(row0 + ai * HALF + m * 16) * 1024 + col0;
#pragma unroll
                for (int bj = 0; bj < 2; ++bj) {
                    const u32x4 g = *(const u32x4*)(G + off + bj * HALF);
                    const f32x4 v0 = acc[ai][bj][m][0], v1 = acc[ai][bj][m][1];
                    float o[8];
                    o[0] = v0[0] * bflo(g.x); o[1] = v0[1] * bfhi(g.x); o[2] = v0[2] * bflo(g.y); o[3] = v0[3] * bfhi(g.y);
                    o[4] = v1[0] * bflo(g.z); o[5] = v1[1] * bfhi(g.z); o[6] = v1[2] * bflo(g.w); o[7] = v1[3] * bfhi(g.w);
                    if (ADD) { const u32x4 z = *(const u32x4*)(Z + off + bj * HALF);
                        o[0] += bflo(z.x); o[1] += bfhi(z.x); o[2] += bflo(z.y); o[3] += bfhi(z.y); o[4] += bflo(z.z); o[5] += bfhi(z.z); o[6] += bflo(z.w); o[7] += bfhi(z.w); }
                    u32x4 w; w.x = cvt_pk_bf16(o[0], o[1]); w.y = cvt_pk_bf16(o[2], o[3]); w.z = cvt_pk_bf16(o[4], o[5]); w.w = cvt_pk_bf16(o[6], o[7]);
                    *(u32x4*)(Z + off + bj * HALF) = w;
                }
            }
    }
};
}

constexpr int NWAVES = 8, NTHR = 512;
constexpr int DM = 1024, NB = 4, SEQ = 8192, NLAT = NB * SEQ, NCTX = 256, NCTXR = NB * NCTX, NROWS = NLAT + NCTXR, NKEYS = SEQ + NCTX;
constexpr int DFF = 2816, INW = 7168, NMOD = 9;
constexpr float EPS = 1e-6f;
constexpr size_t MiB = 1u << 20;
constexpr size_t WS_MOD = 1 * MiB, WS_ROPE = 1 * MiB + 256 * 1024, WS_LAM = 1 * MiB + 512 * 1024;
constexpr size_t WS_W13A = 2 * MiB, WS_W2A = 13 * MiB, WS_W13B = WS_W2A + 11 * MiB / 2, WS_W2B = WS_W13B + 11 * MiB, WS_WIN = 35 * MiB, WS_WAP = 49 * MiB, WS_WCP = 51 * MiB, WS_WOUT = 53 * MiB;
constexpr size_t WS_H = 56 * MiB, WS_Y = 122 * MiB, WS_BIG = 188 * MiB;
constexpr size_t WS_ACT = WS_BIG, WS_Q = WS_BIG, WS_K = WS_BIG + 64 * MiB, WS_V = WS_K + 66 * MiB, WS_U = WS_V + 66 * MiB, WS_GB = WS_U + 64 * MiB, WS_END = WS_GB + 64 * MiB;
constexpr size_t WS_GA = WS_Y, WS_UC = WS_H, WS_OSCR = WS_U, WS_Z = WS_U;
static_assert(WS_END == 512 * MiB, "ws map");
static_assert(WS_W2B + 11 * MiB / 2 <= WS_WIN, "ws map weights");
constexpr int LDS_BYTES = 147456;

#define LAS __attribute__((address_space(3)))
typedef unsigned short bf16;
typedef unsigned v4u __attribute__((ext_vector_type(4)));
typedef unsigned v2u __attribute__((ext_vector_type(2)));
typedef float f32x4 __attribute__((ext_vector_type(4)));
#define LDS_WAIT() asm volatile("s_waitcnt lgkmcnt(0)" ::: "memory")
__device__ __forceinline__ unsigned f2bf(float f) { unsigned u = __builtin_bit_cast(unsigned, f); return (u + 0x7fffu + ((u >> 16) & 1u)) >> 16; }
__device__ __forceinline__ unsigned pk2(float lo, float hi) { return f2bf(lo) | (f2bf(hi) << 16); }
__device__ __forceinline__ float wave_sum(float v) {
#pragma unroll
    for (int o = 1; o < 64; o <<= 1) v += __shfl_xor(v, o);
    return v;
}

struct Args { const float* in[21]; float* out; unsigned char* ws; int pad0, pad1; };
enum { I_X = 0, I_C, I_CTX, I_CCTX, I_WADA, I_BADA, I_NORMG, I_F1W13, I_F1W2, I_F2W13, I_F2W2, I_WIN, I_LAMQK, I_SUBLN, I_WAP, I_CONVW, I_CONVB, I_CLNG, I_CLNB, I_WCP, I_WOUT };

template <int MODE> __device__ __forceinline__ int drow(int n0) {
    if (MODE == 1) { const int bj = n0 / DFF, j = n0 % DFF; return 256 * (j / 128) + 128 * bj + (j % 128); }
    if (MODE == 2) { if (n0 >= 3072 && n0 < 5120) { const int c = n0 - 3072, bj = c / 1024, j = c % 1024; return 3072 + 256 * (j / 128) + 128 * bj + (j % 128); } return n0; }
    return n0;
}
template <int MODE> __device__ __forceinline__ void transpose_item(const float* W, int K, int N, bf16* WT, LAS float* scr, int item, int lane) {
    const int nblk = N / 32, kb = item / nblk, nb = item % nblk, k0 = 64 * kb, n0 = 32 * nb, d0 = drow<MODE>(n0);
    float tv[32];
#pragma unroll
    for (int i = 0; i < 32; ++i) tv[i] = W[(size_t)(k0 + 2 * i + (lane >> 5)) * N + n0 + (lane & 31)];
#pragma unroll
    for (int i = 0; i < 32; ++i) scr[(2 * i + (lane >> 5)) * 33 + (lane & 31)] = tv[i];
    LDS_WAIT(); asm volatile("" ::: "memory");
    const int c = lane & 7;
#pragma unroll
    for (int j = 0; j < 4; ++j) { const int n = (lane >> 3) + 8 * j; const LAS float* s = scr + (8 * c) * 33 + n;
        v4u o; o.x = pk2(s[0 * 33], s[1 * 33]); o.y = pk2(s[2 * 33], s[3 * 33]); o.z = pk2(s[4 * 33], s[5 * 33]); o.w = pk2(s[6 * 33], s[7 * 33]);
        *(v4u*)(WT + (size_t)(d0 + n) * K + k0 + 8 * c) = o; }
    LDS_WAIT(); asm volatile("" ::: "memory");
}

template <bool HAS_Y, bool WRITE_X, bool WRITE_H>
__device__ __forceinline__ void norm_rows(int gw, int NGW, int lane, int row_lo, int nrows, const float* xlat, const float* xctx, const bf16* Y, float* xout, bf16* hout, const float* mod,
                                          float mult, const float* g_post, int k_gate, const float* g_pre, int k_in) {
    for (int row0 = row_lo + gw; row0 < nrows; row0 += 2 * NGW) {
        int rows[2]; rows[0] = row0; rows[1] = (row0 + NGW < nrows) ? row0 + NGW : row0;
        f32x4 v[2][4]; v2u yw[2][4]; const float* mp[2]; bool isctx[2];
#pragma unroll
        for (int r = 0; r < 2; ++r) {
            const int row = rows[r]; isctx[r] = row >= NLAT; const int mv = isctx[r] ? 4 : (row >> 13);
            const float* xr = isctx[r] ? xctx + (size_t)(row - NLAT) * DM : xlat + (size_t)row * DM;
            mp[r] = mod + (size_t)mv * (NMOD * DM);
#pragma unroll
            for (int j = 0; j < 4; ++j) v[r][j] = ((const f32x4*)xr)[lane + 64 * j];
            if (HAS_Y) {
#pragma unroll
                for (int j = 0; j < 4; ++j) yw[r][j] = ((const v2u*)(Y + (size_t)row * DM))[lane + 64 * j];
            }
        }
        if (HAS_Y) {
            f32x4 y[2][4]; float ss[2];
#pragma unroll
            for (int r = 0; r < 2; ++r) { ss[r] = 0.f;
#pragma unroll
                for (int j = 0; j < 4; ++j) { const v2u w = yw[r][j]; y[r][j] = (f32x4){pg8::bflo(w.x), pg8::bfhi(w.x), pg8::bflo(w.y), pg8::bfhi(w.y)};
                    ss[r] += (y[r][j].x * y[r][j].x + y[r][j].y * y[r][j].y) + (y[r][j].z * y[r][j].z + y[r][j].w * y[r][j].w); } }
#pragma unroll
            for (int o = 1; o < 64; o <<= 1) { ss[0] += __shfl_xor(ss[0], o); ss[1] += __shfl_xor(ss[1], o); }
#pragma unroll
            for (int r = 0; r < 2; ++r) { const float rstd = 1.0f / sqrtf(ss[r] * (1.f / DM) + EPS);
#pragma unroll
                for (int j = 0; j < 4; ++j) { const f32x4 gp = ((const f32x4*)g_post)[lane + 64 * j], gt = ((const f32x4*)(mp[r] + k_gate * DM))[lane + 64 * j];
                    v[r][j] = v[r][j] + (mult * gt) * ((y[r][j] * rstd) * gp); }
                if (WRITE_X && !isctx[r]) {
#pragma unroll
                    for (int j = 0; j < 4; ++j) ((f32x4*)(xout + (size_t)rows[r] * DM))[lane + 64 * j] = v[r][j];
                } }
        }
        if (WRITE_H) {
            float ss[2];
#pragma unroll
            for (int r = 0; r < 2; ++r) { ss[r] = 0.f;
#pragma unroll
                for (int j = 0; j < 4; ++j) ss[r] += (v[r][j].x * v[r][j].x + v[r][j].y * v[r][j].y) + (v[r][j].z * v[r][j].z + v[r][j].w * v[r][j].w); }
#pragma unroll
            for (int o = 1; o < 64; o <<= 1) { ss[0] += __shfl_xor(ss[0], o); ss[1] += __shfl_xor(ss[1], o); }
#pragma unroll
            for (int r = 0; r < 2; ++r) { const float rstd = 1.0f / sqrtf(ss[r] * (1.f / DM) + EPS);
#pragma unroll
                for (int j = 0; j < 4; ++j) { const f32x4 gp = ((const f32x4*)g_pre)[lane + 64 * j], sh = ((const f32x4*)(mp[r] + k_in * DM))[lane + 64 * j], sc = ((const f32x4*)(mp[r] + (k_in + 1) * DM))[lane + 64 * j];
                    const f32x4 h = ((v[r][j] * rstd) * gp) * (1.0f + sc) + sh;
                    v2u w; w.x = pk2(h.x, h.y); w.y = pk2(h.z, h.w); ((v2u*)(hout + (size_t)rows[r] * DM))[lane + 64 * j] = w; } }
        }
    }
}

#define RLX_AGENT __ATOMIC_RELAXED, __HIP_MEMORY_SCOPE_AGENT
#define XB_TMO      128
#define XB_XCNT(j)  (256  + 64 * (j))
#define XB_XSUB(j)  (1280 + 64 * (j))
#define XB_XGEN(j)  (2304 + 64 * (j))
#define XB_TOP      3328
#define XB_TOPGEN   3392
#define XCD_BAR_WORDS 3456
#define XB_SPIN_CAP (1u << 22)

__device__ __forceinline__ unsigned xb_ld(unsigned* p)              { return __hip_atomic_load(p, __ATOMIC_RELAXED, __HIP_MEMORY_SCOPE_AGENT); }
__device__ __forceinline__ unsigned xb_add(unsigned* p, unsigned v) { return __hip_atomic_fetch_add(p, v, __ATOMIC_RELAXED, __HIP_MEMORY_SCOPE_AGENT); }
__device__ __forceinline__ unsigned xb_xcc_id() { return (unsigned)__builtin_amdgcn_s_getreg((3 << 11) | 20) & 0xFu; }
#define XB_SPIN(cond, bar) do { unsigned _sp = 0; while (cond) { __builtin_amdgcn_s_sleep(1); \
    if ((++_sp & 255u) == 0u) { if (xb_ld(&(bar)[XB_TMO])) break; if (_sp > XB_SPIN_CAP) { atomicAdd(&(bar)[XB_TMO], 1u); break; } } } } while (0)

struct XcdBarrier {
    unsigned* bar; unsigned x;
    volatile LAS unsigned* st;
};

__device__ __forceinline__ XcdBarrier xcd_barrier_post(unsigned* bar, volatile LAS unsigned* st) {
    XcdBarrier b; b.bar = bar; b.x = xb_xcc_id(); b.st = st;
    if (threadIdx.x == 0) (void)xb_add(&bar[XB_XCNT(b.x)], 1u);
    return b;
}
__device__ __forceinline__ void xcd_barrier_complete(unsigned* bar, unsigned x, unsigned& nloc, unsigned& nx) {
    const unsigned G = gridDim.x * gridDim.y * gridDim.z;
    unsigned sum, cnt, mine, sp = 0u;
    for (;;) {
        sum = 0u; cnt = 0u; mine = 0u;
#pragma unroll
        for (unsigned j = 0; j < 16; ++j) { const unsigned c = xb_ld(&bar[XB_XCNT(j)]); sum += c; cnt += (c > 0u) ? 1u : 0u; mine = (j == x) ? c : mine; }
        if (sum == G) break;
        __builtin_amdgcn_s_sleep(1);
        if ((++sp & 255u) == 0u) { if (xb_ld(&bar[XB_TMO])) break; if (sp > XB_SPIN_CAP) { atomicAdd(&bar[XB_TMO], 1u); break; } }
    }
    nloc = mine > 0u ? mine : 1u; nx = cnt > 0u ? cnt : 1u;
}

__device__ __forceinline__ void xcd_barrier(const XcdBarrier& b) {
    asm volatile("s_waitcnt vmcnt(0)" ::: "memory");
    __syncthreads();
    if (threadIdx.x == 0) {
        unsigned* bar = b.bar;
        __builtin_amdgcn_s_waitcnt(0);
        unsigned nloc = b.st[0], nx = b.st[1];
        if (nloc == 0u) { xcd_barrier_complete(bar, b.x, nloc, nx); b.st[0] = nloc; b.st[1] = nx; }
        const unsigned old = xb_add(&bar[XB_XSUB(b.x)], 1u);
        const unsigned gen = old / nloc;
        if (old + 1u == (gen + 1u) * nloc) {
            __builtin_amdgcn_fence(__ATOMIC_RELEASE, "agent");
            asm volatile("s_waitcnt vmcnt(0)" ::: "memory");
            const unsigned og = xb_add(&bar[XB_TOP], 1u);
            const unsigned tg = og / nx;
            if (og + 1u == (tg + 1u) * nx) xb_add(&bar[XB_TOPGEN], 1u);
            else XB_SPIN(xb_ld(&bar[XB_TOPGEN]) == tg, bar);
            __builtin_amdgcn_fence(__ATOMIC_ACQUIRE, "agent");
            xb_add(&bar[XB_XGEN(b.x)], 1u);
            asm volatile("s_waitcnt vmcnt(0)" ::: "memory");
        } else {
            XB_SPIN(xb_ld(&bar[XB_XGEN(b.x)]) == gen, bar);
            __builtin_amdgcn_fence(__ATOMIC_ACQUIRE, "agent");
            asm volatile("s_waitcnt vmcnt(0)" ::: "memory");
        }
    }
    __syncthreads();
}

__global__ void __launch_bounds__(NTHR, 2) fwd_mega(Args args) {
    extern __shared__ __attribute__((aligned(16))) unsigned char lds[];
    cg::grid_group grid = cg::this_grid();
#define GSYNC_CG() do { asm volatile("s_waitcnt vmcnt(0) lgkmcnt(0)" ::: "memory"); grid.sync(); __builtin_amdgcn_fence(__ATOMIC_ACQUIRE, "agent"); asm volatile("s_waitcnt vmcnt(0)" ::: "memory"); } while (0)
#define GSYNC() xcd_barrier(xbar)
    LAS unsigned char* L = (LAS unsigned char*)lds;
    const int tid = threadIdx.x, lane = tid & 63, wave = __builtin_amdgcn_readfirstlane(tid >> 6);
    const int G = gridDim.x, bx = blockIdx.x, vcu = (G % 8 == 0) ? (bx % 8) * (G / 8) + bx / 8 : bx;
    const int gw = vcu * NWAVES + wave, NGW = G * NWAVES;
    unsigned char* ws = args.ws;
    volatile LAS unsigned* xst = (volatile LAS unsigned*)(L + LDS_BYTES - 64);
    static_assert(attn2::PARK_OFF + attn2::PARK_BYTES <= LDS_BYTES - 64, "LDS map");
    if (tid < 2) xst[tid] = 0u;
    __syncthreads();
    XcdBarrier xbar = xcd_barrier_post((unsigned*)ws, xst);
    float* mod = (float*)(ws + WS_MOD); float* rope = (float*)(ws + WS_ROPE); float* lamp = (float*)(ws + WS_LAM);
    bf16 *W13A = (bf16*)(ws + WS_W13A), *W2A = (bf16*)(ws + WS_W2A), *W13B = (bf16*)(ws + WS_W13B), *W2B = (bf16*)(ws + WS_W2B), *WIN = (bf16*)(ws + WS_WIN), *WAP = (bf16*)(ws + WS_WAP), *WCP = (bf16*)(ws + WS_WCP), *WOUT = (bf16*)(ws + WS_WOUT);
    bf16 *H = (bf16*)(ws + WS_H), *Y = (bf16*)(ws + WS_Y), *ACT = (bf16*)(ws + WS_ACT), *Qb = (bf16*)(ws + WS_Q), *Kb = (bf16*)(ws + WS_K), *Vb = (bf16*)(ws + WS_V), *Ub = (bf16*)(ws + WS_U), *GA = (bf16*)(ws + WS_GA), *GB = (bf16*)(ws + WS_GB);
    bf16 *UC = (bf16*)(ws + WS_UC), *OSCR = (bf16*)(ws + WS_OSCR), *Zb = (bf16*)(ws + WS_Z);
    const float* x = args.in[I_X]; const float* ctx = args.in[I_CTX]; const float* normg = args.in[I_NORMG]; float* out = args.out;

    {
        LAS float* sc = (LAS float*)L;
        LAS float* red = (LAS float*)(L + 20480);
        if (bx < 144) {
            for (int i = tid; i < 5 * DM; i += NTHR) { const float c = i < 4 * DM ? args.in[I_C][i] : args.in[I_CCTX][i - 4 * DM]; sc[i] = c / (1.0f + expf(-c)); }
            __syncthreads();
            for (int it = bx; it < 144; it += G) {
                const int col = it * 64 + lane; const float* wp = args.in[I_WADA] + (size_t)(wave * 128) * (NMOD * DM) + col;
                float a0 = 0.f, a1 = 0.f, a2 = 0.f, a3 = 0.f, a4 = 0.f;
#pragma unroll 32
                for (int kk = 0; kk < 128; ++kk) { const float w = wp[(size_t)kk * (NMOD * DM)]; const int k = wave * 128 + kk;
                    a0 += sc[k] * w; a1 += sc[DM + k] * w; a2 += sc[2 * DM + k] * w; a3 += sc[3 * DM + k] * w; a4 += sc[4 * DM + k] * w; }
                red[(wave * 5 + 0) * 64 + lane] = a0; red[(wave * 5 + 1) * 64 + lane] = a1; red[(wave * 5 + 2) * 64 + lane] = a2; red[(wave * 5 + 3) * 64 + lane] = a3; red[(wave * 5 + 4) * 64 + lane] = a4;
                __syncthreads();
                if (tid < 320) { const int v = tid >> 6, cl = tid & 63; float s = 0.f;
#pragma unroll
                    for (int w8 = 0; w8 < 8; ++w8) s += red[(w8 * 5 + v) * 64 + cl];
                    mod[(size_t)v * (NMOD * DM) + it * 64 + cl] = s + args.in[I_BADA][it * 64 + cl]; }
                __syncthreads();
            }
        }
        if (bx == G - 1) {
            for (int i = tid; i < 2048; i += NTHR) { const int pos = i >> 4, f = i & 15; double inv = 1.0; for (int j = 0; j < f; ++j) inv *= 0.56234132519034908; const double ang = (double)pos * inv; rope[i] = (float)cos(ang); rope[2048 + i] = (float)sin(ang); }
        }
        if (bx == G - 2 && tid < 64) {
            const float* lq = args.in[I_LAMQK];
            const float s01 = wave_sum(lq[tid] * lq[64 + tid]), s23 = wave_sum(lq[128 + tid] * lq[192 + tid]);
            if (tid == 0) lamp[0] = expf(s01) - expf(s23) + 0.2f;
        }
        __syncthreads();
        LAS float* scr = (LAS float*)(L + wave * 16384);
        constexpr int I_13 = (DM / 64) * (2 * DFF / 32), I_2 = (DFF / 64) * (DM / 32);
        for (int it = gw; it < I_13 + I_2; it += NGW) {
            if (it < I_13) transpose_item<1>(args.in[I_F1W13], DM, 2 * DFF, W13A, scr, it, lane);
            else transpose_item<0>(args.in[I_F1W2], DFF, DM, W2A, scr, it - I_13, lane);
        }
    }
    if (args.pad0 != 0) GSYNC_CG();
    GSYNC();
    norm_rows<false, false, true>(gw, NGW, lane, 0, NROWS, x, ctx, nullptr, nullptr, H, mod, 0.f, nullptr, 0, normg + 0 * DM, 0);
    GSYNC();
    { pg8::Gemm g{H, W13A, NROWS, 2 * DFF, DM}; pg8::StaticOrder S; S.init(NROWS, 2 * DFF, G, bx); pg8::EpiSwiglu E{ACT, DFF};
      pg8::gemm_phase<pg8::EpiSwiglu, pg8::StaticOrder, PG8_ALIGN, PG8_SP2>(L, g, S, E); }
    {
        constexpr int NU = (NROWS / 256) * (2 * DFF / 256), NFULL = NU / 256, NREM = NU - NFULL * 256;
        static_assert(NREM > 0 && NREM < 256, "partial round");
        if (G == 256 ? bx >= NREM : true) {
            const int nhelp = (G == 256) ? (256 - NREM) : G, hid = (G == 256) ? bx - NREM : bx;
            LAS float* scr = (LAS float*)(L + wave * 16384);
            constexpr int I_13 = (DM / 64) * (2 * DFF / 32), I_2 = (DFF / 64) * (DM / 32), I_IN = (DM / 64) * (INW / 32), I_SQ = (DM / 64) * (DM / 32);
            constexpr int NITEMS = I_13 + I_2 + I_IN + 3 * I_SQ;
            for (int it = hid * NWAVES + wave; it < NITEMS; it += nhelp * NWAVES) {
                int r = it;
                if (r < I_IN) { transpose_item<2>(args.in[I_WIN], DM, INW, WIN, scr, r, lane); continue; } r -= I_IN;
                if (r < I_SQ) { transpose_item<0>(args.in[I_WAP], DM, DM, WAP, scr, r, lane); continue; } r -= I_SQ;
                if (r < I_SQ) { transpose_item<0>(args.in[I_WCP], DM, DM, WCP, scr, r, lane); continue; } r -= I_SQ;
                if (r < I_SQ) { transpose_item<0>(args.in[I_WOUT], DM, DM, WOUT, scr, r, lane); continue; } r -= I_SQ;
                if (r < I_13) { transpose_item<1>(args.in[I_F2W13], DM, 2 * DFF, W13B, scr, r, lane); continue; } r -= I_13;
                transpose_item<0>(args.in[I_F2W2], DFF, DM, W2B, scr, r, lane);
            }
        }
    }
    GSYNC();
    { pg8::Gemm g{ACT, W2A, NLAT, DM, DFF}; pg8::StaticOrder S; S.init(NLAT, DM, G, bx); pg8::EpiBf16<0> E{Y, DM, nullptr, 0, 0, 1.f};
      pg8::gemm_phase<pg8::EpiBf16<0>, pg8::StaticOrder, PG8_ALIGN, PG8_SP2>(L, g, S, E); }
    GSYNC();
    if (G == 256) {
        if (bx < 16) { pg8::Gemm g{ACT + (size_t)NLAT * DFF, W2A, NCTXR, DM, DFF}; pg8::StaticOrder S; S.init(NCTXR, DM, G, bx); pg8::EpiBf16<0> E{Y + (size_t)NLAT * DM, DM, nullptr, 0, 0, 1.f};
            pg8::gemm_phase<pg8::EpiBf16<0>, pg8::StaticOrder, PG8_ALIGN, PG8_SP2>(L, g, S, E); }
        else norm_rows<true, true, true>((bx - 16) * NWAVES + wave, (G - 16) * NWAVES, lane, 0, NLAT, x, ctx, Y, out, H, mod, 0.5f, normg + 1 * DM, 2, normg + 2 * DM, 3);
    } else {
        { pg8::Gemm g{ACT + (size_t)NLAT * DFF, W2A, NCTXR, DM, DFF}; pg8::StaticOrder S; S.init(NCTXR, DM, G, bx); pg8::EpiBf16<0> E{Y + (size_t)NLAT * DM, DM, nullptr, 0, 0, 1.f};
          pg8::gemm_phase<pg8::EpiBf16<0>, pg8::StaticOrder, PG8_ALIGN, PG8_SP2>(L, g, S, E); }
        norm_rows<true, true, true>(gw, NGW, lane, 0, NLAT, x, ctx, Y, out, H, mod, 0.5f, normg + 1 * DM, 2, normg + 2 * DM, 3);
    }
    GSYNC();
    norm_rows<true, true, true>(gw, NGW, lane, NLAT, NROWS, x, ctx, Y, out, H, mod, 0.5f, normg + 1 * DM, 2, normg + 2 * DM, 3);
    GSYNC();
    { pg8::Gemm g{H, WIN, NLAT, INW, DM}; pg8::StaticOrder S; S.init(NLAT, INW, G, bx);
      pg8::EpiWin E{Qb, Kb, Vb, Ub, GA, GB, rope, 1.0f};

      pg8::gemm_phase<pg8::EpiWin, pg8::StaticOrder, PG8_ALIGN, PG8_SP2>(L, g, S, E);
    }
    { pg8::Gemm g{H + (size_t)NLAT * DM, WIN + (size_t)1024 * DM, NCTXR, 2048, DM}; pg8::StaticOrder S; S.init(NCTXR, 2048, G, bx); pg8::EpiKVc E{Kb, Vb};
      pg8::gemm_phase<pg8::EpiKVc, pg8::StaticOrder, PG8_ALIGN, PG8_SP2>(L, g, S, E); }
    GSYNC();
    {
        const int c0 = 2 * tid;
        float w0[31], w1[31];
#pragma unroll
        for (int k = 0; k < 31; ++k) { const float2 w = *(const float2*)(args.in[I_CONVW] + k * DM + c0); w0[k] = w.x; w1[k] = w.y; }
        const float2 cb = *(const float2*)(args.in[I_CONVB] + c0), lg = *(const float2*)(args.in[I_CLNG] + c0), lb = *(const float2*)(args.in[I_CLNB] + c0);
        LAS float* red = (LAS float*)L;
        LAS float* stat = (LAS float*)(L + 2048);
        for (int item = vcu; item < NLAT / 16; item += G) {
            const int tg = item * 16, b = tg >> 13, t0 = tg & 8191;
            float a0[16], a1[16];
#pragma unroll
            for (int o = 0; o < 16; ++o) { a0[o] = 0.f; a1[o] = 0.f; }
#pragma unroll
            for (int i = 0; i < 46; ++i) {
                const int t = t0 - 15 + i; const bool valid = (t >= 0) && (t < SEQ); const int tt = valid ? t : t0;
                const unsigned wv = *(const unsigned*)(Ub + ((size_t)(b * SEQ + tt)) * DM + c0);
                const float x0 = valid ? pg8::bflo(wv) : 0.f, x1 = valid ? pg8::bfhi(wv) : 0.f;
#pragma unroll
                for (int o = 0; o < 16; ++o) { if (i - o >= 0 && i - o <= 30) { a0[o] += w0[i - o] * x0; a1[o] += w1[i - o] * x1; } }
            }
#pragma unroll
            for (int o = 0; o < 16; ++o) { a0[o] += cb.x; a1[o] += cb.y; const float s = wave_sum(a0[o] + a1[o]), ss = wave_sum(a0[o] * a0[o] + a1[o] * a1[o]);
                if (lane == 0) { red[wave * 32 + 2 * o] = s; red[wave * 32 + 2 * o + 1] = ss; } }
            __syncthreads();
            if (tid < 32) { float s = 0.f;
#pragma unroll
                for (int w8 = 0; w8 < 8; ++w8) s += red[w8 * 32 + tid];
                stat[tid] = s; }
            __syncthreads();
#pragma unroll
            for (int o = 0; o < 16; ++o) { const float mean = stat[2 * o] * (1.f / DM), var = stat[2 * o + 1] * (1.f / DM) - mean * mean, rstd = 1.0f / sqrtf(fmaxf(var, 0.f) + EPS);
                const float y0 = (a0[o] - mean) * rstd * lg.x + lb.x, y1 = (a1[o] - mean) * rstd * lg.y + lb.y;
                *(unsigned*)(UC + ((size_t)(tg + o)) * DM + c0) = pk2(pg8::fsilu(y0), pg8::fsilu(y1)); }
        }
    }
    __syncthreads();
    {
        const float lam = lamp[0];
#pragma unroll 1
        for (int un = vcu; un < NB * 8 * (SEQ / 256); un += G) {
            const int qb = un & 31, bh = (un >> 8) * 8 + ((un & 255) >> 5), b = bh >> 3, h = bh & 7;
            const size_t qrow0 = (size_t)b * SEQ + (size_t)qb * 256;
            const bf16* kbase = Kb + (size_t)b * NKEYS * DM; const bf16* vbase = Vb + (size_t)b * NKEYS * DM + h * 128;
            attn2::body<0>(Qb + qrow0 * DM + (2 * h) * 64, kbase + (2 * h) * 64, vbase, NKEYS, (char*)lds, lam, args.in[I_SUBLN], nullptr);
            attn2::body<1>(Qb + qrow0 * DM + (2 * h + 1) * 64, kbase + (2 * h + 1) * 64, vbase, NKEYS, (char*)lds, lam, args.in[I_SUBLN], Qb + qrow0 * DM + h * 128);
        }
    }
    GSYNC();
    { pg8::Gemm g{Qb, WAP, NLAT, DM, DM}; pg8::StaticOrder S; S.init(NLAT, DM, G, bx); pg8::EpiGate<false> E{Zb, GA};
      pg8::gemm_phase<pg8::EpiGate<false>, pg8::StaticOrder, PG8_ALIGN, PG8_SP2>(L, g, S, E); }
    asm volatile("s_waitcnt vmcnt(0)" ::: "memory");
    { pg8::Gemm g{UC, WCP, NLAT, DM, DM}; pg8::StaticOrder S; S.init(NLAT, DM, G, bx); pg8::EpiGate<true> E{Zb, GB};
      pg8::gemm_phase<pg8::EpiGate<true>, pg8::StaticOrder, PG8_ALIGN, PG8_SP2>(L, g, S, E); }
    GSYNC();
    { pg8::Gemm g{Zb, WOUT, NLAT, DM, DM}; pg8::StaticOrder S; S.init(NLAT, DM, G, bx); pg8::EpiBf16<0> E{Y, DM, nullptr, 0, 0, 1.f};
      pg8::gemm_phase<pg8::EpiBf16<0>, pg8::StaticOrder, PG8_ALIGN, PG8_SP2>(L, g, S, E);
    }
    GSYNC();
    norm_rows<true, true, true>(gw, NGW, lane, 0, NLAT, out, ctx, Y, out, H, mod, 1.0f, normg + 3 * DM, 5, normg + 4 * DM, 6);
    GSYNC();
    { pg8::Gemm g{H, W13B, NLAT, 2 * DFF, DM}; pg8::StaticOrder S; S.init(NLAT, 2 * DFF, G, bx); pg8::EpiSwiglu E{ACT, DFF};
      pg8::gemm_phase<pg8::EpiSwiglu, pg8::StaticOrder, PG8_ALIGN, PG8_SP2>(L, g, S, E);
    }
    GSYNC();
    { pg8::Gemm g{ACT, W2B, NLAT, DM, DFF}; pg8::StaticOrder S; S.init(NLAT, DM, G, bx); pg8::EpiBf16<0> E{Y, DM, nullptr, 0, 0, 1.f};
      pg8::gemm_phase<pg8::EpiBf16<0>, pg8::StaticOrder, PG8_ALIGN, PG8_SP2>(L, g, S, E);
    }
    GSYNC();
    norm_rows<true, true, false>(gw, NGW, lane, 0, NLAT, out, ctx, Y, out, nullptr, mod, 0.5f, normg + 5 * DM, 8, nullptr, 0);
}

extern "C" void kernel_launch(void* const* d_in, const int* in_sizes, int n_in, void* d_out, int out_size, void* d_ws, size_t ws_size, hipStream_t stream) {
    static int grid = 0;
    if (grid == 0) {
        if (n_in != 21 || ws_size < WS_END || out_size != NLAT * DM) { fprintf(stderr, "kernel_launch: unexpected shapes (n_in %d, out %d, ws %zu)\n", n_in, out_size, ws_size); grid = -1; return; }
        int dev = 0, cus = 0, per_cu = 0;
        if (hipGetDevice(&dev) != hipSuccess || hipDeviceGetAttribute(&cus, hipDeviceAttributeMultiprocessorCount, dev) != hipSuccess) { grid = -1; return; }
        if (hipFuncSetAttribute((const void*)fwd_mega, hipFuncAttributeMaxDynamicSharedMemorySize, LDS_BYTES) != hipSuccess) { fprintf(stderr, "kernel_launch: hipFuncSetAttribute failed\n"); grid = -1; return; }
        if (hipOccupancyMaxActiveBlocksPerMultiprocessor(&per_cu, (const void*)fwd_mega, NTHR, LDS_BYTES) != hipSuccess || per_cu < 1) fprintf(stderr, "kernel_launch: occupancy query says %d\n", per_cu);
        (void)hipGetLastError();
        grid = cus;
    }
    if (grid < 0) return;
    if (hipMemsetAsync(d_ws, 0, 16384, stream) != hipSuccess) { fprintf(stderr, "kernel_launch: memset of the barrier words failed\n"); return; }
    Args a{};
    for (int i = 0; i < 21; ++i) a.in[i] = (const float*)d_in[i];
    a.out = (float*)d_out; a.ws = (unsigned char*)d_ws;
    void* kargs[] = {&a};
    const hipError_t e = hipLaunchCooperativeKernel((const void*)fwd_mega, dim3(grid), dim3(NTHR), kargs, LDS_BYTES, stream);
    if (e != hipSuccess) fprintf(stderr, "cooperative launch failed: %s (grid %d)\n", hipGetErrorString(e), grid);
}
```

```cpp
#include <hip/hip_runtime.h>
#include <hip/hip_cooperative_groups.h>
#include <cstdio>
#include <cstdint>
namespace cg = cooperative_groups;
namespace pg8 {
#define PG8_LAS __attribute__((address_space(3)))
typedef unsigned short bf16_t;
typedef short bf16x8 __attribute__((ext_vector_type(8)));
typedef float f32x4 __attribute__((ext_vector_type(4)));
typedef unsigned u32x4 __attribute__((ext_vector_type(4)));
constexpr int BM = 256, BK = 64, HALF = 128, HTB = HALF * BK * 2  , STAGE_BYTES = 8 * HTB, NXCD = 8, WGM = 8;

__host__ __device__ __forceinline__ int lds_byte(int r, int c) { const int st = (r >> 4) * 2 + (c >> 5), rr = r & 15, cc = c & 31, ob = rr * 64 + cc * 2; return st * 1024 + (ob ^ (((ob >> 9) & 1) << 5)); }
__host__ __device__ __forceinline__ void stage_rc(int b, int& R, int& C) { const int st = b / 1024, sb = b % 1024, swz = sb ^ (((sb >> 9) & 1) << 5); R = (st >> 1) * 16 + swz / 64; C = (st & 1) * 32 + (swz % 64) / 2; }
__host__ __device__ __forceinline__ int perm32(int rho) { const int n = rho >> 4, i = rho & 15; return 8 * (i >> 2) + 4 * n + (i & 3); }

struct Unit { int pm, pn; };
struct Gemm { const bf16_t* A; const bf16_t* Bt; int M, N, K; };

struct StaticOrder {
    int nM, nN, nwg, G, c;
    __host__ __device__ void init(int M, int N, int G_, int c_) { nM = M / BM; nN = N / BM; nwg = nM * nN; G = G_; c = c_; }
    __host__ __device__ bool next(int i, Unit& u) const {
        const long L = (long)i * G + c; if (L >= nwg) return false;
        int wgid = (int)L; { const int q = nwg / NXCD, r = nwg % NXCD, xcd = wgid % NXCD, off = wgid / NXCD; wgid = (xcd < r ? xcd * (q + 1) : r * (q + 1) + (xcd - r) * q) + off; }
        const int nig = WGM * nN, gid = wgid / nig, fm = gid * WGM, gsz = (nM - fm) < WGM ? (nM - fm) : WGM;
        u.pm = fm + ((wgid % nig) % gsz); u.pn = (wgid % nig) / gsz; return true;
    }
    __device__ __forceinline__ void a_ready(const Unit&) const {}
    __device__ __forceinline__ void done(const Unit&) const {}
};

typedef float f32x2c_t __attribute__((ext_vector_type(2))); typedef __bf16 bf16x2c_t __attribute__((ext_vector_type(2)));
__device__ __forceinline__ unsigned cvt_pk_bf16(float lo, float hi) { f32x2c_t v = {lo, hi}; bf16x2c_t b = __builtin_convertvector(v, bf16x2c_t); return __builtin_bit_cast(unsigned, b); }
typedef float f32x2 __attribute__((ext_vector_type(2)));
__device__ __forceinline__ f32x2 gelu_pk(f32x2 v) {
    const f32x2 av = __builtin_elementwise_abs(v), d = av * 0.2316418882f + 1.0f;
    f32x2 t; t.x = __builtin_amdgcn_rcpf(d.x); t.y = __builtin_amdgcn_rcpf(d.y);
    f32x2 q = t * 0.5307027145f + (-0.7265760135f); q = q * t + 0.7107068705f; q = q * t + (-0.142248368f); q = q * t + 0.127414796f; q = q * t;
    const f32x2 s = (v * v) * (-0.72134752044f);
    f32x2 e; e.x = __builtin_amdgcn_exp2f(s.x); e.y = __builtin_amdgcn_exp2f(s.y);
    const f32x2 m = v * (q * e), r = v - m;
    f32x2 o; o.x = v.x < 0.f ? m.x : r.x; o.y = v.y < 0.f ? m.y : r.y; return o;
}

template <int ACT  > struct EpiBf16 {
    static constexpr bool PERM = true, AFTER_DRAIN = false; static_assert(ACT == 0 || ACT == 1, "EpiBf16: ACT is 0 (none) or 1 (gelu_pk)");
    bf16_t* O; int ldc; const float* bias; int split_cols; size_t split_stride; float scale0;
    __device__ __forceinline__ void operator()(const f32x4 (&acc)[2][2][4][2], const Unit& u, int wr, int wc, int fr, int fq) const {
        const int row0 = u.pm * BM + wr * 64 + fr; int colt = u.pn * BM; bf16_t* base = O;
        float sc = 1.f; if (split_cols) { const int t = colt / split_cols; base += (size_t)t * split_stride; colt -= t * split_cols; if (t == 0) sc = scale0; }
        const int col0 = colt + wc * 32 + 8 * fq, bcol0 = u.pn * BM + wc * 32 + 8 * fq;
        f32x4 bv[2][2];
#pragma unroll
        for (int bj = 0; bj < 2; ++bj)
#pragma unroll
            for (int n = 0; n < 2; ++n) bv[bj][n] = bias ? *(const f32x4*)(bias + bcol0 + bj * HALF + 4 * n) : (f32x4){0.f, 0.f, 0.f, 0.f};
#pragma unroll
        for (int ai = 0; ai < 2; ++ai)
#pragma unroll
            for (int m = 0; m < 4; ++m) { bf16_t* rowp = base + (size_t)(row0 + ai * HALF + m * 16) * ldc + col0;
#pragma unroll
                for (int bj = 0; bj < 2; ++bj) { f32x4 v0 = acc[ai][bj][m][0] + bv[bj][0], v1 = acc[ai][bj][m][1] + bv[bj][1];
                    if (ACT == 1) { f32x2 a = gelu_pk((f32x2){v0[0], v0[1]}), b = gelu_pk((f32x2){v0[2], v0[3]}), c = gelu_pk((f32x2){v1[0], v1[1]}), d = gelu_pk((f32x2){v1[2], v1[3]});
                        v0 = (f32x4){a.x, a.y, b.x, b.y}; v1 = (f32x4){c.x, c.y, d.x, d.y}; }
                    v0 = v0 * sc; v1 = v1 * sc; u32x4 w; w.x = cvt_pk_bf16(v0[0], v0[1]); w.y = cvt_pk_bf16(v0[2], v0[3]); w.z = cvt_pk_bf16(v1[0], v1[1]); w.w = cvt_pk_bf16(v1[2], v1[3]);
                    *(u32x4*)(rowp + bj * HALF) = w; } }
    }
};
template <class Epi, class Sched, bool ALIGN_EPI = false, bool SP2 = false>
__device__ __forceinline__ void gemm_phase(PG8_LAS unsigned char* lds, const Gemm g, const Sched& S, const Epi& E) {
    int tid_ = threadIdx.x; asm volatile("" : "+v"(tid_));
    const int tid = tid_, wid = __builtin_amdgcn_readfirstlane(tid >> 6), lane = tid & 63, wr = wid >> 2, wc = wid & 3, fr = lane & 15, fq = lane >> 4;
    const int K = g.K, nt = K / BK;
    unsigned voffA[2], voffB[2];
#pragma unroll
    for (int i = 0; i < 2; ++i) { int R, C; stage_rc(tid * 16 + i * 8192, R, C); const int Rb = Epi::PERM ? ((R & ~31) + perm32(R & 31)) : R;
        voffA[i] = (unsigned)(R * K + C) * 2u; voffB[i] = (unsigned)(Rb * K + C) * 2u; }
    const size_t kstep = (size_t)(BK * 2);
    const size_t hstep = (size_t)HALF * K * 2;
    const size_t tstep = 2 * hstep;
    const unsigned ldsw = (unsigned)wid * 1024u;
    const int aoff = lds_byte(wr * 64 + fr, fq * 8), boff = lds_byte(wc * 32 + fr, fq * 8);
#define PG8_SA(b, h) (((b) * 2 + (h)) * HTB)
#define PG8_SB(b, h) ((4 + (b) * 2 + (h)) * HTB)
#define PG8_STAGE(bufoff, gbase, voff) do { _Pragma("unroll") for (int _i = 0; _i < 2; ++_i) \
        __builtin_amdgcn_global_load_lds((const unsigned*)((const char*)(gbase) + (voff)[_i]), (PG8_LAS unsigned*)(lds + (bufoff) + ldsw + _i * 8192), 16, 0, 0); } while (0)
#define PG8_LDA(dst, b, h) do { _Pragma("unroll") for (int m = 0; m < 4; ++m) _Pragma("unroll") for (int k = 0; k < 2; ++k) dst[m][k] = *(const PG8_LAS bf16x8*)(lds + PG8_SA(b, h) + aoff + m * 2048 + k * 1024); } while (0)
#define PG8_LDB(dst, b, h) do { _Pragma("unroll") for (int n = 0; n < 2; ++n) _Pragma("unroll") for (int k = 0; k < 2; ++k) dst[n][k] = *(const PG8_LAS bf16x8*)(lds + PG8_SB(b, h) + boff + n * 2048 + k * 1024); } while (0)
#define PG8_MMA(ai, bj, At, Bt) do { __builtin_amdgcn_s_setprio(1); _Pragma("unroll") for (int m = 0; m < 4; ++m) _Pragma("unroll") for (int n = 0; n < 2; ++n) _Pragma("unroll") for (int k = 0; k < 2; ++k) \
        acc[ai][bj][m][n] = __builtin_amdgcn_mfma_f32_16x16x32_bf16(Bt[n][k], At[m][k], acc[ai][bj][m][n], 0, 0, 0); __builtin_amdgcn_s_setprio(0); } while (0)
#define PG8_WAIT_V(n) asm volatile("s_waitcnt vmcnt(" #n ")" ::: "memory")
#define PG8_WAIT_L(n) asm volatile("s_waitcnt lgkmcnt(" #n ")" ::: "memory")
#define PG8_BAR __builtin_amdgcn_s_barrier()
#define PG8_SCHED __builtin_amdgcn_sched_barrier(0)
    Unit cur, nxt; int ui = 0;
    if (!S.next(0, cur)) return;
    f32x4 acc[2][2][4][2];
#pragma unroll
    for (int a = 0; a < 2; ++a)
#pragma unroll
        for (int b = 0; b < 2; ++b)
#pragma unroll
            for (int m = 0; m < 4; ++m)
#pragma unroll
                for (int n = 0; n < 2; ++n) acc[a][b][m][n] = (f32x4){0.f, 0.f, 0.f, 0.f};
    bf16x8 At[4][2], B0[2][2], B1[2][2];
    const char* cA = (const char*)g.A + (size_t)cur.pm * tstep; const char* cB = (const char*)g.Bt + (size_t)cur.pn * tstep;
    S.a_ready(cur);
    if constexpr (SP2) {
        PG8_STAGE(PG8_SB(0, 0), cB, voffB); PG8_STAGE(PG8_SB(0, 1), cB + hstep, voffB); PG8_STAGE(PG8_SA(0, 0), cA, voffA); PG8_STAGE(PG8_SA(0, 1), cA + hstep, voffA);
        if (wr == 1) PG8_BAR;
        PG8_WAIT_V(2); PG8_BAR;
        PG8_STAGE(PG8_SB(1, 0), cB + kstep, voffB); PG8_STAGE(PG8_SA(1, 0), cA + kstep, voffA); PG8_STAGE(PG8_SB(1, 1), cB + hstep + kstep, voffB);
        PG8_WAIT_V(6); PG8_BAR;
    } else {
        PG8_STAGE(PG8_SB(0, 0), cB, voffB); PG8_STAGE(PG8_SA(0, 0), cA, voffA); PG8_STAGE(PG8_SB(0, 1), cB + hstep, voffB); PG8_STAGE(PG8_SA(0, 1), cA + hstep, voffA);
        if (wr == 1) PG8_BAR;
        PG8_WAIT_V(4); PG8_BAR;
        PG8_STAGE(PG8_SB(1, 0), cB + kstep, voffB); PG8_STAGE(PG8_SA(1, 0), cA + kstep, voffA); PG8_STAGE(PG8_SB(1, 1), cB + hstep + kstep, voffB);
        PG8_WAIT_V(6); PG8_BAR;
    }
    for (;;) {
        const bool has_next = S.next(ui + 1, nxt);
        const char* nA = has_next ? (const char*)g.A + (size_t)nxt.pm * tstep : cA; const char* nB = has_next ? (const char*)g.Bt + (size_t)nxt.pn * tstep : cB;
        for (int t = 0; t < nt; t += 2) {
            const bool last = (t == nt - 2);
            const char* a1 = cA + (size_t)(t + 1) * kstep;
            const char* a2 = last ? nA : cA + (size_t)(t + 2) * kstep; const char* b2 = last ? nB : cB + (size_t)(t + 2) * kstep;
            const char* a3 = a2 + kstep; const char* b3 = b2 + kstep;
            if (last && has_next) S.a_ready(nxt);
            if constexpr (SP2) {
            PG8_LDB(B0, 0, 0); PG8_LDB(B1, 0, 1); PG8_SCHED; PG8_LDA(At, 0, 0); PG8_STAGE(PG8_SA(1, 1), a1 + hstep, voffA);
            PG8_WAIT_V(8); PG8_WAIT_L(0); PG8_BAR; PG8_MMA(0, 0, At, B0); PG8_MMA(0, 1, At, B1); PG8_BAR; PG8_SCHED;
            PG8_LDA(At, 0, 1); PG8_STAGE(PG8_SB(0, 0), b2, voffB); PG8_STAGE(PG8_SB(0, 1), b2 + hstep, voffB); PG8_STAGE(PG8_SA(0, 0), a2, voffA);
            PG8_WAIT_V(8); PG8_WAIT_L(0); PG8_BAR; PG8_MMA(1, 0, At, B0); PG8_MMA(1, 1, At, B1); PG8_BAR; PG8_SCHED;
            PG8_LDB(B0, 1, 0); PG8_LDB(B1, 1, 1); PG8_SCHED; PG8_LDA(At, 1, 0); PG8_STAGE(PG8_SA(0, 1), a2 + hstep, voffA);
            PG8_WAIT_V(8); PG8_WAIT_L(0); PG8_BAR; PG8_MMA(0, 0, At, B0); PG8_MMA(0, 1, At, B1); PG8_BAR; PG8_SCHED;
            PG8_LDA(At, 1, 1); PG8_STAGE(PG8_SB(1, 0), b3, voffB); PG8_STAGE(PG8_SB(1, 1), b3 + hstep, voffB); PG8_STAGE(PG8_SA(1, 0), a3, voffA);
            PG8_WAIT_V(8); PG8_WAIT_L(0); PG8_BAR; PG8_MMA(1, 0, At, B0); PG8_MMA(1, 1, At, B1); PG8_BAR; PG8_SCHED;
            } else {
            PG8_LDB(B0, 0, 0); PG8_SCHED; PG8_LDA(At, 0, 0); PG8_STAGE(PG8_SA(1, 1), a1 + hstep, voffA);
            PG8_WAIT_L(8); PG8_BAR; PG8_WAIT_L(0); PG8_MMA(0, 0, At, B0); PG8_BAR; PG8_SCHED;
            PG8_LDB(B1, 0, 1); PG8_STAGE(PG8_SB(0, 0), b2, voffB);
            PG8_BAR; PG8_WAIT_L(0); PG8_MMA(0, 1, At, B1); PG8_BAR;
            PG8_LDA(At, 0, 1); PG8_STAGE(PG8_SA(0, 0), a2, voffA);
            PG8_BAR; PG8_WAIT_L(0); PG8_MMA(1, 0, At, B0); PG8_BAR; PG8_SCHED;
            PG8_STAGE(PG8_SB(0, 1), b2 + hstep, voffB);
            PG8_WAIT_V(6); PG8_BAR; PG8_MMA(1, 1, At, B1); PG8_BAR;
            PG8_LDB(B0, 1, 0); PG8_SCHED; PG8_LDA(At, 1, 0); PG8_STAGE(PG8_SA(0, 1), a2 + hstep, voffA);
            PG8_WAIT_L(8); PG8_BAR; PG8_WAIT_L(0); PG8_MMA(0, 0, At, B0); PG8_BAR; PG8_SCHED;
            PG8_LDB(B1, 1, 1); PG8_STAGE(PG8_SB(1, 0), b3, voffB);
            PG8_BAR; PG8_WAIT_L(0); PG8_MMA(0, 1, At, B1); PG8_BAR;
            PG8_LDA(At, 1, 1); PG8_STAGE(PG8_SA(1, 0), a3, voffA);
            PG8_BAR; PG8_WAIT_L(0); PG8_MMA(1, 0, At, B0); PG8_BAR; PG8_SCHED;
            PG8_STAGE(PG8_SB(1, 1), b3 + hstep, voffB);
            PG8_WAIT_V(6); PG8_BAR; PG8_MMA(1, 1, At, B1); PG8_BAR;
            }
        }
        if constexpr (ALIGN_EPI) { if (wr == 0) PG8_BAR; }
        if constexpr (!Epi::AFTER_DRAIN) { E(acc, cur, wr, wc, fr, fq); S.done(cur); }
        if (!has_next) break;
#pragma unroll
        for (int a = 0; a < 2; ++a)
#pragma unroll
            for (int b = 0; b < 2; ++b)
#pragma unroll
                for (int m = 0; m < 4; ++m)
#pragma unroll
                    for (int n = 0; n < 2; ++n) acc[a][b][m][n] = (f32x4){0.f, 0.f, 0.f, 0.f};
        cur = nxt; cA = nA; cB = nB; ++ui;
        if constexpr (ALIGN_EPI) { if (wr == 1) PG8_BAR; }
    }
    PG8_WAIT_V(0);
    if constexpr (!ALIGN_EPI) { if (wr == 0) PG8_BAR; }
    PG8_BAR;
    if constexpr (Epi::AFTER_DRAIN) { E.fused(acc, cur, wr, wc, fr, fq, lds, wid, lane); S.done(cur); }
#undef PG8_SA
#undef PG8_SB
#undef PG8_STAGE
#undef PG8_LDA
#undef PG8_LDB
#undef PG8_MMA
#undef PG8_WAIT_V
#undef PG8_WAIT_L
#undef PG8_BAR
#undef PG8_SCHED
}
}

#ifndef PG8_SP2
#define PG8_SP2 true
#endif
#ifndef PG8_ALIGN
#define PG8_ALIGN true
#endif
#include <hip/hip_bf16.h>
#include <cmath>
namespace attn2 {
using bf16x8 = __attribute__((ext_vector_type(8))) short;
using s16x4  = __attribute__((ext_vector_type(4))) short;
using f32x16 = __attribute__((ext_vector_type(16))) float;
using u32x4  = __attribute__((ext_vector_type(4))) unsigned;
typedef unsigned short bf16r;
constexpr int DQ = 64, DV = 128, NW = 8, QBLK = 32, KVBLK = 64, LD = 1024;
constexpr float SCALE = 0.125f, THR = 8.f;
constexpr size_t SHM_V = KVBLK * DV * 2, SHM_K = KVBLK * DQ * 2, SHM_ATTN = 3 * SHM_V + 3 * SHM_K + NW * 64 * 4;
constexpr size_t PARK_OFF = SHM_ATTN, PARK_BYTES = NW * 2048 * 4;
#define A2_KSWZ(row, colB) ((row) * 128 + ((colB) ^ ((((row) >> 1) & 7) << 4)))
#define A2_SBAR() __builtin_amdgcn_sched_barrier(0)
__device__ __forceinline__ int crow(int r, int hi) { return (r & 3) + 8 * (r >> 2) + 4 * hi; }
typedef float f32x2_t __attribute__((ext_vector_type(2))); typedef __bf16 bf16x2_t __attribute__((ext_vector_type(2)));
__device__ __forceinline__ unsigned cvtpk(float lo, float hi) { f32x2_t v = {lo, hi}; bf16x2_t b = __builtin_convertvector(v, bf16x2_t); return __builtin_bit_cast(unsigned, b); }

__device__ __forceinline__ void partialSM(f32x16& p0, f32x16& p1, float& m_reg, float& mn, float& alpha) {
  constexpr float C = SCALE * 1.4426950408889634f;
  float pmax = p0[0];
#pragma unroll
  for (int r = 1; r < 16; ++r) pmax = fmaxf(pmax, p0[r]);
#pragma unroll
  for (int r = 0; r < 16; ++r) pmax = fmaxf(pmax, p1[r]);
  { auto rr = __builtin_amdgcn_permlane32_swap(__float_as_uint(pmax), __float_as_uint(pmax), false, false);
    pmax = fmaxf(__uint_as_float(rr[0]), __uint_as_float(rr[1])); }
  if (__builtin_expect(__all(pmax - m_reg <= THR / SCALE), 1)) { mn = m_reg; alpha = 1.f; }
  else { mn = fmaxf(m_reg, pmax); alpha = __builtin_amdgcn_exp2f((m_reg - mn) * C); m_reg = mn; }
  const float mnC = -mn * C;
  { const f32x2_t cv = {C, C}, mv = {mnC, mnC};
#pragma unroll
    for (int i = 0; i < 8; ++i) { f32x2_t t = {p0[2 * i], p0[2 * i + 1]}; t = t * cv + mv; p0[2 * i] = t.x; p0[2 * i + 1] = t.y; }
#pragma unroll
    for (int i = 0; i < 8; ++i) { f32x2_t t = {p1[2 * i], p1[2 * i + 1]}; t = t * cv + mv; p1[2 * i] = t.x; p1[2 * i + 1] = t.y; } }
#pragma unroll
  for (int r = 0; r < 16; ++r) p0[r] = __builtin_amdgcn_exp2f(p0[r]);
}
__device__ __forceinline__ void finishSM(f32x16& p0, f32x16& p1, float alpha, float& l_reg, bf16x8& pa0, bf16x8& pa1, bf16x8& pa2, bf16x8& pa3) {
#pragma unroll
  for (int r = 0; r < 16; ++r) p1[r] = __builtin_amdgcn_exp2f(p1[r]);
  f32x2_t sv = {p0[0], p0[1]};
#pragma unroll
  for (int i = 1; i < 8; ++i) sv += (f32x2_t){p0[2 * i], p0[2 * i + 1]};
#pragma unroll
  for (int i = 0; i < 8; ++i) sv += (f32x2_t){p1[2 * i], p1[2 * i + 1]};
  const float ps = sv.x + sv.y;
  l_reg = l_reg * alpha + ps; asm volatile("" : "+v"(l_reg));
#define A2_PK8(P, BASE, OUT) do { u32x4 w = {cvtpk(P[BASE + 0], P[BASE + 1]), cvtpk(P[BASE + 2], P[BASE + 3]), cvtpk(P[BASE + 4], P[BASE + 5]), cvtpk(P[BASE + 6], P[BASE + 7])}; OUT = *reinterpret_cast<bf16x8*>(&w); } while (0)
  A2_PK8(p0, 0, pa0); A2_PK8(p0, 8, pa1); A2_PK8(p1, 0, pa2); A2_PK8(p1, 8, pa3);
#undef A2_PK8
}
__device__ __forceinline__ void qkt(f32x16& p0, f32x16& p1, const char* Ks, const bf16x8* qr, int r32, int hi) {
  p0 = f32x16{}; p1 = f32x16{};
#pragma unroll
  for (int d0 = 0; d0 < 4; ++d0) { const int cb = (d0 * 16 + hi * 8) * 2;
    const bf16x8 b0 = *reinterpret_cast<const bf16x8*>(Ks + A2_KSWZ(r32, cb));
    const bf16x8 b1 = *reinterpret_cast<const bf16x8*>(Ks + A2_KSWZ(32 + r32, cb));
    p0 = __builtin_amdgcn_mfma_f32_32x32x16_bf16(b0, qr[d0], p0, 0, 0, 0);
    p1 = __builtin_amdgcn_mfma_f32_32x32x16_bf16(b1, qr[d0], p1, 0, 0, 0); }
}
__device__ __forceinline__ int v_st(int k, int c) { const int kk = k;     return ((kk >> 3) * 4 + (c >> 5)) * 512 + ((kk & 7) * 32 + (c & 31)) * 2; }
__device__ __forceinline__ int v_rd_base(int lane) { return ((lane & 3) << 3) | (((lane >> 2) & 3) << 6) | (((lane >> 4) & 1) << 5) | (((lane >> 5) & 1) << 8); }
constexpr int v_rd_off(int d0, int ks, int half) { return d0 * 512 + ks * 4096 + half * 2048; }
template <int OFF> __device__ __forceinline__ s16x4 tr_read(int vb) {
  s16x4 r; asm volatile("ds_read_b64_tr_b16 %0, %1 offset:%2" : "=&v"(r) : "v"(vb), "i"(OFF) : "memory"); return r;
}
template <int D0> __device__ __forceinline__ void pv_one(f32x16& od, int vb, bf16x8 pa0, bf16x8 pa1, bf16x8 pa2, bf16x8 pa3) {
  const s16x4 l0 = tr_read<v_rd_off(D0, 0, 0)>(vb), h0 = tr_read<v_rd_off(D0, 0, 1)>(vb), l1 = tr_read<v_rd_off(D0, 1, 0)>(vb), h1 = tr_read<v_rd_off(D0, 1, 1)>(vb);
  const s16x4 l2 = tr_read<v_rd_off(D0, 2, 0)>(vb), h2 = tr_read<v_rd_off(D0, 2, 1)>(vb), l3 = tr_read<v_rd_off(D0, 3, 0)>(vb), h3 = tr_read<v_rd_off(D0, 3, 1)>(vb);
  asm volatile("s_waitcnt lgkmcnt(0)" ::: "memory"); A2_SBAR();
#define A2_PK(L, H) (bf16x8){L[0], L[1], L[2], L[3], H[0], H[1], H[2], H[3]}
  od = __builtin_amdgcn_mfma_f32_32x32x16_bf16(pa0, A2_PK(l0, h0), od, 0, 0, 0);
  od = __builtin_amdgcn_mfma_f32_32x32x16_bf16(pa1, A2_PK(l1, h1), od, 0, 0, 0);
  od = __builtin_amdgcn_mfma_f32_32x32x16_bf16(pa2, A2_PK(l2, h2), od, 0, 0, 0);
  od = __builtin_amdgcn_mfma_f32_32x32x16_bf16(pa3, A2_PK(l3, h3), od, 0, 0, 0);
#undef A2_PK
}
__device__ __forceinline__ void pv_d0(f32x16* o, int vb, bf16x8 pa0, bf16x8 pa1, bf16x8 pa2, bf16x8 pa3) {
  pv_one<0>(o[0], vb, pa0, pa1, pa2, pa3); pv_one<1>(o[1], vb, pa0, pa1, pa2, pa3); pv_one<2>(o[2], vb, pa0, pa1, pa2, pa3); pv_one<3>(o[3], vb, pa0, pa1, pa2, pa3);
}

struct VF { s16x4 l0, h0, l1, h1, l2, h2, l3, h3; };
template <int D0> __device__ __forceinline__ VF vread(int vb) { VF f;
  f.l0 = tr_read<v_rd_off(D0, 0, 0)>(vb); f.h0 = tr_read<v_rd_off(D0, 0, 1)>(vb); f.l1 = tr_read<v_rd_off(D0, 1, 0)>(vb); f.h1 = tr_read<v_rd_off(D0, 1, 1)>(vb);
  f.l2 = tr_read<v_rd_off(D0, 2, 0)>(vb); f.h2 = tr_read<v_rd_off(D0, 2, 1)>(vb); f.l3 = tr_read<v_rd_off(D0, 3, 0)>(vb); f.h3 = tr_read<v_rd_off(D0, 3, 1)>(vb); return f; }
__device__ __forceinline__ void mfma4(f32x16& od, const VF& f, bf16x8 pa0, bf16x8 pa1, bf16x8 pa2, bf16x8 pa3) {
#define A2_PK(L, H) (bf16x8){L[0], L[1], L[2], L[3], H[0], H[1], H[2], H[3]}
  od = __builtin_amdgcn_mfma_f32_32x32x16_bf16(pa0, A2_PK(f.l0, f.h0), od, 0, 0, 0);
  od = __builtin_amdgcn_mfma_f32_32x32x16_bf16(pa1, A2_PK(f.l1, f.h1), od, 0, 0, 0);
  od = __builtin_amdgcn_mfma_f32_32x32x16_bf16(pa2, A2_PK(f.l2, f.h2), od, 0, 0, 0);
  od = __builtin_amdgcn_mfma_f32_32x32x16_bf16(pa3, A2_PK(f.l3, f.h3), od, 0, 0, 0);
#undef A2_PK
}
#define A2_LWAIT(n) do { asm volatile("s_waitcnt lgkmcnt(" #n ")" ::: "memory"); A2_SBAR(); } while (0)
__device__ __forceinline__ void pv_psm(f32x16* o, int vb, bf16x8 pa0, bf16x8 pa1, bf16x8 pa2, bf16x8 pa3, f32x16& p0, f32x16& p1, float& m_reg, float& mn, float& alpha) {
  constexpr float C = SCALE * 1.4426950408889634f;
  const VF f0 = vread<0>(vb);
  const VF f1 = vread<1>(vb); A2_LWAIT(8); mfma4(o[0], f0, pa0, pa1, pa2, pa3);
  float pmax = p0[0];
#pragma unroll
  for (int r = 1; r < 16; ++r) pmax = fmaxf(pmax, p0[r]);
#pragma unroll
  for (int r = 0; r < 16; ++r) pmax = fmaxf(pmax, p1[r]);
  { auto rr = __builtin_amdgcn_permlane32_swap(__float_as_uint(pmax), __float_as_uint(pmax), false, false);
    pmax = fmaxf(__uint_as_float(rr[0]), __uint_as_float(rr[1])); }
  asm volatile("" : "+v"(pmax));
  const VF f2 = vread<2>(vb); A2_LWAIT(8); mfma4(o[1], f1, pa0, pa1, pa2, pa3);
  if (__builtin_expect(__all(pmax - m_reg <= THR / SCALE), 1)) { mn = m_reg; alpha = 1.f; }
  else { mn = fmaxf(m_reg, pmax); alpha = __builtin_amdgcn_exp2f((m_reg - mn) * C); m_reg = mn; }
  const float mnC = -mn * C; const f32x2_t cv = {C, C}, mv = {mnC, mnC};
#pragma unroll
  for (int i = 0; i < 8; ++i) { f32x2_t t = {p0[2 * i], p0[2 * i + 1]}; t = t * cv + mv; p0[2 * i] = t.x; p0[2 * i + 1] = t.y; }
  asm volatile("" : "+v"(p0));
  const VF f3 = vread<3>(vb); A2_LWAIT(8); mfma4(o[2], f2, pa0, pa1, pa2, pa3);
#pragma unroll
  for (int i = 0; i < 8; ++i) { f32x2_t t = {p1[2 * i], p1[2 * i + 1]}; t = t * cv + mv; p1[2 * i] = t.x; p1[2 * i + 1] = t.y; }
  asm volatile("" : "+v"(p1));
  A2_LWAIT(0); mfma4(o[3], f3, pa0, pa1, pa2, pa3);
#pragma unroll
  for (int r = 0; r < 16; ++r) p0[r] = __builtin_amdgcn_exp2f(p0[r]);
  asm volatile("" : "+v"(p0)); A2_SBAR();
}
template <int PASS>
__device__ __forceinline__ void body(const bf16r* Qb, const bf16r* Kh, const bf16r* Vh, int seq, char* lds, float lam, const float* subln, bf16r* Ob) {
  int tid_ = threadIdx.x; asm volatile("" : "+v"(tid_));
  const int tid = tid_, wid = tid >> 6, lane = tid & 63, r32 = lane & 31, hi = lane >> 5;
  char* V_lds = lds; char* K_lds = lds + 3 * SHM_V;
  float* ws = (float*)(lds + 3 * SHM_V + 3 * SHM_K) + wid * 64; float* li_l = ws; float* al_l = ws + 32;
  float m_reg = -1e30f, l_reg = 0; f32x16 o[4] = {}; bf16x8 qr[4];
  const bf16r* Qw = Qb + (long)(wid * QBLK + r32) * LD + hi * 8;
#pragma unroll
  for (int d0 = 0; d0 < 4; ++d0) qr[d0] = *reinterpret_cast<const bf16x8*>(Qw + d0 * 16);
  const int sr = tid >> 4, sc = (tid & 15) * 8, vst0 = v_st(sr, sc), vst1 = v_st(32 + sr, sc);
  const int kr = tid >> 3, kc = (tid & 7) * 8, kst = A2_KSWZ(kr, kc * 2);
  const int vb0 = (int)(uintptr_t)V_lds + v_rd_base(lane);
  struct { bf16x8 vs0, vs1, ks0; } sr_[2];
#define A2_SLOAD(i, k0) do { sr_[i].vs0 = *reinterpret_cast<const bf16x8*>(&Vh[(long)((k0) + sr) * LD + sc]); sr_[i].vs1 = *reinterpret_cast<const bf16x8*>(&Vh[(long)((k0) + 32 + sr) * LD + sc]); \
    sr_[i].ks0 = *reinterpret_cast<const bf16x8*>(&Kh[(long)((k0) + kr) * LD + kc]); } while (0)
#define A2_SWRITE(b, i) do { *(bf16x8*)(V_lds + (b) * SHM_V + vst0) = sr_[i].vs0; *(bf16x8*)(V_lds + (b) * SHM_V + vst1) = sr_[i].vs1; *(bf16x8*)(K_lds + (b) * SHM_K + kst) = sr_[i].ks0; } while (0)
#define A2_SWAIT() asm volatile("s_waitcnt vmcnt(3)" ::: "memory")
#define A2_RESC(a) do { if (__any((a) < 1.f)) { if (hi == 0) al_l[r32] = (a); asm volatile("s_waitcnt lgkmcnt(0)" ::: "memory"); \
    _Pragma("unroll") for (int d = 0; d < 4; ++d) _Pragma("unroll") for (int r = 0; r < 16; ++r) o[d][r] *= al_l[crow(r, hi)]; } } while (0)
  if (wid >= 4) __builtin_amdgcn_s_setprio(1);
  f32x16 pA0, pA1, pB0, pB1; float mnA, mnB, alA, alB; bf16x8 pa0, pa1, pa2, pa3; const int NT = seq / KVBLK;
  A2_SLOAD(0, 0); asm volatile("s_waitcnt vmcnt(0)" ::: "memory"); A2_SWRITE(0, 0);
  A2_SLOAD(1, KVBLK); A2_SLOAD(0, 2 * KVBLK);
  __syncthreads();
  qkt(pA0, pA1, K_lds, qr, r32, hi); partialSM(pA0, pA1, m_reg, mnA, alA);
  A2_SWAIT(); A2_SWRITE(1, 1); A2_SLOAD(1, 3 * KVBLK);
  int bp = 0, bc = 1, bn = 2;
#define A2_STEP(PC0, PC1, mnC_, alC_, PP0, PP1, alP_, j_, SL) do { \
    __syncthreads(); \
    if ((j_) + 1 < NT) { A2_SWAIT(); A2_SWRITE(bn, SL); } \
    A2_SBAR(); qkt(PC0, PC1, K_lds + bc * SHM_K, qr, r32, hi); \
    finishSM(PP0, PP1, alP_, l_reg, pa0, pa1, pa2, pa3); A2_SBAR(); \
    if ((j_) + 3 < NT) A2_SLOAD(SL, ((j_) + 3) * KVBLK); A2_SBAR(); \
    pv_psm(o, vb0 + bp * (int)SHM_V, pa0, pa1, pa2, pa3, PC0, PC1, m_reg, mnC_, alC_); \
    A2_RESC(alC_); \
    { const int t_ = bp; bp = bc; bc = bn; bn = t_; } } while (0)
  for (int j = 1; j + 1 < NT; j += 2) {
    A2_STEP(pB0, pB1, mnB, alB, pA0, pA1, alA, j, 0);
    A2_STEP(pA0, pA1, mnA, alA, pB0, pB1, alB, j + 1, 1);
  }
  A2_STEP(pB0, pB1, mnB, alB, pA0, pA1, alA, NT - 1, 0);
#undef A2_STEP
  finishSM(pB0, pB1, alB, l_reg, pa0, pa1, pa2, pa3); A2_SBAR();
  pv_d0(o, vb0 + bp * (int)SHM_V, pa0, pa1, pa2, pa3);
  __builtin_amdgcn_s_setprio(0);
  { auto rr = __builtin_amdgcn_permlane32_swap(__float_as_uint(l_reg), __float_as_uint(l_reg), false, false); l_reg = __uint_as_float(rr[0]) + __uint_as_float(rr[1]); }
  if (hi == 0) li_l[r32] = l_reg; asm volatile("s_waitcnt lgkmcnt(0)" ::: "memory");
  float rli[16];
#pragma unroll
  for (int r = 0; r < 16; ++r) rli[r] = __builtin_amdgcn_rcpf(li_l[crow(r, hi)]);
  unsigned* sw = (unsigned*)(lds + PARK_OFF) + wid * 2048 + lane;
  if (PASS == 0) {
#pragma unroll
    for (int r = 0; r < 16; ++r)
#pragma unroll
      for (int dp = 0; dp < 2; ++dp) sw[(r * 2 + dp) * 64] = cvtpk(o[2 * dp][r] * rli[r], o[2 * dp + 1][r] * rli[r]);
  } else {
    float sg[4];
#pragma unroll
    for (int d0 = 0; d0 < 4; ++d0) sg[d0] = subln[d0 * 32 + r32];
    bf16r* Ow = Ob + (long)(wid * QBLK) * LD + r32;
#pragma unroll
    for (int r = 0; r < 16; ++r) {
      float d[4]; float ss = 0.f;
#pragma unroll
      for (int dp = 0; dp < 2; ++dp) { const unsigned w = sw[(r * 2 + dp) * 64];
        d[2 * dp] = __uint_as_float(w << 16) - lam * (o[2 * dp][r] * rli[r]); d[2 * dp + 1] = __uint_as_float(w & 0xffff0000u) - lam * (o[2 * dp + 1][r] * rli[r]); }
#pragma unroll
      for (int d0 = 0; d0 < 4; ++d0) ss += d[d0] * d[d0];
      ss += __shfl_xor(ss, 1); ss += __shfl_xor(ss, 2); ss += __shfl_xor(ss, 4); ss += __shfl_xor(ss, 8); ss += __shfl_xor(ss, 16);
      const float rstd = 0.8f / sqrtf(ss * (1.f / 128.f) + 1e-6f);
      const int orow = crow(r, hi);
#pragma unroll
      for (int d0 = 0; d0 < 4; ++d0) Ow[(long)orow * LD + d0 * 32] = (bf16r)(cvtpk(d[d0] * rstd * sg[d0], 0.f) & 0xffffu);
    }
  }
  __syncthreads();
#undef A2_SLOAD
#undef A2_SWRITE
#undef A2_SWAIT
#undef A2_RESC
}
#undef A2_KSWZ
#undef A2_LWAIT
#undef A2_SBAR
}
namespace pg8 {
typedef unsigned u32x2 __attribute__((ext_vector_type(2)));
__device__ __forceinline__ float fsigmoid(float x) { return __builtin_amdgcn_rcpf(1.0f + __builtin_amdgcn_exp2f(-1.4426950408889634f * x)); }
__device__ __forceinline__ float fsilu(float x) { return x * fsigmoid(x); }
__device__ __forceinline__ float bflo(unsigned w) { return __uint_as_float(w << 16); }
__device__ __forceinline__ float bfhi(unsigned w) { return __uint_as_float(w & 0xffff0000u); }

struct EpiSwiglu {
    static constexpr bool PERM = true, AFTER_DRAIN = false;
    bf16_t* O; int ldc;
    __device__ __forceinline__ void operator()(const f32x4 (&acc)[2][2][4][2], const Unit& u, int wr, int wc, int fr, int fq) const {
        const int row0 = u.pm * BM + wr * 64 + fr, col0 = u.pn * HALF + wc * 32 + 8 * fq;
#pragma unroll
        for (int ai = 0; ai < 2; ++ai)
#pragma unroll
            for (int m = 0; m < 4; ++m) {
                bf16_t* rowp = O + (size_t)(row0 + ai * HALF + m * 16) * ldc + col0;
                const f32x4 g0 = acc[ai][0][m][0], g1 = acc[ai][0][m][1], u0 = acc[ai][1][m][0], u1 = acc[ai][1][m][1];
                u32x4 w;
                w.x = cvt_pk_bf16(fsilu(g0[0]) * u0[0], fsilu(g0[1]) * u0[1]); w.y = cvt_pk_bf16(fsilu(g0[2]) * u0[2], fsilu(g0[3]) * u0[3]);
                w.z = cvt_pk_bf16(fsilu(g1[0]) * u1[0], fsilu(g1[1]) * u1[1]); w.w = cvt_pk_bf16(fsilu(g1[2]) * u1[2], fsilu(g1[3]) * u1[3]);
                *(u32x4*)rowp = w;
            }
    }
};

struct EpiWin {
    static constexpr bool PERM = true, AFTER_DRAIN = false;
    bf16_t *q, *k, *v, *u, *ga, *gb; const float* rope; float qscale;
    __device__ __forceinline__ void operator()(const f32x4 (&acc)[2][2][4][2], const Unit& un, int wr, int wc, int fr, int fq) const {
        const int pn = un.pn, rowt = un.pm * BM + wr * 64 + fr, bidx = un.pm >> 5;
        if (pn < 8) {
            const bool isq = pn < 4; const float sc = isq ? qscale : 1.f; bf16_t* base = isq ? q : k;
            const int colt = (pn & 3) * 256 + wc * 32 + 8 * fq, axis = wc & 1, f0 = 8 * (fq & 1);
            const float sgn = (fq < 2) ? -sc : sc;
#pragma unroll
            for (int ai = 0; ai < 2; ++ai)
#pragma unroll
                for (int m = 0; m < 4; ++m) {
                    const int r = rowt + ai * HALF + m * 16, t = r & 8191, pos = axis ? (t & 63) : (t >> 6);
                    const f32x4 cs0 = *(const f32x4*)(rope + pos * 16 + f0), cs1 = *(const f32x4*)(rope + pos * 16 + f0 + 4);
                    const f32x4 sn0 = *(const f32x4*)(rope + 2048 + pos * 16 + f0), sn1 = *(const f32x4*)(rope + 2048 + pos * 16 + f0 + 4);
                    const size_t orow = isq ? (size_t)r : (size_t)bidx * 8448 + 256 + t;
                    bf16_t* rowp = base + orow * 1024 + colt;
#pragma unroll
                    for (int bj = 0; bj < 2; ++bj) {
                        const f32x4 s0 = acc[ai][bj][m][0], s1 = acc[ai][bj][m][1]; f32x4 o0, o1;
#pragma unroll
                        for (int jj = 0; jj < 4; ++jj) { const float p0 = __shfl_xor(s0[jj], 32), p1 = __shfl_xor(s1[jj], 32);
                            o0[jj] = s0[jj] * (cs0[jj] * sc) + p0 * (sn0[jj] * sgn); o1[jj] = s1[jj] * (cs1[jj] * sc) + p1 * (sn1[jj] * sgn); }
                        u32x4 w; w.x = cvt_pk_bf16(o0[0], o0[1]); w.y = cvt_pk_bf16(o0[2], o0[3]); w.z = cvt_pk_bf16(o1[0], o1[1]); w.w = cvt_pk_bf16(o1[2], o1[3]);
                        *(u32x4*)(rowp + bj * HALF) = w;
                    }
                }
        } else if (pn < 12) {
            const int colt = (pn - 8) * 256 + wc * 32 + 8 * fq;
#pragma unroll
            for (int ai = 0; ai < 2; ++ai)
#pragma unroll
                for (int m = 0; m < 4; ++m) {
                    const int r = rowt + ai * HALF + m * 16, t = r & 8191;
                    bf16_t* rowp = v + ((size_t)bidx * 8448 + 256 + t) * 1024 + colt;
#pragma unroll
                    for (int bj = 0; bj < 2; ++bj) { const f32x4 v0 = acc[ai][bj][m][0], v1 = acc[ai][bj][m][1]; u32x4 w;
                        w.x = cvt_pk_bf16(v0[0], v0[1]); w.y = cvt_pk_bf16(v0[2], v0[3]); w.z = cvt_pk_bf16(v1[0], v1[1]); w.w = cvt_pk_bf16(v1[2], v1[3]); *(u32x4*)(rowp + bj * HALF) = w; }
                }
        } else if (pn < 20) {
            const int colt = (pn - 12) * HALF + wc * 32 + 8 * fq;
#pragma unroll
            for (int ai = 0; ai < 2; ++ai)
#pragma unroll
                for (int m = 0; m < 4; ++m) {
                    bf16_t* rowp = u + (size_t)(rowt + ai * HALF + m * 16) * 1024 + colt;
                    const f32x4 a0 = acc[ai][0][m][0], a1 = acc[ai][0][m][1], g0 = acc[ai][1][m][0], g1 = acc[ai][1][m][1]; u32x4 w;
                    w.x = cvt_pk_bf16(a0[0] * fsigmoid(g0[0]), a0[1] * fsigmoid(g0[1])); w.y = cvt_pk_bf16(a0[2] * fsigmoid(g0[2]), a0[3] * fsigmoid(g0[3]));
                    w.z = cvt_pk_bf16(a1[0] * fsigmoid(g1[0]), a1[1] * fsigmoid(g1[1])); w.w = cvt_pk_bf16(a1[2] * fsigmoid(g1[2]), a1[3] * fsigmoid(g1[3]));
                    *(u32x4*)rowp = w;
                }
        } else {
            bf16_t* base = pn < 24 ? ga : gb; const int colt = (pn & 3) * 256 + wc * 32 + 8 * fq;
#pragma unroll
            for (int ai = 0; ai < 2; ++ai)
#pragma unroll
                for (int m = 0; m < 4; ++m) {
                    bf16_t* rowp = base + (size_t)(rowt + ai * HALF + m * 16) * 1024 + colt;
#pragma unroll
                    for (int bj = 0; bj < 2; ++bj) { const f32x4 v0 = acc[ai][bj][m][0], v1 = acc[ai][bj][m][1]; u32x4 w;
                        w.x = cvt_pk_bf16(fsigmoid(v0[0]), fsigmoid(v0[1])); w.y = cvt_pk_bf16(fsigmoid(v0[2]), fsigmoid(v0[3]));
                        w.z = cvt_pk_bf16(fsigmoid(v1[0]), fsigmoid(v1[1])); w.w = cvt_pk_bf16(fsigmoid(v1[2]), fsigmoid(v1[3])); *(u32x4*)(rowp + bj * HALF) = w; }
                }
        }
    }
};

struct EpiKVc {
    static constexpr bool PERM = true, AFTER_DRAIN = false;
    bf16_t *k, *v;
    __device__ __forceinline__ void operator()(const f32x4 (&acc)[2][2][4][2], const Unit& un, int wr, int wc, int fr, int fq) const {
        bf16_t* base = un.pn < 4 ? k : v; const int colt = (un.pn & 3) * 256 + wc * 32 + 8 * fq;
#pragma unroll
        for (int ai = 0; ai < 2; ++ai)
#pragma unroll
            for (int m = 0; m < 4; ++m) {
                bf16_t* rowp = base + ((size_t)un.pm * 8448 + wr * 64 + fr + ai * HALF + m * 16) * 1024 + colt;
#pragma unroll
                for (int bj = 0; bj < 2; ++bj) { const f32x4 v0 = acc[ai][bj][m][0], v1 = acc[ai][bj][m][1]; u32x4 w;
                    w.x = cvt_pk_bf16(v0[0], v0[1]); w.y = cvt_pk_bf16(v0[2], v0[3]); w.z = cvt_pk_bf16(v1[0], v1[1]); w.w = cvt_pk_bf16(v1[2], v1[3]); *(u32x4*)(rowp + bj * HALF) = w; }
            }
    }
};

template <bool ADD> struct EpiGate {
    static constexpr bool PERM = true, AFTER_DRAIN = false;
    bf16_t* Z; const bf16_t* G;
    __device__ __forceinline__ void operator()(const f32x4 (&acc)[2][2][4][2], const Unit& un, int wr, int wc, int fr, int fq) const {
        const int row0 = un.pm * BM + wr * 64 + fr, col0 = un.pn * BM + wc * 32 + 8 * fq;
#pragma unroll
        for (int ai = 0; ai < 2; ++ai)
#pragma unroll
            for (int m = 0; m < 4; ++m) {
                const size_t off = (size_t)(row0 + ai * HALF + m * 16) * 1024 + col0;
#pragma unroll
                for (int bj = 0; bj < 2; ++bj) {
                    const u32x4 g = *(const u32x4*)(G + off + bj * HALF);
                    const f32x4 v0 = acc[ai][bj][m][0], v1 = acc[ai][bj][m][1];
                    float o[8];
                    o[0] = v0[0] * bflo(g.x); o[1] = v0[1] * bfhi(g.x); o[2] = v0[2] * bflo(g.y); o[3] = v0[3] * bfhi(g.y);
                    o[4] = v1[0] * bflo(g.z); o[5] = v1[1] * bfhi(g.z); o[6] = v1[2] * bflo(g.w); o[7] = v1[3] * bfhi(g.w);
                    if (ADD) { const u32x4 z = *(const u32x4*)(Z + off + bj * HALF);
                        o[0] += bflo(z.x); o[1] += bfhi(z.x); o[2] += bflo(z.y); o[3] += bfhi(z.y); o[4] += bflo(z.z); o[5] += bfhi(z.z); o[6] += bflo(z.w); o[7] += bfhi(z.w); }
                    u32x4 w; w.x = cvt_pk_bf16(o[0], o[1]); w.y = cvt_pk_bf16(o[2], o[3]); w.z = cvt_pk_bf16(o[4], o[5]); w.w = cvt_pk_bf16(o[6], o[7]);
                    *(u32x4*)(Z + off + bj * HALF) = w;
                }
            }
    }
};
}

constexpr int NWAVES = 8, NTHR = 512;
constexpr int DM = 1024, NB = 4, SEQ = 8192, NLAT = NB * SEQ, NCTX = 256, NCTXR = NB * NCTX, NROWS = NLAT + NCTXR, NKEYS = SEQ + NCTX;
constexpr int DFF = 2816, INW = 7168, NMOD = 9;
constexpr float EPS = 1e-6f;
constexpr size_t MiB = 1u << 20;
constexpr size_t WS_MOD = 1 * MiB, WS_ROPE = 1 * MiB + 256 * 1024, WS_LAM = 1 * MiB + 512 * 1024;
constexpr size_t WS_W13A = 2 * MiB, WS_W2A = 13 * MiB, WS_W13B = WS_W2A + 11 * MiB / 2, WS_W2B = WS_W13B + 11 * MiB, WS_WIN = 35 * MiB, WS_WAP = 49 * MiB, WS_WCP = 51 * MiB, WS_WOUT = 53 * MiB;
constexpr size_t WS_H = 56 * MiB, WS_Y = 122 * MiB, WS_BIG = 188 * MiB;
constexpr size_t WS_ACT = WS_BIG, WS_Q = WS_BIG, WS_K = WS_BIG + 64 * MiB, WS_V = WS_K + 66 * MiB, WS_U = WS_V + 66 * MiB, WS_GB = WS_U + 64 * MiB, WS_END = WS_GB + 64 * MiB;
constexpr size_t WS_GA = WS_Y, WS_UC = WS_H, WS_OSCR = WS_U, WS_Z = WS_U;
static_assert(WS_END == 512 * MiB, "ws map");
static_assert(WS_W2B + 11 * MiB / 2 <= WS_WIN, "ws map weights");
constexpr int LDS_BYTES = 147456;

#define LAS __attribute__((address_space(3)))
typedef unsigned short bf16;
typedef unsigned v4u __attribute__((ext_vector_type(4)));
typedef unsigned v2u __attribute__((ext_vector_type(2)));
typedef float f32x4 __attribute__((ext_vector_type(4)));
#define LDS_WAIT() asm volatile("s_waitcnt lgkmcnt(0)" ::: "memory")
__device__ __forceinline__ unsigned f2bf(float f) { unsigned u = __builtin_bit_cast(unsigned, f); return (u + 0x7fffu + ((u >> 16) & 1u)) >> 16; }
__device__ __forceinline__ unsigned pk2(float lo, float hi) { return f2bf(lo) | (f2bf(hi) << 16); }
__device__ __forceinline__ float wave_sum(float v) {
#pragma unroll
    for (int o = 1; o < 64; o <<= 1) v += __shfl_xor(v, o);
    return v;
}

struct Args { const float* in[21]; float* out; unsigned char* ws; int pad0, pad1; };
enum { I_X = 0, I_C, I_CTX, I_CCTX, I_WADA, I_BADA, I_NORMG, I_F1W13, I_F1W2, I_F2W13, I_F2W2, I_WIN, I_LAMQK, I_SUBLN, I_WAP, I_CONVW, I_CONVB, I_CLNG, I_CLNB, I_WCP, I_WOUT };

template <int MODE> __device__ __forceinline__ int drow(int n0) {
    if (MODE == 1) { const int bj = n0 / DFF, j = n0 % DFF; return 256 * (j / 128) + 128 * bj + (j % 128); }
    if (MODE == 2) { if (n0 >= 3072 && n0 < 5120) { const int c = n0 - 3072, bj = c / 1024, j = c % 1024; return 3072 + 256 * (j / 128) + 128 * bj + (j % 128); } return n0; }
    return n0;
}
template <int MODE> __device__ __forceinline__ void transpose_item(const float* W, int K, int N, bf16* WT, LAS float* scr, int item, int lane) {
    const int nblk = N / 32, kb = item / nblk, nb = item % nblk, k0 = 64 * kb, n0 = 32 * nb, d0 = drow<MODE>(n0);
    float tv[32];
#pragma unroll
    for (int i = 0; i < 32; ++i) tv[i] = W[(size_t)(k0 + 2 * i + (lane >> 5)) * N + n0 + (lane & 31)];
#pragma unroll
    for (int i = 0; i < 32; ++i) scr[(2 * i + (lane >> 5)) * 33 + (lane & 31)] = tv[i];
    LDS_WAIT(); asm volatile("" ::: "memory");
    const int c = lane & 7;
#pragma unroll
    for (int j = 0; j < 4; ++j) { const int n = (lane >> 3) + 8 * j; const LAS float* s = scr + (8 * c) * 33 + n;
        v4u o; o.x = pk2(s[0 * 33], s[1 * 33]); o.y = pk2(s[2 * 33], s[3 * 33]); o.z = pk2(s[4 * 33], s[5 * 33]); o.w = pk2(s[6 * 33], s[7 * 33]);
        *(v4u*)(WT + (size_t)(d0 + n) * K + k0 + 8 * c) = o; }
    LDS_WAIT(); asm volatile("" ::: "memory");
}

template <bool HAS_Y, bool WRITE_X, bool WRITE_H>
__device__ __forceinline__ void norm_rows(int gw, int NGW, int lane, int row_lo, int nrows, const float* xlat, const float* xctx, const bf16* Y, float* xout, bf16* hout, const float* mod,
                                          float mult, const float* g_post, int k_gate, const float* g_pre, int k_in) {
    for (int row0 = row_lo + gw; row0 < nrows; row0 += 2 * NGW) {
        int rows[2]; rows[0] = row0; rows[1] = (row0 + NGW < nrows) ? row0 + NGW : row0;
        f32x4 v[2][4]; v2u yw[2][4]; const float* mp[2]; bool isctx[2];
#pragma unroll
        for (int r = 0; r < 2; ++r) {
            const int row = rows[r]; isctx[r] = row >= NLAT; const int mv = isctx[r] ? 4 : (row >> 13);
            const float* xr = isctx[r] ? xctx + (size_t)(row - NLAT) * DM : xlat + (size_t)row * DM;
            mp[r] = mod + (size_t)mv * (NMOD * DM);
#pragma unroll
            for (int j = 0; j < 4; ++j) v[r][j] = ((const f32x4*)xr)[lane + 64 * j];
            if (HAS_Y) {
#pragma unroll
                for (int j = 0; j < 4; ++j) yw[r][j] = ((const v2u*)(Y + (size_t)row * DM))[lane + 64 * j];
            }
        }
        if (HAS_Y) {
            f32x4 y[2][4]; float ss[2];
#pragma unroll
            for (int r = 0; r < 2; ++r) { ss[r] = 0.f;
#pragma unroll
                for (int j = 0; j < 4; ++j) { const v2u w = yw[r][j]; y[r][j] = (f32x4){pg8::bflo(w.x), pg8::bfhi(w.x), pg8::bflo(w.y), pg8::bfhi(w.y)};
                    ss[r] += (y[r][j].x * y[r][j].x + y[r][j].y * y[r][j].y) + (y[r][j].z * y[r][j].z + y[r][j].w * y[r][j].w); } }
#pragma unroll
            for (int o = 1; o < 64; o <<= 1) { ss[0] += __shfl_xor(ss[0], o); ss[1] += __shfl_xor(ss[1], o); }
#pragma unroll
            for (int r = 0; r < 2; ++r) { const float rstd = 1.0f / sqrtf(ss[r] * (1.f / DM) + EPS);
#pragma unroll
                for (int j = 0; j < 4; ++j) { const f32x4 gp = ((const f32x4*)g_post)[lane + 64 * j], gt = ((const f32x4*)(mp[r] + k_gate * DM))[lane + 64 * j];
                    v[r][j] = v[r][j] + (mult * gt) * ((y[r][j] * rstd) * gp); }
                if (WRITE_X && !isctx[r]) {
#pragma unroll
                    for (int j = 0; j < 4; ++j) ((f32x4*)(xout + (size_t)rows[r] * DM))[lane + 64 * j] = v[r][j];
                } }
        }
        if (WRITE_H) {
            float ss[2];
#pragma unroll
            for (int r = 0; r < 2; ++r) { ss[r] = 0.f;
#pragma unroll
                for (int j = 0; j < 4; ++j) ss[r] += (v[r][j].x * v[r][j].x + v[r][j].y * v[r][j].y) + (v[r][j].z * v[r][j].z + v[r][j].w * v[r][j].w); }
#pragma unroll
            for (int o = 1; o < 64; o <<= 1) { ss[0] += __shfl_xor(ss[0], o); ss[1] += __shfl_xor(ss[1], o); }
#pragma unroll
            for (int r = 0; r < 2; ++r) { const float rstd = 1.0f / sqrtf(ss[r] * (1.f / DM) + EPS);
#pragma unroll
                for (int j = 0; j < 4; ++j) { const f32x4 gp = ((const f32x4*)g_pre)[lane + 64 * j], sh = ((const f32x4*)(mp[r] + k_in * DM))[lane + 64 * j], sc = ((const f32x4*)(mp[r] + (k_in + 1) * DM))[lane + 64 * j];
                    const f32x4 h = ((v[r][j] * rstd) * gp) * (1.0f + sc) + sh;
                    v2u w; w.x = pk2(h.x, h.y); w.y = pk2(h.z, h.w); ((v2u*)(hout + (size_t)rows[r] * DM))[lane + 64 * j] = w; } }
        }
    }
}

#define RLX_AGENT __ATOMIC_RELAXED, __HIP_MEMORY_SCOPE_AGENT
#define XB_TMO      128
#define XB_XCNT(j)  (256  + 64 * (j))
#define XB_XSUB(j)  (1280 + 64 * (j))
#define XB_XGEN(j)  (2304 + 64 * (j))
#define XB_TOP      3328
#define XB_TOPGEN   3392
#define XCD_BAR_WORDS 3456
#define XB_SPIN_CAP (1u << 22)

__device__ __forceinline__ unsigned xb_ld(unsigned* p)              { return __hip_atomic_load(p, __ATOMIC_RELAXED, __HIP_MEMORY_SCOPE_AGENT); }
__device__ __forceinline__ unsigned xb_add(unsigned* p, unsigned v) { return __hip_atomic_fetch_add(p, v, __ATOMIC_RELAXED, __HIP_MEMORY_SCOPE_AGENT); }
__device__ __forceinline__ unsigned xb_xcc_id() { return (unsigned)__builtin_amdgcn_s_getreg((3 << 11) | 20) & 0xFu; }
#define XB_SPIN(cond, bar) do { unsigned _sp = 0; while (cond) { __builtin_amdgcn_s_sleep(1); \
    if ((++_sp & 255u) == 0u) { if (xb_ld(&(bar)[XB_TMO])) break; if (_sp > XB_SPIN_CAP) { atomicAdd(&(bar)[XB_TMO], 1u); break; } } } } while (0)

struct XcdBarrier {
    unsigned* bar; unsigned x;
    volatile LAS unsigned* st;
};

__device__ __forceinline__ XcdBarrier xcd_barrier_post(unsigned* bar, volatile LAS unsigned* st) {
    XcdBarrier b; b.bar = bar; b.x = xb_xcc_id(); b.st = st;
    if (threadIdx.x == 0) (void)xb_add(&bar[XB_XCNT(b.x)], 1u);
    return b;
}
__device__ __forceinline__ void xcd_barrier_complete(unsigned* bar, unsigned x, unsigned& nloc, unsigned& nx) {
    const unsigned G = gridDim.x * gridDim.y * gridDim.z;
    unsigned sum, cnt, mine, sp = 0u;
    for (;;) {
        sum = 0u; cnt = 0u; mine = 0u;
#pragma unroll
        for (unsigned j = 0; j < 16; ++j) { const unsigned c = xb_ld(&bar[XB_XCNT(j)]); sum += c; cnt += (c > 0u) ? 1u : 0u; mine = (j == x) ? c : mine; }
        if (sum == G) break;
        __builtin_amdgcn_s_sleep(1);
        if ((++sp & 255u) == 0u) { if (xb_ld(&bar[XB_TMO])) break; if (sp > XB_SPIN_CAP) { atomicAdd(&bar[XB_TMO], 1u); break; } }
    }
    nloc = mine > 0u ? mine : 1u; nx = cnt > 0u ? cnt : 1u;
}

__device__ __forceinline__ void xcd_barrier(const XcdBarrier& b) {
    asm volatile("s_waitcnt vmcnt(0)" ::: "memory");
    __syncthreads();
    if (threadIdx.x == 0) {
        unsigned* bar = b.bar;
        __builtin_amdgcn_s_waitcnt(0);
        unsigned nloc = b.st[0], nx = b.st[1];
        if (nloc == 0u) { xcd_barrier_complete(bar, b.x, nloc, nx); b.st[0] = nloc; b.st[1] = nx; }
        const unsigned old = xb_add(&bar[XB_XSUB(b.x)], 1u);
        const unsigned gen = old / nloc;
        if (old + 1u == (gen + 1u) * nloc) {
            __builtin_amdgcn_fence(__ATOMIC_RELEASE, "agent");
            asm volatile("s_waitcnt vmcnt(0)" ::: "memory");
            const unsigned og = xb_add(&bar[XB_TOP], 1u);
            const unsigned tg = og / nx;
            if (og + 1u == (tg + 1u) * nx) xb_add(&bar[XB_TOPGEN], 1u);
            else XB_SPIN(xb_ld(&bar[XB_TOPGEN]) == tg, bar);
            __builtin_amdgcn_fence(__ATOMIC_ACQUIRE, "agent");
            xb_add(&bar[XB_XGEN(b.x)], 1u);
            asm volatile("s_waitcnt vmcnt(0)" ::: "memory");
        } else {
            XB_SPIN(xb_ld(&bar[XB_XGEN(b.x)]) == gen, bar);
            __builtin_amdgcn_fence(__ATOMIC_ACQUIRE, "agent");
            asm volatile("s_waitcnt vmcnt(0)" ::: "memory");
        }
    }
    __syncthreads();
}

__global__ void __launch_bounds__(NTHR, 2) fwd_mega(Args args) {
    extern __shared__ __attribute__((aligned(16))) unsigned char lds[];
    cg::grid_group grid = cg::this_grid();
#define GSYNC_CG() do { asm volatile("s_waitcnt vmcnt(0) lgkmcnt(0)" ::: "memory"); grid.sync(); __builtin_amdgcn_fence(__ATOMIC_ACQUIRE, "agent"); asm volatile("s_waitcnt vmcnt(0)" ::: "memory"); } while (0)
#define GSYNC() xcd_barrier(xbar)
    LAS unsigned char* L = (LAS unsigned char*)lds;
    const int tid = threadIdx.x, lane = tid & 63, wave = __builtin_amdgcn_readfirstlane(tid >> 6);
    const int G = gridDim.x, bx = blockIdx.x, vcu = (G % 8 == 0) ? (bx % 8) * (G / 8) + bx / 8 : bx;
    const int gw = vcu * NWAVES + wave, NGW = G * NWAVES;
    unsigned char* ws = args.ws;
    volatile LAS unsigned* xst = (volatile LAS unsigned*)(L + LDS_BYTES - 64);
    static_assert(attn2::PARK_OFF + attn2::PARK_BYTES <= LDS_BYTES - 64, "LDS map");
    if (tid < 2) xst[tid] = 0u;
    __syncthreads();
    XcdBarrier xbar = xcd_barrier_post((unsigned*)ws, xst);
    float* mod = (float*)(ws + WS_MOD); float* rope = (float*)(ws + WS_ROPE); float* lamp = (float*)(ws + WS_LAM);
    bf16 *W13A = (bf16*)(ws + WS_W13A), *W2A = (bf16*)(ws + WS_W2A), *W13B = (bf16*)(ws + WS_W13B), *W2B = (bf16*)(ws + WS_W2B), *WIN = (bf16*)(ws + WS_WIN), *WAP = (bf16*)(ws + WS_WAP), *WCP = (bf16*)(ws + WS_WCP), *WOUT = (bf16*)(ws + WS_WOUT);
    bf16 *H = (bf16*)(ws + WS_H), *Y = (bf16*)(ws + WS_Y), *ACT = (bf16*)(ws + WS_ACT), *Qb = (bf16*)(ws + WS_Q), *Kb = (bf16*)(ws + WS_K), *Vb = (bf16*)(ws + WS_V), *Ub = (bf16*)(ws + WS_U), *GA = (bf16*)(ws + WS_GA), *GB = (bf16*)(ws + WS_GB);
    bf16 *UC = (bf16*)(ws + WS_UC), *OSCR = (bf16*)(ws + WS_OSCR), *Zb = (bf16*)(ws + WS_Z);
    const float* x = args.in[I_X]; const float* ctx = args.in[I_CTX]; const float* normg = args.in[I_NORMG]; float* out = args.out;

    {
        LAS float* sc = (LAS float*)L;
        LAS float* red = (LAS float*)(L + 20480);
        if (bx < 144) {
            for (int i = tid; i < 5 * DM; i += NTHR) { const float c = i < 4 * DM ? args.in[I_C][i] : args.in[I_CCTX][i - 4 * DM]; sc[i] = c / (1.0f + expf(-c)); }
            __syncthreads();
            for (int it = bx; it < 144; it += G) {
                const int col = it * 64 + lane; const float* wp = args.in[I_WADA] + (size_t)(wave * 128) * (NMOD * DM) + col;
                float a0 = 0.f, a1 = 0.f, a2 = 0.f, a3 = 0.f, a4 = 0.f;
#pragma unroll 32
                for (int kk = 0; kk < 128; ++kk) { const float w = wp[(size_t)kk * (NMOD * DM)]; const int k = wave * 128 + kk;
                    a0 += sc[k] * w; a1 += sc[DM + k] * w; a2 += sc[2 * DM + k] * w; a3 += sc[3 * DM + k] * w; a4 += sc[4 * DM + k] * w; }
                red[(wave * 5 + 0) * 64 + lane] = a0; red[(wave * 5 + 1) * 64 + lane] = a1; red[(wave * 5 + 2) * 64 + lane] = a2; red[(wave * 5 + 3) * 64 + lane] = a3; red[(wave * 5 + 4) * 64 + lane] = a4;
                __syncthreads();
                if (tid < 320) { const int v = tid >> 6, cl = tid & 63; float s = 0.f;
#pragma unroll
                    for (int w8 = 0; w8 < 8; ++w8) s += red[(w8 * 5 + v) * 64 + cl];
                    mod[(size_t)v * (NMOD * DM) + it * 64 + cl] = s + args.in[I_BADA][it * 64 + cl]; }
                __syncthreads();
            }
        }
        if (bx == G - 1) {
            for (int i = tid; i < 2048; i += NTHR) { const int pos = i >> 4, f = i & 15; double inv = 1.0; for (int j = 0; j < f; ++j) inv *= 0.56234132519034908; const double ang = (double)pos * inv; rope[i] = (float)cos(ang); rope[2048 + i] = (float)sin(ang); }
        }
        if (bx == G - 2 && tid < 64) {
            const float* lq = args.in[I_LAMQK];
            const float s01 = wave_sum(lq[tid] * lq[64 + tid]), s23 = wave_sum(lq[128 + tid] * lq[192 + tid]);
            if (tid == 0) lamp[0] = expf(s01) - expf(s23) + 0.2f;
        }
        __syncthreads();
        LAS float* scr = (LAS float*)(L + wave * 16384);
        constexpr int I_13 = (DM / 64) * (2 * DFF / 32), I_2 = (DFF / 64) * (DM / 32);
        for (int it = gw; it < I_13 + I_2; it += NGW) {
            if (it < I_13) transpose_item<1>(args.in[I_F1W13], DM, 2 * DFF, W13A, scr, it, lane);
            else transpose_item<0>(args.in[I_F1W2], DFF, DM, W2A, scr, it - I_13, lane);
        }
    }
    if (args.pad0 != 0) GSYNC_CG();
    GSYNC();
    norm_rows<false, false, true>(gw, NGW, lane, 0, NROWS, x, ctx, nullptr, nullptr, H, mod, 0.f, nullptr, 0, normg + 0 * DM, 0);
    GSYNC();
    { pg8::Gemm g{H, W13A, NROWS, 2 * DFF, DM}; pg8::StaticOrder S; S.init(NROWS, 2 * DFF, G, bx); pg8::EpiSwiglu E{ACT, DFF};
      pg8::gemm_phase<pg8::EpiSwiglu, pg8::StaticOrder, PG8_ALIGN, PG8_SP2>(L, g, S, E); }
    {
        constexpr int NU = (NROWS / 256) * (2 * DFF / 256), NFULL = NU / 256, NREM = NU - NFULL * 256;
        static_assert(NREM > 0 && NREM < 256, "partial round");
        if (G == 256 ? bx >= NREM : true) {
            const int nhelp = (G == 256) ? (256 - NREM) : G, hid = (G == 256) ? bx - NREM : bx;
            LAS float* scr = (LAS float*)(L + wave * 16384);
            constexpr int I_13 = (DM / 64) * (2 * DFF / 32), I_2 = (DFF / 64) * (DM / 32), I_IN = (DM / 64) * (INW / 32), I_SQ = (DM / 64) * (DM / 32);
            constexpr int NITEMS = I_13 + I_2 + I_IN + 3 * I_SQ;
            for (int it = hid * NWAVES + wave; it < NITEMS; it += nhelp * NWAVES) {
                int r = it;
                if (r < I_IN) { transpose_item<2>(args.in[I_WIN], DM, INW, WIN, scr, r, lane); continue; } r -= I_IN;
                if (r < I_SQ) { transpose_item<0>(args.in[I_WAP], DM, DM, WAP, scr, r, lane); continue; } r -= I_SQ;
                if (r < I_SQ) { transpose_item<0>(args.in[I_WCP], DM, DM, WCP, scr, r, lane); continue; } r -= I_SQ;
                if (r < I_SQ) { transpose_item<0>(args.in[I_WOUT], DM, DM, WOUT, scr, r, lane); continue; } r -= I_SQ;
                if (r < I_13) { transpose_item<1>(args.in[I_F2W13], DM, 2 * DFF, W13B, scr, r, lane); continue; } r -= I_13;
                transpose_item<0>(args.in[I_F2W2], DFF, DM, W2B, scr, r, lane);
            }
        }
    }
    GSYNC();
    { pg8::Gemm g{ACT, W2A, NLAT, DM, DFF}; pg8::StaticOrder S; S.init(NLAT, DM, G, bx); pg8::EpiBf16<0> E{Y, DM, nullptr, 0, 0, 1.f};
      pg8::gemm_phase<pg8::EpiBf16<0>, pg8::StaticOrder, PG8_ALIGN, PG8_SP2>(L, g, S, E); }
    GSYNC();
    if (G == 256) {
        if (bx < 16) { pg8::Gemm g{ACT + (size_t)NLAT * DFF, W2A, NCTXR, DM, DFF}; pg8::StaticOrder S; S.init(NCTXR, DM, G, bx); pg8::EpiBf16<0> E{Y + (size_t)NLAT * DM, DM, nullptr, 0, 0, 1.f};
            pg8::gemm_phase<pg8::EpiBf16<0>, pg8::StaticOrder, PG8_ALIGN, PG8_SP2>(L, g, S, E); }
        else norm_rows<true, true, true>((bx - 16) * NWAVES + wave, (G - 16) * NWAVES, lane, 0, NLAT, x, ctx, Y, out, H, mod, 0.5f, normg + 1 * DM, 2, normg + 2 * DM, 3);
    } else {
        { pg8::Gemm g{ACT + (size_t)NLAT * DFF, W2A, NCTXR, DM, DFF}; pg8::StaticOrder S; S.init(NCTXR, DM, G, bx); pg8::EpiBf16<0> E{Y + (size_t)NLAT * DM, DM, nullptr, 0, 0, 1.f};
          pg8::gemm_phase<pg8::EpiBf16<0>, pg8::StaticOrder, PG8_ALIGN, PG8_SP2>(L, g, S, E); }
        norm_rows<true, true, true>(gw, NGW, lane, 0, NLAT, x, ctx, Y, out, H, mod, 0.5f, normg + 1 * DM, 2, normg + 2 * DM, 3);
    }
    GSYNC();
    norm_rows<true, true, true>(gw, NGW, lane, NLAT, NROWS, x, ctx, Y, out, H, mod, 0.5f, normg + 1 * DM, 2, normg + 2 * DM, 3);
    GSYNC();
    { pg8::Gemm g{H, WIN, NLAT, INW, DM}; pg8::StaticOrder S; S.init(NLAT, INW, G, bx);
      pg8::EpiWin E{Qb, Kb, Vb, Ub, GA, GB, rope, 1.0f};

      pg8::gemm_phase<pg8::EpiWin, pg8::StaticOrder, PG8_ALIGN, PG8_SP2>(L, g, S, E);
    }
    { pg8::Gemm g{H + (size_t)NLAT * DM, WIN + (size_t)1024 * DM, NCTXR, 2048, DM}; pg8::StaticOrder S; S.init(NCTXR, 2048, G, bx); pg8::EpiKVc E{Kb, Vb};
      pg8::gemm_phase<pg8::EpiKVc, pg8::StaticOrder, PG8_ALIGN, PG8_SP2>(L, g, S, E); }
    GSYNC();
    {
        const int c0 = 2 * tid;
        float w0[31], w1[31];
#pragma unroll
        for (int k = 0; k < 31; ++k) { const float2 w = *(const float2*)(args.in[I_CONVW] + k * DM + c0); w0[k] = w.x; w1[k] = w.y; }
        const float2 cb = *(const float2*)(args.in[I_CONVB] + c0), lg = *(const float2*)(args.in[I_CLNG] + c0), lb = *(const float2*)(args.in[I_CLNB] + c0);
        LAS float* red = (LAS float*)L;
        LAS float* stat = (LAS float*)(L + 2048);
        for (int item = vcu; item < NLAT / 16; item += G) {
            const int tg = item * 16, b = tg >> 13, t0 = tg & 8191;
            float a0[16], a1[16];
#pragma unroll
            for (int o = 0; o < 16; ++o) { a0[o] = 0.f; a1[o] = 0.f; }
#pragma unroll
            for (int i = 0; i < 46; ++i) {
                const int t = t0 - 15 + i; const bool valid = (t >= 0) && (t < SEQ); const int tt = valid ? t : t0;
                const unsigned wv = *(const unsigned*)(Ub + ((size_t)(b * SEQ + tt)) * DM + c0);
                const float x0 = valid ? pg8::bflo(wv) : 0.f, x1 = valid ? pg8::bfhi(wv) : 0.f;
#pragma unroll
                for (int o = 0; o < 16; ++o) { if (i - o >= 0 && i - o <= 30) { a0[o] += w0[i - o] * x0; a1[o] += w1[i - o] * x1; } }
            }
#pragma unroll
            for (int o = 0; o < 16; ++o) { a0[o] += cb.x; a1[o] += cb.y; const float s = wave_sum(a0[o] + a1[o]), ss = wave_sum(a0[o] * a0[o] + a1[o] * a1[o]);
                if (lane == 0) { red[wave * 32 + 2 * o] = s; red[wave * 32 + 2 * o + 1] = ss; } }
            __syncthreads();
            if (tid < 32) { float s = 0.f;
#pragma unroll
                for (int w8 = 0; w8 < 8; ++w8) s += red[w8 * 32 + tid];
                stat[tid] = s; }
            __syncthreads();
#pragma unroll
            for (int o = 0; o < 16; ++o) { const float mean = stat[2 * o] * (1.f / DM), var = stat[2 * o + 1] * (1.f / DM) - mean * mean, rstd = 1.0f / sqrtf(fmaxf(var, 0.f) + EPS);
                const float y0 = (a0[o] - mean) * rstd * lg.x + lb.x, y1 = (a1[o] - mean) * rstd * lg.y + lb.y;
                *(unsigned*)(UC + ((size_t)(tg + o)) * DM + c0) = pk2(pg8::fsilu(y0), pg8::fsilu(y1)); }
        }
    }
    __syncthreads();
    {
        const float lam = lamp[0];
#pragma unroll 1
        for (int un = vcu; un < NB * 8 * (SEQ / 256); un += G) {
            const int qb = un & 31, bh = (un >> 8) * 8 + ((un & 255) >> 5), b = bh >> 3, h = bh & 7;
            const size_t qrow0 = (size_t)b * SEQ + (size_t)qb * 256;
            const bf16* kbase = Kb + (size_t)b * NKEYS * DM; const bf16* vbase = Vb + (size_t)b * NKEYS * DM + h * 128;
            attn2::body<0>(Qb + qrow0 * DM + (2 * h) * 64, kbase + (2 * h) * 64, vbase, NKEYS, (char*)lds, lam, args.in[I_SUBLN], nullptr);
            attn2::body<1>(Qb + qrow0 * DM + (2 * h + 1) * 64, kbase + (2 * h + 1) * 64, vbase, NKEYS, (char*)lds, lam, args.in[I_SUBLN], Qb + qrow0 * DM + h * 128);
        }
    }
    GSYNC();
    { pg8::Gemm g{Qb, WAP, NLAT, DM, DM}; pg8::StaticOrder S; S.init(NLAT, DM, G, bx); pg8::EpiGate<false> E{Zb, GA};
      pg8::gemm_phase<pg8::EpiGate<false>, pg8::StaticOrder, PG8_ALIGN, PG8_SP2>(L, g, S, E); }
    asm volatile("s_waitcnt vmcnt(0)" ::: "memory");
    { pg8::Gemm g{UC, WCP, NLAT, DM, DM}; pg8::StaticOrder S; S.init(NLAT, DM, G, bx); pg8::EpiGate<true> E{Zb, GB};
      pg8::gemm_phase<pg8::EpiGate<true>, pg8::StaticOrder, PG8_ALIGN, PG8_SP2>(L, g, S, E); }
    GSYNC();
    { pg8::Gemm g{Zb, WOUT, NLAT, DM, DM}; pg8::StaticOrder S; S.init(NLAT, DM, G, bx); pg8::EpiBf16<0> E{Y, DM, nullptr, 0, 0, 1.f};
      pg8::gemm_phase<pg8::EpiBf16<0>, pg8::StaticOrder, PG8_ALIGN, PG8_SP2>(L, g, S, E);
    }
    GSYNC();
    norm_rows<true, true, true>(gw, NGW, lane, 0, NLAT, out, ctx, Y, out, H, mod, 1.0f, normg + 3 * DM, 5, normg + 4 * DM, 6);
    GSYNC();
    { pg8::Gemm g{H, W13B, NLAT, 2 * DFF, DM}; pg8::StaticOrder S; S.init(NLAT, 2 * DFF, G, bx); pg8::EpiSwiglu E{ACT, DFF};
      pg8::gemm_phase<pg8::EpiSwiglu, pg8::StaticOrder, PG8_ALIGN, PG8_SP2>(L, g, S, E);
    }
    GSYNC();
    { pg8::Gemm g{ACT, W2B, NLAT, DM, DFF}; pg8::StaticOrder S; S.init(NLAT, DM, G, bx); pg8::EpiBf16<0> E{Y, DM, nullptr, 0, 0, 1.f};
      pg8::gemm_phase<pg8::EpiBf16<0>, pg8::StaticOrder, PG8_ALIGN, PG8_SP2>(L, g, S, E);
    }
    GSYNC();
    norm_rows<true, true, false>(gw, NGW, lane, 0, NLAT, out, ctx, Y, out, nullptr, mod, 0.5f, normg + 5 * DM, 8, nullptr, 0);
}

extern "C" void kernel_launch(void* const* d_in, const int* in_sizes, int n_in, void* d_out, int out_size, void* d_ws, size_t ws_size, hipStream_t stream) {
    static int grid = 0;
    if (grid == 0) {
        if (n_in != 21 || ws_size < WS_END || out_size != NLAT * DM) { fprintf(stderr, "kernel_launch: unexpected shapes (n_in %d, out %d, ws %zu)\n", n_in, out_size, ws_size); grid = -1; return; }
        int dev = 0, cus = 0, per_cu = 0;
        if (hipGetDevice(&dev) != hipSuccess || hipDeviceGetAttribute(&cus, hipDeviceAttributeMultiprocessorCount, dev) != hipSuccess) { grid = -1; return; }
        if (hipFuncSetAttribute((const void*)fwd_mega, hipFuncAttributeMaxDynamicSharedMemorySize, LDS_BYTES) != hipSuccess) { fprintf(stderr, "kernel_launch: hipFuncSetAttribute failed\n"); grid = -1; return; }
        if (hipOccupancyMaxActiveBlocksPerMultiprocessor(&per_cu, (const void*)fwd_mega, NTHR, LDS_BYTES) != hipSuccess || per_cu < 1) fprintf(stderr, "kernel_launch: occupancy query says %d\n", per_cu);
        (void)hipGetLastError();
        grid = cus;
    }
    if (grid < 0) return;
    if (hipMemsetAsync(d_ws, 0, 16384, stream) != hipSuccess) { fprintf(stderr, "kernel_launch: memset of the barrier words failed\n"); return; }
    Args a{};
    for (int i = 0; i < 21; ++i) a.in[i] = (const float*)d_in[i];
    a.out = (float*)d_out; a.ws = (unsigned char*)d_ws;
    void* kargs[] = {&a};
    const hipError_t e = hipLaunchCooperativeKernel((const void*)fwd_mega, dim3(grid), dim3(NTHR), kargs, LDS_BYTES, stream);
    if (e != hipSuccess) fprintf(stderr, "cooperative launch failed: %s (grid %d)\n", hipGetErrorString(e), grid);
}
```

```cpp
#include <hip/hip_runtime.h>
#include <hip/hip_cooperative_groups.h>
#include <cstdio>
#include <cstdint>
namespace cg = cooperative_groups;
namespace pg8 {
#define PG8_LAS __attribute__((address_space(3)))
typedef unsigned short bf16_t;
typedef short bf16x8 __attribute__((ext_vector_type(8)));
typedef float f32x4 __attribute__((ext_vector_type(4)));
typedef unsigned u32x4 __attribute__((ext_vector_type(4)));
constexpr int BM = 256, BK = 64, HALF = 128, HTB = HALF * BK * 2  , STAGE_BYTES = 8 * HTB, NXCD = 8, WGM = 8;

__host__ __device__ __forceinline__ int lds_byte(int r, int c) { const int st = (r >> 4) * 2 + (c >> 5), rr = r & 15, cc = c & 31, ob = rr * 64 + cc * 2; return st * 1024 + (ob ^ (((ob >> 9) & 1) << 5)); }
__host__ __device__ __forceinline__ void stage_rc(int b, int& R, int& C) { const int st = b / 1024, sb = b % 1024, swz = sb ^ (((sb >> 9) & 1) << 5); R = (st >> 1) * 16 + swz / 64; C = (st & 1) * 32 + (swz % 64) / 2; }
__host__ __device__ __forceinline__ int perm32(int rho) { const int n = rho >> 4, i = rho & 15; return 8 * (i >> 2) + 4 * n + (i & 3); }

struct Unit { int pm, pn; };
struct Gemm { const bf16_t* A; const bf16_t* Bt; int M, N, K; };

struct StaticOrder {
    int nM, nN, nwg, G, c;
    __host__ __device__ void init(int M, int N, int G_, int c_) { nM = M / BM; nN = N / BM; nwg = nM * nN; G = G_; c = c_; }
    __host__ __device__ bool next(int i, Unit& u) const {
        const long L = (long)i * G + c; if (L >= nwg) return false;
        int wgid = (int)L; { const int q = nwg / NXCD, r = nwg % NXCD, xcd = wgid % NXCD, off = wgid / NXCD; wgid = (xcd < r ? xcd * (q + 1) : r * (q + 1) + (xcd - r) * q) + off; }
        const int nig = WGM * nN, gid = wgid / nig, fm = gid * WGM, gsz = (nM - fm) < WGM ? (nM - fm) : WGM;
        u.pm = fm + ((wgid % nig) % gsz); u.pn = (wgid % nig) / gsz; return true;
    }
    __device__ __forceinline__ void a_ready(const Unit&) const {}
    __device__ __forceinline__ void done(const Unit&) const {}
};

typedef float f32x2c_t __attribute__((ext_vector_type(2))); typedef __bf16 bf16x2c_t __attribute__((ext_vector_type(2)));
__device__ __forceinline__ unsigned cvt_pk_bf16(float lo, float hi) { f32x2c_t v = {lo, hi}; bf16x2c_t b = __builtin_convertvector(v, bf16x2c_t); return __builtin_bit_cast(unsigned, b); }
typedef float f32x2 __attribute__((ext_vector_type(2)));
__device__ __forceinline__ f32x2 gelu_pk(f32x2 v) {
    const f32x2 av = __builtin_elementwise_abs(v), d = av * 0.2316418882f + 1.0f;
    f32x2 t; t.x = __builtin_amdgcn_rcpf(d.x); t.y = __builtin_amdgcn_rcpf(d.y);
    f32x2 q = t * 0.5307027145f + (-0.7265760135f); q = q * t + 0.7107068705f; q = q * t + (-0.142248368f); q = q * t + 0.127414796f; q = q * t;
    const f32x2 s = (v * v) * (-0.72134752044f);
    f32x2 e; e.x = __builtin_amdgcn_exp2f(s.x); e.y = __builtin_amdgcn_exp2f(s.y);
    const f32x2 m = v * (q * e), r = v - m;
    f32x2 o; o.x = v.x < 0.f ? m.x : r.x; o.y = v.y < 0.f ? m.y : r.y; return o;
}

template <int ACT  > struct EpiBf16 {
    static constexpr bool PERM = true, AFTER_DRAIN = false; static_assert(ACT == 0 || ACT == 1, "EpiBf16: ACT is 0 (none) or 1 (gelu_pk)");
    bf16_t* O; int ldc; const float* bias; int split_cols; size_t split_stride; float scale0;
    __device__ __forceinline__ void operator()(const f32x4 (&acc)[2][2][4][2], const Unit& u, int wr, int wc, int fr, int fq) const {
        const int row0 = u.pm * BM + wr * 64 + fr; int colt = u.pn * BM; bf16_t* base = O;
        float sc = 1.f; if (split_cols) { const int t = colt / split_cols; base += (size_t)t * split_stride; colt -= t * split_cols; if (t == 0) sc = scale0; }
        const int col0 = colt + wc * 32 + 8 * fq, bcol0 = u.pn * BM + wc * 32 + 8 * fq;
        f32x4 bv[2][2];
#pragma unroll
        for (int bj = 0; bj < 2; ++bj)
#pragma unroll
            for (int n = 0; n < 2; ++n) bv[bj][n] = bias ? *(const f32x4*)(bias + bcol0 + bj * HALF + 4 * n) : (f32x4){0.f, 0.f, 0.f, 0.f};
#pragma unroll
        for (int ai = 0; ai < 2; ++ai)
#pragma unroll
            for (int m = 0; m < 4; ++m) { bf16_t* rowp = base + (size_t)(row0 + ai * HALF + m * 16) * ldc + col0;
#pragma unroll
                for (int bj = 0; bj < 2; ++bj) { f32x4 v0 = acc[ai][bj][m][0] + bv[bj][0], v1 = acc[ai][bj][m][1] + bv[bj][1];
                    if (ACT == 1) { f32x2 a = gelu_pk((f32x2){v0[0], v0[1]}), b = gelu_pk((f32x2){v0[2], v0[3]}), c = gelu_pk((f32x2){v1[0], v1[1]}), d = gelu_pk((f32x2){v1[2], v1[3]});
                        v0 = (f32x4){a.x, a.y, b.x, b.y}; v1 = (f32x4){c.x, c.y, d.x, d.y}; }
                    v0 = v0 * sc; v1 = v1 * sc; u32x4 w; w.x = cvt_pk_bf16(v0[0], v0[1]); w.y = cvt_pk_bf16(v0[2], v0[3]); w.z = cvt_pk_bf16(v1[0], v1[1]); w.w = cvt_pk_bf16(v1[2], v1[3]);
                    *(u32x4*)(rowp + bj * HALF) = w; } }
    }
};
template <class Epi, class Sched, bool ALIGN_EPI = false, bool SP2 = false>
__device__ __forceinline__ void gemm_phase(PG8_LAS unsigned char* lds, const Gemm g, const Sched& S, const Epi& E) {
    int tid_ = threadIdx.x; asm volatile("" : "+v"(tid_));
    const int tid = tid_, wid = __builtin_amdgcn_readfirstlane(tid >> 6), lane = tid & 63, wr = wid >> 2, wc = wid & 3, fr = lane & 15, fq = lane >> 4;
    const int K = g.K, nt = K / BK;
    unsigned voffA[2], voffB[2];
#pragma unroll
    for (int i = 0; i < 2; ++i) { int R, C; stage_rc(tid * 16 + i * 8192, R, C); const int Rb = Epi::PERM ? ((R & ~31) + perm32(R & 31)) : R;
        voffA[i] = (unsigned)(R * K + C) * 2u; voffB[i] = (unsigned)(Rb * K + C) * 2u; }
    const size_t kstep = (size_t)(BK * 2);
    const size_t hstep = (size_t)HALF * K * 2;
    const size_t tstep = 2 * hstep;
    const unsigned ldsw = (unsigned)wid * 1024u;
    const int aoff = lds_byte(wr * 64 + fr, fq * 8), boff = lds_byte(wc * 32 + fr, fq * 8);
#define PG8_SA(b, h) (((b) * 2 + (h)) * HTB)
#define PG8_SB(b, h) ((4 + (b) * 2 + (h)) * HTB)
#define PG8_STAGE(bufoff, gbase, voff) do { _Pragma("unroll") for (int _i = 0; _i < 2; ++_i) \
        __builtin_amdgcn_global_load_lds((const unsigned*)((const char*)(gbase) + (voff)[_i]), (PG8_LAS unsigned*)(lds + (bufoff) + ldsw + _i * 8192), 16, 0, 0); } while (0)
#define PG8_LDA(dst, b, h) do { _Pragma("unroll") for (int m = 0; m < 4; ++m) _Pragma("unroll") for (int k = 0; k < 2; ++k) dst[m][k] = *(const PG8_LAS bf16x8*)(lds + PG8_SA(b, h) + aoff + m * 2048 + k * 1024); } while (0)
#define PG8_LDB(dst, b, h) do { _Pragma("unroll") for (int n = 0; n < 2; ++n) _Pragma("unroll") for (int k = 0; k < 2; ++k) dst[n][k] = *(const PG8_LAS bf16x8*)(lds + PG8_SB(b, h) + boff + n * 2048 + k * 1024); } while (0)
#define PG8_MMA(ai, bj, At, Bt) do { __builtin_amdgcn_s_setprio(1); _Pragma("unroll") for (int m = 0; m < 4; ++m) _Pragma("unroll") for (int n = 0; n < 2; ++n) _Pragma("unroll") for (int k = 0; k < 2; ++k) \
        acc[ai][bj][m][n] = __builtin_amdgcn_mfma_f32_16x16x32_bf16(Bt[n][k], At[m][k], acc[ai][bj][m][n], 0, 0, 0); __builtin_amdgcn_s_setprio(0); } while (0)
#define PG8_WAIT_V(n) asm volatile("s_waitcnt vmcnt(" #n ")" ::: "memory")
#define PG8_WAIT_L(n) asm volatile("s_waitcnt lgkmcnt(" #n ")" ::: "memory")
#define PG8_BAR __builtin_amdgcn_s_barrier()
#define PG8_SCHED __builtin_amdgcn_sched_barrier(0)
    Unit cur, nxt; int ui = 0;
    if (!S.next(0, cur)) return;
    f32x4 acc[2][2][4][2];
#pragma unroll
    for (int a = 0; a < 2; ++a)
#pragma unroll
        for (int b = 0; b < 2; ++b)
#pragma unroll
            for (int m = 0; m < 4; ++m)
#pragma unroll
                for (int n = 0; n < 2; ++n) acc[a][b][m][n] = (f32x4){0.f, 0.f, 0.f, 0.f};
    bf16x8 At[4][2], B0[2][2], B1[2][2];
    const char* cA = (const char*)g.A + (size_t)cur.pm * tstep; const char* cB = (const char*)g.Bt + (size_t)cur.pn * tstep;
    S.a_ready(cur);
    if constexpr (SP2) {
        PG8_STAGE(PG8_SB(0, 0), cB, voffB); PG8_STAGE(PG8_SB(0, 1), cB + hstep, voffB); PG8_STAGE(PG8_SA(0, 0), cA, voffA); PG8_STAGE(PG8_SA(0, 1), cA + hstep, voffA);
        if (wr == 1) PG8_BAR;
        PG8_WAIT_V(2); PG8_BAR;
        PG8_STAGE(PG8_SB(1, 0), cB + kstep, voffB); PG8_STAGE(PG8_SA(1, 0), cA + kstep, voffA); PG8_STAGE(PG8_SB(1, 1), cB + hstep + kstep, voffB);
        PG8_WAIT_V(6); PG8_BAR;
    } else {
        PG8_STAGE(PG8_SB(0, 0), cB, voffB); PG8_STAGE(PG8_SA(0, 0), cA, voffA); PG8_STAGE(PG8_SB(0, 1), cB + hstep, voffB); PG8_STAGE(PG8_SA(0, 1), cA + hstep, voffA);
        if (wr == 1) PG8_BAR;
        PG8_WAIT_V(4); PG8_BAR;
        PG8_STAGE(PG8_SB(1, 0), cB + kstep, voffB); PG8_STAGE(PG8_SA(1, 0), cA + kstep, voffA); PG8_STAGE(PG8_SB(1, 1), cB + hstep + kstep, voffB);
        PG8_WAIT_V(6); PG8_BAR;
    }
    for (;;) {
        const bool has_next = S.next(ui + 1, nxt);
        const char* nA = has_next ? (const char*)g.A + (size_t)nxt.pm * tstep : cA; const char* nB = has_next ? (const char*)g.Bt + (size_t)nxt.pn * tstep : cB;
        for (int t = 0; t < nt; t += 2) {
            const bool last = (t == nt - 2);
            const char* a1 = cA + (size_t)(t + 1) * kstep;
            const char* a2 = last ? nA : cA + (size_t)(t + 2) * kstep; const char* b2 = last ? nB : cB + (size_t)(t + 2) * kstep;
            const char* a3 = a2 + kstep; const char* b3 = b2 + kstep;
            if (last && has_next) S.a_ready(nxt);
            if constexpr (SP2) {
            PG8_LDB(B0, 0, 0); PG8_LDB(B1, 0, 1); PG8_SCHED; PG8_LDA(At, 0, 0); PG8_STAGE(PG8_SA(1, 1), a1 + hstep, voffA);
            PG8_WAIT_V(8); PG8_WAIT_L(0); PG8_BAR; PG8_MMA(0, 0, At, B0); PG8_MMA(0, 1, At, B1); PG8_BAR; PG8_SCHED;
            PG8_LDA(At, 0, 1); PG8_STAGE(PG8_SB(0, 0), b2, voffB); PG8_STAGE(PG8_SB(0, 1), b2 + hstep, voffB); PG8_STAGE(PG8_SA(0, 0), a2, voffA);
            PG8_WAIT_V(8); PG8_WAIT_L(0); PG8_BAR; PG8_MMA(1, 0, At, B0); PG8_MMA(1, 1, At, B1); PG8_BAR; PG8_SCHED;
            PG8_LDB(B0, 1, 0); PG8_LDB(B1, 1, 1); PG8_SCHED; PG8_LDA(At, 1, 0); PG8_STAGE(PG8_SA(0, 1), a2 + hstep, voffA);
            PG8_WAIT_V(8); PG8_WAIT_L(0); PG8_BAR; PG8_MMA(0, 0, At, B0); PG8_MMA(0, 1, At, B1); PG8_BAR; PG8_SCHED;
            PG8_LDA(At, 1, 1); PG8_STAGE(PG8_SB(1, 0), b3, voffB); PG8_STAGE(PG8_SB(1, 1), b3 + hstep, voffB); PG8_STAGE(PG8_SA(1, 0), a3, voffA);
            PG8_WAIT_V(8); PG8_WAIT_L(0); PG8_BAR; PG8_MMA(1, 0, At, B0); PG8_MMA(1, 1, At, B1); PG8_BAR; PG8_SCHED;
            } else {
            PG8_LDB(B0, 0, 0); PG8_SCHED; PG8_LDA(At, 0, 0); PG8_STAGE(PG8_SA(1, 1), a1 + hstep, voffA);
            PG8_WAIT_L(8); PG8_BAR; PG8_WAIT_L(0); PG8_MMA(0, 0, At, B0); PG8_BAR; PG8_SCHED;
            PG8_LDB(B1, 0, 1); PG8_STAGE(PG8_SB(0, 0), b2, voffB);
            PG8_BAR; PG8_WAIT_L(0); PG8_MMA(0, 1, At, B1); PG8_BAR;
            PG8_LDA(At, 0, 1); PG8_STAGE(PG8_SA(0, 0), a2, voffA);
            PG8_BAR; PG8_WAIT_L(0); PG8_MMA(1, 0, At, B0); PG8_BAR; PG8_SCHED;
            PG8_STAGE(PG8_SB(0, 1), b2 + hstep, voffB);
            PG8_WAIT_V(6); PG8_BAR; PG8_MMA(1, 1, At, B1); PG8_BAR;
            PG8_LDB(B0, 1, 0); PG8_SCHED; PG8_LDA(At, 1, 0); PG8_STAGE(PG8_SA(0, 1), a2 + hstep, voffA);
            PG8_WAIT_L(8); PG8_BAR; PG8_WAIT_L(0); PG8_MMA(0, 0, At, B0); PG8_BAR; PG8_SCHED;
            PG8_LDB(B1, 1, 1); PG8_STAGE(PG8_SB(1, 0), b3, voffB);
            PG8_BAR; PG8_WAIT_L(0); PG8_MMA(0, 1, At, B1); PG8_BAR;
            PG8_LDA(At, 1, 1); PG8_STAGE(PG8_SA(1, 0), a3, voffA);
            PG8_BAR; PG8_WAIT_L(0); PG8_MMA(1, 0, At, B0); PG8_BAR; PG8_SCHED;
            PG8_STAGE(PG8_SB(1, 1), b3 + hstep, voffB);
            PG8_WAIT_V(6); PG8_BAR; PG8_MMA(1, 1, At, B1); PG8_BAR;
            }
        }
        if constexpr (ALIGN_EPI) { if (wr == 0) PG8_BAR; }
        if constexpr (!Epi::AFTER_DRAIN) { E(acc, cur, wr, wc, fr, fq); S.done(cur); }
        if (!has_next) break;
#pragma unroll
        for (int a = 0; a < 2; ++a)
#pragma unroll
            for (int b = 0; b < 2; ++b)
#pragma unroll
                for (int m = 0; m < 4; ++m)
#pragma unroll
                    for (int n = 0; n < 2; ++n) acc[a][b][m][n] = (f32x4){0.f, 0.f, 0.f, 0.f};
        cur = nxt; cA = nA; cB = nB; ++ui;
        if constexpr (ALIGN_EPI) { if (wr == 1) PG8_BAR; }
    }
    PG8_WAIT_V(0);
    if constexpr (!ALIGN_EPI) { if (wr == 0) PG8_BAR; }
    PG8_BAR;
    if constexpr (Epi::AFTER_DRAIN) { E.fused(acc, cur, wr, wc, fr, fq, lds, wid, lane); S.done(cur); }
#undef PG8_SA
#undef PG8_SB
#undef PG8_STAGE
#undef PG8_LDA
#undef PG8_LDB
#undef PG8_MMA
#undef PG8_WAIT_V
#undef PG8_WAIT_L
#undef PG8_BAR
#undef PG8_SCHED
}
}

#ifndef PG8_SP2
#define PG8_SP2 true
#endif
#ifndef PG8_ALIGN
#define PG8_ALIGN true
#endif
#include <hip/hip_bf16.h>
#include <cmath>
namespace attn2 {
using bf16x8 = __attribute__((ext_vector_type(8))) short;
using s16x4  = __attribute__((ext_vector_type(4))) short;
using f32x16 = __attribute__((ext_vector_type(16))) float;
using u32x4  = __attribute__((ext_vector_type(4))) unsigned;
typedef unsigned short bf16r;
constexpr int DQ = 64, DV = 128, NW = 8, QBLK = 32, KVBLK = 64, LD = 1024;
constexpr float SCALE = 0.125f, THR = 8.f;
constexpr size_t SHM_V = KVBLK * DV * 2, SHM_K = KVBLK * DQ * 2, SHM_ATTN = 3 * SHM_V + 3 * SHM_K + NW * 64 * 4;
constexpr size_t PARK_OFF = SHM_ATTN, PARK_BYTES = NW * 2048 * 4;
#define A2_KSWZ(row, colB) ((row) * 128 + ((colB) ^ ((((row) >> 1) & 7) << 4)))
#define A2_SBAR() __builtin_amdgcn_sched_barrier(0)
__device__ __forceinline__ int crow(int r, int hi) { return (r & 3) + 8 * (r >> 2) + 4 * hi; }
typedef float f32x2_t __attribute__((ext_vector_type(2))); typedef __bf16 bf16x2_t __attribute__((ext_vector_type(2)));
__device__ __forceinline__ unsigned cvtpk(float lo, float hi) { f32x2_t v = {lo, hi}; bf16x2_t b = __builtin_convertvector(v, bf16x2_t); return __builtin_bit_cast(unsigned, b); }

__device__ __forceinline__ void partialSM(f32x16& p0, f32x16& p1, float& m_reg, float& mn, float& alpha) {
  constexpr float C = SCALE * 1.4426950408889634f;
  float pmax = p0[0];
#pragma unroll
  for (int r = 1; r < 16; ++r) pmax = fmaxf(pmax, p0[r]);
#pragma unroll
  for (int r = 0; r < 16; ++r) pmax = fmaxf(pmax, p1[r]);
  { auto rr = __builtin_amdgcn_permlane32_swap(__float_as_uint(pmax), __float_as_uint(pmax), false, false);
    pmax = fmaxf(__uint_as_float(rr[0]), __uint_as_float(rr[1])); }
  if (__builtin_expect(__all(pmax - m_reg <= THR / SCALE), 1)) { mn = m_reg; alpha = 1.f; }
  else { mn = fmaxf(m_reg, pmax); alpha = __builtin_amdgcn_exp2f((m_reg - mn) * C); m_reg = mn; }
  const float mnC = -mn * C;
  { const f32x2_t cv = {C, C}, mv = {mnC, mnC};
#pragma unroll
    for (int i = 0; i < 8; ++i) { f32x2_t t = {p0[2 * i], p0[2 * i + 1]}; t = t * cv + mv; p0[2 * i] = t.x; p0[2 * i + 1] = t.y; }
#pragma unroll
    for (int i = 0; i < 8; ++i) { f32x2_t t = {p1[2 * i], p1[2 * i + 1]}; t = t * cv + mv; p1[2 * i] = t.x; p1[2 * i + 1] = t.y; } }
#pragma unroll
  for (int r = 0; r < 16; ++r) p0[r] = __builtin_amdgcn_exp2f(p0[r]);
}
constexpr float LAZY_BIG = 1073741824.f;
__device__ __forceinline__ void finishSM(f32x16& p0, f32x16& p1, float& m_reg, float& alpha, float& l_reg, bf16x8& pa0, bf16x8& pa1, bf16x8& pa2, bf16x8& pa3) {
  constexpr float C = SCALE * 1.4426950408889634f;
#pragma unroll
  for (int r = 0; r < 16; ++r) p1[r] = __builtin_amdgcn_exp2f(p1[r]);
  f32x2_t sv = {p0[0], p0[1]};
#pragma unroll
  for (int i = 1; i < 8; ++i) sv += (f32x2_t){p0[2 * i], p0[2 * i + 1]};
#pragma unroll
  for (int i = 0; i < 8; ++i) sv += (f32x2_t){p1[2 * i], p1[2 * i + 1]};
  float ps = sv.x + sv.y;
  alpha = 1.f;
  if (__builtin_expect(__any(!(ps <= LAZY_BIG)), 0)) {
    auto rr = __builtin_amdgcn_permlane32_swap(__float_as_uint(ps), __float_as_uint(ps), false, false);
    const float pt = __uint_as_float(rr[0]) + __uint_as_float(rr[1]);
    const float dl = (pt > LAZY_BIG) ? floorf(__log2f(pt)) + 1.f : 0.f;
    alpha = __builtin_amdgcn_exp2f(-dl); m_reg += dl * (1.0f / C);
#pragma unroll
    for (int r = 0; r < 16; ++r) { p0[r] *= alpha; p1[r] *= alpha; }
    ps *= alpha;
  }
  l_reg = l_reg * alpha + ps; asm volatile("" : "+v"(l_reg));
#define A2_PK8(P, BASE, OUT) do { u32x4 w = {cvtpk(P[BASE + 0], P[BASE + 1]), cvtpk(P[BASE + 2], P[BASE + 3]), cvtpk(P[BASE + 4], P[BASE + 5]), cvtpk(P[BASE + 6], P[BASE + 7])}; OUT = *reinterpret_cast<bf16x8*>(&w); } while (0)
  A2_PK8(p0, 0, pa0); A2_PK8(p0, 8, pa1); A2_PK8(p1, 0, pa2); A2_PK8(p1, 8, pa3);
#undef A2_PK8
}
__device__ __forceinline__ void qkt(f32x16& p0, f32x16& p1, const char* Ks, const bf16x8* qr, int r32, int hi) {
  p0 = f32x16{}; p1 = f32x16{};
#pragma unroll
  for (int d0 = 0; d0 < 4; ++d0) { const int cb = (d0 * 16 + hi * 8) * 2;
    const bf16x8 b0 = *reinterpret_cast<const bf16x8*>(Ks + A2_KSWZ(r32, cb));
    const bf16x8 b1 = *reinterpret_cast<const bf16x8*>(Ks + A2_KSWZ(32 + r32, cb));
    p0 = __builtin_amdgcn_mfma_f32_32x32x16_bf16(b0, qr[d0], p0, 0, 0, 0);
    p1 = __builtin_amdgcn_mfma_f32_32x32x16_bf16(b1, qr[d0], p1, 0, 0, 0); }
}
__device__ __forceinline__ int v_st(int k, int c) { const int kk = k;     return ((kk >> 3) * 4 + (c >> 5)) * 512 + ((kk & 7) * 32 + (c & 31)) * 2; }
__device__ __forceinline__ int v_rd_base(int lane) { return ((lane & 3) << 3) | (((lane >> 2) & 3) << 6) | (((lane >> 4) & 1) << 5) | (((lane >> 5) & 1) << 8); }
constexpr int v_rd_off(int d0, int ks, int half) { return d0 * 512 + ks * 4096 + half * 2048; }
template <int OFF> __device__ __forceinline__ s16x4 tr_read(int vb) {
  s16x4 r; asm volatile("ds_read_b64_tr_b16 %0, %1 offset:%2" : "=&v"(r) : "v"(vb), "i"(OFF) : "memory"); return r;
}
template <int D0> __device__ __forceinline__ void pv_one(f32x16& od, int vb, bf16x8 pa0, bf16x8 pa1, bf16x8 pa2, bf16x8 pa3) {
  const s16x4 l0 = tr_read<v_rd_off(D0, 0, 0)>(vb), h0 = tr_read<v_rd_off(D0, 0, 1)>(vb), l1 = tr_read<v_rd_off(D0, 1, 0)>(vb), h1 = tr_read<v_rd_off(D0, 1, 1)>(vb);
  const s16x4 l2 = tr_read<v_rd_off(D0, 2, 0)>(vb), h2 = tr_read<v_rd_off(D0, 2, 1)>(vb), l3 = tr_read<v_rd_off(D0, 3, 0)>(vb), h3 = tr_read<v_rd_off(D0, 3, 1)>(vb);
  asm volatile("s_waitcnt lgkmcnt(0)" ::: "memory"); A2_SBAR();
#define A2_PK(L, H) (bf16x8){L[0], L[1], L[2], L[3], H[0], H[1], H[2], H[3]}
  od = __builtin_amdgcn_mfma_f32_32x32x16_bf16(pa0, A2_PK(l0, h0), od, 0, 0, 0);
  od = __builtin_amdgcn_mfma_f32_32x32x16_bf16(pa1, A2_PK(l1, h1), od, 0, 0, 0);
  od = __builtin_amdgcn_mfma_f32_32x32x16_bf16(pa2, A2_PK(l2, h2), od, 0, 0, 0);
  od = __builtin_amdgcn_mfma_f32_32x32x16_bf16(pa3, A2_PK(l3, h3), od, 0, 0, 0);
#undef A2_PK
}
__device__ __forceinline__ void pv_d0(f32x16* o, int vb, bf16x8 pa0, bf16x8 pa1, bf16x8 pa2, bf16x8 pa3) {
  pv_one<0>(o[0], vb, pa0, pa1, pa2, pa3); pv_one<1>(o[1], vb, pa0, pa1, pa2, pa3); pv_one<2>(o[2], vb, pa0, pa1, pa2, pa3); pv_one<3>(o[3], vb, pa0, pa1, pa2, pa3);
}

struct VF { s16x4 l0, h0, l1, h1, l2, h2, l3, h3; };
template <int D0> __device__ __forceinline__ VF vread(int vb) { VF f;
  f.l0 = tr_read<v_rd_off(D0, 0, 0)>(vb); f.h0 = tr_read<v_rd_off(D0, 0, 1)>(vb); f.l1 = tr_read<v_rd_off(D0, 1, 0)>(vb); f.h1 = tr_read<v_rd_off(D0, 1, 1)>(vb);
  f.l2 = tr_read<v_rd_off(D0, 2, 0)>(vb); f.h2 = tr_read<v_rd_off(D0, 2, 1)>(vb); f.l3 = tr_read<v_rd_off(D0, 3, 0)>(vb); f.h3 = tr_read<v_rd_off(D0, 3, 1)>(vb); return f; }
__device__ __forceinline__ void mfma4(f32x16& od, const VF& f, bf16x8 pa0, bf16x8 pa1, bf16x8 pa2, bf16x8 pa3) {
#define A2_PK(L, H) (bf16x8){L[0], L[1], L[2], L[3], H[0], H[1], H[2], H[3]}
  od = __builtin_amdgcn_mfma_f32_32x32x16_bf16(pa0, A2_PK(f.l0, f.h0), od, 0, 0, 0);
  od = __builtin_amdgcn_mfma_f32_32x32x16_bf16(pa1, A2_PK(f.l1, f.h1), od, 0, 0, 0);
  od = __builtin_amdgcn_mfma_f32_32x32x16_bf16(pa2, A2_PK(f.l2, f.h2), od, 0, 0, 0);
  od = __builtin_amdgcn_mfma_f32_32x32x16_bf16(pa3, A2_PK(f.l3, f.h3), od, 0, 0, 0);
#undef A2_PK
}
#define A2_LWAIT(n) do { asm volatile("s_waitcnt lgkmcnt(" #n ")" ::: "memory"); A2_SBAR(); } while (0)
__device__ __forceinline__ void pv_psm(f32x16* o, int vb, bf16x8 pa0, bf16x8 pa1, bf16x8 pa2, bf16x8 pa3, f32x16& p0, f32x16& p1, float m_reg) {
  constexpr float C = SCALE * 1.4426950408889634f;
  const float mnC = -m_reg * C; const f32x2_t cv = {C, C}, mv = {mnC, mnC};
  const VF f0 = vread<0>(vb);
  const VF f1 = vread<1>(vb); A2_LWAIT(8); mfma4(o[0], f0, pa0, pa1, pa2, pa3);
#pragma unroll
  for (int i = 0; i < 8; ++i) { f32x2_t t = {p0[2 * i], p0[2 * i + 1]}; t = t * cv + mv; p0[2 * i] = t.x; p0[2 * i + 1] = t.y; }
  asm volatile("" : "+v"(p0));
  const VF f2 = vread<2>(vb); A2_LWAIT(8); mfma4(o[1], f1, pa0, pa1, pa2, pa3);
#pragma unroll
  for (int i = 0; i < 8; ++i) { f32x2_t t = {p1[2 * i], p1[2 * i + 1]}; t = t * cv + mv; p1[2 * i] = t.x; p1[2 * i + 1] = t.y; }
  asm volatile("" : "+v"(p1));
  const VF f3 = vread<3>(vb); A2_LWAIT(8); mfma4(o[2], f2, pa0, pa1, pa2, pa3);
#pragma unroll
  for (int r = 0; r < 8; ++r) p0[r] = __builtin_amdgcn_exp2f(p0[r]);
  asm volatile("" : "+v"(p0));
  A2_LWAIT(0); mfma4(o[3], f3, pa0, pa1, pa2, pa3);
#pragma unroll
  for (int r = 8; r < 16; ++r) p0[r] = __builtin_amdgcn_exp2f(p0[r]);
  asm volatile("" : "+v"(p0)); A2_SBAR();
}
template <int PASS>
__device__ __forceinline__ void body(const bf16r* Qb, const bf16r* Kh, const bf16r* Vh, int seq, char* lds, float lam, const float* subln, bf16r* Ob) {
  int tid_ = threadIdx.x; asm volatile("" : "+v"(tid_));
  const int tid = tid_, wid = tid >> 6, lane = tid & 63, r32 = lane & 31, hi = lane >> 5;
  char* V_lds = lds; char* K_lds = lds + 3 * SHM_V;
  float* ws = (float*)(lds + 3 * SHM_V + 3 * SHM_K) + wid * 64; float* li_l = ws; float* al_l = ws + 32;
  float m_reg = -1e30f, l_reg = 0; f32x16 o[4] = {}; bf16x8 qr[4];
  const bf16r* Qw = Qb + (long)(wid * QBLK + r32) * LD + hi * 8;
#pragma unroll
  for (int d0 = 0; d0 < 4; ++d0) qr[d0] = *reinterpret_cast<const bf16x8*>(Qw + d0 * 16);
  const int sr = tid >> 4, sc = (tid & 15) * 8, vst0 = v_st(sr, sc), vst1 = v_st(32 + sr, sc);
  const int kr = tid >> 3, kc = (tid & 7) * 8, kst = A2_KSWZ(kr, kc * 2);
  const int vb0 = (int)(uintptr_t)V_lds + v_rd_base(lane);
  struct { bf16x8 vs0, vs1, ks0; } sr_[2];
#define A2_SLOAD(i, k0) do { sr_[i].vs0 = *reinterpret_cast<const bf16x8*>(&Vh[(long)((k0) + sr) * LD + sc]); sr_[i].vs1 = *reinterpret_cast<const bf16x8*>(&Vh[(long)((k0) + 32 + sr) * LD + sc]); \
    sr_[i].ks0 = *reinterpret_cast<const bf16x8*>(&Kh[(long)((k0) + kr) * LD + kc]); } while (0)
#define A2_SWRITE(b, i) do { *(bf16x8*)(V_lds + (b) * SHM_V + vst0) = sr_[i].vs0; *(bf16x8*)(V_lds + (b) * SHM_V + vst1) = sr_[i].vs1; *(bf16x8*)(K_lds + (b) * SHM_K + kst) = sr_[i].ks0; } while (0)
#define A2_SWAIT() asm volatile("s_waitcnt vmcnt(3)" ::: "memory")
#define A2_RESC(a) do { if (__any((a) < 1.f)) { if (hi == 0) al_l[r32] = (a); asm volatile("s_waitcnt lgkmcnt(0)" ::: "memory"); \
    _Pragma("unroll") for (int d = 0; d < 4; ++d) _Pragma("unroll") for (int r = 0; r < 16; ++r) o[d][r] *= al_l[crow(r, hi)]; } } while (0)
  if (wid >= 4) __builtin_amdgcn_s_setprio(1);
  f32x16 pA0, pA1, pB0, pB1; float mnA, alA, al; bf16x8 pa0, pa1, pa2, pa3; const int NT = seq / KVBLK;
  A2_SLOAD(0, 0); asm volatile("s_waitcnt vmcnt(0)" ::: "memory"); A2_SWRITE(0, 0);
  A2_SLOAD(1, KVBLK); A2_SLOAD(0, 2 * KVBLK);
  __syncthreads();
  qkt(pA0, pA1, K_lds, qr, r32, hi); partialSM(pA0, pA1, m_reg, mnA, alA);
  A2_SWAIT(); A2_SWRITE(1, 1); A2_SLOAD(1, 3 * KVBLK);
  int bp = 0, bc = 1, bn = 2;
#define A2_STEP(PC0, PC1, PP0, PP1, j_, SL) do { \
    __syncthreads(); \
    if ((j_) + 1 < NT) { A2_SWAIT(); A2_SWRITE(bn, SL); } \
    A2_SBAR(); qkt(PC0, PC1, K_lds + bc * SHM_K, qr, r32, hi); \
    finishSM(PP0, PP1, m_reg, al, l_reg, pa0, pa1, pa2, pa3); A2_RESC(al); A2_SBAR(); \
    if ((j_) + 3 < NT) A2_SLOAD(SL, ((j_) + 3) * KVBLK); A2_SBAR(); \
    pv_psm(o, vb0 + bp * (int)SHM_V, pa0, pa1, pa2, pa3, PC0, PC1, m_reg); \
    { const int t_ = bp; bp = bc; bc = bn; bn = t_; } } while (0)
  for (int j = 1; j + 1 < NT; j += 2) {
    A2_STEP(pB0, pB1, pA0, pA1, j, 0);
    A2_STEP(pA0, pA1, pB0, pB1, j + 1, 1);
  }
  A2_STEP(pB0, pB1, pA0, pA1, NT - 1, 0);
#undef A2_STEP
  finishSM(pB0, pB1, m_reg, al, l_reg, pa0, pa1, pa2, pa3); A2_RESC(al); A2_SBAR();
  pv_d0(o, vb0 + bp * (int)SHM_V, pa0, pa1, pa2, pa3);
  __builtin_amdgcn_s_setprio(0);
  { auto rr = __builtin_amdgcn_permlane32_swap(__float_as_uint(l_reg), __float_as_uint(l_reg), false, false); l_reg = __uint_as_float(rr[0]) + __uint_as_float(rr[1]); }
  if (hi == 0) li_l[r32] = l_reg; asm volatile("s_waitcnt lgkmcnt(0)" ::: "memory");
  float rli[16];
#pragma unroll
  for (int r = 0; r < 16; ++r) rli[r] = __builtin_amdgcn_rcpf(li_l[crow(r, hi)]);
  unsigned* sw = (unsigned*)(lds + PARK_OFF) + wid * 2048 + lane;
  if (PASS == 0) {
#pragma unroll
    for (int r = 0; r < 16; ++r)
#pragma unroll
      for (int dp = 0; dp < 2; ++dp) sw[(r * 2 + dp) * 64] = cvtpk(o[2 * dp][r] * rli[r], o[2 * dp + 1][r] * rli[r]);
  } else {
    float sg[4];
#pragma unroll
    for (int d0 = 0; d0 < 4; ++d0) sg[d0] = subln[d0 * 32 + r32];
    bf16r* Ow = Ob + (long)(wid * QBLK) * LD + r32;
#pragma unroll
    for (int r = 0; r < 16; ++r) {
      float d[4]; float ss = 0.f;
#pragma unroll
      for (int dp = 0; dp < 2; ++dp) { const unsigned w = sw[(r * 2 + dp) * 64];
        d[2 * dp] = __uint_as_float(w << 16) - lam * (o[2 * dp][r] * rli[r]); d[2 * dp + 1] = __uint_as_float(w & 0xffff0000u) - lam * (o[2 * dp + 1][r] * rli[r]); }
#pragma unroll
      for (int d0 = 0; d0 < 4; ++d0) ss += d[d0] * d[d0];
      ss += __shfl_xor(ss, 1); ss += __shfl_xor(ss, 2); ss += __shfl_xor(ss, 4); ss += __shfl_xor(ss, 8); ss += __shfl_xor(ss, 16);
      const float rstd = 0.8f / sqrtf(ss * (1.f / 128.f) + 1e-6f);
      const int orow = crow(r, hi);
#pragma unroll
      for (int d0 = 0; d0 < 4; ++d0) Ow[(long)orow * LD + d0 * 32] = (bf16r)(cvtpk(d[d0] * rstd * sg[d0], 0.f) & 0xffffu);
    }
  }
  __syncthreads();
#undef A2_SLOAD
#undef A2_SWRITE
#undef A2_SWAIT
#undef A2_RESC
}
#undef A2_KSWZ
#undef A2_LWAIT
#undef A2_SBAR
}
namespace pg8 {
typedef unsigned u32x2 __attribute__((ext_vector_type(2)));
__device__ __forceinline__ float fsigmoid(float x) { return __builtin_amdgcn_rcpf(1.0f + __builtin_amdgcn_exp2f(-1.4426950408889634f * x)); }
__device__ __forceinline__ float fsilu(float x) { return x * fsigmoid(x); }
__device__ __forceinline__ float bflo(unsigned w) { return __uint_as_float(w << 16); }
__device__ __forceinline__ float bfhi(unsigned w) { return __uint_as_float(w & 0xffff0000u); }

struct EpiSwiglu {
    static constexpr bool PERM = true, AFTER_DRAIN = false;
    bf16_t* O; int ldc;
    __device__ __forceinline__ void operator()(const f32x4 (&acc)[2][2][4][2], const Unit& u, int wr, int wc, int fr, int fq) const {
        const int row0 = u.pm * BM + wr * 64 + fr, col0 = u.pn * HALF + wc * 32 + 8 * fq;
#pragma unroll
        for (int ai = 0; ai < 2; ++ai)
#pragma unroll
            for (int m = 0; m < 4; ++m) {
                bf16_t* rowp = O + (size_t)(row0 + ai * HALF + m * 16) * ldc + col0;
                const f32x4 g0 = acc[ai][0][m][0], g1 = acc[ai][0][m][1], u0 = acc[ai][1][m][0], u1 = acc[ai][1][m][1];
                u32x4 w;
                w.x = cvt_pk_bf16(fsilu(g0[0]) * u0[0], fsilu(g0[1]) * u0[1]); w.y = cvt_pk_bf16(fsilu(g0[2]) * u0[2], fsilu(g0[3]) * u0[3]);
                w.z = cvt_pk_bf16(fsilu(g1[0]) * u1[0], fsilu(g1[1]) * u1[1]); w.w = cvt_pk_bf16(fsilu(g1[2]) * u1[2], fsilu(g1[3]) * u1[3]);
                *(u32x4*)rowp = w;
            }
    }
};

struct EpiWin {
    static constexpr bool PERM = true, AFTER_DRAIN = false;
    bf16_t *q, *k, *v, *u, *ga, *gb; const float* rope; float qscale;
    __device__ __forceinline__ void operator()(const f32x4 (&acc)[2][2][4][2], const Unit& un, int wr, int wc, int fr, int fq) const {
        const int pn = un.pn, rowt = un.pm * BM + wr * 64 + fr, bidx = un.pm >> 5;
        if (pn < 8) {
            const bool isq = pn < 4; const float sc = isq ? qscale : 1.f; bf16_t* base = isq ? q : k;
            const int colt = (pn & 3) * 256 + wc * 32 + 8 * fq, axis = wc & 1, f0 = 8 * (fq & 1);
            const float sgn = (fq < 2) ? -sc : sc;
#pragma unroll
            for (int ai = 0; ai < 2; ++ai)
#pragma unroll
                for (int m = 0; m < 4; ++m) {
                    const int r = rowt + ai * HALF + m * 16, t = r & 8191, pos = axis ? (t & 63) : (t >> 6);
                    const f32x4 cs0 = *(const f32x4*)(rope + pos * 16 + f0), cs1 = *(const f32x4*)(rope + pos * 16 + f0 + 4);
                    const f32x4 sn0 = *(const f32x4*)(rope + 2048 + pos * 16 + f0), sn1 = *(const f32x4*)(rope + 2048 + pos * 16 + f0 + 4);
                    const size_t orow = isq ? (size_t)r : (size_t)bidx * 8448 + 256 + t;
                    bf16_t* rowp = base + orow * 1024 + colt;
#pragma unroll
                    for (int bj = 0; bj < 2; ++bj) {
                        const f32x4 s0 = acc[ai][bj][m][0], s1 = acc[ai][bj][m][1]; f32x4 o0, o1;
#pragma unroll
                        for (int jj = 0; jj < 4; ++jj) { const float p0 = __shfl_xor(s0[jj], 32), p1 = __shfl_xor(s1[jj], 32);
                            o0[jj] = s0[jj] * (cs0[jj] * sc) + p0 * (sn0[jj] * sgn); o1[jj] = s1[jj] * (cs1[jj] * sc) + p1 * (sn1[jj] * sgn); }
                        u32x4 w; w.x = cvt_pk_bf16(o0[0], o0[1]); w.y = cvt_pk_bf16(o0[2], o0[3]); w.z = cvt_pk_bf16(o1[0], o1[1]); w.w = cvt_pk_bf16(o1[2], o1[3]);
                        *(u32x4*)(rowp + bj * HALF) = w;
                    }
                }
        } else if (pn < 12) {
            const int colt = (pn - 8) * 256 + wc * 32 + 8 * fq;
#pragma unroll
            for (int ai = 0; ai < 2; ++ai)
#pragma unroll
                for (int m = 0; m < 4; ++m) {
                    const int r = rowt + ai * HALF + m * 16, t = r & 8191;
                    bf16_t* rowp = v + ((size_t)bidx * 8448 + 256 + t) * 1024 + colt;
#pragma unroll
                    for (int bj = 0; bj < 2; ++bj) { const f32x4 v0 = acc[ai][bj][m][0], v1 = acc[ai][bj][m][1]; u32x4 w;
                        w.x = cvt_pk_bf16(v0[0], v0[1]); w.y = cvt_pk_bf16(v0[2], v0[3]); w.z = cvt_pk_bf16(v1[0], v1[1]); w.w = cvt_pk_bf16(v1[2], v1[3]); *(u32x4*)(rowp + bj * HALF) = w; }
                }
        } else if (pn < 20) {
            const int colt = (pn - 12) * HALF + wc * 32 + 8 * fq;
#pragma unroll
            for (int ai = 0; ai < 2; ++ai)
#pragma unroll
                for (int m = 0; m < 4; ++m) {
                    bf16_t* rowp = u + (size_t)(rowt + ai * HALF + m * 16) * 1024 + colt;
                    const f32x4 a0 = acc[ai][0][m][0], a1 = acc[ai][0][m][1], g0 = acc[ai][1][m][0], g1 = acc[ai][1][m][1]; u32x4 w;
                    w.x = cvt_pk_bf16(a0[0] * fsigmoid(g0[0]), a0[1] * fsigmoid(g0[1])); w.y = cvt_pk_bf16(a0[2] * fsigmoid(g0[2]), a0[3] * fsigmoid(g0[3]));
                    w.z = cvt_pk_bf16(a1[0] * fsigmoid(g1[0]), a1[1] * fsigmoid(g1[1])); w.w = cvt_pk_bf16(a1[2] * fsigmoid(g1[2]), a1[3] * fsigmoid(g1[3]));
                    *(u32x4*)rowp = w;
                }
        } else {
            bf16_t* base = pn < 24 ? ga : gb; const int colt = (pn & 3) * 256 + wc * 32 + 8 * fq;
#pragma unroll
            for (int ai = 0; ai < 2; ++ai)
#pragma unroll
                for (int m = 0; m < 4; ++m) {
                    bf16_t* rowp = base + (size_t)(rowt + ai * HALF + m * 16) * 1024 + colt;
#pragma unroll
                    for (int bj = 0; bj < 2; ++bj) { const f32x4 v0 = acc[ai][bj][m][0], v1 = acc[ai][bj][m][1]; u32x4 w;
                        w.x = cvt_pk_bf16(fsigmoid(v0[0]), fsigmoid(v0[1])); w.y = cvt_pk_bf16(fsigmoid(v0[2]), fsigmoid(v0[3]));
                        w.z = cvt_pk_bf16(fsigmoid(v1[0]), fsigmoid(v1[1])); w.w = cvt_pk_bf16(fsigmoid(v1[2]), fsigmoid(v1[3])); *(u32x4*)(rowp + bj * HALF) = w; }
                }
        }
    }
};

struct EpiKVc {
    static constexpr bool PERM = true, AFTER_DRAIN = false;
    bf16_t *k, *v;
    __device__ __forceinline__ void operator()(const f32x4 (&acc)[2][2][4][2], const Unit& un, int wr, int wc, int fr, int fq) const {
        bf16_t* base = un.pn < 4 ? k : v; const int colt = (un.pn & 3) * 256 + wc * 32 + 8 * fq;
#pragma unroll
        for (int ai = 0; ai < 2; ++ai)
#pragma unroll
            for (int m = 0; m < 4; ++m) {
                bf16_t* rowp = base + ((size_t)un.pm * 8448 + wr * 64 + fr + ai * HALF + m * 16) * 1024 + colt;
#pragma unroll
                for (int bj = 0; bj < 2; ++bj) { const f32x4 v0 = acc[ai][bj][m][0], v1 = acc[ai][bj][m][1]; u32x4 w;
                    w.x = cvt_pk_bf16(v0[0], v0[1]); w.y = cvt_pk_bf16(v0[2], v0[3]); w.z = cvt_pk_bf16(v1[0], v1[1]); w.w = cvt_pk_bf16(v1[2], v1[3]); *(u32x4*)(rowp + bj * HALF) = w; }
            }
    }
};

template <bool ADD> struct EpiGate {
    static constexpr bool PERM = true, AFTER_DRAIN = false;
    bf16_t* Z; const bf16_t* G;
    __device__ __forceinline__ void operator()(const f32x4 (&acc)[2][2][4][2], const Unit& un, int wr, int wc, int fr, int fq) const {
        const int row0 = un.pm * BM + wr * 64 + fr, col0 = un.pn * BM + wc * 32 + 8 * fq;
#pragma unroll
        for (int ai = 0; ai < 2; ++ai)
#pragma unroll
            for (int m = 0; m < 4; ++m) {
                const size_t off = (size_t)(row0 + ai * HALF + m * 16) * 1024 + col0;
#pragma unroll
                for (int bj = 0; bj < 2; ++bj) {
                    const u32x4 g = *(const u32x4*)(G + off + bj * HALF);
                    const f32x4 v0 = acc[ai][bj][m][0], v1 = acc[ai][bj][m][1];
                    float o[8];
                    o[0] = v0[0] * bflo(g.x); o[1] = v0[1] * bfhi(g.x); o[2] = v0[2] * bflo(g.y); o[3] = v0[3] * bfhi(g.y);
                    o[4] = v1[0] * bflo(g.z); o[5] = v1[1] * bfhi(g.z); o[6] = v1[2] * bflo(g.w); o[7] = v1[3] * bfhi(g.w);
                    if (ADD) { const u32x4 z = *(const u32x4*)(Z + off + bj * HALF);
                        o[0] += bflo(z.x); o[1] += bfhi(z.x); o[2] += bflo(z.y); o[3] += bfhi(z.y); o[4] += bflo(z.z); o[5] += bfhi(z.z); o[6] += bflo(z.w); o[7] += bfhi(z.w); }
                    u32x4 w; w.x = cvt_pk_bf16(o[0], o[1]); w.y = cvt_pk_bf16(o[2], o[3]); w.z = cvt_pk_bf16(o[4], o[5]); w.w = cvt_pk_bf16(o[6], o[7]);
                    *(u32x4*)(Z + off + bj * HALF) = w;
                }
            }
    }
};
}

constexpr int NWAVES = 8, NTHR = 512;
constexpr int DM = 1024, NB = 4, SEQ = 8192, NLAT = NB * SEQ, NCTX = 256, NCTXR = NB * NCTX, NROWS = NLAT + NCTXR, NKEYS = SEQ + NCTX;
constexpr int DFF = 2816, INW = 7168, NMOD = 9;
constexpr float EPS = 1e-6f;
constexpr size_t MiB = 1u << 20;
constexpr size_t WS_MOD = 1 * MiB, WS_ROPE = 1 * MiB + 256 * 1024, WS_LAM = 1 * MiB + 512 * 1024;
constexpr size_t WS_W13A = 2 * MiB, WS_W2A = 13 * MiB, WS_W13B = WS_W2A + 11 * MiB / 2, WS_W2B = WS_W13B + 11 * MiB, WS_WIN = 35 * MiB, WS_WAP = 49 * MiB, WS_WCP = 51 * MiB, WS_WOUT = 53 * MiB;
constexpr size_t WS_H = 56 * MiB, WS_Y = 122 * MiB, WS_BIG = 188 * MiB;
constexpr size_t WS_ACT = WS_BIG, WS_Q = WS_BIG, WS_K = WS_BIG + 64 * MiB, WS_V = WS_K + 66 * MiB, WS_U = WS_V + 66 * MiB, WS_GB = WS_U + 64 * MiB, WS_END = WS_GB + 64 * MiB;
constexpr size_t WS_GA = WS_Y, WS_UC = WS_H, WS_OSCR = WS_U, WS_Z = WS_U;
static_assert(WS_END == 512 * MiB, "ws map");
static_assert(WS_W2B + 11 * MiB / 2 <= WS_WIN, "ws map weights");
constexpr int LDS_BYTES = 147456;

#define LAS __attribute__((address_space(3)))
typedef unsigned short bf16;
typedef unsigned v4u __attribute__((ext_vector_type(4)));
typedef unsigned v2u __attribute__((ext_vector_type(2)));
typedef float f32x4 __attribute__((ext_vector_type(4)));
#define LDS_WAIT() asm volatile("s_waitcnt lgkmcnt(0)" ::: "memory")
__device__ __forceinline__ unsigned f2bf(float f) { unsigned u = __builtin_bit_cast(unsigned, f); return (u + 0x7fffu + ((u >> 16) & 1u)) >> 16; }
__device__ __forceinline__ unsigned pk2(float lo, float hi) { return f2bf(lo) | (f2bf(hi) << 16); }
__device__ __forceinline__ float wave_sum(float v) {
#pragma unroll
    for (int o = 1; o < 64; o <<= 1) v += __shfl_xor(v, o);
    return v;
}

struct Args { const float* in[21]; float* out; unsigned char* ws; int pad0, pad1; };
enum { I_X = 0, I_C, I_CTX, I_CCTX, I_WADA, I_BADA, I_NORMG, I_F1W13, I_F1W2, I_F2W13, I_F2W2, I_WIN, I_LAMQK, I_SUBLN, I_WAP, I_CONVW, I_CONVB, I_CLNG, I_CLNB, I_WCP, I_WOUT };

template <int MODE> __device__ __forceinline__ int drow(int n0) {
    if (MODE == 1) { const int bj = n0 / DFF, j = n0 % DFF; return 256 * (j / 128) + 128 * bj + (j % 128); }
    if (MODE == 2) { if (n0 >= 3072 && n0 < 5120) { const int c = n0 - 3072, bj = c / 1024, j = c % 1024; return 3072 + 256 * (j / 128) + 128 * bj + (j % 128); } return n0; }
    return n0;
}
template <int MODE> __device__ __forceinline__ void transpose_item(const float* W, int K, int N, bf16* WT, LAS float* scr, int item, int lane) {
    const int nblk = N / 32, kb = item / nblk, nb = item % nblk, k0 = 64 * kb, n0 = 32 * nb, d0 = drow<MODE>(n0);
    float tv[32];
#pragma unroll
    for (int i = 0; i < 32; ++i) tv[i] = W[(size_t)(k0 + 2 * i + (lane >> 5)) * N + n0 + (lane & 31)];
#pragma unroll
    for (int i = 0; i < 32; ++i) scr[(2 * i + (lane >> 5)) * 33 + (lane & 31)] = tv[i];
    LDS_WAIT(); asm volatile("" ::: "memory");
    const int c = lane & 7;
#pragma unroll
    for (int j = 0; j < 4; ++j) { const int n = (lane >> 3) + 8 * j; const LAS float* s = scr + (8 * c) * 33 + n;
        v4u o; o.x = pk2(s[0 * 33], s[1 * 33]); o.y = pk2(s[2 * 33], s[3 * 33]); o.z = pk2(s[4 * 33], s[5 * 33]); o.w = pk2(s[6 * 33], s[7 * 33]);
        *(v4u*)(WT + (size_t)(d0 + n) * K + k0 + 8 * c) = o; }
    LDS_WAIT(); asm volatile("" ::: "memory");
}

template <bool HAS_Y, bool WRITE_X, bool WRITE_H>
__device__ __forceinline__ void norm_rows(int gw, int NGW, int lane, int row_lo, int nrows, const float* xlat, const float* xctx, const bf16* Y, float* xout, bf16* hout, const float* mod,
                                          float mult, const float* g_post, int k_gate, const float* g_pre, int k_in) {
    for (int row0 = row_lo + gw; row0 < nrows; row0 += 2 * NGW) {
        int rows[2]; rows[0] = row0; rows[1] = (row0 + NGW < nrows) ? row0 + NGW : row0;
        f32x4 v[2][4]; v2u yw[2][4]; const float* mp[2]; bool isctx[2];
#pragma unroll
        for (int r = 0; r < 2; ++r) {
            const int row = rows[r]; isctx[r] = row >= NLAT; const int mv = isctx[r] ? 4 : (row >> 13);
            const float* xr = isctx[r] ? xctx + (size_t)(row - NLAT) * DM : xlat + (size_t)row * DM;
            mp[r] = mod + (size_t)mv * (NMOD * DM);
#pragma unroll
            for (int j = 0; j < 4; ++j) v[r][j] = ((const f32x4*)xr)[lane + 64 * j];
            if (HAS_Y) {
#pragma unroll
                for (int j = 0; j < 4; ++j) yw[r][j] = ((const v2u*)(Y + (size_t)row * DM))[lane + 64 * j];
            }
        }
        if (HAS_Y) {
            f32x4 y[2][4]; float ss[2];
#pragma unroll
            for (int r = 0; r < 2; ++r) { ss[r] = 0.f;
#pragma unroll
                for (int j = 0; j < 4; ++j) { const v2u w = yw[r][j]; y[r][j] = (f32x4){pg8::bflo(w.x), pg8::bfhi(w.x), pg8::bflo(w.y), pg8::bfhi(w.y)};
                    ss[r] += (y[r][j].x * y[r][j].x + y[r][j].y * y[r][j].y) + (y[r][j].z * y[r][j].z + y[r][j].w * y[r][j].w); } }
#pragma unroll
            for (int o = 1; o < 64; o <<= 1) { ss[0] += __shfl_xor(ss[0], o); ss[1] += __shfl_xor(ss[1], o); }
#pragma unroll
            for (int r = 0; r < 2; ++r) { const float rstd = 1.0f / sqrtf(ss[r] * (1.f / DM) + EPS);
#pragma unroll
                for (int j = 0; j < 4; ++j) { const f32x4 gp = ((const f32x4*)g_post)[lane + 64 * j], gt = ((const f32x4*)(mp[r] + k_gate * DM))[lane + 64 * j];
                    v[r][j] = v[r][j] + (mult * gt) * ((y[r][j] * rstd) * gp); }
                if (WRITE_X && !isctx[r]) {
#pragma unroll
                    for (int j = 0; j < 4; ++j) ((f32x4*)(xout + (size_t)rows[r] * DM))[lane + 64 * j] = v[r][j];
                } }
        }
        if (WRITE_H) {
            float ss[2];
#pragma unroll
            for (int r = 0; r < 2; ++r) { ss[r] = 0.f;
#pragma unroll
                for (int j = 0; j < 4; ++j) ss[r] += (v[r][j].x * v[r][j].x + v[r][j].y * v[r][j].y) + (v[r][j].z * v[r][j].z + v[r][j].w * v[r][j].w); }
#pragma unroll
            for (int o = 1; o < 64; o <<= 1) { ss[0] += __shfl_xor(ss[0], o); ss[1] += __shfl_xor(ss[1], o); }
#pragma unroll
            for (int r = 0; r < 2; ++r) { const float rstd = 1.0f / sqrtf(ss[r] * (1.f / DM) + EPS);
#pragma unroll
                for (int j = 0; j < 4; ++j) { const f32x4 gp = ((const f32x4*)g_pre)[lane + 64 * j], sh = ((const f32x4*)(mp[r] + k_in * DM))[lane + 64 * j], sc = ((const f32x4*)(mp[r] + (k_in + 1) * DM))[lane + 64 * j];
                    const f32x4 h = ((v[r][j] * rstd) * gp) * (1.0f + sc) + sh;
                    v2u w; w.x = pk2(h.x, h.y); w.y = pk2(h.z, h.w); ((v2u*)(hout + (size_t)rows[r] * DM))[lane + 64 * j] = w; } }
        }
    }
}

#define RLX_AGENT __ATOMIC_RELAXED, __HIP_MEMORY_SCOPE_AGENT
#define XB_TMO      128
#define XB_XCNT(j)  (256  + 64 * (j))
#define XB_XSUB(j)  (1280 + 64 * (j))
#define XB_XGEN(j)  (2304 + 64 * (j))
#define XB_TOP      3328
#define XB_TOPGEN   3392
#define XCD_BAR_WORDS 3456
#define XB_SPIN_CAP (1u << 22)

__device__ __forceinline__ unsigned xb_ld(unsigned* p)              { return __hip_atomic_load(p, __ATOMIC_RELAXED, __HIP_MEMORY_SCOPE_AGENT); }
__device__ __forceinline__ unsigned xb_add(unsigned* p, unsigned v) { return __hip_atomic_fetch_add(p, v, __ATOMIC_RELAXED, __HIP_MEMORY_SCOPE_AGENT); }
__device__ __forceinline__ unsigned xb_xcc_id() { return (unsigned)__builtin_amdgcn_s_getreg((3 << 11) | 20) & 0xFu; }
#define XB_SPIN(cond, bar) do { unsigned _sp = 0; while (cond) { __builtin_amdgcn_s_sleep(1); \
    if ((++_sp & 255u) == 0u) { if (xb_ld(&(bar)[XB_TMO])) break; if (_sp > XB_SPIN_CAP) { atomicAdd(&(bar)[XB_TMO], 1u); break; } } } } while (0)

struct XcdBarrier {
    unsigned* bar; unsigned x;
    volatile LAS unsigned* st;
};

__device__ __forceinline__ XcdBarrier xcd_barrier_post(unsigned* bar, volatile LAS unsigned* st) {
    XcdBarrier b; b.bar = bar; b.x = xb_xcc_id(); b.st = st;
    if (threadIdx.x == 0) (void)xb_add(&bar[XB_XCNT(b.x)], 1u);
    return b;
}
__device__ __forceinline__ void xcd_barrier_complete(unsigned* bar, unsigned x, unsigned& nloc, unsigned& nx) {
    const unsigned G = gridDim.x * gridDim.y * gridDim.z;
    unsigned sum, cnt, mine, sp = 0u;
    for (;;) {
        sum = 0u; cnt = 0u; mine = 0u;
#pragma unroll
        for (unsigned j = 0; j < 16; ++j) { const unsigned c = xb_ld(&bar[XB_XCNT(j)]); sum += c; cnt += (c > 0u) ? 1u : 0u; mine = (j == x) ? c : mine; }
        if (sum == G) break;
        __builtin_amdgcn_s_sleep(1);
        if ((++sp & 255u) == 0u) { if (xb_ld(&bar[XB_TMO])) break; if (sp > XB_SPIN_CAP) { atomicAdd(&bar[XB_TMO], 1u); break; } }
    }
    nloc = mine > 0u ? mine : 1u; nx = cnt > 0u ? cnt : 1u;
}

__device__ __forceinline__ void xcd_barrier(const XcdBarrier& b) {
    asm volatile("s_waitcnt vmcnt(0)" ::: "memory");
    __syncthreads();
    if (threadIdx.x == 0) {
        unsigned* bar = b.bar;
        __builtin_amdgcn_s_waitcnt(0);
        unsigned nloc = b.st[0], nx = b.st[1];
        if (nloc == 0u) { xcd_barrier_complete(bar, b.x, nloc, nx); b.st[0] = nloc; b.st[1] = nx; }
        const unsigned old = xb_add(&bar[XB_XSUB(b.x)], 1u);
        const unsigned gen = old / nloc;
        if (old + 1u == (gen + 1u) * nloc) {
            __builtin_amdgcn_fence(__ATOMIC_RELEASE, "agent");
            asm volatile("s_waitcnt vmcnt(0)" ::: "memory");
            const unsigned og = xb_add(&bar[XB_TOP], 1u);
            const unsigned tg = og / nx;
            if (og + 1u == (tg + 1u) * nx) xb_add(&bar[XB_TOPGEN], 1u);
            else XB_SPIN(xb_ld(&bar[XB_TOPGEN]) == tg, bar);
            __builtin_amdgcn_fence(__ATOMIC_ACQUIRE, "agent");
            xb_add(&bar[XB_XGEN(b.x)], 1u);
            asm volatile("s_waitcnt vmcnt(0)" ::: "memory");
        } else {
            XB_SPIN(xb_ld(&bar[XB_XGEN(b.x)]) == gen, bar);
            __builtin_amdgcn_fence(__ATOMIC_ACQUIRE, "agent");
            asm volatile("s_waitcnt vmcnt(0)" ::: "memory");
        }
    }
    __syncthreads();
}

__global__ void __launch_bounds__(NTHR, 2) fwd_mega(Args args) {
    extern __shared__ __attribute__((aligned(16))) unsigned char lds[];
    cg::grid_group grid = cg::this_grid();
#define GSYNC_CG() do { asm volatile("s_waitcnt vmcnt(0) lgkmcnt(0)" ::: "memory"); grid.sync(); __builtin_amdgcn_fence(__ATOMIC_ACQUIRE, "agent"); asm volatile("s_waitcnt vmcnt(0)" ::: "memory"); } while (0)
#define GSYNC() xcd_barrier(xbar)
    LAS unsigned char* L = (LAS unsigned char*)lds;
    const int tid = threadIdx.x, lane = tid & 63, wave = __builtin_amdgcn_readfirstlane(tid >> 6);
    const int G = gridDim.x, bx = blockIdx.x, vcu = (G % 8 == 0) ? (bx % 8) * (G / 8) + bx / 8 : bx;
    const int gw = vcu * NWAVES + wave, NGW = G * NWAVES;
    unsigned char* ws = args.ws;
    volatile LAS unsigned* xst = (volatile LAS unsigned*)(L + LDS_BYTES - 64);
    static_assert(attn2::PARK_OFF + attn2::PARK_BYTES <= LDS_BYTES - 64, "LDS map");
    if (tid < 2) xst[tid] = 0u;
    __syncthreads();
    XcdBarrier xbar = xcd_barrier_post((unsigned*)ws, xst);
    float* mod = (float*)(ws + WS_MOD); float* rope = (float*)(ws + WS_ROPE); float* lamp = (float*)(ws + WS_LAM);
    bf16 *W13A = (bf16*)(ws + WS_W13A), *W2A = (bf16*)(ws + WS_W2A), *W13B = (bf16*)(ws + WS_W13B), *W2B = (bf16*)(ws + WS_W2B), *WIN = (bf16*)(ws + WS_WIN), *WAP = (bf16*)(ws + WS_WAP), *WCP = (bf16*)(ws + WS_WCP), *WOUT = (bf16*)(ws + WS_WOUT);
    bf16 *H = (bf16*)(ws + WS_H), *Y = (bf16*)(ws + WS_Y), *ACT = (bf16*)(ws + WS_ACT), *Qb = (bf16*)(ws + WS_Q), *Kb = (bf16*)(ws + WS_K), *Vb = (bf16*)(ws + WS_V), *Ub = (bf16*)(ws + WS_U), *GA = (bf16*)(ws + WS_GA), *GB = (bf16*)(ws + WS_GB);
    bf16 *UC = (bf16*)(ws + WS_UC), *OSCR = (bf16*)(ws + WS_OSCR), *Zb = (bf16*)(ws + WS_Z);
    const float* x = args.in[I_X]; const float* ctx = args.in[I_CTX]; const float* normg = args.in[I_NORMG]; float* out = args.out;

    {
        LAS float* sc = (LAS float*)L;
        LAS float* red = (LAS float*)(L + 20480);
        if (bx < 144) {
            for (int i = tid; i < 5 * DM; i += NTHR) { const float c = i < 4 * DM ? args.in[I_C][i] : args.in[I_CCTX][i - 4 * DM]; sc[i] = c / (1.0f + expf(-c)); }
            __syncthreads();
            for (int it = bx; it < 144; it += G) {
                const int col = it * 64 + lane; const float* wp = args.in[I_WADA] + (size_t)(wave * 128) * (NMOD * DM) + col;
                float a0 = 0.f, a1 = 0.f, a2 = 0.f, a3 = 0.f, a4 = 0.f;
#pragma unroll 32
                for (int kk = 0; kk < 128; ++kk) { const float w = wp[(size_t)kk * (NMOD * DM)]; const int k = wave * 128 + kk;
                    a0 += sc[k] * w; a1 += sc[DM + k] * w; a2 += sc[2 * DM + k] * w; a3 += sc[3 * DM + k] * w; a4 += sc[4 * DM + k] * w; }
                red[(wave * 5 + 0) * 64 + lane] = a0; red[(wave * 5 + 1) * 64 + lane] = a1; red[(wave * 5 + 2) * 64 + lane] = a2; red[(wave * 5 + 3) * 64 + lane] = a3; red[(wave * 5 + 4) * 64 + lane] = a4;
                __syncthreads();
                if (tid < 320) { const int v = tid >> 6, cl = tid & 63; float s = 0.f;
#pragma unroll
                    for (int w8 = 0; w8 < 8; ++w8) s += red[(w8 * 5 + v) * 64 + cl];
                    mod[(size_t)v * (NMOD * DM) + it * 64 + cl] = s + args.in[I_BADA][it * 64 + cl]; }
                __syncthreads();
            }
        }
        if (bx == G - 1) {
            for (int i = tid; i < 2048; i += NTHR) { const int pos = i >> 4, f = i & 15; double inv = 1.0; for (int j = 0; j < f; ++j) inv *= 0.56234132519034908; const double ang = (double)pos * inv; rope[i] = (float)cos(ang); rope[2048 + i] = (float)sin(ang); }
        }
        if (bx == G - 2 && tid < 64) {
            const float* lq = args.in[I_LAMQK];
            const float s01 = wave_sum(lq[tid] * lq[64 + tid]), s23 = wave_sum(lq[128 + tid] * lq[192 + tid]);
            if (tid == 0) lamp[0] = expf(s01) - expf(s23) + 0.2f;
        }
        __syncthreads();
        LAS float* scr = (LAS float*)(L + wave * 16384);
        constexpr int I_13 = (DM / 64) * (2 * DFF / 32), I_2 = (DFF / 64) * (DM / 32);
        for (int it = gw; it < I_13 + I_2; it += NGW) {
            if (it < I_13) transpose_item<1>(args.in[I_F1W13], DM, 2 * DFF, W13A, scr, it, lane);
            else transpose_item<0>(args.in[I_F1W2], DFF, DM, W2A, scr, it - I_13, lane);
        }
    }
    if (args.pad0 != 0) GSYNC_CG();
    GSYNC();
    norm_rows<false, false, true>(gw, NGW, lane, 0, NROWS, x, ctx, nullptr, nullptr, H, mod, 0.f, nullptr, 0, normg + 0 * DM, 0);
    GSYNC();
    { pg8::Gemm g{H, W13A, NROWS, 2 * DFF, DM}; pg8::StaticOrder S; S.init(NROWS, 2 * DFF, G, bx); pg8::EpiSwiglu E{ACT, DFF};
      pg8::gemm_phase<pg8::EpiSwiglu, pg8::StaticOrder, PG8_ALIGN, PG8_SP2>(L, g, S, E); }
    {
        constexpr int NU = (NROWS / 256) * (2 * DFF / 256), NFULL = NU / 256, NREM = NU - NFULL * 256;
        static_assert(NREM > 0 && NREM < 256, "partial round");
        if (G == 256 ? bx >= NREM : true) {
            const int nhelp = (G == 256) ? (256 - NREM) : G, hid = (G == 256) ? bx - NREM : bx;
            LAS float* scr = (LAS float*)(L + wave * 16384);
            constexpr int I_13 = (DM / 64) * (2 * DFF / 32), I_2 = (DFF / 64) * (DM / 32), I_IN = (DM / 64) * (INW / 32), I_SQ = (DM / 64) * (DM / 32);
            constexpr int NITEMS = I_13 + I_2 + I_IN + 3 * I_SQ;
            for (int it = hid * NWAVES + wave; it < NITEMS; it += nhelp * NWAVES) {
                int r = it;
                if (r < I_IN) { transpose_item<2>(args.in[I_WIN], DM, INW, WIN, scr, r, lane); continue; } r -= I_IN;
                if (r < I_SQ) { transpose_item<0>(args.in[I_WAP], DM, DM, WAP, scr, r, lane); continue; } r -= I_SQ;
                if (r < I_SQ) { transpose_item<0>(args.in[I_WCP], DM, DM, WCP, scr, r, lane); continue; } r -= I_SQ;
                if (r < I_SQ) { transpose_item<0>(args.in[I_WOUT], DM, DM, WOUT, scr, r, lane); continue; } r -= I_SQ;
                if (r < I_13) { transpose_item<1>(args.in[I_F2W13], DM, 2 * DFF, W13B, scr, r, lane); continue; } r -= I_13;
                transpose_item<0>(args.in[I_F2W2], DFF, DM, W2B, scr, r, lane);
            }
        }
    }
    GSYNC();
    { pg8::Gemm g{ACT, W2A, NLAT, DM, DFF}; pg8::StaticOrder S; S.init(NLAT, DM, G, bx); pg8::EpiBf16<0> E{Y, DM, nullptr, 0, 0, 1.f};
      pg8::gemm_phase<pg8::EpiBf16<0>, pg8::StaticOrder, PG8_ALIGN, PG8_SP2>(L, g, S, E); }
    GSYNC();
    if (G == 256) {
        if (bx < 16) { pg8::Gemm g{ACT + (size_t)NLAT * DFF, W2A, NCTXR, DM, DFF}; pg8::StaticOrder S; S.init(NCTXR, DM, G, bx); pg8::EpiBf16<0> E{Y + (size_t)NLAT * DM, DM, nullptr, 0, 0, 1.f};
            pg8::gemm_phase<pg8::EpiBf16<0>, pg8::StaticOrder, PG8_ALIGN, PG8_SP2>(L, g, S, E); }
        else norm_rows<true, true, true>((bx - 16) * NWAVES + wave, (G - 16) * NWAVES, lane, 0, NLAT, x, ctx, Y, out, H, mod, 0.5f, normg + 1 * DM, 2, normg + 2 * DM, 3);
    } else {
        { pg8::Gemm g{ACT + (size_t)NLAT * DFF, W2A, NCTXR, DM, DFF}; pg8::StaticOrder S; S.init(NCTXR, DM, G, bx); pg8::EpiBf16<0> E{Y + (size_t)NLAT * DM, DM, nullptr, 0, 0, 1.f};
          pg8::gemm_phase<pg8::EpiBf16<0>, pg8::StaticOrder, PG8_ALIGN, PG8_SP2>(L, g, S, E); }
        norm_rows<true, true, true>(gw, NGW, lane, 0, NLAT, x, ctx, Y, out, H, mod, 0.5f, normg + 1 * DM, 2, normg + 2 * DM, 3);
    }
    GSYNC();
    norm_rows<true, true, true>(gw, NGW, lane, NLAT, NROWS, x, ctx, Y, out, H, mod, 0.5f, normg + 1 * DM, 2, normg + 2 * DM, 3);
    GSYNC();
    { pg8::Gemm g{H, WIN, NLAT, INW, DM}; pg8::StaticOrder S; S.init(NLAT, INW, G, bx);
      pg8::EpiWin E{Qb, Kb, Vb, Ub, GA, GB, rope, 1.0f};

      pg8::gemm_phase<pg8::EpiWin, pg8::StaticOrder, PG8_ALIGN, PG8_SP2>(L, g, S, E);
    }
    { pg8::Gemm g{H + (size_t)NLAT * DM, WIN + (size_t)1024 * DM, NCTXR, 2048, DM}; pg8::StaticOrder S; S.init(NCTXR, 2048, G, bx); pg8::EpiKVc E{Kb, Vb};
      pg8::gemm_phase<pg8::EpiKVc, pg8::StaticOrder, PG8_ALIGN, PG8_SP2>(L, g, S, E); }
    GSYNC();
    {
        const int c0 = 2 * tid;
        float w0[31], w1[31];
#pragma unroll
        for (int k = 0; k < 31; ++k) { const float2 w = *(const float2*)(args.in[I_CONVW] + k * DM + c0); w0[k] = w.x; w1[k] = w.y; }
        const float2 cb = *(const float2*)(args.in[I_CONVB] + c0), lg = *(const float2*)(args.in[I_CLNG] + c0), lb = *(const float2*)(args.in[I_CLNB] + c0);
        LAS float* red = (LAS float*)L;
        LAS float* stat = (LAS float*)(L + 2048);
        for (int item = vcu; item < NLAT / 16; item += G) {
            const int tg = item * 16, b = tg >> 13, t0 = tg & 8191;
            float a0[16], a1[16];
#pragma unroll
            for (int o = 0; o < 16; ++o) { a0[o] = 0.f; a1[o] = 0.f; }
#pragma unroll
            for (int i = 0; i < 46; ++i) {
                const int t = t0 - 15 + i; const bool valid = (t >= 0) && (t < SEQ); const int tt = valid ? t : t0;
                const unsigned wv = *(const unsigned*)(Ub + ((size_t)(b * SEQ + tt)) * DM + c0);
                const float x0 = valid ? pg8::bflo(wv) : 0.f, x1 = valid ? pg8::bfhi(wv) : 0.f;
#pragma unroll
                for (int o = 0; o < 16; ++o) { if (i - o >= 0 && i - o <= 30) { a0[o] += w0[i - o] * x0; a1[o] += w1[i - o] * x1; } }
            }
#pragma unroll
            for (int o = 0; o < 16; ++o) { a0[o] += cb.x; a1[o] += cb.y; const float s = wave_sum(a0[o] + a1[o]), ss = wave_sum(a0[o] * a0[o] + a1[o] * a1[o]);
                if (lane == 0) { red[wave * 32 + 2 * o] = s; red[wave * 32 + 2 * o + 1] = ss; } }
            __syncthreads();
            if (tid < 32) { float s = 0.f;
#pragma unroll
                for (int w8 = 0; w8 < 8; ++w8) s += red[w8 * 32 + tid];
                stat[tid] = s; }
            __syncthreads();
#pragma unroll
            for (int o = 0; o < 16; ++o) { const float mean = stat[2 * o] * (1.f / DM), var = stat[2 * o + 1] * (1.f / DM) - mean * mean, rstd = 1.0f / sqrtf(fmaxf(var, 0.f) + EPS);
                const float y0 = (a0[o] - mean) * rstd * lg.x + lb.x, y1 = (a1[o] - mean) * rstd * lg.y + lb.y;
                *(unsigned*)(UC + ((size_t)(tg + o)) * DM + c0) = pk2(pg8::fsilu(y0), pg8::fsilu(y1)); }
        }
    }
    __syncthreads();
    {
        const float lam = lamp[0];
#pragma unroll 1
        for (int un = vcu; un < NB * 8 * (SEQ / 256); un += G) {
            const int qb = un & 31, bh = (un >> 8) * 8 + ((un & 255) >> 5), b = bh >> 3, h = bh & 7;
            const size_t qrow0 = (size_t)b * SEQ + (size_t)qb * 256;
            const bf16* kbase = Kb + (size_t)b * NKEYS * DM; const bf16* vbase = Vb + (size_t)b * NKEYS * DM + h * 128;
            attn2::body<0>(Qb + qrow0 * DM + (2 * h) * 64, kbase + (2 * h) * 64, vbase, NKEYS, (char*)lds, lam, args.in[I_SUBLN], nullptr);
            attn2::body<1>(Qb + qrow0 * DM + (2 * h + 1) * 64, kbase + (2 * h + 1) * 64, vbase, NKEYS, (char*)lds, lam, args.in[I_SUBLN], Qb + qrow0 * DM + h * 128);
        }
    }
    GSYNC();
    { pg8::Gemm g{Qb, WAP, NLAT, DM, DM}; pg8::StaticOrder S; S.init(NLAT, DM, G, bx); pg8::EpiGate<false> E{Zb, GA};
      pg8::gemm_phase<pg8::EpiGate<false>, pg8::StaticOrder, PG8_ALIGN, PG8_SP2>(L, g, S, E); }
    asm volatile("s_waitcnt vmcnt(0)" ::: "memory");
    { pg8::Gemm g{UC, WCP, NLAT, DM, DM}; pg8::StaticOrder S; S.init(NLAT, DM, G, bx); pg8::EpiGate<true> E{Zb, GB};
      pg8::gemm_phase<pg8::EpiGate<true>, pg8::StaticOrder, PG8_ALIGN, PG8_SP2>(L, g, S, E); }
    GSYNC();
    { pg8::Gemm g{Zb, WOUT, NLAT, DM, DM}; pg8::StaticOrder S; S.init(NLAT, DM, G, bx); pg8::EpiBf16<0> E{Y, DM, nullptr, 0, 0, 1.f};
      pg8::gemm_phase<pg8::EpiBf16<0>, pg8::StaticOrder, PG8_ALIGN, PG8_SP2>(L, g, S, E);
    }
    GSYNC();
    norm_rows<true, true, true>(gw, NGW, lane, 0, NLAT, out, ctx, Y, out, H, mod, 1.0f, normg + 3 * DM, 5, normg + 4 * DM, 6);
    GSYNC();
    { pg8::Gemm g{H, W13B, NLAT, 2 * DFF, DM}; pg8::StaticOrder S; S.init(NLAT, 2 * DFF, G, bx); pg8::EpiSwiglu E{ACT, DFF};
      pg8::gemm_phase<pg8::EpiSwiglu, pg8::StaticOrder, PG8_ALIGN, PG8_SP2>(L, g, S, E);
    }
    GSYNC();
    { pg8::Gemm g{ACT, W2B, NLAT, DM, DFF}; pg8::StaticOrder S; S.init(NLAT, DM, G, bx); pg8::EpiBf16<0> E{Y, DM, nullptr, 0, 0, 1.f};
      pg8::gemm_phase<pg8::EpiBf16<0>, pg8::StaticOrder, PG8_ALIGN, PG8_SP2>(L, g, S, E);
    }
    GSYNC();
    norm_rows<true, true, false>(gw, NGW, lane, 0, NLAT, out, ctx, Y, out, nullptr, mod, 0.5f, normg + 5 * DM, 8, nullptr, 0);
}

extern "C" void kernel_launch(void* const* d_in, const int* in_sizes, int n_in, void* d_out, int out_size, void* d_ws, size_t ws_size, hipStream_t stream) {
    static int grid = 0;
    if (grid == 0) {
        if (n_in != 21 || ws_size < WS_END || out_size != NLAT * DM) { fprintf(stderr, "kernel_launch: unexpected shapes (n_in %d, out %d, ws %zu)\n", n_in, out_size, ws_size); grid = -1; return; }
        int dev = 0, cus = 0, per_cu = 0;
        if (hipGetDevice(&dev) != hipSuccess || hipDeviceGetAttribute(&cus, hipDeviceAttributeMultiprocessorCount, dev) != hipSuccess) { grid = -1; return; }
        if (hipFuncSetAttribute((const void*)fwd_mega, hipFuncAttributeMaxDynamicSharedMemorySize, LDS_BYTES) != hipSuccess) { fprintf(stderr, "kernel_launch: hipFuncSetAttribute failed\n"); grid = -1; return; }
        if (hipOccupancyMaxActiveBlocksPerMultiprocessor(&per_cu, (const void*)fwd_mega, NTHR, LDS_BYTES) != hipSuccess || per_cu < 1) fprintf(stderr, "kernel_launch: occupancy query says %d\n", per_cu);
        (void)hipGetLastError();
        grid = cus;
    }
    if (grid < 0) return;
    if (hipMemsetAsync(d_ws, 0, 16384, stream) != hipSuccess) { fprintf(stderr, "kernel_launch: memset of the barrier words failed\n"); return; }
    Args a{};
    for (int i = 0; i < 21; ++i) a.in[i] = (const float*)d_in[i];
    a.out = (float*)d_out; a.ws = (unsigned char*)d_ws;
    void* kargs[] = {&a};
    const hipError_t e = hipLaunchCooperativeKernel((const void*)fwd_mega, dim3(grid), dim3(NTHR), kargs, LDS_BYTES, stream);
    if (e != hipSuccess) fprintf(stderr, "cooperative launch failed: %s (grid %d)\n", hipGetErrorString(e), grid);
}
```

```cpp
#include <hip/hip_runtime.h>
#include <hip/hip_cooperative_groups.h>
#include <cstdio>
#include <cstdint>
namespace cg = cooperative_groups;
namespace pg8 {
#define PG8_LAS __attribute__((address_space(3)))
typedef unsigned short bf16_t;
typedef short bf16x8 __attribute__((ext_vector_type(8)));
typedef float f32x4 __attribute__((ext_vector_type(4)));
typedef unsigned u32x4 __attribute__((ext_vector_type(4)));
constexpr int BM = 256, BK = 64, HALF = 128, HTB = HALF * BK * 2  , STAGE_BYTES = 8 * HTB, NXCD = 8, WGM = 8;

__host__ __device__ __forceinline__ int lds_byte(int r, int c) { const int st = (r >> 4) * 2 + (c >> 5), rr = r & 15, cc = c & 31, ob = rr * 64 + cc * 2; return st * 1024 + (ob ^ (((ob >> 9) & 1) << 5)); }
__host__ __device__ __forceinline__ void stage_rc(int b, int& R, int& C) { const int st = b / 1024, sb = b % 1024, swz = sb ^ (((sb >> 9) & 1) << 5); R = (st >> 1) * 16 + swz / 64; C = (st & 1) * 32 + (swz % 64) / 2; }
__host__ __device__ __forceinline__ int perm32(int rho) { const int n = rho >> 4, i = rho & 15; return 8 * (i >> 2) + 4 * n + (i & 3); }

struct Unit { int pm, pn; };
struct Gemm { const bf16_t* A; const bf16_t* Bt; int M, N, K; };

struct StaticOrder {
    int nM, nN, nwg, G, c;
    __host__ __device__ void init(int M, int N, int G_, int c_) { nM = M / BM; nN = N / BM; nwg = nM * nN; G = G_; c = c_; }
    __host__ __device__ bool next(int i, Unit& u) const {
        const long L = (long)i * G + c; if (L >= nwg) return false;
        int wgid = (int)L; { const int q = nwg / NXCD, r = nwg % NXCD, xcd = wgid % NXCD, off = wgid / NXCD; wgid = (xcd < r ? xcd * (q + 1) : r * (q + 1) + (xcd - r) * q) + off; }
        const int nig = WGM * nN, gid = wgid / nig, fm = gid * WGM, gsz = (nM - fm) < WGM ? (nM - fm) : WGM;
        u.pm = fm + ((wgid % nig) % gsz); u.pn = (wgid % nig) / gsz; return true;
    }
    __device__ __forceinline__ void a_ready(const Unit&) const {}
    __device__ __forceinline__ void done(const Unit&) const {}
};

typedef float f32x2c_t __attribute__((ext_vector_type(2))); typedef __bf16 bf16x2c_t __attribute__((ext_vector_type(2)));
__device__ __forceinline__ unsigned cvt_pk_bf16(float lo, float hi) { f32x2c_t v = {lo, hi}; bf16x2c_t b = __builtin_convertvector(v, bf16x2c_t); return __builtin_bit_cast(unsigned, b); }
typedef float f32x2 __attribute__((ext_vector_type(2)));
__device__ __forceinline__ f32x2 gelu_pk(f32x2 v) {
    const f32x2 av = __builtin_elementwise_abs(v), d = av * 0.2316418882f + 1.0f;
    f32x2 t; t.x = __builtin_amdgcn_rcpf(d.x); t.y = __builtin_amdgcn_rcpf(d.y);
    f32x2 q = t * 0.5307027145f + (-0.7265760135f); q = q * t + 0.7107068705f; q = q * t + (-0.142248368f); q = q * t + 0.127414796f; q = q * t;
    const f32x2 s = (v * v) * (-0.72134752044f);
    f32x2 e; e.x = __builtin_amdgcn_exp2f(s.x); e.y = __builtin_amdgcn_exp2f(s.y);
    const f32x2 m = v * (q * e), r = v - m;
    f32x2 o; o.x = v.x < 0.f ? m.x : r.x; o.y = v.y < 0.f ? m.y : r.y; return o;
}

template <int ACT  > struct EpiBf16 {
    static constexpr bool PERM = true, AFTER_DRAIN = false; static_assert(ACT == 0 || ACT == 1, "EpiBf16: ACT is 0 (none) or 1 (gelu_pk)");
    bf16_t* O; int ldc; const float* bias; int split_cols; size_t split_stride; float scale0;
    __device__ __forceinline__ void operator()(const f32x4 (&acc)[2][2][4][2], const Unit& u, int wr, int wc, int fr, int fq) const {
        const int row0 = u.pm * BM + wr * 64 + fr; int colt = u.pn * BM; bf16_t* base = O;
        float sc = 1.f; if (split_cols) { const int t = colt / split_cols; base += (size_t)t * split_stride; colt -= t * split_cols; if (t == 0) sc = scale0; }
        const int col0 = colt + wc * 32 + 8 * fq, bcol0 = u.pn * BM + wc * 32 + 8 * fq;
        f32x4 bv[2][2];
#pragma unroll
        for (int bj = 0; bj < 2; ++bj)
#pragma unroll
            for (int n = 0; n < 2; ++n) bv[bj][n] = bias ? *(const f32x4*)(bias + bcol0 + bj * HALF + 4 * n) : (f32x4){0.f, 0.f, 0.f, 0.f};
#pragma unroll
        for (int ai = 0; ai < 2; ++ai)
#pragma unroll
            for (int m = 0; m < 4; ++m) { bf16_t* rowp = base + (size_t)(row0 + ai * HALF + m * 16) * ldc + col0;
#pragma unroll
                for (int bj = 0; bj < 2; ++bj) { f32x4 v0 = acc[ai][bj][m][0] + bv[bj][0], v1 = acc[ai][bj][m][1] + bv[bj][1];
                    if (ACT == 1) { f32x2 a = gelu_pk((f32x2){v0[0], v0[1]}), b = gelu_pk((f32x2){v0[2], v0[3]}), c = gelu_pk((f32x2){v1[0], v1[1]}), d = gelu_pk((f32x2){v1[2], v1[3]});
                        v0 = (f32x4){a.x, a.y, b.x, b.y}; v1 = (f32x4){c.x, c.y, d.x, d.y}; }
                    v0 = v0 * sc; v1 = v1 * sc; u32x4 w; w.x = cvt_pk_bf16(v0[0], v0[1]); w.y = cvt_pk_bf16(v0[2], v0[3]); w.z = cvt_pk_bf16(v1[0], v1[1]); w.w = cvt_pk_bf16(v1[2], v1[3]);
                    *(u32x4*)(rowp + bj * HALF) = w; } }
    }
};
template <class Epi, class Sched, bool ALIGN_EPI = false, bool SP2 = false>
__device__ __forceinline__ void gemm_phase(PG8_LAS unsigned char* lds, const Gemm g, const Sched& S, const Epi& E) {
    int tid_ = threadIdx.x; asm volatile("" : "+v"(tid_));
    const int tid = tid_, wid = __builtin_amdgcn_readfirstlane(tid >> 6), lane = tid & 63, wr = wid >> 2, wc = wid & 3, fr = lane & 15, fq = lane >> 4;
    const int K = g.K, nt = K / BK;
    unsigned voffA[2], voffB[2];
#pragma unroll
    for (int i = 0; i < 2; ++i) { int R, C; stage_rc(tid * 16 + i * 8192, R, C); const int Rb = Epi::PERM ? ((R & ~31) + perm32(R & 31)) : R;
        voffA[i] = (unsigned)(R * K + C) * 2u; voffB[i] = (unsigned)(Rb * K + C) * 2u; }
    const size_t kstep = (size_t)(BK * 2);
    const size_t hstep = (size_t)HALF * K * 2;
    const size_t tstep = 2 * hstep;
    const unsigned ldsw = (unsigned)wid * 1024u;
    const int aoff = lds_byte(wr * 64 + fr, fq * 8), boff = lds_byte(wc * 32 + fr, fq * 8);
#define PG8_SA(b, h) (((b) * 2 + (h)) * HTB)
#define PG8_SB(b, h) ((4 + (b) * 2 + (h)) * HTB)
#define PG8_STAGE(bufoff, gbase, voff) do { _Pragma("unroll") for (int _i = 0; _i < 2; ++_i) \
        __builtin_amdgcn_global_load_lds((const unsigned*)((const char*)(gbase) + (voff)[_i]), (PG8_LAS unsigned*)(lds + (bufoff) + ldsw + _i * 8192), 16, 0, 0); } while (0)
#define PG8_LDA(dst, b, h) do { _Pragma("unroll") for (int m = 0; m < 4; ++m) _Pragma("unroll") for (int k = 0; k < 2; ++k) dst[m][k] = *(const PG8_LAS bf16x8*)(lds + PG8_SA(b, h) + aoff + m * 2048 + k * 1024); } while (0)
#define PG8_LDB(dst, b, h) do { _Pragma("unroll") for (int n = 0; n < 2; ++n) _Pragma("unroll") for (int k = 0; k < 2; ++k) dst[n][k] = *(const PG8_LAS bf16x8*)(lds + PG8_SB(b, h) + boff + n * 2048 + k * 1024); } while (0)
#define PG8_MMA(ai, bj, At, Bt) do { __builtin_amdgcn_s_setprio(1); _Pragma("unroll") for (int m = 0; m < 4; ++m) _Pragma("unroll") for (int n = 0; n < 2; ++n) _Pragma("unroll") for (int k = 0; k < 2; ++k) \
        acc[ai][bj][m][n] = __builtin_amdgcn_mfma_f32_16x16x32_bf16(Bt[n][k], At[m][k], acc[ai][bj][m][n], 0, 0, 0); __builtin_amdgcn_s_setprio(0); } while (0)
#define PG8_WAIT_V(n) asm volatile("s_waitcnt vmcnt(" #n ")" ::: "memory")
#define PG8_WAIT_L(n) asm volatile("s_waitcnt lgkmcnt(" #n ")" ::: "memory")
#define PG8_BAR __builtin_amdgcn_s_barrier()
#define PG8_SCHED __builtin_amdgcn_sched_barrier(0)
    Unit cur, nxt; int ui = 0;
    if (!S.next(0, cur)) return;
    f32x4 acc[2][2][4][2];
#pragma unroll
    for (int a = 0; a < 2; ++a)
#pragma unroll
        for (int b = 0; b < 2; ++b)
#pragma unroll
            for (int m = 0; m < 4; ++m)
#pragma unroll
                for (int n = 0; n < 2; ++n) acc[a][b][m][n] = (f32x4){0.f, 0.f, 0.f, 0.f};
    bf16x8 At[4][2], B0[2][2], B1[2][2];
    const char* cA = (const char*)g.A + (size_t)cur.pm * tstep; const char* cB = (const char*)g.Bt + (size_t)cur.pn * tstep;
    S.a_ready(cur);
    if constexpr (SP2) {
        PG8_STAGE(PG8_SB(0, 0), cB, voffB); PG8_STAGE(PG8_SB(0, 1), cB + hstep, voffB); PG8_STAGE(PG8_SA(0, 0), cA, voffA); PG8_STAGE(PG8_SA(0, 1), cA + hstep, voffA);
        if (wr == 1) PG8_BAR;
        PG8_WAIT_V(2); PG8_BAR;
        PG8_STAGE(PG8_SB(1, 0), cB + kstep, voffB); PG8_STAGE(PG8_SA(1, 0), cA + kstep, voffA); PG8_STAGE(PG8_SB(1, 1), cB + hstep + kstep, voffB);
        PG8_WAIT_V(6); PG8_BAR;
    } else {
        PG8_STAGE(PG8_SB(0, 0), cB, voffB); PG8_STAGE(PG8_SA(0, 0), cA, voffA); PG8_STAGE(PG8_SB(0, 1), cB + hstep, voffB); PG8_STAGE(PG8_SA(0, 1), cA + hstep, voffA);
        if (wr == 1) PG8_BAR;
        PG8_WAIT_V(4); PG8_BAR;
        PG8_STAGE(PG8_SB(1, 0), cB + kstep, voffB); PG8_STAGE(PG8_SA(1, 0), cA + kstep, voffA); PG8_STAGE(PG8_SB(1, 1), cB + hstep + kstep, voffB);
        PG8_WAIT_V(6); PG8_BAR;
    }
    for (;;) {
        const bool has_next = S.next(ui + 1, nxt);
        const char* nA = has_next ? (const char*)g.A + (size_t)nxt.pm * tstep : cA; const char* nB = has_next ? (const char*)g.Bt + (size_t)nxt.pn * tstep : cB;
        for (int t = 0; t < nt; t += 2) {
            const bool last = (t == nt - 2);
            const char* a1 = cA + (size_t)(t + 1) * kstep;
            const char* a2 = last ? nA : cA + (size_t)(t + 2) * kstep; const char* b2 = last ? nB : cB + (size_t)(t + 2) * kstep;
            const char* a3 = a2 + kstep; const char* b3 = b2 + kstep;
            if (last && has_next) S.a_ready(nxt);
            if constexpr (SP2) {
            PG8_LDB(B0, 0, 0); PG8_LDB(B1, 0, 1); PG8_SCHED; PG8_LDA(At, 0, 0); PG8_STAGE(PG8_SA(1, 1), a1 + hstep, voffA);
            PG8_WAIT_V(8); PG8_WAIT_L(0); PG8_BAR; PG8_MMA(0, 0, At, B0); PG8_MMA(0, 1, At, B1); PG8_BAR; PG8_SCHED;
            PG8_LDA(At, 0, 1); PG8_STAGE(PG8_SB(0, 0), b2, voffB); PG8_STAGE(PG8_SB(0, 1), b2 + hstep, voffB); PG8_STAGE(PG8_SA(0, 0), a2, voffA);
            PG8_WAIT_V(8); PG8_WAIT_L(0); PG8_BAR; PG8_MMA(1, 0, At, B0); PG8_MMA(1, 1, At, B1); PG8_BAR; PG8_SCHED;
            PG8_LDB(B0, 1, 0); PG8_LDB(B1, 1, 1); PG8_SCHED; PG8_LDA(At, 1, 0); PG8_STAGE(PG8_SA(0, 1), a2 + hstep, voffA);
            PG8_WAIT_V(8); PG8_WAIT_L(0); PG8_BAR; PG8_MMA(0, 0, At, B0); PG8_MMA(0, 1, At, B1); PG8_BAR; PG8_SCHED;
            PG8_LDA(At, 1, 1); PG8_STAGE(PG8_SB(1, 0), b3, voffB); PG8_STAGE(PG8_SB(1, 1), b3 + hstep, voffB); PG8_STAGE(PG8_SA(1, 0), a3, voffA);
            PG8_WAIT_V(8); PG8_WAIT_L(0); PG8_BAR; PG8_MMA(1, 0, At, B0); PG8_MMA(1, 1, At, B1); PG8_BAR; PG8_SCHED;
            } else {
            PG8_LDB(B0, 0, 0); PG8_SCHED; PG8_LDA(At, 0, 0); PG8_STAGE(PG8_SA(1, 1), a1 + hstep, voffA);
            PG8_WAIT_L(8); PG8_BAR; PG8_WAIT_L(0); PG8_MMA(0, 0, At, B0); PG8_BAR; PG8_SCHED;
            PG8_LDB(B1, 0, 1); PG8_STAGE(PG8_SB(0, 0), b2, voffB);
            PG8_BAR; PG8_WAIT_L(0); PG8_MMA(0, 1, At, B1); PG8_BAR;
            PG8_LDA(At, 0, 1); PG8_STAGE(PG8_SA(0, 0), a2, voffA);
            PG8_BAR; PG8_WAIT_L(0); PG8_MMA(1, 0, At, B0); PG8_BAR; PG8_SCHED;
            PG8_STAGE(PG8_SB(0, 1), b2 + hstep, voffB);
            PG8_WAIT_V(6); PG8_BAR; PG8_MMA(1, 1, At, B1); PG8_BAR;
            PG8_LDB(B0, 1, 0); PG8_SCHED; PG8_LDA(At, 1, 0); PG8_STAGE(PG8_SA(0, 1), a2 + hstep, voffA);
            PG8_WAIT_L(8); PG8_BAR; PG8_WAIT_L(0); PG8_MMA(0, 0, At, B0); PG8_BAR; PG8_SCHED;
            PG8_LDB(B1, 1, 1); PG8_STAGE(PG8_SB(1, 0), b3, voffB);
            PG8_BAR; PG8_WAIT_L(0); PG8_MMA(0, 1, At, B1); PG8_BAR;
            PG8_LDA(At, 1, 1); PG8_STAGE(PG8_SA(1, 0), a3, voffA);
            PG8_BAR; PG8_WAIT_L(0); PG8_MMA(1, 0, At, B0); PG8_BAR; PG8_SCHED;
            PG8_STAGE(PG8_SB(1, 1), b3 + hstep, voffB);
            PG8_WAIT_V(6); PG8_BAR; PG8_MMA(1, 1, At, B1); PG8_BAR;
            }
        }
        if constexpr (ALIGN_EPI) { if (wr == 0) PG8_BAR; }
        if constexpr (!Epi::AFTER_DRAIN) { E(acc, cur, wr, wc, fr, fq); S.done(cur); }
        if (!has_next) break;
#pragma unroll
        for (int a = 0; a < 2; ++a)
#pragma unroll
            for (int b = 0; b < 2; ++b)
#pragma unroll
                for (int m = 0; m < 4; ++m)
#pragma unroll
                    for (int n = 0; n < 2; ++n) acc[a][b][m][n] = (f32x4){0.f, 0.f, 0.f, 0.f};
        cur = nxt; cA = nA; cB = nB; ++ui;
        if constexpr (ALIGN_EPI) { if (wr == 1) PG8_BAR; }
    }
    PG8_WAIT_V(0);
    if constexpr (!ALIGN_EPI) { if (wr == 0) PG8_BAR; }
    PG8_BAR;
    if constexpr (Epi::AFTER_DRAIN) { E.fused(acc, cur, wr, wc, fr, fq, lds, wid, lane); S.done(cur); }
#undef PG8_SA
#undef PG8_SB
#undef PG8_STAGE
#undef PG8_LDA
#undef PG8_LDB
#undef PG8_MMA
#undef PG8_WAIT_V
#undef PG8_WAIT_L
#undef PG8_BAR
#undef PG8_SCHED
}
}

#ifndef PG8_SP2
#define PG8_SP2 true
#endif
#ifndef PG8_ALIGN
#define PG8_ALIGN true
#endif
#include <hip/hip_bf16.h>
#include <cmath>
namespace attn2 {
using bf16x8 = __attribute__((ext_vector_type(8))) short;
using s16x4  = __attribute__((ext_vector_type(4))) short;
using f32x16 = __attribute__((ext_vector_type(16))) float;
using u32x4  = __attribute__((ext_vector_type(4))) unsigned;
typedef unsigned short bf16r;
constexpr int DQ = 64, DV = 128, NW = 8, QBLK = 32, KVBLK = 64, LD = 1024;
constexpr float SCALE = 0.125f, THR = 8.f, QSCALE = SCALE * 1.4426950408889634f;
#ifndef A2_FORCE_REF
#define A2_FORCE_REF 0
#endif
constexpr size_t SHM_V = KVBLK * DV * 2, SHM_K = KVBLK * DQ * 2, SHM_ATTN = 3 * SHM_V + 3 * SHM_K + NW * 64 * 4;
constexpr size_t PARK_OFF = SHM_ATTN, PARK_BYTES = NW * 2048 * 4;
#define A2_KSWZ(row, colB) ((row) * 128 + ((colB) ^ ((((row) >> 1) & 7) << 4)))
#define A2_SBAR() __builtin_amdgcn_sched_barrier(0)
__device__ __forceinline__ int crow(int r, int hi) { return (r & 3) + 8 * (r >> 2) + 4 * hi; }
typedef float f32x2_t __attribute__((ext_vector_type(2))); typedef __bf16 bf16x2_t __attribute__((ext_vector_type(2)));
__device__ __forceinline__ unsigned cvtpk(float lo, float hi) { f32x2_t v = {lo, hi}; bf16x2_t b = __builtin_convertvector(v, bf16x2_t); return __builtin_bit_cast(unsigned, b); }

__device__ __forceinline__ void partialSM0(f32x16& p0, f32x16& p1, float& m_reg, bool& refz) {
  float pmax = p0[0];
#pragma unroll
  for (int r = 1; r < 16; ++r) pmax = fmaxf(pmax, p0[r]);
#pragma unroll
  for (int r = 0; r < 16; ++r) pmax = fmaxf(pmax, p1[r]);
  { auto rr = __builtin_amdgcn_permlane32_swap(__float_as_uint(pmax), __float_as_uint(pmax), false, false);
    pmax = fmaxf(__uint_as_float(rr[0]), __uint_as_float(rr[1])); }
  refz = (A2_FORCE_REF == 0) && __all(fabsf(pmax) < 64.f);
  m_reg = refz ? 0.f : pmax;
  if (!refz) {
#pragma unroll
    for (int r = 0; r < 16; ++r) { p0[r] -= m_reg; p1[r] -= m_reg; }
  }
#pragma unroll
  for (int r = 0; r < 16; ++r) p0[r] = __builtin_amdgcn_exp2f(p0[r]);
}
constexpr float LAZY_BIG = 1073741824.f;
__device__ __forceinline__ void finishSM(f32x16& p0, f32x16& p1, float& m_reg, bool& refz, float& alpha, float& l_reg, bf16x8& pa0, bf16x8& pa1, bf16x8& pa2, bf16x8& pa3) {
#pragma unroll
  for (int r = 0; r < 16; ++r) p1[r] = __builtin_amdgcn_exp2f(p1[r]);
  f32x2_t sv = {p0[0], p0[1]};
#pragma unroll
  for (int i = 1; i < 8; ++i) sv += (f32x2_t){p0[2 * i], p0[2 * i + 1]};
#pragma unroll
  for (int i = 0; i < 8; ++i) sv += (f32x2_t){p1[2 * i], p1[2 * i + 1]};
  float ps = sv.x + sv.y;
  alpha = 1.f;
  if (__builtin_expect(__any(!(ps <= LAZY_BIG)), 0)) {
    auto rr = __builtin_amdgcn_permlane32_swap(__float_as_uint(ps), __float_as_uint(ps), false, false);
    const float pt = __uint_as_float(rr[0]) + __uint_as_float(rr[1]);
    const float dl = (pt > LAZY_BIG) ? floorf(__log2f(pt)) + 1.f : 0.f;
    alpha = __builtin_amdgcn_exp2f(-dl); m_reg += dl; refz = false;
#pragma unroll
    for (int r = 0; r < 16; ++r) { p0[r] *= alpha; p1[r] *= alpha; }
    ps *= alpha;
  }
  l_reg = l_reg * alpha + ps; asm volatile("" : "+v"(l_reg));
#define A2_PK8(P, BASE, OUT) do { u32x4 w = {cvtpk(P[BASE + 0], P[BASE + 1]), cvtpk(P[BASE + 2], P[BASE + 3]), cvtpk(P[BASE + 4], P[BASE + 5]), cvtpk(P[BASE + 6], P[BASE + 7])}; OUT = *reinterpret_cast<bf16x8*>(&w); } while (0)
  A2_PK8(p0, 0, pa0); A2_PK8(p0, 8, pa1); A2_PK8(p1, 0, pa2); A2_PK8(p1, 8, pa3);
#undef A2_PK8
}
__device__ __forceinline__ void qkt(f32x16& p0, f32x16& p1, const char* Ks, const bf16x8* qr, int r32, int hi) {
  p0 = f32x16{}; p1 = f32x16{};
#pragma unroll
  for (int d0 = 0; d0 < 4; ++d0) { const int cb = (d0 * 16 + hi * 8) * 2;
    const bf16x8 b0 = *reinterpret_cast<const bf16x8*>(Ks + A2_KSWZ(r32, cb));
    const bf16x8 b1 = *reinterpret_cast<const bf16x8*>(Ks + A2_KSWZ(32 + r32, cb));
    p0 = __builtin_amdgcn_mfma_f32_32x32x16_bf16(b0, qr[d0], p0, 0, 0, 0);
    p1 = __builtin_amdgcn_mfma_f32_32x32x16_bf16(b1, qr[d0], p1, 0, 0, 0); }
}
__device__ __forceinline__ int v_st(int k, int c) { const int kk = k;     return ((kk >> 3) * 4 + (c >> 5)) * 512 + ((kk & 7) * 32 + (c & 31)) * 2; }
__device__ __forceinline__ int v_rd_base(int lane) { return ((lane & 3) << 3) | (((lane >> 2) & 3) << 6) | (((lane >> 4) & 1) << 5) | (((lane >> 5) & 1) << 8); }
constexpr int v_rd_off(int d0, int ks, int half) { return d0 * 512 + ks * 4096 + half * 2048; }
template <int OFF> __device__ __forceinline__ s16x4 tr_read(int vb) {
  s16x4 r; asm volatile("ds_read_b64_tr_b16 %0, %1 offset:%2" : "=&v"(r) : "v"(vb), "i"(OFF) : "memory"); return r;
}
template <int D0> __device__ __forceinline__ void pv_one(f32x16& od, int vb, bf16x8 pa0, bf16x8 pa1, bf16x8 pa2, bf16x8 pa3) {
  const s16x4 l0 = tr_read<v_rd_off(D0, 0, 0)>(vb), h0 = tr_read<v_rd_off(D0, 0, 1)>(vb), l1 = tr_read<v_rd_off(D0, 1, 0)>(vb), h1 = tr_read<v_rd_off(D0, 1, 1)>(vb);
  const s16x4 l2 = tr_read<v_rd_off(D0, 2, 0)>(vb), h2 = tr_read<v_rd_off(D0, 2, 1)>(vb), l3 = tr_read<v_rd_off(D0, 3, 0)>(vb), h3 = tr_read<v_rd_off(D0, 3, 1)>(vb);
  asm volatile("s_waitcnt lgkmcnt(0)" ::: "memory"); A2_SBAR();
#define A2_PK(L, H) (bf16x8){L[0], L[1], L[2], L[3], H[0], H[1], H[2], H[3]}
  od = __builtin_amdgcn_mfma_f32_32x32x16_bf16(pa0, A2_PK(l0, h0), od, 0, 0, 0);
  od = __builtin_amdgcn_mfma_f32_32x32x16_bf16(pa1, A2_PK(l1, h1), od, 0, 0, 0);
  od = __builtin_amdgcn_mfma_f32_32x32x16_bf16(pa2, A2_PK(l2, h2), od, 0, 0, 0);
  od = __builtin_amdgcn_mfma_f32_32x32x16_bf16(pa3, A2_PK(l3, h3), od, 0, 0, 0);
#undef A2_PK
}
__device__ __forceinline__ void pv_d0(f32x16* o, int vb, bf16x8 pa0, bf16x8 pa1, bf16x8 pa2, bf16x8 pa3) {
  pv_one<0>(o[0], vb, pa0, pa1, pa2, pa3); pv_one<1>(o[1], vb, pa0, pa1, pa2, pa3); pv_one<2>(o[2], vb, pa0, pa1, pa2, pa3); pv_one<3>(o[3], vb, pa0, pa1, pa2, pa3);
}

struct VF { s16x4 l0, h0, l1, h1, l2, h2, l3, h3; };
template <int D0> __device__ __forceinline__ VF vread(int vb) { VF f;
  f.l0 = tr_read<v_rd_off(D0, 0, 0)>(vb); f.h0 = tr_read<v_rd_off(D0, 0, 1)>(vb); f.l1 = tr_read<v_rd_off(D0, 1, 0)>(vb); f.h1 = tr_read<v_rd_off(D0, 1, 1)>(vb);
  f.l2 = tr_read<v_rd_off(D0, 2, 0)>(vb); f.h2 = tr_read<v_rd_off(D0, 2, 1)>(vb); f.l3 = tr_read<v_rd_off(D0, 3, 0)>(vb); f.h3 = tr_read<v_rd_off(D0, 3, 1)>(vb); return f; }
__device__ __forceinline__ void mfma4(f32x16& od, const VF& f, bf16x8 pa0, bf16x8 pa1, bf16x8 pa2, bf16x8 pa3) {
#define A2_PK(L, H) (bf16x8){L[0], L[1], L[2], L[3], H[0], H[1], H[2], H[3]}
  od = __builtin_amdgcn_mfma_f32_32x32x16_bf16(pa0, A2_PK(f.l0, f.h0), od, 0, 0, 0);
  od = __builtin_amdgcn_mfma_f32_32x32x16_bf16(pa1, A2_PK(f.l1, f.h1), od, 0, 0, 0);
  od = __builtin_amdgcn_mfma_f32_32x32x16_bf16(pa2, A2_PK(f.l2, f.h2), od, 0, 0, 0);
  od = __builtin_amdgcn_mfma_f32_32x32x16_bf16(pa3, A2_PK(f.l3, f.h3), od, 0, 0, 0);
#undef A2_PK
}
#define A2_LWAIT(n) do { asm volatile("s_waitcnt lgkmcnt(" #n ")" ::: "memory"); A2_SBAR(); } while (0)
__device__ __forceinline__ void pv_psm(f32x16* o, int vb, bf16x8 pa0, bf16x8 pa1, bf16x8 pa2, bf16x8 pa3, f32x16& p0, f32x16& p1, float m_reg, bool refz) {
  const VF f0 = vread<0>(vb);
  const VF f1 = vread<1>(vb); A2_LWAIT(8); mfma4(o[0], f0, pa0, pa1, pa2, pa3);
  if (!refz) {
#pragma unroll
    for (int r = 0; r < 16; ++r) { p0[r] -= m_reg; p1[r] -= m_reg; }
  }
  const VF f2 = vread<2>(vb); A2_LWAIT(8); mfma4(o[1], f1, pa0, pa1, pa2, pa3);
#pragma unroll
  for (int r = 0; r < 6; ++r) p0[r] = __builtin_amdgcn_exp2f(p0[r]);
  asm volatile("" : "+v"(p0));
  const VF f3 = vread<3>(vb); A2_LWAIT(8); mfma4(o[2], f2, pa0, pa1, pa2, pa3);
#pragma unroll
  for (int r = 6; r < 11; ++r) p0[r] = __builtin_amdgcn_exp2f(p0[r]);
  asm volatile("" : "+v"(p0));
  A2_LWAIT(0); mfma4(o[3], f3, pa0, pa1, pa2, pa3);
#pragma unroll
  for (int r = 11; r < 16; ++r) p0[r] = __builtin_amdgcn_exp2f(p0[r]);
  asm volatile("" : "+v"(p0)); A2_SBAR();
}
template <int PASS>
__device__ __forceinline__ void body(const bf16r* Qb, const bf16r* Kh, const bf16r* Vh, int seq, char* lds, float lam, const float* subln, bf16r* Ob) {
  int tid_ = threadIdx.x; asm volatile("" : "+v"(tid_));
  const int tid = tid_, wid = tid >> 6, lane = tid & 63, r32 = lane & 31, hi = lane >> 5;
  char* V_lds = lds; char* K_lds = lds + 3 * SHM_V;
  float* ws = (float*)(lds + 3 * SHM_V + 3 * SHM_K) + wid * 64; float* li_l = ws; float* al_l = ws + 32;
  float m_reg = 0.f, l_reg = 0; f32x16 o[4] = {}; bf16x8 qr[4];
  const bf16r* Qw = Qb + (long)(wid * QBLK + r32) * LD + hi * 8;
#pragma unroll
  for (int d0 = 0; d0 < 4; ++d0) qr[d0] = *reinterpret_cast<const bf16x8*>(Qw + d0 * 16);
  const int sr = tid >> 4, sc = (tid & 15) * 8, vst0 = v_st(sr, sc), vst1 = v_st(32 + sr, sc);
  const int kr = tid >> 3, kc = (tid & 7) * 8, kst = A2_KSWZ(kr, kc * 2);
  const int vb0 = (int)(uintptr_t)V_lds + v_rd_base(lane);
  struct { bf16x8 vs0, vs1, ks0; } sr_[2];
#define A2_SLOAD(i, k0) do { sr_[i].vs0 = *reinterpret_cast<const bf16x8*>(&Vh[(long)((k0) + sr) * LD + sc]); sr_[i].vs1 = *reinterpret_cast<const bf16x8*>(&Vh[(long)((k0) + 32 + sr) * LD + sc]); \
    sr_[i].ks0 = *reinterpret_cast<const bf16x8*>(&Kh[(long)((k0) + kr) * LD + kc]); } while (0)
#define A2_SWRITE(b, i) do { *(bf16x8*)(V_lds + (b) * SHM_V + vst0) = sr_[i].vs0; *(bf16x8*)(V_lds + (b) * SHM_V + vst1) = sr_[i].vs1; *(bf16x8*)(K_lds + (b) * SHM_K + kst) = sr_[i].ks0; } while (0)
#define A2_SWAIT() asm volatile("s_waitcnt vmcnt(3)" ::: "memory")
#define A2_RESC(a) do { if (__any((a) < 1.f)) { if (hi == 0) al_l[r32] = (a); asm volatile("s_waitcnt lgkmcnt(0)" ::: "memory"); \
    _Pragma("unroll") for (int d = 0; d < 4; ++d) _Pragma("unroll") for (int r = 0; r < 16; ++r) o[d][r] *= al_l[crow(r, hi)]; } } while (0)
  if (wid >= 4) __builtin_amdgcn_s_setprio(1);
  f32x16 pA0, pA1, pB0, pB1; float al; bool refz; bf16x8 pa0, pa1, pa2, pa3; const int NT = seq / KVBLK;
  A2_SLOAD(0, 0); asm volatile("s_waitcnt vmcnt(0)" ::: "memory"); A2_SWRITE(0, 0);
  A2_SLOAD(1, KVBLK); A2_SLOAD(0, 2 * KVBLK);
  __syncthreads();
  qkt(pA0, pA1, K_lds, qr, r32, hi); partialSM0(pA0, pA1, m_reg, refz);
  A2_SWAIT(); A2_SWRITE(1, 1); A2_SLOAD(1, 3 * KVBLK);
  int bp = 0, bc = 1, bn = 2;
#define A2_STEP(PC0, PC1, PP0, PP1, j_, SL) do { \
    __syncthreads(); \
    if ((j_) + 1 < NT) { A2_SWAIT(); A2_SWRITE(bn, SL); } \
    A2_SBAR(); qkt(PC0, PC1, K_lds + bc * SHM_K, qr, r32, hi); \
    finishSM(PP0, PP1, m_reg, refz, al, l_reg, pa0, pa1, pa2, pa3); A2_RESC(al); A2_SBAR(); \
    if ((j_) + 3 < NT) A2_SLOAD(SL, ((j_) + 3) * KVBLK); A2_SBAR(); \
    pv_psm(o, vb0 + bp * (int)SHM_V, pa0, pa1, pa2, pa3, PC0, PC1, m_reg, refz); \
    { const int t_ = bp; bp = bc; bc = bn; bn = t_; } } while (0)
  for (int j = 1; j + 1 < NT; j += 2) {
    A2_STEP(pB0, pB1, pA0, pA1, j, 0);
    A2_STEP(pA0, pA1, pB0, pB1, j + 1, 1);
  }
  A2_STEP(pB0, pB1, pA0, pA1, NT - 1, 0);
#undef A2_STEP
  finishSM(pB0, pB1, m_reg, refz, al, l_reg, pa0, pa1, pa2, pa3); A2_RESC(al); A2_SBAR();
  pv_d0(o, vb0 + bp * (int)SHM_V, pa0, pa1, pa2, pa3);
  __builtin_amdgcn_s_setprio(0);
  { auto rr = __builtin_amdgcn_permlane32_swap(__float_as_uint(l_reg), __float_as_uint(l_reg), false, false); l_reg = __uint_as_float(rr[0]) + __uint_as_float(rr[1]); }
  if (hi == 0) li_l[r32] = l_reg; asm volatile("s_waitcnt lgkmcnt(0)" ::: "memory");
  float rli[16];
#pragma unroll
  for (int r = 0; r < 16; ++r) rli[r] = __builtin_amdgcn_rcpf(li_l[crow(r, hi)]);
  unsigned* sw = (unsigned*)(lds + PARK_OFF) + wid * 2048 + lane;
  if (PASS == 0) {
#pragma unroll
    for (int r = 0; r < 16; ++r)
#pragma unroll
      for (int dp = 0; dp < 2; ++dp) sw[(r * 2 + dp) * 64] = cvtpk(o[2 * dp][r] * rli[r], o[2 * dp + 1][r] * rli[r]);
  } else {
    float sg[4];
#pragma unroll
    for (int d0 = 0; d0 < 4; ++d0) sg[d0] = subln[d0 * 32 + r32];
    bf16r* Ow = Ob + (long)(wid * QBLK) * LD + r32;
#pragma unroll
    for (int r = 0; r < 16; ++r) {
      float d[4]; float ss = 0.f;
#pragma unroll
      for (int dp = 0; dp < 2; ++dp) { const unsigned w = sw[(r * 2 + dp) * 64];
        d[2 * dp] = __uint_as_float(w << 16) - lam * (o[2 * dp][r] * rli[r]); d[2 * dp + 1] = __uint_as_float(w & 0xffff0000u) - lam * (o[2 * dp + 1][r] * rli[r]); }
#pragma unroll
      for (int d0 = 0; d0 < 4; ++d0) ss += d[d0] * d[d0];
      ss += __shfl_xor(ss, 1); ss += __shfl_xor(ss, 2); ss += __shfl_xor(ss, 4); ss += __shfl_xor(ss, 8); ss += __shfl_xor(ss, 16);
      const float rstd = 0.8f / sqrtf(ss * (1.f / 128.f) + 1e-6f);
      const int orow = crow(r, hi);
#pragma unroll
      for (int d0 = 0; d0 < 4; ++d0) Ow[(long)orow * LD + d0 * 32] = (bf16r)(cvtpk(d[d0] * rstd * sg[d0], 0.f) & 0xffffu);
    }
  }
  __syncthreads();
#undef A2_SLOAD
#undef A2_SWRITE
#undef A2_SWAIT
#undef A2_RESC
}
#undef A2_KSWZ
#undef A2_LWAIT
#undef A2_SBAR
}
namespace pg8 {
typedef unsigned u32x2 __attribute__((ext_vector_type(2)));
__device__ __forceinline__ float fsigmoid(float x) { return __builtin_amdgcn_rcpf(1.0f + __builtin_amdgcn_exp2f(-1.4426950408889634f * x)); }
__device__ __forceinline__ float fsilu(float x) { return x * fsigmoid(x); }
__device__ __forceinline__ float bflo(unsigned w) { return __uint_as_float(w << 16); }
__device__ __forceinline__ float bfhi(unsigned w) { return __uint_as_float(w & 0xffff0000u); }

struct EpiSwiglu {
    static constexpr bool PERM = true, AFTER_DRAIN = false;
    bf16_t* O; int ldc;
    __device__ __forceinline__ void operator()(const f32x4 (&acc)[2][2][4][2], const Unit& u, int wr, int wc, int fr, int fq) const {
        const int row0 = u.pm * BM + wr * 64 + fr, col0 = u.pn * HALF + wc * 32 + 8 * fq;
#pragma unroll
        for (int ai = 0; ai < 2; ++ai)
#pragma unroll
            for (int m = 0; m < 4; ++m) {
                bf16_t* rowp = O + (size_t)(row0 + ai * HALF + m * 16) * ldc + col0;
                const f32x4 g0 = acc[ai][0][m][0], g1 = acc[ai][0][m][1], u0 = acc[ai][1][m][0], u1 = acc[ai][1][m][1];
                u32x4 w;
                w.x = cvt_pk_bf16(fsilu(g0[0]) * u0[0], fsilu(g0[1]) * u0[1]); w.y = cvt_pk_bf16(fsilu(g0[2]) * u0[2], fsilu(g0[3]) * u0[3]);
                w.z = cvt_pk_bf16(fsilu(g1[0]) * u1[0], fsilu(g1[1]) * u1[1]); w.w = cvt_pk_bf16(fsilu(g1[2]) * u1[2], fsilu(g1[3]) * u1[3]);
                *(u32x4*)rowp = w;
            }
    }
};

struct EpiWin {
    static constexpr bool PERM = true, AFTER_DRAIN = false;
    bf16_t *q, *k, *v, *u, *ga, *gb; const float* rope; float qscale;
    __device__ __forceinline__ void operator()(const f32x4 (&acc)[2][2][4][2], const Unit& un, int wr, int wc, int fr, int fq) const {
        const int pn = un.pn, rowt = un.pm * BM + wr * 64 + fr, bidx = un.pm >> 5;
        if (pn < 8) {
            const bool isq = pn < 4; const float sc = isq ? qscale : 1.f; bf16_t* base = isq ? q : k;
            const int colt = (pn & 3) * 256 + wc * 32 + 8 * fq, axis = wc & 1, f0 = 8 * (fq & 1);
            const float sgn = (fq < 2) ? -sc : sc;
#pragma unroll
            for (int ai = 0; ai < 2; ++ai)
#pragma unroll
                for (int m = 0; m < 4; ++m) {
                    const int r = rowt + ai * HALF + m * 16, t = r & 8191, pos = axis ? (t & 63) : (t >> 6);
                    const f32x4 cs0 = *(const f32x4*)(rope + pos * 16 + f0), cs1 = *(const f32x4*)(rope + pos * 16 + f0 + 4);
                    const f32x4 sn0 = *(const f32x4*)(rope + 2048 + pos * 16 + f0), sn1 = *(const f32x4*)(rope + 2048 + pos * 16 + f0 + 4);
                    const size_t orow = isq ? (size_t)r : (size_t)bidx * 8448 + 256 + t;
                    bf16_t* rowp = base + orow * 1024 + colt;
#pragma unroll
                    for (int bj = 0; bj < 2; ++bj) {
                        const f32x4 s0 = acc[ai][bj][m][0], s1 = acc[ai][bj][m][1]; f32x4 o0, o1;
#pragma unroll
                        for (int jj = 0; jj < 4; ++jj) { const float p0 = __shfl_xor(s0[jj], 32), p1 = __shfl_xor(s1[jj], 32);
                            o0[jj] = s0[jj] * (cs0[jj] * sc) + p0 * (sn0[jj] * sgn); o1[jj] = s1[jj] * (cs1[jj] * sc) + p1 * (sn1[jj] * sgn); }
                        u32x4 w; w.x = cvt_pk_bf16(o0[0], o0[1]); w.y = cvt_pk_bf16(o0[2], o0[3]); w.z = cvt_pk_bf16(o1[0], o1[1]); w.w = cvt_pk_bf16(o1[2], o1[3]);
                        *(u32x4*)(rowp + bj * HALF) = w;
                    }
                }
        } else if (pn < 12) {
            const int colt = (pn - 8) * 256 + wc * 32 + 8 * fq;
#pragma unroll
            for (int ai = 0; ai < 2; ++ai)
#pragma unroll
                for (int m = 0; m < 4; ++m) {
                    const int r = rowt + ai * HALF + m * 16, t = r & 8191;
                    bf16_t* rowp = v + ((size_t)bidx * 8448 + 256 + t) * 1024 + colt;
#pragma unroll
                    for (int bj = 0; bj < 2; ++bj) { const f32x4 v0 = acc[ai][bj][m][0], v1 = acc[ai][bj][m][1]; u32x4 w;
                        w.x = cvt_pk_bf16(v0[0], v0[1]); w.y = cvt_pk_bf16(v0[2], v0[3]); w.z = cvt_pk_bf16(v1[0], v1[1]); w.w = cvt_pk_bf16(v1[2], v1[3]); *(u32x4*)(rowp + bj * HALF) = w; }
                }
        } else if (pn < 20) {
            const int colt = (pn - 12) * HALF + wc * 32 + 8 * fq;
#pragma unroll
            for (int ai = 0; ai < 2; ++ai)
#pragma unroll
                for (int m = 0; m < 4; ++m) {
                    bf16_t* rowp = u + (size_t)(rowt + ai * HALF + m * 16) * 1024 + colt;
                    const f32x4 a0 = acc[ai][0][m][0], a1 = acc[ai][0][m][1], g0 = acc[ai][1][m][0], g1 = acc[ai][1][m][1]; u32x4 w;
                    w.x = cvt_pk_bf16(a0[0] * fsigmoid(g0[0]), a0[1] * fsigmoid(g0[1])); w.y = cvt_pk_bf16(a0[2] * fsigmoid(g0[2]), a0[3] * fsigmoid(g0[3]));
                    w.z = cvt_pk_bf16(a1[0] * fsigmoid(g1[0]), a1[1] * fsigmoid(g1[1])); w.w = cvt_pk_bf16(a1[2] * fsigmoid(g1[2]), a1[3] * fsigmoid(g1[3]));
                    *(u32x4*)rowp = w;
                }
        } else {
            bf16_t* base = pn < 24 ? ga : gb; const int colt = (pn & 3) * 256 + wc * 32 + 8 * fq;
#pragma unroll
            for (int ai = 0; ai < 2; ++ai)
#pragma unroll
                for (int m = 0; m < 4; ++m) {
                    bf16_t* rowp = base + (size_t)(rowt + ai * HALF + m * 16) * 1024 + colt;
#pragma unroll
                    for (int bj = 0; bj < 2; ++bj) { const f32x4 v0 = acc[ai][bj][m][0], v1 = acc[ai][bj][m][1]; u32x4 w;
                        w.x = cvt_pk_bf16(fsigmoid(v0[0]), fsigmoid(v0[1])); w.y = cvt_pk_bf16(fsigmoid(v0[2]), fsigmoid(v0[3]));
                        w.z = cvt_pk_bf16(fsigmoid(v1[0]), fsigmoid(v1[1])); w.w = cvt_pk_bf16(fsigmoid(v1[2]), fsigmoid(v1[3])); *(u32x4*)(rowp + bj * HALF) = w; }
                }
        }
    }
};

struct EpiKVc {
    static constexpr bool PERM = true, AFTER_DRAIN = false;
    bf16_t *k, *v;
    __device__ __forceinline__ void operator()(const f32x4 (&acc)[2][2][4][2], const Unit& un, int wr, int wc, int fr, int fq) const {
        bf16_t* base = un.pn < 4 ? k : v; const int colt = (un.pn & 3) * 256 + wc * 32 + 8 * fq;
#pragma unroll
        for (int ai = 0; ai < 2; ++ai)
#pragma unroll
            for (int m = 0; m < 4; ++m) {
                bf16_t* rowp = base + ((size_t)un.pm * 8448 + wr * 64 + fr + ai * HALF + m * 16) * 1024 + colt;
#pragma unroll
                for (int bj = 0; bj < 2; ++bj) { const f32x4 v0 = acc[ai][bj][m][0], v1 = acc[ai][bj][m][1]; u32x4 w;
                    w.x = cvt_pk_bf16(v0[0], v0[1]); w.y = cvt_pk_bf16(v0[2], v0[3]); w.z = cvt_pk_bf16(v1[0], v1[1]); w.w = cvt_pk_bf16(v1[2], v1[3]); *(u32x4*)(rowp + bj * HALF) = w; }
            }
    }
};

template <bool ADD> struct EpiGate {
    static constexpr bool PERM = true, AFTER_DRAIN = false;
    bf16_t* Z; const bf16_t* G;
    __device__ __forceinline__ void operator()(const f32x4 (&acc)[2][2][4][2], const Unit& un, int wr, int wc, int fr, int fq) const {
        const int row0 = un.pm * BM + wr * 64 + fr, col0 = un.pn * BM + wc * 32 + 8 * fq;
#pragma unroll
        for (int ai = 0; ai < 2; ++ai)
#pragma unroll
            for (int m = 0; m < 4; ++m) {
                const size_t off = (size_t)(row0 + ai * HALF + m * 16) * 1024 + col0;
#pragma unroll
                for (int bj = 0; bj < 2; ++bj) {
                    const u32x4 g = *(const u32x4*)(G + off + bj * HALF);
                    const f32x4 v0 = acc[ai][bj][m][0], v1 = acc[ai][bj][m][1];
                    float o[8];
                    o[0] = v0[0] * bflo(g.x); o[1] = v0[1] * bfhi(g.x); o[2] = v0[2] * bflo(g.y); o[3] = v0[3] * bfhi(g.y);
                    o[4] = v1[0] * bflo(g.z); o[5] = v1[1] * bfhi(g.z); o[6] = v1[2] * bflo(g.w); o[7] = v1[3] * bfhi(g.w);
                    if (ADD) { const u32x4 z = *(const u32x4*)(Z + off + bj * HALF);
                        o[0] += bflo(z.x); o[1] += bfhi(z.x); o[2] += bflo(z.y); o[3] += bfhi(z.y); o[4] += bflo(z.z); o[5] += bfhi(z.z); o[6] += bflo(z.w); o[7] += bfhi(z.w); }
                    u32x4 w; w.x = cvt_pk_bf16(o[0], o[1]); w.y = cvt_pk_bf16(o[2], o[3]); w.z = cvt_pk_bf16(o[4], o[5]); w.w = cvt_pk_bf16(o[6], o[7]);
                    *(u32x4*)(Z + off + bj * HALF) = w;
                }
            }
    }
};
}

constexpr int NWAVES = 8, NTHR = 512;
constexpr int DM = 1024, NB = 4, SEQ = 8192, NLAT = NB * SEQ, NCTX = 256, NCTXR = NB * NCTX, NROWS = NLAT + NCTXR, NKEYS = SEQ + NCTX;
constexpr int DFF = 2816, INW = 7168, NMOD = 9;
constexpr float EPS = 1e-6f;
constexpr size_t MiB = 1u << 20;
constexpr size_t WS_MOD = 1 * MiB, WS_ROPE = 1 * MiB + 256 * 1024, WS_LAM = 1 * MiB + 512 * 1024;
constexpr size_t WS_W13A = 2 * MiB, WS_W2A = 13 * MiB, WS_W13B = WS_W2A + 11 * MiB / 2, WS_W2B = WS_W13B + 11 * MiB, WS_WIN = 35 * MiB, WS_WAP = 49 * MiB, WS_WCP = 51 * MiB, WS_WOUT = 53 * MiB;
constexpr size_t WS_H = 56 * MiB, WS_Y = 122 * MiB, WS_BIG = 188 * MiB;
constexpr size_t WS_ACT = WS_BIG, WS_Q = WS_BIG, WS_K = WS_BIG + 64 * MiB, WS_V = WS_K + 66 * MiB, WS_U = WS_V + 66 * MiB, WS_GB = WS_U + 64 * MiB, WS_END = WS_GB + 64 * MiB;
constexpr size_t WS_GA = WS_Y, WS_UC = WS_H, WS_OSCR = WS_U, WS_Z = WS_U;
static_assert(WS_END == 512 * MiB, "ws map");
static_assert(WS_W2B + 11 * MiB / 2 <= WS_WIN, "ws map weights");
constexpr int LDS_BYTES = 147456;

#define LAS __attribute__((address_space(3)))
typedef unsigned short bf16;
typedef unsigned v4u __attribute__((ext_vector_type(4)));
typedef unsigned v2u __attribute__((ext_vector_type(2)));
typedef float f32x4 __attribute__((ext_vector_type(4)));
#define LDS_WAIT() asm volatile("s_waitcnt lgkmcnt(0)" ::: "memory")
__device__ __forceinline__ unsigned f2bf(float f) { unsigned u = __builtin_bit_cast(unsigned, f); return (u + 0x7fffu + ((u >> 16) & 1u)) >> 16; }
__device__ __forceinline__ unsigned pk2(float lo, float hi) { return f2bf(lo) | (f2bf(hi) << 16); }
__device__ __forceinline__ float wave_sum(float v) {
#pragma unroll
    for (int o = 1; o < 64; o <<= 1) v += __shfl_xor(v, o);
    return v;
}

struct Args { const float* in[21]; float* out; unsigned char* ws; int pad0, pad1; };
enum { I_X = 0, I_C, I_CTX, I_CCTX, I_WADA, I_BADA, I_NORMG, I_F1W13, I_F1W2, I_F2W13, I_F2W2, I_WIN, I_LAMQK, I_SUBLN, I_WAP, I_CONVW, I_CONVB, I_CLNG, I_CLNB, I_WCP, I_WOUT };

template <int MODE> __device__ __forceinline__ int drow(int n0) {
    if (MODE == 1) { const int bj = n0 / DFF, j = n0 % DFF; return 256 * (j / 128) + 128 * bj + (j % 128); }
    if (MODE == 2) { if (n0 >= 3072 && n0 < 5120) { const int c = n0 - 3072, bj = c / 1024, j = c % 1024; return 3072 + 256 * (j / 128) + 128 * bj + (j % 128); } return n0; }
    return n0;
}
template <int MODE> __device__ __forceinline__ void transpose_item(const float* W, int K, int N, bf16* WT, LAS float* scr, int item, int lane) {
    const int nblk = N / 32, kb = item / nblk, nb = item % nblk, k0 = 64 * kb, n0 = 32 * nb, d0 = drow<MODE>(n0);
    float tv[32];
#pragma unroll
    for (int i = 0; i < 32; ++i) tv[i] = W[(size_t)(k0 + 2 * i + (lane >> 5)) * N + n0 + (lane & 31)];
#pragma unroll
    for (int i = 0; i < 32; ++i) scr[(2 * i + (lane >> 5)) * 33 + (lane & 31)] = tv[i];
    LDS_WAIT(); asm volatile("" ::: "memory");
    const int c = lane & 7;
#pragma unroll
    for (int j = 0; j < 4; ++j) { const int n = (lane >> 3) + 8 * j; const LAS float* s = scr + (8 * c) * 33 + n;
        v4u o; o.x = pk2(s[0 * 33], s[1 * 33]); o.y = pk2(s[2 * 33], s[3 * 33]); o.z = pk2(s[4 * 33], s[5 * 33]); o.w = pk2(s[6 * 33], s[7 * 33]);
        *(v4u*)(WT + (size_t)(d0 + n) * K + k0 + 8 * c) = o; }
    LDS_WAIT(); asm volatile("" ::: "memory");
}

template <bool HAS_Y, bool WRITE_X, bool WRITE_H>
__device__ __forceinline__ void norm_rows(int gw, int NGW, int lane, int row_lo, int nrows, const float* xlat, const float* xctx, const bf16* Y, float* xout, bf16* hout, const float* mod,
                                          float mult, const float* g_post, int k_gate, const float* g_pre, int k_in) {
    for (int row0 = row_lo + gw; row0 < nrows; row0 += 2 * NGW) {
        int rows[2]; rows[0] = row0; rows[1] = (row0 + NGW < nrows) ? row0 + NGW : row0;
        f32x4 v[2][4]; v2u yw[2][4]; const float* mp[2]; bool isctx[2];
#pragma unroll
        for (int r = 0; r < 2; ++r) {
            const int row = rows[r]; isctx[r] = row >= NLAT; const int mv = isctx[r] ? 4 : (row >> 13);
            const float* xr = isctx[r] ? xctx + (size_t)(row - NLAT) * DM : xlat + (size_t)row * DM;
            mp[r] = mod + (size_t)mv * (NMOD * DM);
#pragma unroll
            for (int j = 0; j < 4; ++j) v[r][j] = ((const f32x4*)xr)[lane + 64 * j];
            if (HAS_Y) {
#pragma unroll
                for (int j = 0; j < 4; ++j) yw[r][j] = ((const v2u*)(Y + (size_t)row * DM))[lane + 64 * j];
            }
        }
        if (HAS_Y) {
            f32x4 y[2][4]; float ss[2];
#pragma unroll
            for (int r = 0; r < 2; ++r) { ss[r] = 0.f;
#pragma unroll
                for (int j = 0; j < 4; ++j) { const v2u w = yw[r][j]; y[r][j] = (f32x4){pg8::bflo(w.x), pg8::bfhi(w.x), pg8::bflo(w.y), pg8::bfhi(w.y)};
                    ss[r] += (y[r][j].x * y[r][j].x + y[r][j].y * y[r][j].y) + (y[r][j].z * y[r][j].z + y[r][j].w * y[r][j].w); } }
#pragma unroll
            for (int o = 1; o < 64; o <<= 1) { ss[0] += __shfl_xor(ss[0], o); ss[1] += __shfl_xor(ss[1], o); }
#pragma unroll
            for (int r = 0; r < 2; ++r) { const float rstd = 1.0f / sqrtf(ss[r] * (1.f / DM) + EPS);
#pragma unroll
                for (int j = 0; j < 4; ++j) { const f32x4 gp = ((const f32x4*)g_post)[lane + 64 * j], gt = ((const f32x4*)(mp[r] + k_gate * DM))[lane + 64 * j];
                    v[r][j] = v[r][j] + (mult * gt) * ((y[r][j] * rstd) * gp); }
                if (WRITE_X && !isctx[r]) {
#pragma unroll
                    for (int j = 0; j < 4; ++j) ((f32x4*)(xout + (size_t)rows[r] * DM))[lane + 64 * j] = v[r][j];
                } }
        }
        if (WRITE_H) {
            float ss[2];
#pragma unroll
            for (int r = 0; r < 2; ++r) { ss[r] = 0.f;
#pragma unroll
                for (int j = 0; j < 4; ++j) ss[r] += (v[r][j].x * v[r][j].x + v[r][j].y * v[r][j].y) + (v[r][j].z * v[r][j].z + v[r][j].w * v[r][j].w); }
#pragma unroll
            for (int o = 1; o < 64; o <<= 1) { ss[0] += __shfl_xor(ss[0], o); ss[1] += __shfl_xor(ss[1], o); }
#pragma unroll
            for (int r = 0; r < 2; ++r) { const float rstd = 1.0f / sqrtf(ss[r] * (1.f / DM) + EPS);
#pragma unroll
                for (int j = 0; j < 4; ++j) { const f32x4 gp = ((const f32x4*)g_pre)[lane + 64 * j], sh = ((const f32x4*)(mp[r] + k_in * DM))[lane + 64 * j], sc = ((const f32x4*)(mp[r] + (k_in + 1) * DM))[lane + 64 * j];
                    const f32x4 h = ((v[r][j] * rstd) * gp) * (1.0f + sc) + sh;
                    v2u w; w.x = pk2(h.x, h.y); w.y = pk2(h.z, h.w); ((v2u*)(hout + (size_t)rows[r] * DM))[lane + 64 * j] = w; } }
        }
    }
}

#define RLX_AGENT __ATOMIC_RELAXED, __HIP_MEMORY_SCOPE_AGENT
#define XB_TMO      128
#define XB_XCNT(j)  (256  + 64 * (j))
#define XB_XSUB(j)  (1280 + 64 * (j))
#define XB_XGEN(j)  (2304 + 64 * (j))
#define XB_TOP      3328
#define XB_TOPGEN   3392
#define XCD_BAR_WORDS 3456
#define XB_SPIN_CAP (1u << 22)

__device__ __forceinline__ unsigned xb_ld(unsigned* p)              { return __hip_atomic_load(p, __ATOMIC_RELAXED, __HIP_MEMORY_SCOPE_AGENT); }
__device__ __forceinline__ unsigned xb_add(unsigned* p, unsigned v) { return __hip_atomic_fetch_add(p, v, __ATOMIC_RELAXED, __HIP_MEMORY_SCOPE_AGENT); }
__device__ __forceinline__ unsigned xb_xcc_id() { return (unsigned)__builtin_amdgcn_s_getreg((3 << 11) | 20) & 0xFu; }
#define XB_SPIN(cond, bar) do { unsigned _sp = 0; while (cond) { __builtin_amdgcn_s_sleep(1); \
    if ((++_sp & 255u) == 0u) { if (xb_ld(&(bar)[XB_TMO])) break; if (_sp > XB_SPIN_CAP) { atomicAdd(&(bar)[XB_TMO], 1u); break; } } } } while (0)

struct XcdBarrier {
    unsigned* bar; unsigned x;
    volatile LAS unsigned* st;
};

__device__ __forceinline__ XcdBarrier xcd_barrier_post(unsigned* bar, volatile LAS unsigned* st) {
    XcdBarrier b; b.bar = bar; b.x = xb_xcc_id(); b.st = st;
    if (threadIdx.x == 0) (void)xb_add(&bar[XB_XCNT(b.x)], 1u);
    return b;
}
__device__ __forceinline__ void xcd_barrier_complete(unsigned* bar, unsigned x, unsigned& nloc, unsigned& nx) {
    const unsigned G = gridDim.x * gridDim.y * gridDim.z;
    unsigned sum, cnt, mine, sp = 0u;
    for (;;) {
        sum = 0u; cnt = 0u; mine = 0u;
#pragma unroll
        for (unsigned j = 0; j < 16; ++j) { const unsigned c = xb_ld(&bar[XB_XCNT(j)]); sum += c; cnt += (c > 0u) ? 1u : 0u; mine = (j == x) ? c : mine; }
        if (sum == G) break;
        __builtin_amdgcn_s_sleep(1);
        if ((++sp & 255u) == 0u) { if (xb_ld(&bar[XB_TMO])) break; if (sp > XB_SPIN_CAP) { atomicAdd(&bar[XB_TMO], 1u); break; } }
    }
    nloc = mine > 0u ? mine : 1u; nx = cnt > 0u ? cnt : 1u;
}

__device__ __forceinline__ void xcd_barrier(const XcdBarrier& b) {
    asm volatile("s_waitcnt vmcnt(0)" ::: "memory");
    __syncthreads();
    if (threadIdx.x == 0) {
        unsigned* bar = b.bar;
        __builtin_amdgcn_s_waitcnt(0);
        unsigned nloc = b.st[0], nx = b.st[1];
        if (nloc == 0u) { xcd_barrier_complete(bar, b.x, nloc, nx); b.st[0] = nloc; b.st[1] = nx; }
        const unsigned old = xb_add(&bar[XB_XSUB(b.x)], 1u);
        const unsigned gen = old / nloc;
        if (old + 1u == (gen + 1u) * nloc) {
            __builtin_amdgcn_fence(__ATOMIC_RELEASE, "agent");
            asm volatile("s_waitcnt vmcnt(0)" ::: "memory");
            const unsigned og = xb_add(&bar[XB_TOP], 1u);
            const unsigned tg = og / nx;
            if (og + 1u == (tg + 1u) * nx) xb_add(&bar[XB_TOPGEN], 1u);
            else XB_SPIN(xb_ld(&bar[XB_TOPGEN]) == tg, bar);
            __builtin_amdgcn_fence(__ATOMIC_ACQUIRE, "agent");
            xb_add(&bar[XB_XGEN(b.x)], 1u);
            asm volatile("s_waitcnt vmcnt(0)" ::: "memory");
        } else {
            XB_SPIN(xb_ld(&bar[XB_XGEN(b.x)]) == gen, bar);
            __builtin_amdgcn_fence(__ATOMIC_ACQUIRE, "agent");
            asm volatile("s_waitcnt vmcnt(0)" ::: "memory");
        }
    }
    __syncthreads();
}

__global__ void __launch_bounds__(NTHR, 2) fwd_mega(Args args) {
    extern __shared__ __attribute__((aligned(16))) unsigned char lds[];
    cg::grid_group grid = cg::this_grid();
#define GSYNC_CG() do { asm volatile("s_waitcnt vmcnt(0) lgkmcnt(0)" ::: "memory"); grid.sync(); __builtin_amdgcn_fence(__ATOMIC_ACQUIRE, "agent"); asm volatile("s_waitcnt vmcnt(0)" ::: "memory"); } while (0)
#define GSYNC() xcd_barrier(xbar)
    LAS unsigned char* L = (LAS unsigned char*)lds;
    const int tid = threadIdx.x, lane = tid & 63, wave = __builtin_amdgcn_readfirstlane(tid >> 6);
    const int G = gridDim.x, bx = blockIdx.x, vcu = (G % 8 == 0) ? (bx % 8) * (G / 8) + bx / 8 : bx;
    const int gw = vcu * NWAVES + wave, NGW = G * NWAVES;
    unsigned char* ws = args.ws;
    volatile LAS unsigned* xst = (volatile LAS unsigned*)(L + LDS_BYTES - 64);
    static_assert(attn2::PARK_OFF + attn2::PARK_BYTES <= LDS_BYTES - 64, "LDS map");
    if (tid < 2) xst[tid] = 0u;
    __syncthreads();
    XcdBarrier xbar = xcd_barrier_post((unsigned*)ws, xst);
    float* mod = (float*)(ws + WS_MOD); float* rope = (float*)(ws + WS_ROPE); float* lamp = (float*)(ws + WS_LAM);
    bf16 *W13A = (bf16*)(ws + WS_W13A), *W2A = (bf16*)(ws + WS_W2A), *W13B = (bf16*)(ws + WS_W13B), *W2B = (bf16*)(ws + WS_W2B), *WIN = (bf16*)(ws + WS_WIN), *WAP = (bf16*)(ws + WS_WAP), *WCP = (bf16*)(ws + WS_WCP), *WOUT = (bf16*)(ws + WS_WOUT);
    bf16 *H = (bf16*)(ws + WS_H), *Y = (bf16*)(ws + WS_Y), *ACT = (bf16*)(ws + WS_ACT), *Qb = (bf16*)(ws + WS_Q), *Kb = (bf16*)(ws + WS_K), *Vb = (bf16*)(ws + WS_V), *Ub = (bf16*)(ws + WS_U), *GA = (bf16*)(ws + WS_GA), *GB = (bf16*)(ws + WS_GB);
    bf16 *UC = (bf16*)(ws + WS_UC), *OSCR = (bf16*)(ws + WS_OSCR), *Zb = (bf16*)(ws + WS_Z);
    const float* x = args.in[I_X]; const float* ctx = args.in[I_CTX]; const float* normg = args.in[I_NORMG]; float* out = args.out;

    {
        LAS float* sc = (LAS float*)L;
        LAS float* red = (LAS float*)(L + 20480);
        if (bx < 144) {
            for (int i = tid; i < 5 * DM; i += NTHR) { const float c = i < 4 * DM ? args.in[I_C][i] : args.in[I_CCTX][i - 4 * DM]; sc[i] = c / (1.0f + expf(-c)); }
            __syncthreads();
            for (int it = bx; it < 144; it += G) {
                const int col = it * 64 + lane; const float* wp = args.in[I_WADA] + (size_t)(wave * 128) * (NMOD * DM) + col;
                float a0 = 0.f, a1 = 0.f, a2 = 0.f, a3 = 0.f, a4 = 0.f;
#pragma unroll 32
                for (int kk = 0; kk < 128; ++kk) { const float w = wp[(size_t)kk * (NMOD * DM)]; const int k = wave * 128 + kk;
                    a0 += sc[k] * w; a1 += sc[DM + k] * w; a2 += sc[2 * DM + k] * w; a3 += sc[3 * DM + k] * w; a4 += sc[4 * DM + k] * w; }
                red[(wave * 5 + 0) * 64 + lane] = a0; red[(wave * 5 + 1) * 64 + lane] = a1; red[(wave * 5 + 2) * 64 + lane] = a2; red[(wave * 5 + 3) * 64 + lane] = a3; red[(wave * 5 + 4) * 64 + lane] = a4;
                __syncthreads();
                if (tid < 320) { const int v = tid >> 6, cl = tid & 63; float s = 0.f;
#pragma unroll
                    for (int w8 = 0; w8 < 8; ++w8) s += red[(w8 * 5 + v) * 64 + cl];
                    mod[(size_t)v * (NMOD * DM) + it * 64 + cl] = s + args.in[I_BADA][it * 64 + cl]; }
                __syncthreads();
            }
        }
        if (bx == G - 1) {
            for (int i = tid; i < 2048; i += NTHR) { const int pos = i >> 4, f = i & 15; double inv = 1.0; for (int j = 0; j < f; ++j) inv *= 0.56234132519034908; const double ang = (double)pos * inv; rope[i] = (float)cos(ang); rope[2048 + i] = (float)sin(ang); }
        }
        if (bx == G - 2 && tid < 64) {
            const float* lq = args.in[I_LAMQK];
            const float s01 = wave_sum(lq[tid] * lq[64 + tid]), s23 = wave_sum(lq[128 + tid] * lq[192 + tid]);
            if (tid == 0) lamp[0] = expf(s01) - expf(s23) + 0.2f;
        }
        __syncthreads();
        LAS float* scr = (LAS float*)(L + wave * 16384);
        constexpr int I_13 = (DM / 64) * (2 * DFF / 32), I_2 = (DFF / 64) * (DM / 32);
        for (int it = gw; it < I_13 + I_2; it += NGW) {
            if (it < I_13) transpose_item<1>(args.in[I_F1W13], DM, 2 * DFF, W13A, scr, it, lane);
            else transpose_item<0>(args.in[I_F1W2], DFF, DM, W2A, scr, it - I_13, lane);
        }
    }
    if (args.pad0 != 0) GSYNC_CG();
    GSYNC();
    norm_rows<false, false, true>(gw, NGW, lane, 0, NROWS, x, ctx, nullptr, nullptr, H, mod, 0.f, nullptr, 0, normg + 0 * DM, 0);
    GSYNC();
    { pg8::Gemm g{H, W13A, NROWS, 2 * DFF, DM}; pg8::StaticOrder S; S.init(NROWS, 2 * DFF, G, bx); pg8::EpiSwiglu E{ACT, DFF};
      pg8::gemm_phase<pg8::EpiSwiglu, pg8::StaticOrder, PG8_ALIGN, PG8_SP2>(L, g, S, E); }
    {
        constexpr int NU = (NROWS / 256) * (2 * DFF / 256), NFULL = NU / 256, NREM = NU - NFULL * 256;
        static_assert(NREM > 0 && NREM < 256, "partial round");
        if (G == 256 ? bx >= NREM : true) {
            const int nhelp = (G == 256) ? (256 - NREM) : G, hid = (G == 256) ? bx - NREM : bx;
            LAS float* scr = (LAS float*)(L + wave * 16384);
            constexpr int I_13 = (DM / 64) * (2 * DFF / 32), I_2 = (DFF / 64) * (DM / 32), I_IN = (DM / 64) * (INW / 32), I_SQ = (DM / 64) * (DM / 32);
            constexpr int NITEMS = I_13 + I_2 + I_IN + 3 * I_SQ;
            for (int it = hid * NWAVES + wave; it < NITEMS; it += nhelp * NWAVES) {
                int r = it;
                if (r < I_IN) { transpose_item<2>(args.in[I_WIN], DM, INW, WIN, scr, r, lane); continue; } r -= I_IN;
                if (r < I_SQ) { transpose_item<0>(args.in[I_WAP], DM, DM, WAP, scr, r, lane); continue; } r -= I_SQ;
                if (r < I_SQ) { transpose_item<0>(args.in[I_WCP], DM, DM, WCP, scr, r, lane); continue; } r -= I_SQ;
                if (r < I_SQ) { transpose_item<0>(args.in[I_WOUT], DM, DM, WOUT, scr, r, lane); continue; } r -= I_SQ;
                if (r < I_13) { transpose_item<1>(args.in[I_F2W13], DM, 2 * DFF, W13B, scr, r, lane); continue; } r -= I_13;
                transpose_item<0>(args.in[I_F2W2], DFF, DM, W2B, scr, r, lane);
            }
        }
    }
    GSYNC();
    { pg8::Gemm g{ACT, W2A, NLAT, DM, DFF}; pg8::StaticOrder S; S.init(NLAT, DM, G, bx); pg8::EpiBf16<0> E{Y, DM, nullptr, 0, 0, 1.f};
      pg8::gemm_phase<pg8::EpiBf16<0>, pg8::StaticOrder, PG8_ALIGN, PG8_SP2>(L, g, S, E); }
    GSYNC();
    if (G == 256) {
        if (bx < 16) { pg8::Gemm g{ACT + (size_t)NLAT * DFF, W2A, NCTXR, DM, DFF}; pg8::StaticOrder S; S.init(NCTXR, DM, G, bx); pg8::EpiBf16<0> E{Y + (size_t)NLAT * DM, DM, nullptr, 0, 0, 1.f};
            pg8::gemm_phase<pg8::EpiBf16<0>, pg8::StaticOrder, PG8_ALIGN, PG8_SP2>(L, g, S, E); }
        else norm_rows<true, true, true>((bx - 16) * NWAVES + wave, (G - 16) * NWAVES, lane, 0, NLAT, x, ctx, Y, out, H, mod, 0.5f, normg + 1 * DM, 2, normg + 2 * DM, 3);
    } else {
        { pg8::Gemm g{ACT + (size_t)NLAT * DFF, W2A, NCTXR, DM, DFF}; pg8::StaticOrder S; S.init(NCTXR, DM, G, bx); pg8::EpiBf16<0> E{Y + (size_t)NLAT * DM, DM, nullptr, 0, 0, 1.f};
          pg8::gemm_phase<pg8::EpiBf16<0>, pg8::StaticOrder, PG8_ALIGN, PG8_SP2>(L, g, S, E); }
        norm_rows<true, true, true>(gw, NGW, lane, 0, NLAT, x, ctx, Y, out, H, mod, 0.5f, normg + 1 * DM, 2, normg + 2 * DM, 3);
    }
    GSYNC();
    norm_rows<true, true, true>(gw, NGW, lane, NLAT, NROWS, x, ctx, Y, out, H, mod, 0.5f, normg + 1 * DM, 2, normg + 2 * DM, 3);
    GSYNC();
    { pg8::Gemm g{H, WIN, NLAT, INW, DM}; pg8::StaticOrder S; S.init(NLAT, INW, G, bx);
      pg8::EpiWin E{Qb, Kb, Vb, Ub, GA, GB, rope, attn2::QSCALE};

      pg8::gemm_phase<pg8::EpiWin, pg8::StaticOrder, PG8_ALIGN, PG8_SP2>(L, g, S, E);
    }
    { pg8::Gemm g{H + (size_t)NLAT * DM, WIN + (size_t)1024 * DM, NCTXR, 2048, DM}; pg8::StaticOrder S; S.init(NCTXR, 2048, G, bx); pg8::EpiKVc E{Kb, Vb};
      pg8::gemm_phase<pg8::EpiKVc, pg8::StaticOrder, PG8_ALIGN, PG8_SP2>(L, g, S, E); }
    GSYNC();
    {
        const int c0 = 2 * tid;
        float w0[31], w1[31];
#pragma unroll
        for (int k = 0; k < 31; ++k) { const float2 w = *(const float2*)(args.in[I_CONVW] + k * DM + c0); w0[k] = w.x; w1[k] = w.y; }
        const float2 cb = *(const float2*)(args.in[I_CONVB] + c0), lg = *(const float2*)(args.in[I_CLNG] + c0), lb = *(const float2*)(args.in[I_CLNB] + c0);
        LAS float* red = (LAS float*)L;
        LAS float* stat = (LAS float*)(L + 2048);
        for (int item = vcu; item < NLAT / 16; item += G) {
            const int tg = item * 16, b = tg >> 13, t0 = tg & 8191;
            float a0[16], a1[16];
#pragma unroll
            for (int o = 0; o < 16; ++o) { a0[o] = 0.f; a1[o] = 0.f; }
#pragma unroll
            for (int i = 0; i < 46; ++i) {
                const int t = t0 - 15 + i; const bool valid = (t >= 0) && (t < SEQ); const int tt = valid ? t : t0;
                const unsigned wv = *(const unsigned*)(Ub + ((size_t)(b * SEQ + tt)) * DM + c0);
                const float x0 = valid ? pg8::bflo(wv) : 0.f, x1 = valid ? pg8::bfhi(wv) : 0.f;
#pragma unroll
                for (int o = 0; o < 16; ++o) { if (i - o >= 0 && i - o <= 30) { a0[o] += w0[i - o] * x0; a1[o] += w1[i - o] * x1; } }
            }
#pragma unroll
            for (int o = 0; o < 16; ++o) { a0[o] += cb.x; a1[o] += cb.y; const float s = wave_sum(a0[o] + a1[o]), ss = wave_sum(a0[o] * a0[o] + a1[o] * a1[o]);
                if (lane == 0) { red[wave * 32 + 2 * o] = s; red[wave * 32 + 2 * o + 1] = ss; } }
            __syncthreads();
            if (tid < 32) { float s = 0.f;
#pragma unroll
                for (int w8 = 0; w8 < 8; ++w8) s += red[w8 * 32 + tid];
                stat[tid] = s; }
            __syncthreads();
#pragma unroll
            for (int o = 0; o < 16; ++o) { const float mean = stat[2 * o] * (1.f / DM), var = stat[2 * o + 1] * (1.f / DM) - mean * mean, rstd = 1.0f / sqrtf(fmaxf(var, 0.f) + EPS);
                const float y0 = (a0[o] - mean) * rstd * lg.x + lb.x, y1 = (a1[o] - mean) * rstd * lg.y + lb.y;
                *(unsigned*)(UC + ((size_t)(tg + o)) * DM + c0) = pk2(pg8::fsilu(y0), pg8::fsilu(y1)); }
        }
    }
    __syncthreads();
    {
        const float lam = lamp[0];
#pragma unroll 1
        for (int un = vcu; un < NB * 8 * (SEQ / 256); un += G) {
            const int qb = un & 31, bh = (un >> 8) * 8 + ((un & 255) >> 5), b = bh >> 3, h = bh & 7;
            const size_t qrow0 = (size_t)b * SEQ + (size_t)qb * 256;
            const bf16* kbase = Kb + (size_t)b * NKEYS * DM; const bf16* vbase = Vb + (size_t)b * NKEYS * DM + h * 128;
            attn2::body<0>(Qb + qrow0 * DM + (2 * h) * 64, kbase + (2 * h) * 64, vbase, NKEYS, (char*)lds, lam, args.in[I_SUBLN], nullptr);
            attn2::body<1>(Qb + qrow0 * DM + (2 * h + 1) * 64, kbase + (2 * h + 1) * 64, vbase, NKEYS, (char*)lds, lam, args.in[I_SUBLN], Qb + qrow0 * DM + h * 128);
        }
    }
    GSYNC();
    { pg8::Gemm g{Qb, WAP, NLAT, DM, DM}; pg8::StaticOrder S; S.init(NLAT, DM, G, bx); pg8::EpiGate<false> E{Zb, GA};
      pg8::gemm_phase<pg8::EpiGate<false>, pg8::StaticOrder, PG8_ALIGN, PG8_SP2>(L, g, S, E); }
    asm volatile("s_waitcnt vmcnt(0)" ::: "memory");
    { pg8::Gemm g{UC, WCP, NLAT, DM, DM}; pg8::StaticOrder S; S.init(NLAT, DM, G, bx); pg8::EpiGate<true> E{Zb, GB};
      pg8::gemm_phase<pg8::EpiGate<true>, pg8::StaticOrder, PG8_ALIGN, PG8_SP2>(L, g, S, E); }
    GSYNC();
    { pg8::Gemm g{Zb, WOUT, NLAT, DM, DM}; pg8::StaticOrder S; S.init(NLAT, DM, G, bx); pg8::EpiBf16<0> E{Y, DM, nullptr, 0, 0, 1.f};
      pg8::gemm_phase<pg8::EpiBf16<0>, pg8::StaticOrder, PG8_ALIGN, PG8_SP2>(L, g, S, E);
    }
    GSYNC();
    norm_rows<true, true, true>(gw, NGW, lane, 0, NLAT, out, ctx, Y, out, H, mod, 1.0f, normg + 3 * DM, 5, normg + 4 * DM, 6);
    GSYNC();
    { pg8::Gemm g{H, W13B, NLAT, 2 * DFF, DM}; pg8::StaticOrder S; S.init(NLAT, 2 * DFF, G, bx); pg8::EpiSwiglu E{ACT, DFF};
      pg8::gemm_phase<pg8::EpiSwiglu, pg8::StaticOrder, PG8_ALIGN, PG8_SP2>(L, g, S, E);
    }
    GSYNC();
    { pg8::Gemm g{ACT, W2B, NLAT, DM, DFF}; pg8::StaticOrder S; S.init(NLAT, DM, G, bx); pg8::EpiBf16<0> E{Y, DM, nullptr, 0, 0, 1.f};
      pg8::gemm_phase<pg8::EpiBf16<0>, pg8::StaticOrder, PG8_ALIGN, PG8_SP2>(L, g, S, E);
    }
    GSYNC();
    norm_rows<true, true, false>(gw, NGW, lane, 0, NLAT, out, ctx, Y, out, nullptr, mod, 0.5f, normg + 5 * DM, 8, nullptr, 0);
}

extern "C" void kernel_launch(void* const* d_in, const int* in_sizes, int n_in, void* d_out, int out_size, void* d_ws, size_t ws_size, hipStream_t stream) {
    static int grid = 0;
    if (grid == 0) {
        if (n_in != 21 || ws_size < WS_END || out_size != NLAT * DM) { fprintf(stderr, "kernel_launch: unexpected shapes (n_in %d, out %d, ws %zu)\n", n_in, out_size, ws_size); grid = -1; return; }
        int dev = 0, cus = 0, per_cu = 0;
        if (hipGetDevice(&dev) != hipSuccess || hipDeviceGetAttribute(&cus, hipDeviceAttributeMultiprocessorCount, dev) != hipSuccess) { grid = -1; return; }
        if (hipFuncSetAttribute((const void*)fwd_mega, hipFuncAttributeMaxDynamicSharedMemorySize, LDS_BYTES) != hipSuccess) { fprintf(stderr, "kernel_launch: hipFuncSetAttribute failed\n"); grid = -1; return; }
        if (hipOccupancyMaxActiveBlocksPerMultiprocessor(&per_cu, (const void*)fwd_mega, NTHR, LDS_BYTES) != hipSuccess || per_cu < 1) fprintf(stderr, "kernel_launch: occupancy query says %d\n", per_cu);
        (void)hipGetLastError();
        grid = cus;
    }
    if (grid < 0) return;
    if (hipMemsetAsync(d_ws, 0, 16384, stream) != hipSuccess) { fprintf(stderr, "kernel_launch: memset of the barrier words failed\n"); return; }
    Args a{};
    for (int i = 0; i < 21; ++i) a.in[i] = (const float*)d_in[i];
    a.out = (float*)d_out; a.ws = (unsigned char*)d_ws;
    void* kargs[] = {&a};
    const hipError_t e = hipLaunchCooperativeKernel((const void*)fwd_mega, dim3(grid), dim3(NTHR), kargs, LDS_BYTES, stream);
    if (e != hipSuccess) fprintf(stderr, "cooperative launch failed: %s (grid %d)\n", hipGetErrorString(e), grid);
}
```

```cpp
#include <hip/hip_runtime.h>
#include <hip/hip_cooperative_groups.h>
#include <cstdio>
#include <cstdint>
namespace cg = cooperative_groups;
namespace pg8 {
#define PG8_LAS __attribute__((address_space(3)))
typedef unsigned short bf16_t;
typedef short bf16x8 __attribute__((ext_vector_type(8)));
typedef float f32x4 __attribute__((ext_vector_type(4)));
typedef unsigned u32x4 __attribute__((ext_vector_type(4)));
constexpr int BM = 256, BK = 64, HALF = 128, HTB = HALF * BK * 2  , STAGE_BYTES = 8 * HTB, NXCD = 8, WGM = 8;

__host__ __device__ __forceinline__ int lds_byte(int r, int c) { const int st = (r >> 4) * 2 + (c >> 5), rr = r & 15, cc = c & 31, ob = rr * 64 + cc * 2; return st * 1024 + (ob ^ (((ob >> 9) & 1) << 5)); }
__host__ __device__ __forceinline__ void stage_rc(int b, int& R, int& C) { const int st = b / 1024, sb = b % 1024, swz = sb ^ (((sb >> 9) & 1) << 5); R = (st >> 1) * 16 + swz / 64; C = (st & 1) * 32 + (swz % 64) / 2; }
__host__ __device__ __forceinline__ int perm32(int rho) { const int n = rho >> 4, i = rho & 15; return 8 * (i >> 2) + 4 * n + (i & 3); }

struct Unit { int pm, pn; };
struct Gemm { const bf16_t* A; const bf16_t* Bt; int M, N, K; };

struct StaticOrder {
    int nM, nN, nwg, G, c;
    __host__ __device__ void init(int M, int N, int G_, int c_) { nM = M / BM; nN = N / BM; nwg = nM * nN; G = G_; c = c_; }
    __host__ __device__ bool next(int i, Unit& u) const {
        const long L = (long)i * G + c; if (L >= nwg) return false;
        int wgid = (int)L; { const int q = nwg / NXCD, r = nwg % NXCD, xcd = wgid % NXCD, off = wgid / NXCD; wgid = (xcd < r ? xcd * (q + 1) : r * (q + 1) + (xcd - r) * q) + off; }
        const int nig = WGM * nN, gid = wgid / nig, fm = gid * WGM, gsz = (nM - fm) < WGM ? (nM - fm) : WGM;
        u.pm = fm + ((wgid % nig) % gsz); u.pn = (wgid % nig) / gsz; return true;
    }
    __device__ __forceinline__ void a_ready(const Unit&) const {}
    __device__ __forceinline__ void done(const Unit&) const {}
};

typedef float f32x2c_t __attribute__((ext_vector_type(2))); typedef __bf16 bf16x2c_t __attribute__((ext_vector_type(2)));
__device__ __forceinline__ unsigned cvt_pk_bf16(float lo, float hi) { f32x2c_t v = {lo, hi}; bf16x2c_t b = __builtin_convertvector(v, bf16x2c_t); return __builtin_bit_cast(unsigned, b); }
typedef float f32x2 __attribute__((ext_vector_type(2)));
__device__ __forceinline__ f32x2 gelu_pk(f32x2 v) {
    const f32x2 av = __builtin_elementwise_abs(v), d = av * 0.2316418882f + 1.0f;
    f32x2 t; t.x = __builtin_amdgcn_rcpf(d.x); t.y = __builtin_amdgcn_rcpf(d.y);
    f32x2 q = t * 0.5307027145f + (-0.7265760135f); q = q * t + 0.7107068705f; q = q * t + (-0.142248368f); q = q * t + 0.127414796f; q = q * t;
    const f32x2 s = (v * v) * (-0.72134752044f);
    f32x2 e; e.x = __builtin_amdgcn_exp2f(s.x); e.y = __builtin_amdgcn_exp2f(s.y);
    const f32x2 m = v * (q * e), r = v - m;
    f32x2 o; o.x = v.x < 0.f ? m.x : r.x; o.y = v.y < 0.f ? m.y : r.y; return o;
}

template <int ACT  > struct EpiBf16 {
    static constexpr bool PERM = true, AFTER_DRAIN = false; static_assert(ACT == 0 || ACT == 1, "EpiBf16: ACT is 0 (none) or 1 (gelu_pk)");
    bf16_t* O; int ldc; const float* bias; int split_cols; size_t split_stride; float scale0;
    __device__ __forceinline__ void operator()(const f32x4 (&acc)[2][2][4][2], const Unit& u, int wr, int wc, int fr, int fq) const {
        const int row0 = u.pm * BM + wr * 64 + fr; int colt = u.pn * BM; bf16_t* base = O;
        float sc = 1.f; if (split_cols) { const int t = colt / split_cols; base += (size_t)t * split_stride; colt -= t * split_cols; if (t == 0) sc = scale0; }
        const int col0 = colt + wc * 32 + 8 * fq, bcol0 = u.pn * BM + wc * 32 + 8 * fq;
        f32x4 bv[2][2];
#pragma unroll
        for (int bj = 0; bj < 2; ++bj)
#pragma unroll
            for (int n = 0; n < 2; ++n) bv[bj][n] = bias ? *(const f32x4*)(bias + bcol0 + bj * HALF + 4 * n) : (f32x4){0.f, 0.f, 0.f, 0.f};
#pragma unroll
        for (int ai = 0; ai < 2; ++ai)
#pragma unroll
            for (int m = 0; m < 4; ++m) { bf16_t* rowp = base + (size_t)(row0 + ai * HALF + m * 16) * ldc + col0;
#pragma unroll
                for (int bj = 0; bj < 2; ++bj) { f32x4 v0 = acc[ai][bj][m][0] + bv[bj][0], v1 = acc[ai][bj][m][1] + bv[bj][1];
                    if (ACT == 1) { f32x2 a = gelu_pk((f32x2){v0[0], v0[1]}), b = gelu_pk((f32x2){v0[2], v0[3]}), c = gelu_pk((f32x2){v1[0], v1[1]}), d = gelu_pk((f32x2){v1[2], v1[3]});
                        v0 = (f32x4){a.x, a.y, b.x, b.y}; v1 = (f32x4){c.x, c.y, d.x, d.y}; }
                    v0 = v0 * sc; v1 = v1 * sc; u32x4 w; w.x = cvt_pk_bf16(v0[0], v0[1]); w.y = cvt_pk_bf16(v0[2], v0[3]); w.z = cvt_pk_bf16(v1[0], v1[1]); w.w = cvt_pk_bf16(v1[2], v1[3]);
                    *(u32x4*)(rowp + bj * HALF) = w; } }
    }
};
template <class Epi, class Sched, bool ALIGN_EPI = false, bool SP2 = false>
__device__ __forceinline__ void gemm_phase(PG8_LAS unsigned char* lds, const Gemm g, const Sched& S, const Epi& E) {
    int tid_ = threadIdx.x; asm volatile("" : "+v"(tid_));
    const int tid = tid_, wid = __builtin_amdgcn_readfirstlane(tid >> 6), lane = tid & 63, wr = wid >> 2, wc = wid & 3, fr = lane & 15, fq = lane >> 4;
    const int K = g.K, nt = K / BK;
    unsigned voffA[2], voffB[2];
#pragma unroll
    for (int i = 0; i < 2; ++i) { int R, C; stage_rc(tid * 16 + i * 8192, R, C); const int Rb = Epi::PERM ? ((R & ~31) + perm32(R & 31)) : R;
        voffA[i] = (unsigned)(R * K + C) * 2u; voffB[i] = (unsigned)(Rb * K + C) * 2u; }
    const size_t kstep = (size_t)(BK * 2);
    const size_t hstep = (size_t)HALF * K * 2;
    const size_t tstep = 2 * hstep;
    const unsigned ldsw = (unsigned)wid * 1024u;
    const int aoff = lds_byte(wr * 64 + fr, fq * 8), boff = lds_byte(wc * 32 + fr, fq * 8);
#define PG8_SA(b, h) (((b) * 2 + (h)) * HTB)
#define PG8_SB(b, h) ((4 + (b) * 2 + (h)) * HTB)
#define PG8_STAGE(bufoff, gbase, voff) do { _Pragma("unroll") for (int _i = 0; _i < 2; ++_i) \
        __builtin_amdgcn_global_load_lds((const unsigned*)((const char*)(gbase) + (voff)[_i]), (PG8_LAS unsigned*)(lds + (bufoff) + ldsw + _i * 8192), 16, 0, 0); } while (0)
#define PG8_LDA(dst, b, h) do { _Pragma("unroll") for (int m = 0; m < 4; ++m) _Pragma("unroll") for (int k = 0; k < 2; ++k) dst[m][k] = *(const PG8_LAS bf16x8*)(lds + PG8_SA(b, h) + aoff + m * 2048 + k * 1024); } while (0)
#define PG8_LDB(dst, b, h) do { _Pragma("unroll") for (int n = 0; n < 2; ++n) _Pragma("unroll") for (int k = 0; k < 2; ++k) dst[n][k] = *(const PG8_LAS bf16x8*)(lds + PG8_SB(b, h) + boff + n * 2048 + k * 1024); } while (0)
#define PG8_MMA(ai, bj, At, Bt) do { __builtin_amdgcn_s_setprio(1); _Pragma("unroll") for (int m = 0; m < 4; ++m) _Pragma("unroll") for (int n = 0; n < 2; ++n) _Pragma("unroll") for (int k = 0; k < 2; ++k) \
        acc[ai][bj][m][n] = __builtin_amdgcn_mfma_f32_16x16x32_bf16(Bt[n][k], At[m][k], acc[ai][bj][m][n], 0, 0, 0); __builtin_amdgcn_s_setprio(0); } while (0)
#define PG8_WAIT_V(n) asm volatile("s_waitcnt vmcnt(" #n ")" ::: "memory")
#define PG8_WAIT_L(n) asm volatile("s_waitcnt lgkmcnt(" #n ")" ::: "memory")
#define PG8_BAR __builtin_amdgcn_s_barrier()
#define PG8_SCHED __builtin_amdgcn_sched_barrier(0)
    Unit cur, nxt; int ui = 0;
    if (!S.next(0, cur)) return;
    f32x4 acc[2][2][4][2];
#pragma unroll
    for (int a = 0; a < 2; ++a)
#pragma unroll
        for (int b = 0; b < 2; ++b)
#pragma unroll
            for (int m = 0; m < 4; ++m)
#pragma unroll
                for (int n = 0; n < 2; ++n) acc[a][b][m][n] = (f32x4){0.f, 0.f, 0.f, 0.f};
    bf16x8 At[4][2], B0[2][2], B1[2][2];
    const char* cA = (const char*)g.A + (size_t)cur.pm * tstep; const char* cB = (const char*)g.Bt + (size_t)cur.pn * tstep;
    S.a_ready(cur);
    if constexpr (SP2) {
        PG8_STAGE(PG8_SB(0, 0), cB, voffB); PG8_STAGE(PG8_SB(0, 1), cB + hstep, voffB); PG8_STAGE(PG8_SA(0, 0), cA, voffA); PG8_STAGE(PG8_SA(0, 1), cA + hstep, voffA);
        if (wr == 1) PG8_BAR;
        PG8_WAIT_V(2); PG8_BAR;
        PG8_STAGE(PG8_SB(1, 0), cB + kstep, voffB); PG8_STAGE(PG8_SA(1, 0), cA + kstep, voffA); PG8_STAGE(PG8_SB(1, 1), cB + hstep + kstep, voffB);
        PG8_WAIT_V(6); PG8_BAR;
    } else {
        PG8_STAGE(PG8_SB(0, 0), cB, voffB); PG8_STAGE(PG8_SA(0, 0), cA, voffA); PG8_STAGE(PG8_SB(0, 1), cB + hstep, voffB); PG8_STAGE(PG8_SA(0, 1), cA + hstep, voffA);
        if (wr == 1) PG8_BAR;
        PG8_WAIT_V(4); PG8_BAR;
        PG8_STAGE(PG8_SB(1, 0), cB + kstep, voffB); PG8_STAGE(PG8_SA(1, 0), cA + kstep, voffA); PG8_STAGE(PG8_SB(1, 1), cB + hstep + kstep, voffB);
        PG8_WAIT_V(6); PG8_BAR;
    }
    for (;;) {
        const bool has_next = S.next(ui + 1, nxt);
        const char* nA = has_next ? (const char*)g.A + (size_t)nxt.pm * tstep : cA; const char* nB = has_next ? (const char*)g.Bt + (size_t)nxt.pn * tstep : cB;
        for (int t = 0; t < nt; t += 2) {
            const bool last = (t == nt - 2);
            const char* a1 = cA + (size_t)(t + 1) * kstep;
            const char* a2 = last ? nA : cA + (size_t)(t + 2) * kstep; const char* b2 = last ? nB : cB + (size_t)(t + 2) * kstep;
            const char* a3 = a2 + kstep; const char* b3 = b2 + kstep;
            if (last && has_next) S.a_ready(nxt);
            if constexpr (SP2) {
            PG8_LDB(B0, 0, 0); PG8_LDB(B1, 0, 1); PG8_SCHED; PG8_LDA(At, 0, 0); PG8_STAGE(PG8_SA(1, 1), a1 + hstep, voffA);
            PG8_WAIT_V(8); PG8_WAIT_L(0); PG8_BAR; PG8_MMA(0, 0, At, B0); PG8_MMA(0, 1, At, B1); PG8_BAR; PG8_SCHED;
            PG8_LDA(At, 0, 1); PG8_STAGE(PG8_SB(0, 0), b2, voffB); PG8_STAGE(PG8_SB(0, 1), b2 + hstep, voffB); PG8_STAGE(PG8_SA(0, 0), a2, voffA);
            PG8_WAIT_V(8); PG8_WAIT_L(0); PG8_BAR; PG8_MMA(1, 0, At, B0); PG8_MMA(1, 1, At, B1); PG8_BAR; PG8_SCHED;
            PG8_LDB(B0, 1, 0); PG8_LDB(B1, 1, 1); PG8_SCHED; PG8_LDA(At, 1, 0); PG8_STAGE(PG8_SA(0, 1), a2 + hstep, voffA);
            PG8_WAIT_V(8); PG8_WAIT_L(0); PG8_BAR; PG8_MMA(0, 0, At, B0); PG8_MMA(0, 1, At, B1); PG8_BAR; PG8_SCHED;
            PG8_LDA(At, 1, 1); PG8_STAGE(PG8_SB(1, 0), b3, voffB); PG8_STAGE(PG8_SB(1, 1), b3 + hstep, voffB); PG8_STAGE(PG8_SA(1, 0), a3, voffA);
            PG8_WAIT_V(8); PG8_WAIT_L(0); PG8_BAR; PG8_MMA(1, 0, At, B0); PG8_MMA(1, 1, At, B1); PG8_BAR; PG8_SCHED;
            } else {
            PG8_LDB(B0, 0, 0); PG8_SCHED; PG8_LDA(At, 0, 0); PG8_STAGE(PG8_SA(1, 1), a1 + hstep, voffA);
            PG8_WAIT_L(8); PG8_BAR; PG8_WAIT_L(0); PG8_MMA(0, 0, At, B0); PG8_BAR; PG8_SCHED;
            PG8_LDB(B1, 0, 1); PG8_STAGE(PG8_SB(0, 0), b2, voffB);
            PG8_BAR; PG8_WAIT_L(0); PG8_MMA(0, 1, At, B1); PG8_BAR;
            PG8_LDA(At, 0, 1); PG8_STAGE(PG8_SA(0, 0), a2, voffA);
            PG8_BAR; PG8_WAIT_L(0); PG8_MMA(1, 0, At, B0); PG8_BAR; PG8_SCHED;
            PG8_STAGE(PG8_SB(0, 1), b2 + hstep, voffB);
            PG8_WAIT_V(6); PG8_BAR; PG8_MMA(1, 1, At, B1); PG8_BAR;
            PG8_LDB(B0, 1, 0); PG8_SCHED; PG8_LDA(At, 1, 0); PG8_STAGE(PG8_SA(0, 1), a2 + hstep, voffA);
            PG8_WAIT_L(8); PG8_BAR; PG8_WAIT_L(0); PG8_MMA(0, 0, At, B0); PG8_BAR; PG8_SCHED;
            PG8_LDB(B1, 1, 1); PG8_STAGE(PG8_SB(1, 0), b3, voffB);
            PG8_BAR; PG8_WAIT_L(0); PG8_MMA(0, 1, At, B1); PG8_BAR;
            PG8_LDA(At, 1, 1); PG8_STAGE(PG8_SA(1, 0), a3, voffA);
            PG8_BAR; PG8_WAIT_L(0); PG8_MMA(1, 0, At, B0); PG8_BAR; PG8_SCHED;
            PG8_STAGE(PG8_SB(1, 1), b3 + hstep, voffB);
            PG8_WAIT_V(6); PG8_BAR; PG8_MMA(1, 1, At, B1); PG8_BAR;
            }
        }
        if constexpr (ALIGN_EPI) { if (wr == 0) PG8_BAR; }
        if constexpr (!Epi::AFTER_DRAIN) { E(acc, cur, wr, wc, fr, fq); S.done(cur); }
        if (!has_next) break;
#pragma unroll
        for (int a = 0; a < 2; ++a)
#pragma unroll
            for (int b = 0; b < 2; ++b)
#pragma unroll
                for (int m = 0; m < 4; ++m)
#pragma unroll
                    for (int n = 0; n < 2; ++n) acc[a][b][m][n] = (f32x4){0.f, 0.f, 0.f, 0.f};
        cur = nxt; cA = nA; cB = nB; ++ui;
        if constexpr (ALIGN_EPI) { if (wr == 1) PG8_BAR; }
    }
    PG8_WAIT_V(0);
    if constexpr (!ALIGN_EPI) { if (wr == 0) PG8_BAR; }
    PG8_BAR;
    if constexpr (Epi::AFTER_DRAIN) { E.fused(acc, cur, wr, wc, fr, fq, lds, wid, lane); S.done(cur); }
#undef PG8_SA
#undef PG8_SB
#undef PG8_STAGE
#undef PG8_LDA
#undef PG8_LDB
#undef PG8_MMA
#undef PG8_WAIT_V
#undef PG8_WAIT_L
#undef PG8_BAR
#undef PG8_SCHED
}
}

#ifndef PG8_SP2
#define PG8_SP2 true
#endif
#ifndef PG8_ALIGN
#define PG8_ALIGN true
#endif
#include <hip/hip_bf16.h>
#include <cmath>
namespace attn2 {
using bf16x8 = __attribute__((ext_vector_type(8))) short;
using s16x4  = __attribute__((ext_vector_type(4))) short;
using f32x16 = __attribute__((ext_vector_type(16))) float;
using u32x4  = __attribute__((ext_vector_type(4))) unsigned;
typedef unsigned short bf16r;
constexpr int DQ = 64, DV = 128, NW = 8, QBLK = 32, KVBLK = 64, LD = 1024;
constexpr float SCALE = 0.125f, THR = 8.f, QSCALE = SCALE * 1.4426950408889634f;
#ifndef A2_FORCE_REF
#define A2_FORCE_REF 0
#endif
constexpr size_t SHM_V = KVBLK * DV * 2, SHM_K = KVBLK * DQ * 2, SHM_ATTN = 3 * SHM_V + 3 * SHM_K + NW * 64 * 4;
constexpr size_t PARK_OFF = SHM_ATTN, PARK_BYTES = NW * 2048 * 4;
#define A2_KSWZ(row, colB) ((row) * 128 + ((colB) ^ ((((row) >> 1) & 7) << 4)))
#define A2_SBAR() __builtin_amdgcn_sched_barrier(0)
__device__ __forceinline__ int crow(int r, int hi) { return (r & 3) + 8 * (r >> 2) + 4 * hi; }
typedef float f32x2_t __attribute__((ext_vector_type(2))); typedef __bf16 bf16x2_t __attribute__((ext_vector_type(2)));
__device__ __forceinline__ unsigned cvtpk(float lo, float hi) { f32x2_t v = {lo, hi}; bf16x2_t b = __builtin_convertvector(v, bf16x2_t); return __builtin_bit_cast(unsigned, b); }

__device__ __forceinline__ void partialSM0(f32x16& p0, f32x16& p1, float& m_reg, bool& refz) {
  float pmax = p0[0];
#pragma unroll
  for (int r = 1; r < 16; ++r) pmax = fmaxf(pmax, p0[r]);
#pragma unroll
  for (int r = 0; r < 16; ++r) pmax = fmaxf(pmax, p1[r]);
  { auto rr = __builtin_amdgcn_permlane32_swap(__float_as_uint(pmax), __float_as_uint(pmax), false, false);
    pmax = fmaxf(__uint_as_float(rr[0]), __uint_as_float(rr[1])); }
  refz = (A2_FORCE_REF == 0) && __all(fabsf(pmax) < 64.f);
  m_reg = refz ? 0.f : pmax;
  if (!refz) {
#pragma unroll
    for (int r = 0; r < 16; ++r) { p0[r] -= m_reg; p1[r] -= m_reg; }
  }
#pragma unroll
  for (int r = 0; r < 16; ++r) p0[r] = __builtin_amdgcn_exp2f(p0[r]);
}
constexpr float LAZY_BIG = 1073741824.f;
__device__ __forceinline__ void finishSM(f32x16& p0, f32x16& p1, float& m_reg, bool& refz, float& alpha, float& l_reg, bf16x8& pa0, bf16x8& pa1, bf16x8& pa2, bf16x8& pa3) {
#pragma unroll
  for (int r = 0; r < 16; ++r) p1[r] = __builtin_amdgcn_exp2f(p1[r]);
  f32x2_t sv = {p0[0], p0[1]};
#pragma unroll
  for (int i = 1; i < 8; ++i) sv += (f32x2_t){p0[2 * i], p0[2 * i + 1]};
#pragma unroll
  for (int i = 0; i < 8; ++i) sv += (f32x2_t){p1[2 * i], p1[2 * i + 1]};
  float ps = sv.x + sv.y;
  alpha = 1.f;
  if (__builtin_expect(__any(!(ps <= LAZY_BIG)), 0)) {
    auto rr = __builtin_amdgcn_permlane32_swap(__float_as_uint(ps), __float_as_uint(ps), false, false);
    const float pt = __uint_as_float(rr[0]) + __uint_as_float(rr[1]);
    const float dl = (pt > LAZY_BIG) ? floorf(__log2f(pt)) + 1.f : 0.f;
    alpha = __builtin_amdgcn_exp2f(-dl); m_reg += dl; refz = false;
#pragma unroll
    for (int r = 0; r < 16; ++r) { p0[r] *= alpha; p1[r] *= alpha; }
    ps *= alpha;
  }
  l_reg = l_reg * alpha + ps; asm volatile("" : "+v"(l_reg));
#define A2_PK8(P, BASE, OUT) do { u32x4 w = {cvtpk(P[BASE + 0], P[BASE + 1]), cvtpk(P[BASE + 2], P[BASE + 3]), cvtpk(P[BASE + 4], P[BASE + 5]), cvtpk(P[BASE + 6], P[BASE + 7])}; OUT = *reinterpret_cast<bf16x8*>(&w); } while (0)
  A2_PK8(p0, 0, pa0); A2_PK8(p0, 8, pa1); A2_PK8(p1, 0, pa2); A2_PK8(p1, 8, pa3);
#undef A2_PK8
}
__device__ __forceinline__ void qkt(f32x16& p0, f32x16& p1, const char* Ks, const bf16x8* qr, int r32, int hi) {
  p0 = f32x16{}; p1 = f32x16{};
#pragma unroll
  for (int d0 = 0; d0 < 4; ++d0) { const int cb = (d0 * 16 + hi * 8) * 2;
    const bf16x8 b0 = *reinterpret_cast<const bf16x8*>(Ks + A2_KSWZ(r32, cb));
    const bf16x8 b1 = *reinterpret_cast<const bf16x8*>(Ks + A2_KSWZ(32 + r32, cb));
    p0 = __builtin_amdgcn_mfma_f32_32x32x16_bf16(b0, qr[d0], p0, 0, 0, 0);
    p1 = __builtin_amdgcn_mfma_f32_32x32x16_bf16(b1, qr[d0], p1, 0, 0, 0); }
}
__device__ __forceinline__ int v_st(int k, int c) { const int kk = k;     return ((kk >> 3) * 4 + (c >> 5)) * 512 + ((kk & 7) * 32 + (c & 31)) * 2; }
__device__ __forceinline__ int v_rd_base(int lane) { return ((lane & 3) << 3) | (((lane >> 2) & 3) << 6) | (((lane >> 4) & 1) << 5) | (((lane >> 5) & 1) << 8); }
constexpr int v_rd_off(int d0, int ks, int half) { return d0 * 512 + ks * 4096 + half * 2048; }
template <int OFF> __device__ __forceinline__ s16x4 tr_read(int vb) {
  s16x4 r; asm volatile("ds_read_b64_tr_b16 %0, %1 offset:%2" : "=&v"(r) : "v"(vb), "i"(OFF) : "memory"); return r;
}
template <int D0> __device__ __forceinline__ void pv_one(f32x16& od, int vb, bf16x8 pa0, bf16x8 pa1, bf16x8 pa2, bf16x8 pa3) {
  const s16x4 l0 = tr_read<v_rd_off(D0, 0, 0)>(vb), h0 = tr_read<v_rd_off(D0, 0, 1)>(vb), l1 = tr_read<v_rd_off(D0, 1, 0)>(vb), h1 = tr_read<v_rd_off(D0, 1, 1)>(vb);
  const s16x4 l2 = tr_read<v_rd_off(D0, 2, 0)>(vb), h2 = tr_read<v_rd_off(D0, 2, 1)>(vb), l3 = tr_read<v_rd_off(D0, 3, 0)>(vb), h3 = tr_read<v_rd_off(D0, 3, 1)>(vb);
  asm volatile("s_waitcnt lgkmcnt(0)" ::: "memory"); A2_SBAR();
#define A2_PK(L, H) (bf16x8){L[0], L[1], L[2], L[3], H[0], H[1], H[2], H[3]}
  od = __builtin_amdgcn_mfma_f32_32x32x16_bf16(pa0, A2_PK(l0, h0), od, 0, 0, 0);
  od = __builtin_amdgcn_mfma_f32_32x32x16_bf16(pa1, A2_PK(l1, h1), od, 0, 0, 0);
  od = __builtin_amdgcn_mfma_f32_32x32x16_bf16(pa2, A2_PK(l2, h2), od, 0, 0, 0);
  od = __builtin_amdgcn_mfma_f32_32x32x16_bf16(pa3, A2_PK(l3, h3), od, 0, 0, 0);
#undef A2_PK
}
__device__ __forceinline__ void pv_d0(f32x16* o, int vb, bf16x8 pa0, bf16x8 pa1, bf16x8 pa2, bf16x8 pa3) {
  pv_one<0>(o[0], vb, pa0, pa1, pa2, pa3); pv_one<1>(o[1], vb, pa0, pa1, pa2, pa3); pv_one<2>(o[2], vb, pa0, pa1, pa2, pa3); pv_one<3>(o[3], vb, pa0, pa1, pa2, pa3);
}

struct VF { s16x4 l0, h0, l1, h1, l2, h2, l3, h3; };
template <int D0> __device__ __forceinline__ VF vread(int vb) { VF f;
  f.l0 = tr_read<v_rd_off(D0, 0, 0)>(vb); f.h0 = tr_read<v_rd_off(D0, 0, 1)>(vb); f.l1 = tr_read<v_rd_off(D0, 1, 0)>(vb); f.h1 = tr_read<v_rd_off(D0, 1, 1)>(vb);
  f.l2 = tr_read<v_rd_off(D0, 2, 0)>(vb); f.h2 = tr_read<v_rd_off(D0, 2, 1)>(vb); f.l3 = tr_read<v_rd_off(D0, 3, 0)>(vb); f.h3 = tr_read<v_rd_off(D0, 3, 1)>(vb); return f; }
__device__ __forceinline__ void mfma4(f32x16& od, const VF& f, bf16x8 pa0, bf16x8 pa1, bf16x8 pa2, bf16x8 pa3) {
#define A2_PK(L, H) (bf16x8){L[0], L[1], L[2], L[3], H[0], H[1], H[2], H[3]}
  od = __builtin_amdgcn_mfma_f32_32x32x16_bf16(pa0, A2_PK(f.l0, f.h0), od, 0, 0, 0);
  od = __builtin_amdgcn_mfma_f32_32x32x16_bf16(pa1, A2_PK(f.l1, f.h1), od, 0, 0, 0);
  od = __builtin_amdgcn_mfma_f32_32x32x16_bf16(pa2, A2_PK(f.l2, f.h2), od, 0, 0, 0);
  od = __builtin_amdgcn_mfma_f32_32x32x16_bf16(pa3, A2_PK(f.l3, f.h3), od, 0, 0, 0);
#undef A2_PK
}
#define A2_LWAIT(n) do { asm volatile("s_waitcnt lgkmcnt(" #n ")" ::: "memory"); A2_SBAR(); } while (0)
__device__ __forceinline__ void pv_psm(f32x16* o, int vb, bf16x8 pa0, bf16x8 pa1, bf16x8 pa2, bf16x8 pa3, f32x16& p0, f32x16& p1, float m_reg, bool refz) {
  const VF f0 = vread<0>(vb);
  const VF f1 = vread<1>(vb);
  if (!refz) {
#pragma unroll
    for (int r = 0; r < 16; ++r) { p0[r] -= m_reg; p1[r] -= m_reg; }
  }
#pragma unroll
  for (int r = 0; r < 4; ++r) p0[r] = __builtin_amdgcn_exp2f(p0[r]);
  asm volatile("" : "+v"(p0));
  A2_LWAIT(8); mfma4(o[0], f0, pa0, pa1, pa2, pa3);
  const VF f2 = vread<2>(vb); A2_LWAIT(8); mfma4(o[1], f1, pa0, pa1, pa2, pa3);
#pragma unroll
  for (int r = 4; r < 8; ++r) p0[r] = __builtin_amdgcn_exp2f(p0[r]);
  asm volatile("" : "+v"(p0));
  const VF f3 = vread<3>(vb); A2_LWAIT(8); mfma4(o[2], f2, pa0, pa1, pa2, pa3);
#pragma unroll
  for (int r = 8; r < 12; ++r) p0[r] = __builtin_amdgcn_exp2f(p0[r]);
  asm volatile("" : "+v"(p0));
  A2_LWAIT(0); mfma4(o[3], f3, pa0, pa1, pa2, pa3);
#pragma unroll
  for (int r = 12; r < 16; ++r) p0[r] = __builtin_amdgcn_exp2f(p0[r]);
  asm volatile("" : "+v"(p0)); A2_SBAR();
}
template <int PASS>
__device__ __forceinline__ void body(const bf16r* Qb, const bf16r* Kh, const bf16r* Vh, int seq, char* lds, float lam, const float* subln, bf16r* Ob) {
  int tid_ = threadIdx.x; asm volatile("" : "+v"(tid_));
  const int tid = tid_, wid = tid >> 6, lane = tid & 63, r32 = lane & 31, hi = lane >> 5;
  char* V_lds = lds; char* K_lds = lds + 3 * SHM_V;
  float* ws = (float*)(lds + 3 * SHM_V + 3 * SHM_K) + wid * 64; float* li_l = ws; float* al_l = ws + 32;
  float m_reg = 0.f, l_reg = 0; f32x16 o[4] = {}; bf16x8 qr[4];
  const bf16r* Qw = Qb + (long)(wid * QBLK + r32) * LD + hi * 8;
#pragma unroll
  for (int d0 = 0; d0 < 4; ++d0) qr[d0] = *reinterpret_cast<const bf16x8*>(Qw + d0 * 16);
  const int sr = tid >> 4, sc = (tid & 15) * 8, vst0 = v_st(sr, sc), vst1 = v_st(32 + sr, sc);
  const int kr = tid >> 3, kc = (tid & 7) * 8, kst = A2_KSWZ(kr, kc * 2);
  const int vb0 = (int)(uintptr_t)V_lds + v_rd_base(lane);
  struct { bf16x8 vs0, vs1, ks0; } sr_[2];
#define A2_SLOAD(i, k0) do { sr_[i].vs0 = *reinterpret_cast<const bf16x8*>(&Vh[(long)((k0) + sr) * LD + sc]); sr_[i].vs1 = *reinterpret_cast<const bf16x8*>(&Vh[(long)((k0) + 32 + sr) * LD + sc]); \
    sr_[i].ks0 = *reinterpret_cast<const bf16x8*>(&Kh[(long)((k0) + kr) * LD + kc]); } while (0)
#define A2_SWRITE(b, i) do { *(bf16x8*)(V_lds + (b) * SHM_V + vst0) = sr_[i].vs0; *(bf16x8*)(V_lds + (b) * SHM_V + vst1) = sr_[i].vs1; *(bf16x8*)(K_lds + (b) * SHM_K + kst) = sr_[i].ks0; } while (0)
#define A2_SWAIT() asm volatile("s_waitcnt vmcnt(3)" ::: "memory")
#define A2_RESC(a) do { if (__any((a) < 1.f)) { if (hi == 0) al_l[r32] = (a); asm volatile("s_waitcnt lgkmcnt(0)" ::: "memory"); \
    _Pragma("unroll") for (int d = 0; d < 4; ++d) _Pragma("unroll") for (int r = 0; r < 16; ++r) o[d][r] *= al_l[crow(r, hi)]; } } while (0)
  if (wid >= 4) __builtin_amdgcn_s_setprio(1);
  f32x16 pA0, pA1, pB0, pB1; float al; bool refz; bf16x8 pa0, pa1, pa2, pa3; const int NT = seq / KVBLK;
  A2_SLOAD(0, 0); asm volatile("s_waitcnt vmcnt(0)" ::: "memory"); A2_SWRITE(0, 0);
  A2_SLOAD(1, KVBLK); A2_SLOAD(0, 2 * KVBLK);
  __syncthreads();
  qkt(pA0, pA1, K_lds, qr, r32, hi); partialSM0(pA0, pA1, m_reg, refz);
  A2_SWAIT(); A2_SWRITE(1, 1); A2_SLOAD(1, 3 * KVBLK);
  int bp = 0, bc = 1, bn = 2;
#define A2_STEP(PC0, PC1, PP0, PP1, j_, SL) do { \
    __syncthreads(); \
    if ((j_) + 1 < NT) { A2_SWAIT(); A2_SWRITE(bn, SL); } \
    A2_SBAR(); qkt(PC0, PC1, K_lds + bc * SHM_K, qr, r32, hi); \
    finishSM(PP0, PP1, m_reg, refz, al, l_reg, pa0, pa1, pa2, pa3); A2_RESC(al); A2_SBAR(); \
    if ((j_) + 3 < NT) A2_SLOAD(SL, ((j_) + 3) * KVBLK); A2_SBAR(); \
    pv_psm(o, vb0 + bp * (int)SHM_V, pa0, pa1, pa2, pa3, PC0, PC1, m_reg, refz); \
    { const int t_ = bp; bp = bc; bc = bn; bn = t_; } } while (0)
  for (int j = 1; j + 1 < NT; j += 2) {
    A2_STEP(pB0, pB1, pA0, pA1, j, 0);
    A2_STEP(pA0, pA1, pB0, pB1, j + 1, 1);
  }
  A2_STEP(pB0, pB1, pA0, pA1, NT - 1, 0);
#undef A2_STEP
  finishSM(pB0, pB1, m_reg, refz, al, l_reg, pa0, pa1, pa2, pa3); A2_RESC(al); A2_SBAR();
  pv_d0(o, vb0 + bp * (int)SHM_V, pa0, pa1, pa2, pa3);
  __builtin_amdgcn_s_setprio(0);
  { auto rr = __builtin_amdgcn_permlane32_swap(__float_as_uint(l_reg), __float_as_uint(l_reg), false, false); l_reg = __uint_as_float(rr[0]) + __uint_as_float(rr[1]); }
  if (hi == 0) li_l[r32] = l_reg; asm volatile("s_waitcnt lgkmcnt(0)" ::: "memory");
  float rli[16];
#pragma unroll
  for (int r = 0; r < 16; ++r) rli[r] = __builtin_amdgcn_rcpf(li_l[crow(r, hi)]);
  unsigned* sw = (unsigned*)(lds + PARK_OFF) + wid * 2048 + lane;
  if (PASS == 0) {
#pragma unroll
    for (int r = 0; r < 16; ++r)
#pragma unroll
      for (int dp = 0; dp < 2; ++dp) sw[(r * 2 + dp) * 64] = cvtpk(o[2 * dp][r] * rli[r], o[2 * dp + 1][r] * rli[r]);
  } else {
    float sg[4];
#pragma unroll
    for (int d0 = 0; d0 < 4; ++d0) sg[d0] = subln[d0 * 32 + r32];
    bf16r* Ow = Ob + (long)(wid * QBLK) * LD + r32;
#pragma unroll
    for (int r = 0; r < 16; ++r) {
      float d[4]; float ss = 0.f;
#pragma unroll
      for (int dp = 0; dp < 2; ++dp) { const unsigned w = sw[(r * 2 + dp) * 64];
        d[2 * dp] = __uint_as_float(w << 16) - lam * (o[2 * dp][r] * rli[r]); d[2 * dp + 1] = __uint_as_float(w & 0xffff0000u) - lam * (o[2 * dp + 1][r] * rli[r]); }
#pragma unroll
      for (int d0 = 0; d0 < 4; ++d0) ss += d[d0] * d[d0];
      ss += __shfl_xor(ss, 1); ss += __shfl_xor(ss, 2); ss += __shfl_xor(ss, 4); ss += __shfl_xor(ss, 8); ss += __shfl_xor(ss, 16);
      const float rstd = 0.8f / sqrtf(ss * (1.f / 128.f) + 1e-6f);
      const int orow = crow(r, hi);
#pragma unroll
      for (int d0 = 0; d0 < 4; ++d0) Ow[(long)orow * LD + d0 * 32] = (bf16r)(cvtpk(d[d0] * rstd * sg[d0], 0.f) & 0xffffu);
    }
  }
  __syncthreads();
#undef A2_SLOAD
#undef A2_SWRITE
#undef A2_SWAIT
#undef A2_RESC
}
#undef A2_KSWZ
#undef A2_LWAIT
#undef A2_SBAR
}
namespace pg8 {
typedef unsigned u32x2 __attribute__((ext_vector_type(2)));
__device__ __forceinline__ float fsigmoid(float x) { return __builtin_amdgcn_rcpf(1.0f + __builtin_amdgcn_exp2f(-1.4426950408889634f * x)); }
__device__ __forceinline__ float fsilu(float x) { return x * fsigmoid(x); }
__device__ __forceinline__ float bflo(unsigned w) { return __uint_as_float(w << 16); }
__device__ __forceinline__ float bfhi(unsigned w) { return __uint_as_float(w & 0xffff0000u); }

struct EpiSwiglu {
    static constexpr bool PERM = true, AFTER_DRAIN = false;
    bf16_t* O; int ldc;
    __device__ __forceinline__ void operator()(const f32x4 (&acc)[2][2][4][2], const Unit& u, int wr, int wc, int fr, int fq) const {
        const int row0 = u.pm * BM + wr * 64 + fr, col0 = u.pn * HALF + wc * 32 + 8 * fq;
#pragma unroll
        for (int ai = 0; ai < 2; ++ai)
#pragma unroll
            for (int m = 0; m < 4; ++m) {
                bf16_t* rowp = O + (size_t)(row0 + ai * HALF + m * 16) * ldc + col0;
                const f32x4 g0 = acc[ai][0][m][0], g1 = acc[ai][0][m][1], u0 = acc[ai][1][m][0], u1 = acc[ai][1][m][1];
                u32x4 w;
                w.x = cvt_pk_bf16(fsilu(g0[0]) * u0[0], fsilu(g0[1]) * u0[1]); w.y = cvt_pk_bf16(fsilu(g0[2]) * u0[2], fsilu(g0[3]) * u0[3]);
                w.z = cvt_pk_bf16(fsilu(g1[0]) * u1[0], fsilu(g1[1]) * u1[1]); w.w = cvt_pk_bf16(fsilu(g1[2]) * u1[2], fsilu(g1[3]) * u1[3]);
                *(u32x4*)rowp = w;
            }
    }
};

struct EpiWin {
    static constexpr bool PERM = true, AFTER_DRAIN = false;
    bf16_t *q, *k, *v, *u, *ga, *gb; const float* rope; float qscale;
    __device__ __forceinline__ void operator()(const f32x4 (&acc)[2][2][4][2], const Unit& un, int wr, int wc, int fr, int fq) const {
        const int pn = un.pn, rowt = un.pm * BM + wr * 64 + fr, bidx = un.pm >> 5;
        if (pn < 8) {
            const bool isq = pn < 4; const float sc = isq ? qscale : 1.f; bf16_t* base = isq ? q : k;
            const int colt = (pn & 3) * 256 + wc * 32 + 8 * fq, axis = wc & 1, f0 = 8 * (fq & 1);
            const float sgn = (fq < 2) ? -sc : sc;
#pragma unroll
            for (int ai = 0; ai < 2; ++ai)
#pragma unroll
                for (int m = 0; m < 4; ++m) {
                    const int r = rowt + ai * HALF + m * 16, t = r & 8191, pos = axis ? (t & 63) : (t >> 6);
                    const f32x4 cs0 = *(const f32x4*)(rope + pos * 16 + f0), cs1 = *(const f32x4*)(rope + pos * 16 + f0 + 4);
                    const f32x4 sn0 = *(const f32x4*)(rope + 2048 + pos * 16 + f0), sn1 = *(const f32x4*)(rope + 2048 + pos * 16 + f0 + 4);
                    const size_t orow = isq ? (size_t)r : (size_t)bidx * 8448 + 256 + t;
                    bf16_t* rowp = base + orow * 1024 + colt;
#pragma unroll
                    for (int bj = 0; bj < 2; ++bj) {
                        const f32x4 s0 = acc[ai][bj][m][0], s1 = acc[ai][bj][m][1]; f32x4 o0, o1;
#pragma unroll
                        for (int jj = 0; jj < 4; ++jj) { const float p0 = __shfl_xor(s0[jj], 32), p1 = __shfl_xor(s1[jj], 32);
                            o0[jj] = s0[jj] * (cs0[jj] * sc) + p0 * (sn0[jj] * sgn); o1[jj] = s1[jj] * (cs1[jj] * sc) + p1 * (sn1[jj] * sgn); }
                        u32x4 w; w.x = cvt_pk_bf16(o0[0], o0[1]); w.y = cvt_pk_bf16(o0[2], o0[3]); w.z = cvt_pk_bf16(o1[0], o1[1]); w.w = cvt_pk_bf16(o1[2], o1[3]);
                        *(u32x4*)(rowp + bj * HALF) = w;
                    }
                }
        } else if (pn < 12) {
            const int colt = (pn - 8) * 256 + wc * 32 + 8 * fq;
#pragma unroll
            for (int ai = 0; ai < 2; ++ai)
#pragma unroll
                for (int m = 0; m < 4; ++m) {
                    const int r = rowt + ai * HALF + m * 16, t = r & 8191;
                    bf16_t* rowp = v + ((size_t)bidx * 8448 + 256 + t) * 1024 + colt;
#pragma unroll
                    for (int bj = 0; bj < 2; ++bj) { const f32x4 v0 = acc[ai][bj][m][0], v1 = acc[ai][bj][m][1]; u32x4 w;
                        w.x = cvt_pk_bf16(v0[0], v0[1]); w.y = cvt_pk_bf16(v0[2], v0[3]); w.z = cvt_pk_bf16(v1[0], v1[1]); w.w = cvt_pk_bf16(v1[2], v1[3]); *(u32x4*)(rowp + bj * HALF) = w; }
                }
        } else if (pn < 20) {
            const int colt = (pn - 12) * HALF + wc * 32 + 8 * fq;
#pragma unroll
            for (int ai = 0; ai < 2; ++ai)
#pragma unroll
                for (int m = 0; m < 4; ++m) {
                    bf16_t* rowp = u + (size_t)(rowt + ai * HALF + m * 16) * 1024 + colt;
                    const f32x4 a0 = acc[ai][0][m][0], a1 = acc[ai][0][m][1], g0 = acc[ai][1][m][0], g1 = acc[ai][1][m][1]; u32x4 w;
                    w.x = cvt_pk_bf16(a0[0] * fsigmoid(g0[0]), a0[1] * fsigmoid(g0[1])); w.y = cvt_pk_bf16(a0[2] * fsigmoid(g0[2]), a0[3] * fsigmoid(g0[3]));
                    w.z = cvt_pk_bf16(a1[0] * fsigmoid(g1[0]), a1[1] * fsigmoid(g1[1])); w.w = cvt_pk_bf16(a1[2] * fsigmoid(g1[2]), a1[3] * fsigmoid(g1[3]));
                    *(u32x4*)rowp = w;
                }
        } else {
            bf16_t* base = pn < 24 ? ga : gb; const int colt = (pn & 3) * 256 + wc * 32 + 8 * fq;
#pragma unroll
            for (int ai = 0; ai < 2; ++ai)
#pragma unroll
                for (int m = 0; m < 4; ++m) {
                    bf16_t* rowp = base + (size_t)(rowt + ai * HALF + m * 16) * 1024 + colt;
#pragma unroll
                    for (int bj = 0; bj < 2; ++bj) { const f32x4 v0 = acc[ai][bj][m][0], v1 = acc[ai][bj][m][1]; u32x4 w;
                        w.x = cvt_pk_bf16(fsigmoid(v0[0]), fsigmoid(v0[1])); w.y = cvt_pk_bf16(fsigmoid(v0[2]), fsigmoid(v0[3]));
                        w.z = cvt_pk_bf16(fsigmoid(v1[0]), fsigmoid(v1[1])); w.w = cvt_pk_bf16(fsigmoid(v1[2]), fsigmoid(v1[3])); *(u32x4*)(rowp + bj * HALF) = w; }
                }
        }
    }
};

struct EpiKVc {
    static constexpr bool PERM = true, AFTER_DRAIN = false;
    bf16_t *k, *v;
    __device__ __forceinline__ void operator()(const f32x4 (&acc)[2][2][4][2], const Unit& un, int wr, int wc, int fr, int fq) const {
        bf16_t* base = un.pn < 4 ? k : v; const int colt = (un.pn & 3) * 256 + wc * 32 + 8 * fq;
#pragma unroll
        for (int ai = 0; ai < 2; ++ai)
#pragma unroll
            for (int m = 0; m < 4; ++m) {
                bf16_t* rowp = base + ((size_t)un.pm * 8448 + wr * 64 + fr + ai * HALF + m * 16) * 1024 + colt;
#pragma unroll
                for (int bj = 0; bj < 2; ++bj) { const f32x4 v0 = acc[ai][bj][m][0], v1 = acc[ai][bj][m][1]; u32x4 w;
                    w.x = cvt_pk_bf16(v0[0], v0[1]); w.y = cvt_pk_bf16(v0[2], v0[3]); w.z = cvt_pk_bf16(v1[0], v1[1]); w.w = cvt_pk_bf16(v1[2], v1[3]); *(u32x4*)(rowp + bj * HALF) = w; }
            }
    }
};

template <bool ADD> struct EpiGate {
    static constexpr bool PERM = true, AFTER_DRAIN = false;
    bf16_t* Z; const bf16_t* G;
    __device__ __forceinline__ void operator()(const f32x4 (&acc)[2][2][4][2], const Unit& un, int wr, int wc, int fr, int fq) const {
        const int row0 = un.pm * BM + wr * 64 + fr, col0 = un.pn * BM + wc * 32 + 8 * fq;
#pragma unroll
        for (int ai = 0; ai < 2; ++ai)
#pragma unroll
            for (int m = 0; m < 4; ++m) {
                const size_t off = (size_t)(row0 + ai * HALF + m * 16) * 1024 + col0;
#pragma unroll
                for (int bj = 0; bj < 2; ++bj) {
                    const u32x4 g = *(const u32x4*)(G + off + bj * HALF);
                    const f32x4 v0 = acc[ai][bj][m][0], v1 = acc[ai][bj][m][1];
                    float o[8];
                    o[0] = v0[0] * bflo(g.x); o[1] = v0[1] * bfhi(g.x); o[2] = v0[2] * bflo(g.y); o[3] = v0[3] * bfhi(g.y);
                    o[4] = v1[0] * bflo(g.z); o[5] = v1[1] * bfhi(g.z); o[6] = v1[2] * bflo(g.w); o[7] = v1[3] * bfhi(g.w);
                    if (ADD) { const u32x4 z = *(const u32x4*)(Z + off + bj * HALF);
                        o[0] += bflo(z.x); o[1] += bfhi(z.x); o[2] += bflo(z.y); o[3] += bfhi(z.y); o[4] += bflo(z.z); o[5] += bfhi(z.z); o[6] += bflo(z.w); o[7] += bfhi(z.w); }
                    u32x4 w; w.x = cvt_pk_bf16(o[0], o[1]); w.y = cvt_pk_bf16(o[2], o[3]); w.z = cvt_pk_bf16(o[4], o[5]); w.w = cvt_pk_bf16(o[6], o[7]);
                    *(u32x4*)(Z + off + bj * HALF) = w;
                }
            }
    }
};
}

constexpr int NWAVES = 8, NTHR = 512;
constexpr int DM = 1024, NB = 4, SEQ = 8192, NLAT = NB * SEQ, NCTX = 256, NCTXR = NB * NCTX, NROWS = NLAT + NCTXR, NKEYS = SEQ + NCTX;
constexpr int DFF = 2816, INW = 7168, NMOD = 9;
constexpr float EPS = 1e-6f;
constexpr size_t MiB = 1u << 20;
constexpr size_t WS_MOD = 1 * MiB, WS_ROPE = 1 * MiB + 256 * 1024, WS_LAM = 1 * MiB + 512 * 1024;
constexpr size_t WS_W13A = 2 * MiB, WS_W2A = 13 * MiB, WS_W13B = WS_W2A + 11 * MiB / 2, WS_W2B = WS_W13B + 11 * MiB, WS_WIN = 35 * MiB, WS_WAP = 49 * MiB, WS_WCP = 51 * MiB, WS_WOUT = 53 * MiB;
constexpr size_t WS_H = 56 * MiB, WS_Y = 122 * MiB, WS_BIG = 188 * MiB;
constexpr size_t WS_ACT = WS_BIG, WS_Q = WS_BIG, WS_K = WS_BIG + 64 * MiB, WS_V = WS_K + 66 * MiB, WS_U = WS_V + 66 * MiB, WS_GB = WS_U + 64 * MiB, WS_END = WS_GB + 64 * MiB;
constexpr size_t WS_GA = WS_Y, WS_UC = WS_H, WS_OSCR = WS_U, WS_Z = WS_U;
static_assert(WS_END == 512 * MiB, "ws map");
static_assert(WS_W2B + 11 * MiB / 2 <= WS_WIN, "ws map weights");
constexpr int LDS_BYTES = 147456;

#define LAS __attribute__((address_space(3)))
typedef unsigned short bf16;
typedef unsigned v4u __attribute__((ext_vector_type(4)));
typedef unsigned v2u __attribute__((ext_vector_type(2)));
typedef float f32x4 __attribute__((ext_vector_type(4)));
#define LDS_WAIT() asm volatile("s_waitcnt lgkmcnt(0)" ::: "memory")
__device__ __forceinline__ unsigned f2bf(float f) { unsigned u = __builtin_bit_cast(unsigned, f); return (u + 0x7fffu + ((u >> 16) & 1u)) >> 16; }
__device__ __forceinline__ unsigned pk2(float lo, float hi) { return f2bf(lo) | (f2bf(hi) << 16); }
__device__ __forceinline__ float wave_sum(float v) {
#pragma unroll
    for (int o = 1; o < 64; o <<= 1) v += __shfl_xor(v, o);
    return v;
}

struct Args { const float* in[21]; float* out; unsigned char* ws; int pad0, pad1; };
enum { I_X = 0, I_C, I_CTX, I_CCTX, I_WADA, I_BADA, I_NORMG, I_F1W13, I_F1W2, I_F2W13, I_F2W2, I_WIN, I_LAMQK, I_SUBLN, I_WAP, I_CONVW, I_CONVB, I_CLNG, I_CLNB, I_WCP, I_WOUT };

template <int MODE> __device__ __forceinline__ int drow(int n0) {
    if (MODE == 1) { const int bj = n0 / DFF, j = n0 % DFF; return 256 * (j / 128) + 128 * bj + (j % 128); }
    if (MODE == 2) { if (n0 >= 3072 && n0 < 5120) { const int c = n0 - 3072, bj = c / 1024, j = c % 1024; return 3072 + 256 * (j / 128) + 128 * bj + (j % 128); } return n0; }
    return n0;
}
template <int MODE> __device__ __forceinline__ void transpose_item(const float* W, int K, int N, bf16* WT, LAS float* scr, int item, int lane) {
    const int nblk = N / 32, kb = item / nblk, nb = item % nblk, k0 = 64 * kb, n0 = 32 * nb, d0 = drow<MODE>(n0);
    float tv[32];
#pragma unroll
    for (int i = 0; i < 32; ++i) tv[i] = W[(size_t)(k0 + 2 * i + (lane >> 5)) * N + n0 + (lane & 31)];
#pragma unroll
    for (int i = 0; i < 32; ++i) scr[(2 * i + (lane >> 5)) * 33 + (lane & 31)] = tv[i];
    LDS_WAIT(); asm volatile("" ::: "memory");
    const int c = lane & 7;
#pragma unroll
    for (int j = 0; j < 4; ++j) { const int n = (lane >> 3) + 8 * j; const LAS float* s = scr + (8 * c) * 33 + n;
        v4u o; o.x = pk2(s[0 * 33], s[1 * 33]); o.y = pk2(s[2 * 33], s[3 * 33]); o.z = pk2(s[4 * 33], s[5 * 33]); o.w = pk2(s[6 * 33], s[7 * 33]);
        *(v4u*)(WT + (size_t)(d0 + n) * K + k0 + 8 * c) = o; }
    LDS_WAIT(); asm volatile("" ::: "memory");
}

template <bool HAS_Y, bool WRITE_X, bool WRITE_H>
__device__ __forceinline__ void norm_rows(int gw, int NGW, int lane, int row_lo, int nrows, const float* xlat, const float* xctx, const bf16* Y, float* xout, bf16* hout, const float* mod,
                                          float mult, const float* g_post, int k_gate, const float* g_pre, int k_in) {
    for (int row0 = row_lo + gw; row0 < nrows; row0 += 2 * NGW) {
        int rows[2]; rows[0] = row0; rows[1] = (row0 + NGW < nrows) ? row0 + NGW : row0;
        f32x4 v[2][4]; v2u yw[2][4]; const float* mp[2]; bool isctx[2];
#pragma unroll
        for (int r = 0; r < 2; ++r) {
            const int row = rows[r]; isctx[r] = row >= NLAT; const int mv = isctx[r] ? 4 : (row >> 13);
            const float* xr = isctx[r] ? xctx + (size_t)(row - NLAT) * DM : xlat + (size_t)row * DM;
            mp[r] = mod + (size_t)mv * (NMOD * DM);
#pragma unroll
            for (int j = 0; j < 4; ++j) v[r][j] = ((const f32x4*)xr)[lane + 64 * j];
            if (HAS_Y) {
#pragma unroll
                for (int j = 0; j < 4; ++j) yw[r][j] = ((const v2u*)(Y + (size_t)row * DM))[lane + 64 * j];
            }
        }
        if (HAS_Y) {
            f32x4 y[2][4]; float ss[2];
#pragma unroll
            for (int r = 0; r < 2; ++r) { ss[r] = 0.f;
#pragma unroll
                for (int j = 0; j < 4; ++j) { const v2u w = yw[r][j]; y[r][j] = (f32x4){pg8::bflo(w.x), pg8::bfhi(w.x), pg8::bflo(w.y), pg8::bfhi(w.y)};
                    ss[r] += (y[r][j].x * y[r][j].x + y[r][j].y * y[r][j].y) + (y[r][j].z * y[r][j].z + y[r][j].w * y[r][j].w); } }
#pragma unroll
            for (int o = 1; o < 64; o <<= 1) { ss[0] += __shfl_xor(ss[0], o); ss[1] += __shfl_xor(ss[1], o); }
#pragma unroll
            for (int r = 0; r < 2; ++r) { const float rstd = 1.0f / sqrtf(ss[r] * (1.f / DM) + EPS);
#pragma unroll
                for (int j = 0; j < 4; ++j) { const f32x4 gp = ((const f32x4*)g_post)[lane + 64 * j], gt = ((const f32x4*)(mp[r] + k_gate * DM))[lane + 64 * j];
                    v[r][j] = v[r][j] + (mult * gt) * ((y[r][j] * rstd) * gp); }
                if (WRITE_X && !isctx[r]) {
#pragma unroll
                    for (int j = 0; j < 4; ++j) ((f32x4*)(xout + (size_t)rows[r] * DM))[lane + 64 * j] = v[r][j];
                } }
        }
        if (WRITE_H) {
            float ss[2];
#pragma unroll
            for (int r = 0; r < 2; ++r) { ss[r] = 0.f;
#pragma unroll
                for (int j = 0; j < 4; ++j) ss[r] += (v[r][j].x * v[r][j].x + v[r][j].y * v[r][j].y) + (v[r][j].z * v[r][j].z + v[r][j].w * v[r][j].w); }
#pragma unroll
            for (int o = 1; o < 64; o <<= 1) { ss[0] += __shfl_xor(ss[0], o); ss[1] += __shfl_xor(ss[1], o); }
#pragma unroll
            for (int r = 0; r < 2; ++r) { const float rstd = 1.0f / sqrtf(ss[r] * (1.f / DM) + EPS);
#pragma unroll
                for (int j = 0; j < 4; ++j) { const f32x4 gp = ((const f32x4*)g_pre)[lane + 64 * j], sh = ((const f32x4*)(mp[r] + k_in * DM))[lane + 64 * j], sc = ((const f32x4*)(mp[r] + (k_in + 1) * DM))[lane + 64 * j];
                    const f32x4 h = ((v[r][j] * rstd) * gp) * (1.0f + sc) + sh;
                    v2u w; w.x = pk2(h.x, h.y); w.y = pk2(h.z, h.w); ((v2u*)(hout + (size_t)rows[r] * DM))[lane + 64 * j] = w; } }
        }
    }
}

#define RLX_AGENT __ATOMIC_RELAXED, __HIP_MEMORY_SCOPE_AGENT
#define XB_TMO      128
#define XB_XCNT(j)  (256  + 64 * (j))
#define XB_XSUB(j)  (1280 + 64 * (j))
#define XB_XGEN(j)  (2304 + 64 * (j))
#define XB_TOP      3328
#define XB_TOPGEN   3392
#define XCD_BAR_WORDS 3456
#define XB_SPIN_CAP (1u << 22)

__device__ __forceinline__ unsigned xb_ld(unsigned* p)              { return __hip_atomic_load(p, __ATOMIC_RELAXED, __HIP_MEMORY_SCOPE_AGENT); }
__device__ __forceinline__ unsigned xb_add(unsigned* p, unsigned v) { return __hip_atomic_fetch_add(p, v, __ATOMIC_RELAXED, __HIP_MEMORY_SCOPE_AGENT); }
__device__ __forceinline__ unsigned xb_xcc_id() { return (unsigned)__builtin_amdgcn_s_getreg((3 << 11) | 20) & 0xFu; }
#define XB_SPIN(cond, bar) do { unsigned _sp = 0; while (cond) { __builtin_amdgcn_s_sleep(1); \
    if ((++_sp & 255u) == 0u) { if (xb_ld(&(bar)[XB_TMO])) break; if (_sp > XB_SPIN_CAP) { atomicAdd(&(bar)[XB_TMO], 1u); break; } } } } while (0)

struct XcdBarrier {
    unsigned* bar; unsigned x;
    volatile LAS unsigned* st;
};

__device__ __forceinline__ XcdBarrier xcd_barrier_post(unsigned* bar, volatile LAS unsigned* st) {
    XcdBarrier b; b.bar = bar; b.x = xb_xcc_id(); b.st = st;
    if (threadIdx.x == 0) (void)xb_add(&bar[XB_XCNT(b.x)], 1u);
    return b;
}
__device__ __forceinline__ void xcd_barrier_complete(unsigned* bar, unsigned x, unsigned& nloc, unsigned& nx) {
    const unsigned G = gridDim.x * gridDim.y * gridDim.z;
    unsigned sum, cnt, mine, sp = 0u;
    for (;;) {
        sum = 0u; cnt = 0u; mine = 0u;
#pragma unroll
        for (unsigned j = 0; j < 16; ++j) { const unsigned c = xb_ld(&bar[XB_XCNT(j)]); sum += c; cnt += (c > 0u) ? 1u : 0u; mine = (j == x) ? c : mine; }
        if (sum == G) break;
        __builtin_amdgcn_s_sleep(1);
        if ((++sp & 255u) == 0u) { if (xb_ld(&bar[XB_TMO])) break; if (sp > XB_SPIN_CAP) { atomicAdd(&bar[XB_TMO], 1u); break; } }
    }
    nloc = mine > 0u ? mine : 1u; nx = cnt > 0u ? cnt : 1u;
}

__device__ __forceinline__ void xcd_barrier(const XcdBarrier& b) {
    asm volatile("s_waitcnt vmcnt(0)" ::: "memory");
    __syncthreads();
    if (threadIdx.x == 0) {
        unsigned* bar = b.bar;
        __builtin_amdgcn_s_waitcnt(0);
        unsigned nloc = b.st[0], nx = b.st[1];
        if (nloc == 0u) { xcd_barrier_complete(bar, b.x, nloc, nx); b.st[0] = nloc; b.st[1] = nx; }
        const unsigned old = xb_add(&bar[XB_XSUB(b.x)], 1u);
        const unsigned gen = old / nloc;
        if (old + 1u == (gen + 1u) * nloc) {
            __builtin_amdgcn_fence(__ATOMIC_RELEASE, "agent");
            asm volatile("s_waitcnt vmcnt(0)" ::: "memory");
            const unsigned og = xb_add(&bar[XB_TOP], 1u);
            const unsigned tg = og / nx;
            if (og + 1u == (tg + 1u) * nx) xb_add(&bar[XB_TOPGEN], 1u);
            else XB_SPIN(xb_ld(&bar[XB_TOPGEN]) == tg, bar);
            __builtin_amdgcn_fence(__ATOMIC_ACQUIRE, "agent");
            xb_add(&bar[XB_XGEN(b.x)], 1u);
            asm volatile("s_waitcnt vmcnt(0)" ::: "memory");
        } else {
            XB_SPIN(xb_ld(&bar[XB_XGEN(b.x)]) == gen, bar);
            __builtin_amdgcn_fence(__ATOMIC_ACQUIRE, "agent");
            asm volatile("s_waitcnt vmcnt(0)" ::: "memory");
        }
    }
    __syncthreads();
}

__global__ void __launch_bounds__(NTHR, 2) fwd_mega(Args args) {
    extern __shared__ __attribute__((aligned(16))) unsigned char lds[];
    cg::grid_group grid = cg::this_grid();
#define GSYNC_CG() do { asm volatile("s_waitcnt vmcnt(0) lgkmcnt(0)" ::: "memory"); grid.sync(); __builtin_amdgcn_fence(__ATOMIC_ACQUIRE, "agent"); asm volatile("s_waitcnt vmcnt(0)" ::: "memory"); } while (0)
#define GSYNC() xcd_barrier(xbar)
    LAS unsigned char* L = (LAS unsigned char*)lds;
    const int tid = threadIdx.x, lane = tid & 63, wave = __builtin_amdgcn_readfirstlane(tid >> 6);
    const int G = gridDim.x, bx = blockIdx.x, vcu = (G % 8 == 0) ? (bx % 8) * (G / 8) + bx / 8 : bx;
    const int gw = vcu * NWAVES + wave, NGW = G * NWAVES;
    unsigned char* ws = args.ws;
    volatile LAS unsigned* xst = (volatile LAS unsigned*)(L + LDS_BYTES - 64);
    static_assert(attn2::PARK_OFF + attn2::PARK_BYTES <= LDS_BYTES - 64, "LDS map");
    if (tid < 2) xst[tid] = 0u;
    __syncthreads();
    XcdBarrier xbar = xcd_barrier_post((unsigned*)ws, xst);
    float* mod = (float*)(ws + WS_MOD); float* rope = (float*)(ws + WS_ROPE); float* lamp = (float*)(ws + WS_LAM);
    bf16 *W13A = (bf16*)(ws + WS_W13A), *W2A = (bf16*)(ws + WS_W2A), *W13B = (bf16*)(ws + WS_W13B), *W2B = (bf16*)(ws + WS_W2B), *WIN = (bf16*)(ws + WS_WIN), *WAP = (bf16*)(ws + WS_WAP), *WCP = (bf16*)(ws + WS_WCP), *WOUT = (bf16*)(ws + WS_WOUT);
    bf16 *H = (bf16*)(ws + WS_H), *Y = (bf16*)(ws + WS_Y), *ACT = (bf16*)(ws + WS_ACT), *Qb = (bf16*)(ws + WS_Q), *Kb = (bf16*)(ws + WS_K), *Vb = (bf16*)(ws + WS_V), *Ub = (bf16*)(ws + WS_U), *GA = (bf16*)(ws + WS_GA), *GB = (bf16*)(ws + WS_GB);
    bf16 *UC = (bf16*)(ws + WS_UC), *OSCR = (bf16*)(ws + WS_OSCR), *Zb = (bf16*)(ws + WS_Z);
    const float* x = args.in[I_X]; const float* ctx = args.in[I_CTX]; const float* normg = args.in[I_NORMG]; float* out = args.out;

    {
        LAS float* sc = (LAS float*)L;
        LAS float* red = (LAS float*)(L + 20480);
        if (bx < 144) {
            for (int i = tid; i < 5 * DM; i += NTHR) { const float c = i < 4 * DM ? args.in[I_C][i] : args.in[I_CCTX][i - 4 * DM]; sc[i] = c / (1.0f + expf(-c)); }
            __syncthreads();
            for (int it = bx; it < 144; it += G) {
                const int col = it * 64 + lane; const float* wp = args.in[I_WADA] + (size_t)(wave * 128) * (NMOD * DM) + col;
                float a0 = 0.f, a1 = 0.f, a2 = 0.f, a3 = 0.f, a4 = 0.f;
#pragma unroll 32
                for (int kk = 0; kk < 128; ++kk) { const float w = wp[(size_t)kk * (NMOD * DM)]; const int k = wave * 128 + kk;
                    a0 += sc[k] * w; a1 += sc[DM + k] * w; a2 += sc[2 * DM + k] * w; a3 += sc[3 * DM + k] * w; a4 += sc[4 * DM + k] * w; }
                red[(wave * 5 + 0) * 64 + lane] = a0; red[(wave * 5 + 1) * 64 + lane] = a1; red[(wave * 5 + 2) * 64 + lane] = a2; red[(wave * 5 + 3) * 64 + lane] = a3; red[(wave * 5 + 4) * 64 + lane] = a4;
                __syncthreads();
                if (tid < 320) { const int v = tid >> 6, cl = tid & 63; float s = 0.f;
#pragma unroll
                    for (int w8 = 0; w8 < 8; ++w8) s += red[(w8 * 5 + v) * 64 + cl];
                    mod[(size_t)v * (NMOD * DM) + it * 64 + cl] = s + args.in[I_BADA][it * 64 + cl]; }
                __syncthreads();
            }
        }
        if (bx == G - 1) {
            for (int i = tid; i < 2048; i += NTHR) { const int pos = i >> 4, f = i & 15; double inv = 1.0; for (int j = 0; j < f; ++j) inv *= 0.56234132519034908; const double ang = (double)pos * inv; rope[i] = (float)cos(ang); rope[2048 + i] = (float)sin(ang); }
        }
        if (bx == G - 2 && tid < 64) {
            const float* lq = args.in[I_LAMQK];
            const float s01 = wave_sum(lq[tid] * lq[64 + tid]), s23 = wave_sum(lq[128 + tid] * lq[192 + tid]);
            if (tid == 0) lamp[0] = expf(s01) - expf(s23) + 0.2f;
        }
        __syncthreads();
        LAS float* scr = (LAS float*)(L + wave * 16384);
        constexpr int I_13 = (DM / 64) * (2 * DFF / 32), I_2 = (DFF / 64) * (DM / 32);
        for (int it = gw; it < I_13 + I_2; it += NGW) {
            if (it < I_13) transpose_item<1>(args.in[I_F1W13], DM, 2 * DFF, W13A, scr, it, lane);
            else transpose_item<0>(args.in[I_F1W2], DFF, DM, W2A, scr, it - I_13, lane);
        }
    }
    if (args.pad0 != 0) GSYNC_CG();
    GSYNC();
    norm_rows<false, false, true>(gw, NGW, lane, 0, NROWS, x, ctx, nullptr, nullptr, H, mod, 0.f, nullptr, 0, normg + 0 * DM, 0);
    GSYNC();
    { pg8::Gemm g{H, W13A, NROWS, 2 * DFF, DM}; pg8::StaticOrder S; S.init(NROWS, 2 * DFF, G, bx); pg8::EpiSwiglu E{ACT, DFF};
      pg8::gemm_phase<pg8::EpiSwiglu, pg8::StaticOrder, PG8_ALIGN, PG8_SP2>(L, g, S, E); }
    {
        constexpr int NU = (NROWS / 256) * (2 * DFF / 256), NFULL = NU / 256, NREM = NU - NFULL * 256;
        static_assert(NREM > 0 && NREM < 256, "partial round");
        if (G == 256 ? bx >= NREM : true) {
            const int nhelp = (G == 256) ? (256 - NREM) : G, hid = (G == 256) ? bx - NREM : bx;
            LAS float* scr = (LAS float*)(L + wave * 16384);
            constexpr int I_13 = (DM / 64) * (2 * DFF / 32), I_2 = (DFF / 64) * (DM / 32), I_IN = (DM / 64) * (INW / 32), I_SQ = (DM / 64) * (DM / 32);
            constexpr int NITEMS = I_13 + I_2 + I_IN + 3 * I_SQ;
            for (int it = hid * NWAVES + wave; it < NITEMS; it += nhelp * NWAVES) {
                int r = it;
                if (r < I_IN) { transpose_item<2>(args.in[I_WIN], DM, INW, WIN, scr, r, lane); continue; } r -= I_IN;
                if (r < I_SQ) { transpose_item<0>(args.in[I_WAP], DM, DM, WAP, scr, r, lane); continue; } r -= I_SQ;
                if (r < I_SQ) { transpose_item<0>(args.in[I_WCP], DM, DM, WCP, scr, r, lane); continue; } r -= I_SQ;
                if (r < I_SQ) { transpose_item<0>(args.in[I_WOUT], DM, DM, WOUT, scr, r, lane); continue; } r -= I_SQ;
                if (r < I_13) { transpose_item<1>(args.in[I_F2W13], DM, 2 * DFF, W13B, scr, r, lane); continue; } r -= I_13;
                transpose_item<0>(args.in[I_F2W2], DFF, DM, W2B, scr, r, lane);
            }
        }
    }
    GSYNC();
    { pg8::Gemm g{ACT, W2A, NLAT, DM, DFF}; pg8::StaticOrder S; S.init(NLAT, DM, G, bx); pg8::EpiBf16<0> E{Y, DM, nullptr, 0, 0, 1.f};
      pg8::gemm_phase<pg8::EpiBf16<0>, pg8::StaticOrder, PG8_ALIGN, PG8_SP2>(L, g, S, E); }
    GSYNC();
    if (G == 256) {
        if (bx < 16) { pg8::Gemm g{ACT + (size_t)NLAT * DFF, W2A, NCTXR, DM, DFF}; pg8::StaticOrder S; S.init(NCTXR, DM, G, bx); pg8::EpiBf16<0> E{Y + (size_t)NLAT * DM, DM, nullptr, 0, 0, 1.f};
            pg8::gemm_phase<pg8::EpiBf16<0>, pg8::StaticOrder, PG8_ALIGN, PG8_SP2>(L, g, S, E); }
        else norm_rows<true, true, true>((bx - 16) * NWAVES + wave, (G - 16) * NWAVES, lane, 0, NLAT, x, ctx, Y, out, H, mod, 0.5f, normg + 1 * DM, 2, normg + 2 * DM, 3);
    } else {
        { pg8::Gemm g{ACT + (size_t)NLAT * DFF, W2A, NCTXR, DM, DFF}; pg8::StaticOrder S; S.init(NCTXR, DM, G, bx); pg8::EpiBf16<0> E{Y + (size_t)NLAT * DM, DM, nullptr, 0, 0, 1.f};
          pg8::gemm_phase<pg8::EpiBf16<0>, pg8::StaticOrder, PG8_ALIGN, PG8_SP2>(L, g, S, E); }
        norm_rows<true, true, true>(gw, NGW, lane, 0, NLAT, x, ctx, Y, out, H, mod, 0.5f, normg + 1 * DM, 2, normg + 2 * DM, 3);
    }
    GSYNC();
    norm_rows<true, true, true>(gw, NGW, lane, NLAT, NROWS, x, ctx, Y, out, H, mod, 0.5f, normg + 1 * DM, 2, normg + 2 * DM, 3);
    GSYNC();
    { pg8::Gemm g{H, WIN, NLAT, INW, DM}; pg8::StaticOrder S; S.init(NLAT, INW, G, bx);
      pg8::EpiWin E{Qb, Kb, Vb, Ub, GA, GB, rope, attn2::QSCALE};

      pg8::gemm_phase<pg8::EpiWin, pg8::StaticOrder, PG8_ALIGN, PG8_SP2>(L, g, S, E);
    }
    { pg8::Gemm g{H + (size_t)NLAT * DM, WIN + (size_t)1024 * DM, NCTXR, 2048, DM}; pg8::StaticOrder S; S.init(NCTXR, 2048, G, bx); pg8::EpiKVc E{Kb, Vb};
      pg8::gemm_phase<pg8::EpiKVc, pg8::StaticOrder, PG8_ALIGN, PG8_SP2>(L, g, S, E); }
    GSYNC();
    {
        const int c0 = 2 * tid;
        float w0[31], w1[31];
#pragma unroll
        for (int k = 0; k < 31; ++k) { const float2 w = *(const float2*)(args.in[I_CONVW] + k * DM + c0); w0[k] = w.x; w1[k] = w.y; }
        const float2 cb = *(const float2*)(args.in[I_CONVB] + c0), lg = *(const float2*)(args.in[I_CLNG] + c0), lb = *(const float2*)(args.in[I_CLNB] + c0);
        LAS float* red = (LAS float*)L;
        LAS float* stat = (LAS float*)(L + 2048);
        for (int item = vcu; item < NLAT / 16; item += G) {
            const int tg = item * 16, b = tg >> 13, t0 = tg & 8191;
            float a0[16], a1[16];
#pragma unroll
            for (int o = 0; o < 16; ++o) { a0[o] = 0.f; a1[o] = 0.f; }
#pragma unroll
            for (int i = 0; i < 46; ++i) {
                const int t = t0 - 15 + i; const bool valid = (t >= 0) && (t < SEQ); const int tt = valid ? t : t0;
                const unsigned wv = *(const unsigned*)(Ub + ((size_t)(b * SEQ + tt)) * DM + c0);
                const float x0 = valid ? pg8::bflo(wv) : 0.f, x1 = valid ? pg8::bfhi(wv) : 0.f;
#pragma unroll
                for (int o = 0; o < 16; ++o) { if (i - o >= 0 && i - o <= 30) { a0[o] += w0[i - o] * x0; a1[o] += w1[i - o] * x1; } }
            }
#pragma unroll
            for (int o = 0; o < 16; ++o) { a0[o] += cb.x; a1[o] += cb.y; const float s = wave_sum(a0[o] + a1[o]), ss = wave_sum(a0[o] * a0[o] + a1[o] * a1[o]);
                if (lane == 0) { red[wave * 32 + 2 * o] = s; red[wave * 32 + 2 * o + 1] = ss; } }
            __syncthreads();
            if (tid < 32) { float s = 0.f;
#pragma unroll
                for (int w8 = 0; w8 < 8; ++w8) s += red[w8 * 32 + tid];
                stat[tid] = s; }
            __syncthreads();
#pragma unroll
            for (int o = 0; o < 16; ++o) { const float mean = stat[2 * o] * (1.f / DM), var = stat[2 * o + 1] * (1.f / DM) - mean * mean, rstd = 1.0f / sqrtf(fmaxf(var, 0.f) + EPS);
                const float y0 = (a0[o] - mean) * rstd * lg.x + lb.x, y1 = (a1[o] - mean) * rstd * lg.y + lb.y;
                *(unsigned*)(UC + ((size_t)(tg + o)) * DM + c0) = pk2(pg8::fsilu(y0), pg8::fsilu(y1)); }
        }
    }
    __syncthreads();
    {
        const float lam = lamp[0];
#pragma unroll 1
        for (int un = vcu; un < NB * 8 * (SEQ / 256); un += G) {
            const int qb = un & 31, bh = (un >> 8) * 8 + ((un & 255) >> 5), b = bh >> 3, h = bh & 7;
            const size_t qrow0 = (size_t)b * SEQ + (size_t)qb * 256;
            const bf16* kbase = Kb + (size_t)b * NKEYS * DM; const bf16* vbase = Vb + (size_t)b * NKEYS * DM + h * 128;
            attn2::body<0>(Qb + qrow0 * DM + (2 * h) * 64, kbase + (2 * h) * 64, vbase, NKEYS, (char*)lds, lam, args.in[I_SUBLN], nullptr);
            attn2::body<1>(Qb + qrow0 * DM + (2 * h + 1) * 64, kbase + (2 * h + 1) * 64, vbase, NKEYS, (char*)lds, lam, args.in[I_SUBLN], Qb + qrow0 * DM + h * 128);
        }
    }
    GSYNC();
    { pg8::Gemm g{Qb, WAP, NLAT, DM, DM}; pg8::StaticOrder S; S.init(NLAT, DM, G, bx); pg8::EpiGate<false> E{Zb, GA};
      pg8::gemm_phase<pg8::EpiGate<false>, pg8::StaticOrder, PG8_ALIGN, PG8_SP2>(L, g, S, E); }
    asm volatile("s_waitcnt vmcnt(0)" ::: "memory");
    { pg8::Gemm g{UC, WCP, NLAT, DM, DM}; pg8::StaticOrder S; S.init(NLAT, DM, G, bx); pg8::EpiGate<true> E{Zb, GB};
      pg8::gemm_phase<pg8::EpiGate<true>, pg8::StaticOrder, PG8_ALIGN, PG8_SP2>(L, g, S, E); }
    GSYNC();
    { pg8::Gemm g{Zb, WOUT, NLAT, DM, DM}; pg8::StaticOrder S; S.init(NLAT, DM, G, bx); pg8::EpiBf16<0> E{Y, DM, nullptr, 0, 0, 1.f};
      pg8::gemm_phase<pg8::EpiBf16<0>, pg8::StaticOrder, PG8_ALIGN, PG8_SP2>(L, g, S, E);
    }
    GSYNC();
    norm_rows<true, true, true>(gw, NGW, lane, 0, NLAT, out, ctx, Y, out, H, mod, 1.0f, normg + 3 * DM, 5, normg + 4 * DM, 6);
    GSYNC();
    { pg8::Gemm g{H, W13B, NLAT, 2 * DFF, DM}; pg8::StaticOrder S; S.init(NLAT, 2 * DFF, G, bx); pg8::EpiSwiglu E{ACT, DFF};
      pg8::gemm_phase<pg8::EpiSwiglu, pg8::StaticOrder, PG8_ALIGN, PG8_SP2>(L, g, S, E);
    }
    GSYNC();
    { pg8::Gemm g{ACT, W2B, NLAT, DM, DFF}; pg8::StaticOrder S; S.init(NLAT, DM, G, bx); pg8::EpiBf16<0> E{Y, DM, nullptr, 0, 0, 1.f};
      pg8::gemm_phase<pg8::EpiBf16<0>, pg8::StaticOrder, PG8_ALIGN, PG8_SP2>(L, g, S, E);
    }
    GSYNC();
    norm_rows<true, true, false>(gw, NGW, lane, 0, NLAT, out, ctx, Y, out, nullptr, mod, 0.5f, normg + 5 * DM, 8, nullptr, 0);
}

extern "C" void kernel_launch(void* const* d_in, const int* in_sizes, int n_in, void* d_out, int out_size, void* d_ws, size_t ws_size, hipStream_t stream) {
    static int grid = 0;
    if (grid == 0) {
        if (n_in != 21 || ws_size < WS_END || out_size != NLAT * DM) { fprintf(stderr, "kernel_launch: unexpected shapes (n_in %d, out %d, ws %zu)\n", n_in, out_size, ws_size); grid = -1; return; }
        int dev = 0, cus = 0, per_cu = 0;
        if (hipGetDevice(&dev) != hipSuccess || hipDeviceGetAttribute(&cus, hipDeviceAttributeMultiprocessorCount, dev) != hipSuccess) { grid = -1; return; }
        if (hipFuncSetAttribute((const void*)fwd_mega, hipFuncAttributeMaxDynamicSharedMemorySize, LDS_BYTES) != hipSuccess) { fprintf(stderr, "kernel_launch: hipFuncSetAttribute failed\n"); grid = -1; return; }
        if (hipOccupancyMaxActiveBlocksPerMultiprocessor(&per_cu, (const void*)fwd_mega, NTHR, LDS_BYTES) != hipSuccess || per_cu < 1) fprintf(stderr, "kernel_launch: occupancy query says %d\n", per_cu);
        (void)hipGetLastError();
        grid = cus;
    }
    if (grid < 0) return;
    if (hipMemsetAsync(d_ws, 0, 16384, stream) != hipSuccess) { fprintf(stderr, "kernel_launch: memset of the barrier words failed\n"); return; }
    Args a{};
    for (int i = 0; i < 21; ++i) a.in[i] = (const float*)d_in[i];
    a.out = (float*)d_out; a.ws = (unsigned char*)d_ws;
    void* kargs[] = {&a};
    const hipError_t e = hipLaunchCooperativeKernel((const void*)fwd_mega, dim3(grid), dim3(NTHR), kargs, LDS_BYTES, stream);
    if (e != hipSuccess) fprintf(stderr, "cooperative launch failed: %s (grid %d)\n", hipGetErrorString(e), grid);
}
```

```cpp
#include <hip/hip_runtime.h>
#include <hip/hip_cooperative_groups.h>
#include <cstdio>
#include <cstdint>
namespace cg = cooperative_groups;
namespace pg8 {
#define PG8_LAS __attribute__((address_space(3)))
typedef unsigned short bf16_t;
typedef short bf16x8 __attribute__((ext_vector_type(8)));
typedef float f32x4 __attribute__((ext_vector_type(4)));
typedef unsigned u32x4 __attribute__((ext_vector_type(4)));
constexpr int BM = 256, BK = 64, HALF = 128, HTB = HALF * BK * 2  , STAGE_BYTES = 8 * HTB, NXCD = 8, WGM = 8;

__host__ __device__ __forceinline__ int lds_byte(int r, int c) { const int st = (r >> 4) * 2 + (c >> 5), rr = r & 15, cc = c & 31, ob = rr * 64 + cc * 2; return st * 1024 + (ob ^ (((ob >> 9) & 1) << 5)); }
__host__ __device__ __forceinline__ void stage_rc(int b, int& R, int& C) { const int st = b / 1024, sb = b % 1024, swz = sb ^ (((sb >> 9) & 1) << 5); R = (st >> 1) * 16 + swz / 64; C = (st & 1) * 32 + (swz % 64) / 2; }
__host__ __device__ __forceinline__ int perm32(int rho) { const int n = rho >> 4, i = rho & 15; return 8 * (i >> 2) + 4 * n + (i & 3); }

struct Unit { int pm, pn; };
struct Gemm { const bf16_t* A; const bf16_t* Bt; int M, N, K; };

struct StaticOrder {
    int nM, nN, nwg, G, c;
    __host__ __device__ void init(int M, int N, int G_, int c_) { nM = M / BM; nN = N / BM; nwg = nM * nN; G = G_; c = c_; }
    __host__ __device__ bool next(int i, Unit& u) const {
        const long L = (long)i * G + c; if (L >= nwg) return false;
        int wgid = (int)L; { const int q = nwg / NXCD, r = nwg % NXCD, xcd = wgid % NXCD, off = wgid / NXCD; wgid = (xcd < r ? xcd * (q + 1) : r * (q + 1) + (xcd - r) * q) + off; }
        const int nig = WGM * nN, gid = wgid / nig, fm = gid * WGM, gsz = (nM - fm) < WGM ? (nM - fm) : WGM;
        u.pm = fm + ((wgid % nig) % gsz); u.pn = (wgid % nig) / gsz; return true;
    }
    __device__ __forceinline__ void a_ready(const Unit&) const {}
    __device__ __forceinline__ void done(const Unit&) const {}
};

typedef float f32x2c_t __attribute__((ext_vector_type(2))); typedef __bf16 bf16x2c_t __attribute__((ext_vector_type(2)));
__device__ __forceinline__ unsigned cvt_pk_bf16(float lo, float hi) { f32x2c_t v = {lo, hi}; bf16x2c_t b = __builtin_convertvector(v, bf16x2c_t); return __builtin_bit_cast(unsigned, b); }
typedef float f32x2 __attribute__((ext_vector_type(2)));
__device__ __forceinline__ f32x2 gelu_pk(f32x2 v) {
    const f32x2 av = __builtin_elementwise_abs(v), d = av * 0.2316418882f + 1.0f;
    f32x2 t; t.x = __builtin_amdgcn_rcpf(d.x); t.y = __builtin_amdgcn_rcpf(d.y);
    f32x2 q = t * 0.5307027145f + (-0.7265760135f); q = q * t + 0.7107068705f; q = q * t + (-0.142248368f); q = q * t + 0.127414796f; q = q * t;
    const f32x2 s = (v * v) * (-0.72134752044f);
    f32x2 e; e.x = __builtin_amdgcn_exp2f(s.x); e.y = __builtin_amdgcn_exp2f(s.y);
    const f32x2 m = v * (q * e), r = v - m;
    f32x2 o; o.x = v.x < 0.f ? m.x : r.x; o.y = v.y < 0.f ? m.y : r.y; return o;
}

template <int ACT  > struct EpiBf16 {
    static constexpr bool PERM = true, AFTER_DRAIN = false; static_assert(ACT == 0 || ACT == 1, "EpiBf16: ACT is 0 (none) or 1 (gelu_pk)");
    bf16_t* O; int ldc; const float* bias; int split_cols; size_t split_stride; float scale0;
    __device__ __forceinline__ void operator()(const f32x4 (&acc)[2][2][4][2], const Unit& u, int wr, int wc, int fr, int fq) const {
        const int row0 = u.pm * BM + wr * 64 + fr; int colt = u.pn * BM; bf16_t* base = O;
        float sc = 1.f; if (split_cols) { const int t = colt / split_cols; base += (size_t)t * split_stride; colt -= t * split_cols; if (t == 0) sc = scale0; }
        const int col0 = colt + wc * 32 + 8 * fq, bcol0 = u.pn * BM + wc * 32 + 8 * fq;
        f32x4 bv[2][2];
#pragma unroll
        for (int bj = 0; bj < 2; ++bj)
#pragma unroll
            for (int n = 0; n < 2; ++n) bv[bj][n] = bias ? *(const f32x4*)(bias + bcol0 + bj * HALF + 4 * n) : (f32x4){0.f, 0.f, 0.f, 0.f};
#pragma unroll
        for (int ai = 0; ai < 2; ++ai)
#pragma unroll
            for (int m = 0; m < 4; ++m) { bf16_t* rowp = base + (size_t)(row0 + ai * HALF + m * 16) * ldc + col0;
#pragma unroll
                for (int bj = 0; bj < 2; ++bj) { f32x4 v0 = acc[ai][bj][m][0] + bv[bj][0], v1 = acc[ai][bj][m][1] + bv[bj][1];
                    if (ACT == 1) { f32x2 a = gelu_pk((f32x2){v0[0], v0[1]}), b = gelu_pk((f32x2){v0[2], v0[3]}), c = gelu_pk((f32x2){v1[0], v1[1]}), d = gelu_pk((f32x2){v1[2], v1[3]});
                        v0 = (f32x4){a.x, a.y, b.x, b.y}; v1 = (f32x4){c.x, c.y, d.x, d.y}; }
                    v0 = v0 * sc; v1 = v1 * sc; u32x4 w; w.x = cvt_pk_bf16(v0[0], v0[1]); w.y = cvt_pk_bf16(v0[2], v0[3]); w.z = cvt_pk_bf16(v1[0], v1[1]); w.w = cvt_pk_bf16(v1[2], v1[3]);
                    *(u32x4*)(rowp + bj * HALF) = w; } }
    }
};
template <class Epi, class Sched, bool ALIGN_EPI = false, bool SP2 = false>
__device__ __forceinline__ void gemm_phase(PG8_LAS unsigned char* lds, const Gemm g, const Sched& S, const Epi& E) {
    int tid_ = threadIdx.x; asm volatile("" : "+v"(tid_));
    const int tid = tid_, wid = __builtin_amdgcn_readfirstlane(tid >> 6), lane = tid & 63, wr = wid >> 2, wc = wid & 3, fr = lane & 15, fq = lane >> 4;
    const int K = g.K, nt = K / BK;
    unsigned voffA[2], voffB[2];
#pragma unroll
    for (int i = 0; i < 2; ++i) { int R, C; stage_rc(tid * 16 + i * 8192, R, C); const int Rb = Epi::PERM ? ((R & ~31) + perm32(R & 31)) : R;
        voffA[i] = (unsigned)(R * K + C) * 2u; voffB[i] = (unsigned)(Rb * K + C) * 2u; }
    const size_t kstep = (size_t)(BK * 2);
    const size_t hstep = (size_t)HALF * K * 2;
    const size_t tstep = 2 * hstep;
    const unsigned ldsw = (unsigned)wid * 1024u;
    const int aoff = lds_byte(wr * 64 + fr, fq * 8), boff = lds_byte(wc * 32 + fr, fq * 8);
#define PG8_SA(b, h) (((b) * 2 + (h)) * HTB)
#define PG8_SB(b, h) ((4 + (b) * 2 + (h)) * HTB)
#define PG8_STAGE(bufoff, gbase, voff) do { _Pragma("unroll") for (int _i = 0; _i < 2; ++_i) \
        __builtin_amdgcn_global_load_lds((const unsigned*)((const char*)(gbase) + (voff)[_i]), (PG8_LAS unsigned*)(lds + (bufoff) + ldsw + _i * 8192), 16, 0, 0); } while (0)
#define PG8_LDA(dst, b, h) do { _Pragma("unroll") for (int m = 0; m < 4; ++m) _Pragma("unroll") for (int k = 0; k < 2; ++k) dst[m][k] = *(const PG8_LAS bf16x8*)(lds + PG8_SA(b, h) + aoff + m * 2048 + k * 1024); } while (0)
#define PG8_LDB(dst, b, h) do { _Pragma("unroll") for (int n = 0; n < 2; ++n) _Pragma("unroll") for (int k = 0; k < 2; ++k) dst[n][k] = *(const PG8_LAS bf16x8*)(lds + PG8_SB(b, h) + boff + n * 2048 + k * 1024); } while (0)
#define PG8_MMA(ai, bj, At, Bt) do { __builtin_amdgcn_s_setprio(1); _Pragma("unroll") for (int m = 0; m < 4; ++m) _Pragma("unroll") for (int n = 0; n < 2; ++n) _Pragma("unroll") for (int k = 0; k < 2; ++k) \
        acc[ai][bj][m][n] = __builtin_amdgcn_mfma_f32_16x16x32_bf16(Bt[n][k], At[m][k], acc[ai][bj][m][n], 0, 0, 0); __builtin_amdgcn_s_setprio(0); } while (0)
#define PG8_WAIT_V(n) asm volatile("s_waitcnt vmcnt(" #n ")" ::: "memory")
#define PG8_WAIT_L(n) asm volatile("s_waitcnt lgkmcnt(" #n ")" ::: "memory")
#define PG8_BAR __builtin_amdgcn_s_barrier()
#define PG8_SCHED __builtin_amdgcn_sched_barrier(0)
    Unit cur, nxt; int ui = 0;
    if (!S.next(0, cur)) return;
    f32x4 acc[2][2][4][2];
#pragma unroll
    for (int a = 0; a < 2; ++a)
#pragma unroll
        for (int b = 0; b < 2; ++b)
#pragma unroll
            for (int m = 0; m < 4; ++m)
#pragma unroll
                for (int n = 0; n < 2; ++n) acc[a][b][m][n] = (f32x4){0.f, 0.f, 0.f, 0.f};
    bf16x8 At[4][2], B0[2][2], B1[2][2];
    const char* cA = (const char*)g.A + (size_t)cur.pm * tstep; const char* cB = (const char*)g.Bt + (size_t)cur.pn * tstep;
    S.a_ready(cur);
    if constexpr (SP2) {
        PG8_STAGE(PG8_SB(0, 0), cB, voffB); PG8_STAGE(PG8_SB(0, 1), cB + hstep, voffB); PG8_STAGE(PG8_SA(0, 0), cA, voffA); PG8_STAGE(PG8_SA(0, 1), cA + hstep, voffA);
        if (wr == 1) PG8_BAR;
        PG8_WAIT_V(2); PG8_BAR;
        PG8_STAGE(PG8_SB(1, 0), cB + kstep, voffB); PG8_STAGE(PG8_SA(1, 0), cA + kstep, voffA); PG8_STAGE(PG8_SB(1, 1), cB + hstep + kstep, voffB);
        PG8_WAIT_V(6); PG8_BAR;
    } else {
        PG8_STAGE(PG8_SB(0, 0), cB, voffB); PG8_STAGE(PG8_SA(0, 0), cA, voffA); PG8_STAGE(PG8_SB(0, 1), cB + hstep, voffB); PG8_STAGE(PG8_SA(0, 1), cA + hstep, voffA);
        if (wr == 1) PG8_BAR;
        PG8_WAIT_V(4); PG8_BAR;
        PG8_STAGE(PG8_SB(1, 0), cB + kstep, voffB); PG8_STAGE(PG8_SA(1, 0), cA + kstep, voffA); PG8_STAGE(PG8_SB(1, 1), cB + hstep + kstep, voffB);
        PG8_WAIT_V(6); PG8_BAR;
    }
    for (;;) {
        const bool has_next = S.next(ui + 1, nxt);
        const char* nA = has_next ? (const char*)g.A + (size_t)nxt.pm * tstep : cA; const char* nB = has_next ? (const char*)g.Bt + (size_t)nxt.pn * tstep : cB;
        for (int t = 0; t < nt; t += 2) {
            const bool last = (t == nt - 2);
            const char* a1 = cA + (size_t)(t + 1) * kstep;
            const char* a2 = last ? nA : cA + (size_t)(t + 2) * kstep; const char* b2 = last ? nB : cB + (size_t)(t + 2) * kstep;
            const char* a3 = a2 + kstep; const char* b3 = b2 + kstep;
            if (last && has_next) S.a_ready(nxt);
            if constexpr (SP2) {
            PG8_LDB(B0, 0, 0); PG8_LDB(B1, 0, 1); PG8_SCHED; PG8_LDA(At, 0, 0); PG8_STAGE(PG8_SA(1, 1), a1 + hstep, voffA);
            PG8_WAIT_V(8); PG8_WAIT_L(0); PG8_BAR; PG8_MMA(0, 0, At, B0); PG8_MMA(0, 1, At, B1); PG8_BAR; PG8_SCHED;
            PG8_LDA(At, 0, 1); PG8_STAGE(PG8_SB(0, 0), b2, voffB); PG8_STAGE(PG8_SB(0, 1), b2 + hstep, voffB); PG8_STAGE(PG8_SA(0, 0), a2, voffA);
            PG8_WAIT_V(8); PG8_WAIT_L(0); PG8_BAR; PG8_MMA(1, 0, At, B0); PG8_MMA(1, 1, At, B1); PG8_BAR; PG8_SCHED;
            PG8_LDB(B0, 1, 0); PG8_LDB(B1, 1, 1); PG8_SCHED; PG8_LDA(At, 1, 0); PG8_STAGE(PG8_SA(0, 1), a2 + hstep, voffA);
            PG8_WAIT_V(8); PG8_WAIT_L(0); PG8_BAR; PG8_MMA(0, 0, At, B0); PG8_MMA(0, 1, At, B1); PG8_BAR; PG8_SCHED;
            PG8_LDA(At, 1, 1); PG8_STAGE(PG8_SB(1, 0), b3, voffB); PG8_STAGE(PG8_SB(1, 1), b3 + hstep, voffB); PG8_STAGE(PG8_SA(1, 0), a3, voffA);
            PG8_WAIT_V(8); PG8_WAIT_L(0); PG8_BAR; PG8_MMA(1, 0, At, B0); PG8_MMA(1, 1, At, B1); PG8_BAR; PG8_SCHED;
            } else {
            PG8_LDB(B0, 0, 0); PG8_SCHED; PG8_LDA(At, 0, 0); PG8_STAGE(PG8_SA(1, 1), a1 + hstep, voffA);
            PG8_WAIT_L(8); PG8_BAR; PG8_WAIT_L(0); PG8_MMA(0, 0, At, B0); PG8_BAR; PG8_SCHED;
            PG8_LDB(B1, 0, 1); PG8_STAGE(PG8_SB(0, 0), b2, voffB);
            PG8_BAR; PG8_WAIT_L(0); PG8_MMA(0, 1, At, B1); PG8_BAR;
            PG8_LDA(At, 0, 1); PG8_STAGE(PG8_SA(0, 0), a2, voffA);
            PG8_BAR; PG8_WAIT_L(0); PG8_MMA(1, 0, At, B0); PG8_BAR; PG8_SCHED;
            PG8_STAGE(PG8_SB(0, 1), b2 + hstep, voffB);
            PG8_WAIT_V(6); PG8_BAR; PG8_MMA(1, 1, At, B1); PG8_BAR;
            PG8_LDB(B0, 1, 0); PG8_SCHED; PG8_LDA(At, 1, 0); PG8_STAGE(PG8_SA(0, 1), a2 + hstep, voffA);
            PG8_WAIT_L(8); PG8_BAR; PG8_WAIT_L(0); PG8_MMA(0, 0, At, B0); PG8_BAR; PG8_SCHED;
            PG8_LDB(B1, 1, 1); PG8_STAGE(PG8_SB(1, 0), b3, voffB);
            PG8_BAR; PG8_WAIT_L(0); PG8_MMA(0, 1, At, B1); PG8_BAR;
            PG8_LDA(At, 1, 1); PG8_STAGE(PG8_SA(1, 0), a3, voffA);
            PG8_BAR; PG8_WAIT_L(0); PG8_MMA(1, 0, At, B0); PG8_BAR; PG8_SCHED;
            PG8_STAGE(PG8_SB(1, 1), b3 + hstep, voffB);
            PG8_WAIT_V(6); PG8_BAR; PG8_MMA(1, 1, At, B1); PG8_BAR;
            }
        }
        if constexpr (ALIGN_EPI) { if (wr == 0) PG8_BAR; }
        if constexpr (!Epi::AFTER_DRAIN) { E(acc, cur, wr, wc, fr, fq); S.done(cur); }
        if (!has_next) break;
#pragma unroll
        for (int a = 0; a < 2; ++a)
#pragma unroll
            for (int b = 0; b < 2; ++b)
#pragma unroll
                for (int m = 0; m < 4; ++m)
#pragma unroll
                    for (int n = 0; n < 2; ++n) acc[a][b][m][n] = (f32x4){0.f, 0.f, 0.f, 0.f};
        cur = nxt; cA = nA; cB = nB; ++ui;
        if constexpr (ALIGN_EPI) { if (wr == 1) PG8_BAR; }
    }
    PG8_WAIT_V(0);
    if constexpr (!ALIGN_EPI) { if (wr == 0) PG8_BAR; }
    PG8_BAR;
    if constexpr (Epi::AFTER_DRAIN) { E.fused(acc, cur, wr, wc, fr, fq, lds, wid, lane); S.done(cur); }
#undef PG8_SA
#undef PG8_SB
#undef PG8_STAGE
#undef PG8_LDA
#undef PG8_LDB
#undef PG8_MMA
#undef PG8_WAIT_V
#undef PG8_WAIT_L
#undef PG8_BAR
#undef PG8_SCHED
}
}

#ifndef PG8_SP2
#define PG8_SP2 true
#endif
#ifndef PG8_ALIGN
#define PG8_ALIGN true
#endif
#include <hip/hip_bf16.h>
#include <cmath>
namespace attn2 {
using bf16x8 = __attribute__((ext_vector_type(8))) short;
using s16x4  = __attribute__((ext_vector_type(4))) short;
using f32x16 = __attribute__((ext_vector_type(16))) float;
using u32x4  = __attribute__((ext_vector_type(4))) unsigned;
typedef unsigned short bf16r;
constexpr int DQ = 64, DV = 128, NW = 8, QBLK = 32, KVBLK = 64, LD = 1024;
constexpr float SCALE = 0.125f, THR = 8.f, QSCALE = SCALE * 1.4426950408889634f;
#ifndef A2_FORCE_REF
#define A2_FORCE_REF 0
#endif
constexpr size_t SHM_V = KVBLK * DV * 2, SHM_K = KVBLK * DQ * 2, SHM_ATTN = 3 * SHM_V + 3 * SHM_K + NW * 64 * 4;
constexpr size_t PARK_OFF = SHM_ATTN, PARK_BYTES = NW * 2048 * 4;
#define A2_KSWZ(row, colB) ((row) * 128 + ((colB) ^ ((((row) >> 1) & 7) << 4)))
#define A2_SBAR() __builtin_amdgcn_sched_barrier(0)
__device__ __forceinline__ int crow(int r, int hi) { return (r & 3) + 8 * (r >> 2) + 4 * hi; }
typedef float f32x2_t __attribute__((ext_vector_type(2))); typedef __bf16 bf16x2_t __attribute__((ext_vector_type(2)));
__device__ __forceinline__ unsigned cvtpk(float lo, float hi) { f32x2_t v = {lo, hi}; bf16x2_t b = __builtin_convertvector(v, bf16x2_t); return __builtin_bit_cast(unsigned, b); }

__device__ __forceinline__ void partialSM0(f32x16& p0, f32x16& p1, float& m_reg, bool& refz) {
  float pmax = p0[0];
#pragma unroll
  for (int r = 1; r < 16; ++r) pmax = fmaxf(pmax, p0[r]);
#pragma unroll
  for (int r = 0; r < 16; ++r) pmax = fmaxf(pmax, p1[r]);
  { auto rr = __builtin_amdgcn_permlane32_swap(__float_as_uint(pmax), __float_as_uint(pmax), false, false);
    pmax = fmaxf(__uint_as_float(rr[0]), __uint_as_float(rr[1])); }
  refz = (A2_FORCE_REF == 0) && __all(fabsf(pmax) < 64.f);
  m_reg = refz ? 0.f : pmax;
  if (!refz) {
#pragma unroll
    for (int r = 0; r < 16; ++r) { p0[r] -= m_reg; p1[r] -= m_reg; }
  }
#pragma unroll
  for (int r = 0; r < 16; ++r) p0[r] = __builtin_amdgcn_exp2f(p0[r]);
}
constexpr float LAZY_BIG = 1073741824.f;
__device__ __forceinline__ void finishSM(f32x16& p0, f32x16& p1, float& m_reg, bool& refz, float& alpha, float& l_reg, bf16x8& pa0, bf16x8& pa1, bf16x8& pa2, bf16x8& pa3) {
#pragma unroll
  for (int r = 0; r < 16; ++r) p1[r] = __builtin_amdgcn_exp2f(p1[r]);
  f32x2_t sv = {p0[0], p0[1]};
#pragma unroll
  for (int i = 1; i < 8; ++i) sv += (f32x2_t){p0[2 * i], p0[2 * i + 1]};
#pragma unroll
  for (int i = 0; i < 8; ++i) sv += (f32x2_t){p1[2 * i], p1[2 * i + 1]};
  float ps = sv.x + sv.y;
  alpha = 1.f;
  if (__builtin_expect(__any(!(ps <= LAZY_BIG)), 0)) {
    auto rr = __builtin_amdgcn_permlane32_swap(__float_as_uint(ps), __float_as_uint(ps), false, false);
    const float pt = __uint_as_float(rr[0]) + __uint_as_float(rr[1]);
    const float dl = (pt > LAZY_BIG) ? floorf(__log2f(pt)) + 1.f : 0.f;
    alpha = __builtin_amdgcn_exp2f(-dl); m_reg += dl; refz = false;
#pragma unroll
    for (int r = 0; r < 16; ++r) { p0[r] *= alpha; p1[r] *= alpha; }
    ps *= alpha;
  }
  l_reg = l_reg * alpha + ps; asm volatile("" : "+v"(l_reg));
#define A2_PK8(P, BASE, OUT) do { u32x4 w = {cvtpk(P[BASE + 0], P[BASE + 1]), cvtpk(P[BASE + 2], P[BASE + 3]), cvtpk(P[BASE + 4], P[BASE + 5]), cvtpk(P[BASE + 6], P[BASE + 7])}; OUT = *reinterpret_cast<bf16x8*>(&w); } while (0)
  A2_PK8(p0, 0, pa0); A2_PK8(p0, 8, pa1); A2_PK8(p1, 0, pa2); A2_PK8(p1, 8, pa3);
#undef A2_PK8
}
__device__ __forceinline__ void qkt(f32x16& p0, f32x16& p1, const char* Ks, const bf16x8* qr, int r32, int hi) {
  p0 = f32x16{}; p1 = f32x16{};
#pragma unroll
  for (int d0 = 0; d0 < 4; ++d0) { const int cb = (d0 * 16 + hi * 8) * 2;
    const bf16x8 b0 = *reinterpret_cast<const bf16x8*>(Ks + A2_KSWZ(r32, cb));
    const bf16x8 b1 = *reinterpret_cast<const bf16x8*>(Ks + A2_KSWZ(32 + r32, cb));
    p0 = __builtin_amdgcn_mfma_f32_32x32x16_bf16(b0, qr[d0], p0, 0, 0, 0);
    p1 = __builtin_amdgcn_mfma_f32_32x32x16_bf16(b1, qr[d0], p1, 0, 0, 0); }
}
__device__ __forceinline__ int v_st(int k, int c) { const int kk = k;     return ((kk >> 3) * 4 + (c >> 5)) * 512 + ((kk & 7) * 32 + (c & 31)) * 2; }
__device__ __forceinline__ int v_rd_base(int lane) { return ((lane & 3) << 3) | (((lane >> 2) & 3) << 6) | (((lane >> 4) & 1) << 5) | (((lane >> 5) & 1) << 8); }
constexpr int v_rd_off(int d0, int ks, int half) { return d0 * 512 + ks * 4096 + half * 2048; }
template <int OFF> __device__ __forceinline__ s16x4 tr_read(int vb) {
  s16x4 r; asm volatile("ds_read_b64_tr_b16 %0, %1 offset:%2" : "=&v"(r) : "v"(vb), "i"(OFF) : "memory"); return r;
}
template <int D0> __device__ __forceinline__ void pv_one(f32x16& od, int vb, bf16x8 pa0, bf16x8 pa1, bf16x8 pa2, bf16x8 pa3) {
  const s16x4 l0 = tr_read<v_rd_off(D0, 0, 0)>(vb), h0 = tr_read<v_rd_off(D0, 0, 1)>(vb), l1 = tr_read<v_rd_off(D0, 1, 0)>(vb), h1 = tr_read<v_rd_off(D0, 1, 1)>(vb);
  const s16x4 l2 = tr_read<v_rd_off(D0, 2, 0)>(vb), h2 = tr_read<v_rd_off(D0, 2, 1)>(vb), l3 = tr_read<v_rd_off(D0, 3, 0)>(vb), h3 = tr_read<v_rd_off(D0, 3, 1)>(vb);
  asm volatile("s_waitcnt lgkmcnt(0)" ::: "memory"); A2_SBAR();
#define A2_PK(L, H) (bf16x8){L[0], L[1], L[2], L[3], H[0], H[1], H[2], H[3]}
  od = __builtin_amdgcn_mfma_f32_32x32x16_bf16(pa0, A2_PK(l0, h0), od, 0, 0, 0);
  od = __builtin_amdgcn_mfma_f32_32x32x16_bf16(pa1, A2_PK(l1, h1), od, 0, 0, 0);
  od = __builtin_amdgcn_mfma_f32_32x32x16_bf16(pa2, A2_PK(l2, h2), od, 0, 0, 0);
  od = __builtin_amdgcn_mfma_f32_32x32x16_bf16(pa3, A2_PK(l3, h3), od, 0, 0, 0);
#undef A2_PK
}
__device__ __forceinline__ void pv_d0(f32x16* o, int vb, bf16x8 pa0, bf16x8 pa1, bf16x8 pa2, bf16x8 pa3) {
  pv_one<0>(o[0], vb, pa0, pa1, pa2, pa3); pv_one<1>(o[1], vb, pa0, pa1, pa2, pa3); pv_one<2>(o[2], vb, pa0, pa1, pa2, pa3); pv_one<3>(o[3], vb, pa0, pa1, pa2, pa3);
}

struct VF { s16x4 l0, h0, l1, h1, l2, h2, l3, h3; };
template <int D0> __device__ __forceinline__ VF vread(int vb) { VF f;
  f.l0 = tr_read<v_rd_off(D0, 0, 0)>(vb); f.h0 = tr_read<v_rd_off(D0, 0, 1)>(vb); f.l1 = tr_read<v_rd_off(D0, 1, 0)>(vb); f.h1 = tr_read<v_rd_off(D0, 1, 1)>(vb);
  f.l2 = tr_read<v_rd_off(D0, 2, 0)>(vb); f.h2 = tr_read<v_rd_off(D0, 2, 1)>(vb); f.l3 = tr_read<v_rd_off(D0, 3, 0)>(vb); f.h3 = tr_read<v_rd_off(D0, 3, 1)>(vb); return f; }
__device__ __forceinline__ void mfma4(f32x16& od, const VF& f, bf16x8 pa0, bf16x8 pa1, bf16x8 pa2, bf16x8 pa3) {
#define A2_PK(L, H) (bf16x8){L[0], L[1], L[2], L[3], H[0], H[1], H[2], H[3]}
  od = __builtin_amdgcn_mfma_f32_32x32x16_bf16(pa0, A2_PK(f.l0, f.h0), od, 0, 0, 0);
  od = __builtin_amdgcn_mfma_f32_32x32x16_bf16(pa1, A2_PK(f.l1, f.h1), od, 0, 0, 0);
  od = __builtin_amdgcn_mfma_f32_32x32x16_bf16(pa2, A2_PK(f.l2, f.h2), od, 0, 0, 0);
  od = __builtin_amdgcn_mfma_f32_32x32x16_bf16(pa3, A2_PK(f.l3, f.h3), od, 0, 0, 0);
#undef A2_PK
}
#define A2_LWAIT(n) do { asm volatile("s_waitcnt lgkmcnt(" #n ")" ::: "memory"); A2_SBAR(); } while (0)
__device__ __forceinline__ void pv_psm(f32x16* o, int vb, bf16x8 pa0, bf16x8 pa1, bf16x8 pa2, bf16x8 pa3, f32x16& p0, f32x16& p1, float m_reg, bool refz) {
  const VF f0 = vread<0>(vb);
  const VF f1 = vread<1>(vb);
  if (!refz) {
#pragma unroll
    for (int r = 0; r < 16; ++r) { p0[r] -= m_reg; p1[r] -= m_reg; }
  }
#pragma unroll
  for (int r = 0; r < 4; ++r) p0[r] = __builtin_amdgcn_exp2f(p0[r]);
  asm volatile("" : "+v"(p0));
  A2_LWAIT(8); mfma4(o[0], f0, pa0, pa1, pa2, pa3);
  const VF f2 = vread<2>(vb); A2_LWAIT(8); mfma4(o[1], f1, pa0, pa1, pa2, pa3);
#pragma unroll
  for (int r = 4; r < 8; ++r) p0[r] = __builtin_amdgcn_exp2f(p0[r]);
  asm volatile("" : "+v"(p0));
  const VF f3 = vread<3>(vb); A2_LWAIT(8); mfma4(o[2], f2, pa0, pa1, pa2, pa3);
#pragma unroll
  for (int r = 8; r < 12; ++r) p0[r] = __builtin_amdgcn_exp2f(p0[r]);
  asm volatile("" : "+v"(p0));
  A2_LWAIT(0); mfma4(o[3], f3, pa0, pa1, pa2, pa3);
#pragma unroll
  for (int r = 12; r < 16; ++r) p0[r] = __builtin_amdgcn_exp2f(p0[r]);
  asm volatile("" : "+v"(p0)); A2_SBAR();
}
template <int PASS>
__device__ __forceinline__ void body(const bf16r* Qb, const bf16r* Kh, const bf16r* Vh, int seq, char* lds, float lam, const float* subln, bf16r* Ob) {
  int tid_ = threadIdx.x; asm volatile("" : "+v"(tid_));
  const int tid = tid_, wid = tid >> 6, lane = tid & 63, r32 = lane & 31, hi = lane >> 5;
  char* V_lds = lds; char* K_lds = lds + 3 * SHM_V;
  float* ws = (float*)(lds + 3 * SHM_V + 3 * SHM_K) + wid * 64; float* li_l = ws; float* al_l = ws + 32;
  float m_reg = 0.f, l_reg = 0; f32x16 o[4] = {}; bf16x8 qr[4];
  const bf16r* Qw = Qb + (long)(wid * QBLK + r32) * LD + hi * 8;
#pragma unroll
  for (int d0 = 0; d0 < 4; ++d0) qr[d0] = *reinterpret_cast<const bf16x8*>(Qw + d0 * 16);
  const int sr = tid >> 4, sc = (tid & 15) * 8, vst0 = v_st(sr, sc), vst1 = v_st(32 + sr, sc);
  const int kr = tid >> 3, kc = (tid & 7) * 8, kst = A2_KSWZ(kr, kc * 2);
  const int vb0 = (int)(uintptr_t)V_lds + v_rd_base(lane);
  struct { bf16x8 vs0, vs1, ks0; } sr_[2];
#define A2_SLOAD(i, k0) do { sr_[i].vs0 = *reinterpret_cast<const bf16x8*>(&Vh[(long)((k0) + sr) * LD + sc]); sr_[i].vs1 = *reinterpret_cast<const bf16x8*>(&Vh[(long)((k0) + 32 + sr) * LD + sc]); \
    sr_[i].ks0 = *reinterpret_cast<const bf16x8*>(&Kh[(long)((k0) + kr) * LD + kc]); } while (0)
#define A2_SWRITE(b, i) do { *(bf16x8*)(V_lds + (b) * SHM_V + vst0) = sr_[i].vs0; *(bf16x8*)(V_lds + (b) * SHM_V + vst1) = sr_[i].vs1; *(bf16x8*)(K_lds + (b) * SHM_K + kst) = sr_[i].ks0; } while (0)
#define A2_SWAIT() asm volatile("s_waitcnt vmcnt(3)" ::: "memory")
#define A2_RESC(a) do { if (__any((a) < 1.f)) { if (hi == 0) al_l[r32] = (a); asm volatile("s_waitcnt lgkmcnt(0)" ::: "memory"); \
    _Pragma("unroll") for (int d = 0; d < 4; ++d) _Pragma("unroll") for (int r = 0; r < 16; ++r) o[d][r] *= al_l[crow(r, hi)]; } } while (0)
  if (wid >= 4) __builtin_amdgcn_s_setprio(1);
  f32x16 pA0, pA1, pB0, pB1; float al; bool refz; bf16x8 pa0, pa1, pa2, pa3; const int NT = seq / KVBLK;
  A2_SLOAD(0, 0); asm volatile("s_waitcnt vmcnt(0)" ::: "memory"); A2_SWRITE(0, 0);
  A2_SLOAD(1, KVBLK); A2_SLOAD(0, 2 * KVBLK);
  __syncthreads();
  qkt(pA0, pA1, K_lds, qr, r32, hi); partialSM0(pA0, pA1, m_reg, refz);
  A2_SWAIT(); A2_SWRITE(1, 1); A2_SLOAD(1, 3 * KVBLK);
  int bp = 0, bc = 1, bn = 2;
#define A2_STEP(PC0, PC1, PP0, PP1, j_, SL) do { \
    __syncthreads(); \
    A2_SBAR(); qkt(PC0, PC1, K_lds + bc * SHM_K, qr, r32, hi); \
    finishSM(PP0, PP1, m_reg, refz, al, l_reg, pa0, pa1, pa2, pa3); A2_RESC(al); A2_SBAR(); \
    if ((j_) + 1 < NT) { A2_SWAIT(); A2_SWRITE(bn, SL); }     \
    if ((j_) + 3 < NT) A2_SLOAD(SL, ((j_) + 3) * KVBLK); A2_SBAR(); \
    pv_psm(o, vb0 + bp * (int)SHM_V, pa0, pa1, pa2, pa3, PC0, PC1, m_reg, refz); \
    { const int t_ = bp; bp = bc; bc = bn; bn = t_; } } while (0)
  for (int j = 1; j + 1 < NT; j += 2) {
    A2_STEP(pB0, pB1, pA0, pA1, j, 0);
    A2_STEP(pA0, pA1, pB0, pB1, j + 1, 1);
  }
  A2_STEP(pB0, pB1, pA0, pA1, NT - 1, 0);
#undef A2_STEP
  finishSM(pB0, pB1, m_reg, refz, al, l_reg, pa0, pa1, pa2, pa3); A2_RESC(al); A2_SBAR();
  pv_d0(o, vb0 + bp * (int)SHM_V, pa0, pa1, pa2, pa3);
  __builtin_amdgcn_s_setprio(0);
  { auto rr = __builtin_amdgcn_permlane32_swap(__float_as_uint(l_reg), __float_as_uint(l_reg), false, false); l_reg = __uint_as_float(rr[0]) + __uint_as_float(rr[1]); }
  if (hi == 0) li_l[r32] = l_reg; asm volatile("s_waitcnt lgkmcnt(0)" ::: "memory");
  float rli[16];
#pragma unroll
  for (int r = 0; r < 16; ++r) rli[r] = __builtin_amdgcn_rcpf(li_l[crow(r, hi)]);
  unsigned* sw = (unsigned*)(lds + PARK_OFF) + wid * 2048 + lane;
  if (PASS == 0) {
#pragma unroll
    for (int r = 0; r < 16; ++r)
#pragma unroll
      for (int dp = 0; dp < 2; ++dp) sw[(r * 2 + dp) * 64] = cvtpk(o[2 * dp][r] * rli[r], o[2 * dp + 1][r] * rli[r]);
  } else {
    float sg[4];
#pragma unroll
    for (int d0 = 0; d0 < 4; ++d0) sg[d0] = subln[d0 * 32 + r32];
    bf16r* Ow = Ob + (long)(wid * QBLK) * LD + r32;
#pragma unroll
    for (int r = 0; r < 16; ++r) {
      float d[4]; float ss = 0.f;
#pragma unroll
      for (int dp = 0; dp < 2; ++dp) { const unsigned w = sw[(r * 2 + dp) * 64];
        d[2 * dp] = __uint_as_float(w << 16) - lam * (o[2 * dp][r] * rli[r]); d[2 * dp + 1] = __uint_as_float(w & 0xffff0000u) - lam * (o[2 * dp + 1][r] * rli[r]); }
#pragma unroll
      for (int d0 = 0; d0 < 4; ++d0) ss += d[d0] * d[d0];
      ss += __shfl_xor(ss, 1); ss += __shfl_xor(ss, 2); ss += __shfl_xor(ss, 4); ss += __shfl_xor(ss, 8); ss += __shfl_xor(ss, 16);
      const float rstd = 0.8f / sqrtf(ss * (1.f / 128.f) + 1e-6f);
      const int orow = crow(r, hi);
#pragma unroll
      for (int d0 = 0; d0 < 4; ++d0) Ow[(long)orow * LD + d0 * 32] = (bf16r)(cvtpk(d[d0] * rstd * sg[d0], 0.f) & 0xffffu);
    }
  }
  __syncthreads();
#undef A2_SLOAD
#undef A2_SWRITE
#undef A2_SWAIT
#undef A2_RESC
}
#undef A2_KSWZ
#undef A2_LWAIT
#undef A2_SBAR
}
namespace pg8 {
typedef unsigned u32x2 __attribute__((ext_vector_type(2)));
__device__ __forceinline__ float fsigmoid(float x) { return __builtin_amdgcn_rcpf(1.0f + __builtin_amdgcn_exp2f(-1.4426950408889634f * x)); }
__device__ __forceinline__ float fsilu(float x) { return x * fsigmoid(x); }
__device__ __forceinline__ float bflo(unsigned w) { return __uint_as_float(w << 16); }
__device__ __forceinline__ float bfhi(unsigned w) { return __uint_as_float(w & 0xffff0000u); }

struct EpiSwiglu {
    static constexpr bool PERM = true, AFTER_DRAIN = false;
    bf16_t* O; int ldc;
    __device__ __forceinline__ void operator()(const f32x4 (&acc)[2][2][4][2], const Unit& u, int wr, int wc, int fr, int fq) const {
        const int row0 = u.pm * BM + wr * 64 + fr, col0 = u.pn * HALF + wc * 32 + 8 * fq;
#pragma unroll
        for (int ai = 0; ai < 2; ++ai)
#pragma unroll
            for (int m = 0; m < 4; ++m) {
                bf16_t* rowp = O + (size_t)(row0 + ai * HALF + m * 16) * ldc + col0;
                const f32x4 g0 = acc[ai][0][m][0], g1 = acc[ai][0][m][1], u0 = acc[ai][1][m][0], u1 = acc[ai][1][m][1];
                u32x4 w;
                w.x = cvt_pk_bf16(fsilu(g0[0]) * u0[0], fsilu(g0[1]) * u0[1]); w.y = cvt_pk_bf16(fsilu(g0[2]) * u0[2], fsilu(g0[3]) * u0[3]);
                w.z = cvt_pk_bf16(fsilu(g1[0]) * u1[0], fsilu(g1[1]) * u1[1]); w.w = cvt_pk_bf16(fsilu(g1[2]) * u1[2], fsilu(g1[3]) * u1[3]);
                *(u32x4*)rowp = w;
            }
    }
};

struct EpiWin {
    static constexpr bool PERM = true, AFTER_DRAIN = false;
    bf16_t *q, *k, *v, *u, *ga, *gb; const float* rope; float qscale;
    __device__ __forceinline__ void operator()(const f32x4 (&acc)[2][2][4][2], const Unit& un, int wr, int wc, int fr, int fq) const {
        const int pn = un.pn, rowt = un.pm * BM + wr * 64 + fr, bidx = un.pm >> 5;
        if (pn < 8) {
            const bool isq = pn < 4; const float sc = isq ? qscale : 1.f; bf16_t* base = isq ? q : k;
            const int colt = (pn & 3) * 256 + wc * 32 + 8 * fq, axis = wc & 1, f0 = 8 * (fq & 1);
            const float sgn = (fq < 2) ? -sc : sc;
#pragma unroll
            for (int ai = 0; ai < 2; ++ai)
#pragma unroll
                for (int m = 0; m < 4; ++m) {
                    const int r = rowt + ai * HALF + m * 16, t = r & 8191, pos = axis ? (t & 63) : (t >> 6);
                    const f32x4 cs0 = *(const f32x4*)(rope + pos * 16 + f0), cs1 = *(const f32x4*)(rope + pos * 16 + f0 + 4);
                    const f32x4 sn0 = *(const f32x4*)(rope + 2048 + pos * 16 + f0), sn1 = *(const f32x4*)(rope + 2048 + pos * 16 + f0 + 4);
                    const size_t orow = isq ? (size_t)r : (size_t)bidx * 8448 + 256 + t;
                    bf16_t* rowp = base + orow * 1024 + colt;
#pragma unroll
                    for (int bj = 0; bj < 2; ++bj) {
                        const f32x4 s0 = acc[ai][bj][m][0], s1 = acc[ai][bj][m][1]; f32x4 o0, o1;
#pragma unroll
                        for (int jj = 0; jj < 4; ++jj) { const float p0 = __shfl_xor(s0[jj], 32), p1 = __shfl_xor(s1[jj], 32);
                            o0[jj] = s0[jj] * (cs0[jj] * sc) + p0 * (sn0[jj] * sgn); o1[jj] = s1[jj] * (cs1[jj] * sc) + p1 * (sn1[jj] * sgn); }
                        u32x4 w; w.x = cvt_pk_bf16(o0[0], o0[1]); w.y = cvt_pk_bf16(o0[2], o0[3]); w.z = cvt_pk_bf16(o1[0], o1[1]); w.w = cvt_pk_bf16(o1[2], o1[3]);
                        *(u32x4*)(rowp + bj * HALF) = w;
                    }
                }
        } else if (pn < 12) {
            const int colt = (pn - 8) * 256 + wc * 32 + 8 * fq;
#pragma unroll
            for (int ai = 0; ai < 2; ++ai)
#pragma unroll
                for (int m = 0; m < 4; ++m) {
                    const int r = rowt + ai * HALF + m * 16, t = r & 8191;
                    bf16_t* rowp = v + ((size_t)bidx * 8448 + 256 + t) * 1024 + colt;
#pragma unroll
                    for (int bj = 0; bj < 2; ++bj) { const f32x4 v0 = acc[ai][bj][m][0], v1 = acc[ai][bj][m][1]; u32x4 w;
                        w.x = cvt_pk_bf16(v0[0], v0[1]); w.y = cvt_pk_bf16(v0[2], v0[3]); w.z = cvt_pk_bf16(v1[0], v1[1]); w.w = cvt_pk_bf16(v1[2], v1[3]); *(u32x4*)(rowp + bj * HALF) = w; }
                }
        } else if (pn < 20) {
            const int colt = (pn - 12) * HALF + wc * 32 + 8 * fq;
#pragma unroll
            for (int ai = 0; ai < 2; ++ai)
#pragma unroll
                for (int m = 0; m < 4; ++m) {
                    bf16_t* rowp = u + (size_t)(rowt + ai * HALF + m * 16) * 1024 + colt;
                    const f32x4 a0 = acc[ai][0][m][0], a1 = acc[ai][0][m][1], g0 = acc[ai][1][m][0], g1 = acc[ai][1][m][1]; u32x4 w;
                    w.x = cvt_pk_bf16(a0[0] * fsigmoid(g0[0]), a0[1] * fsigmoid(g0[1])); w.y = cvt_pk_bf16(a0[2] * fsigmoid(g0[2]), a0[3] * fsigmoid(g0[3]));
                    w.z = cvt_pk_bf16(a1[0] * fsigmoid(g1[0]), a1[1] * fsigmoid(g1[1])); w.w = cvt_pk_bf16(a1[2] * fsigmoid(g1[2]), a1[3] * fsigmoid(g1[3]));
                    *(u32x4*)rowp = w;
                }
        } else {
            bf16_t* base = pn < 24 ? ga : gb; const int colt = (pn & 3) * 256 + wc * 32 + 8 * fq;
#pragma unroll
            for (int ai = 0; ai < 2; ++ai)
#pragma unroll
                for (int m = 0; m < 4; ++m) {
                    bf16_t* rowp = base + (size_t)(rowt + ai * HALF + m * 16) * 1024 + colt;
#pragma unroll
                    for (int bj = 0; bj < 2; ++bj) { const f32x4 v0 = acc[ai][bj][m][0], v1 = acc[ai][bj][m][1]; u32x4 w;
                        w.x = cvt_pk_bf16(fsigmoid(v0[0]), fsigmoid(v0[1])); w.y = cvt_pk_bf16(fsigmoid(v0[2]), fsigmoid(v0[3]));
                        w.z = cvt_pk_bf16(fsigmoid(v1[0]), fsigmoid(v1[1])); w.w = cvt_pk_bf16(fsigmoid(v1[2]), fsigmoid(v1[3])); *(u32x4*)(rowp + bj * HALF) = w; }
                }
        }
    }
};

struct EpiKVc {
    static constexpr bool PERM = true, AFTER_DRAIN = false;
    bf16_t *k, *v;
    __device__ __forceinline__ void operator()(const f32x4 (&acc)[2][2][4][2], const Unit& un, int wr, int wc, int fr, int fq) const {
        bf16_t* base = un.pn < 4 ? k : v; const int colt = (un.pn & 3) * 256 + wc * 32 + 8 * fq;
#pragma unroll
        for (int ai = 0; ai < 2; ++ai)
#pragma unroll
            for (int m = 0; m < 4; ++m) {
                bf16_t* rowp = base + ((size_t)un.pm * 8448 + wr * 64 + fr + ai * HALF + m * 16) * 1024 + colt;
#pragma unroll
                for (int bj = 0; bj < 2; ++bj) { const f32x4 v0 = acc[ai][bj][m][0], v1 = acc[ai][bj][m][1]; u32x4 w;
                    w.x = cvt_pk_bf16(v0[0], v0[1]); w.y = cvt_pk_bf16(v0[2], v0[3]); w.z = cvt_pk_bf16(v1[0], v1[1]); w.w = cvt_pk_bf16(v1[2], v1[3]); *(u32x4*)(rowp + bj * HALF) = w; }
            }
    }
};

template <bool ADD> struct EpiGate {
    static constexpr bool PERM = true, AFTER_DRAIN = false;
    bf16_t* Z; const bf16_t* G;
    __device__ __forceinline__ void operator()(const f32x4 (&acc)[2][2][4][2], const Unit& un, int wr, int wc, int fr, int fq) const {
        const int row0 = un.pm * BM + wr * 64 + fr, col0 = un.pn * BM + wc * 32 + 8 * fq;
#pragma unroll
        for (int ai = 0; ai < 2; ++ai)
#pragma unroll
            for (int m = 0; m < 4; ++m) {
                const size_t off = (size_t)(row0 + ai * HALF + m * 16) * 1024 + col0;
#pragma unroll
                for (int bj = 0; bj < 2; ++bj) {
                    const u32x4 g = *(const u32x4*)(G + off + bj * HALF);
                    const f32x4 v0 = acc[ai][bj][m][0], v1 = acc[ai][bj][m][1];
                    float o[8];
                    o[0] = v0[0] * bflo(g.x); o[1] = v0[1] * bfhi(g.x); o[2] = v0[2] * bflo(g.y); o[3] = v0[3] * bfhi(g.y);
                    o[4] = v1[0] * bflo(g.z); o[5] = v1[1] * bfhi(g.z); o[6] = v1[2] * bflo(g.w); o[7] = v1[3] * bfhi(g.w);
                    if (ADD) { const u32x4 z = *(const u32x4*)(Z + off + bj * HALF);
                        o[0] += bflo(z.x); o[1] += bfhi(z.x); o[2] += bflo(z.y); o[3] += bfhi(z.y); o[4] += bflo(z.z); o[5] += bfhi(z.z); o[6] += bflo(z.w); o[7] += bfhi(z.w); }
                    u32x4 w; w.x = cvt_pk_bf16(o[0], o[1]); w.y = cvt_pk_bf16(o[2], o[3]); w.z = cvt_pk_bf16(o[4], o[5]); w.w = cvt_pk_bf16(o[6], o[7]);
                    *(u32x4*)(Z + off + bj * HALF) = w;
                }
            }
    }
};
}

constexpr int NWAVES = 8, NTHR = 512;
constexpr int DM = 1024, NB = 4, SEQ = 8192, NLAT = NB * SEQ, NCTX = 256, NCTXR = NB * NCTX, NROWS = NLAT + NCTXR, NKEYS = SEQ + NCTX;
constexpr int DFF = 2816, INW = 7168, NMOD = 9;
constexpr float EPS = 1e-6f;
constexpr size_t MiB = 1u << 20;
constexpr size_t WS_MOD = 1 * MiB, WS_ROPE = 1 * MiB + 256 * 1024, WS_LAM = 1 * MiB + 512 * 1024;
constexpr size_t WS_W13A = 2 * MiB, WS_W2A = 13 * MiB, WS_W13B = WS_W2A + 11 * MiB / 2, WS_W2B = WS_W13B + 11 * MiB, WS_WIN = 35 * MiB, WS_WAP = 49 * MiB, WS_WCP = 51 * MiB, WS_WOUT = 53 * MiB;
constexpr size_t WS_H = 56 * MiB, WS_Y = 122 * MiB, WS_BIG = 188 * MiB;
constexpr size_t WS_ACT = WS_BIG, WS_Q = WS_BIG, WS_K = WS_BIG + 64 * MiB, WS_V = WS_K + 66 * MiB, WS_U = WS_V + 66 * MiB, WS_GB = WS_U + 64 * MiB, WS_END = WS_GB + 64 * MiB;
constexpr size_t WS_GA = WS_Y, WS_UC = WS_H, WS_OSCR = WS_U, WS_Z = WS_U;
static_assert(WS_END == 512 * MiB, "ws map");
static_assert(WS_W2B + 11 * MiB / 2 <= WS_WIN, "ws map weights");
constexpr int LDS_BYTES = 147456;

#define LAS __attribute__((address_space(3)))
typedef unsigned short bf16;
typedef unsigned v4u __attribute__((ext_vector_type(4)));
typedef unsigned v2u __attribute__((ext_vector_type(2)));
typedef float f32x4 __attribute__((ext_vector_type(4)));
#define LDS_WAIT() asm volatile("s_waitcnt lgkmcnt(0)" ::: "memory")
__device__ __forceinline__ unsigned f2bf(float f) { unsigned u = __builtin_bit_cast(unsigned, f); return (u + 0x7fffu + ((u >> 16) & 1u)) >> 16; }
__device__ __forceinline__ unsigned pk2(float lo, float hi) { return f2bf(lo) | (f2bf(hi) << 16); }
__device__ __forceinline__ float wave_sum(float v) {
#pragma unroll
    for (int o = 1; o < 64; o <<= 1) v += __shfl_xor(v, o);
    return v;
}

struct Args { const float* in[21]; float* out; unsigned char* ws; int pad0, pad1; };
enum { I_X = 0, I_C, I_CTX, I_CCTX, I_WADA, I_BADA, I_NORMG, I_F1W13, I_F1W2, I_F2W13, I_F2W2, I_WIN, I_LAMQK, I_SUBLN, I_WAP, I_CONVW, I_CONVB, I_CLNG, I_CLNB, I_WCP, I_WOUT };

template <int MODE> __device__ __forceinline__ int drow(int n0) {
    if (MODE == 1) { const int bj = n0 / DFF, j = n0 % DFF; return 256 * (j / 128) + 128 * bj + (j % 128); }
    if (MODE == 2) { if (n0 >= 3072 && n0 < 5120) { const int c = n0 - 3072, bj = c / 1024, j = c % 1024; return 3072 + 256 * (j / 128) + 128 * bj + (j % 128); } return n0; }
    return n0;
}
template <int MODE> __device__ __forceinline__ void transpose_item(const float* W, int K, int N, bf16* WT, LAS float* scr, int item, int lane) {
    const int nblk = N / 32, kb = item / nblk, nb = item % nblk, k0 = 64 * kb, n0 = 32 * nb, d0 = drow<MODE>(n0);
    float tv[32];
#pragma unroll
    for (int i = 0; i < 32; ++i) tv[i] = W[(size_t)(k0 + 2 * i + (lane >> 5)) * N + n0 + (lane & 31)];
#pragma unroll
    for (int i = 0; i < 32; ++i) scr[(2 * i + (lane >> 5)) * 33 + (lane & 31)] = tv[i];
    LDS_WAIT(); asm volatile("" ::: "memory");
    const int c = lane & 7;
#pragma unroll
    for (int j = 0; j < 4; ++j) { const int n = (lane >> 3) + 8 * j; const LAS float* s = scr + (8 * c) * 33 + n;
        v4u o; o.x = pk2(s[0 * 33], s[1 * 33]); o.y = pk2(s[2 * 33], s[3 * 33]); o.z = pk2(s[4 * 33], s[5 * 33]); o.w = pk2(s[6 * 33], s[7 * 33]);
        *(v4u*)(WT + (size_t)(d0 + n) * K + k0 + 8 * c) = o; }
    LDS_WAIT(); asm volatile("" ::: "memory");
}

template <bool HAS_Y, bool WRITE_X, bool WRITE_H>
__device__ __forceinline__ void norm_rows(int gw, int NGW, int lane, int row_lo, int nrows, const float* xlat, const float* xctx, const bf16* Y, float* xout, bf16* hout, const float* mod,
                                          float mult, const float* g_post, int k_gate, const float* g_pre, int k_in) {
    for (int row0 = row_lo + gw; row0 < nrows; row0 += 2 * NGW) {
        int rows[2]; rows[0] = row0; rows[1] = (row0 + NGW < nrows) ? row0 + NGW : row0;
        f32x4 v[2][4]; v2u yw[2][4]; const float* mp[2]; bool isctx[2];
#pragma unroll
        for (int r = 0; r < 2; ++r) {
            const int row = rows[r]; isctx[r] = row >= NLAT; const int mv = isctx[r] ? 4 : (row >> 13);
            const float* xr = isctx[r] ? xctx + (size_t)(row - NLAT) * DM : xlat + (size_t)row * DM;
            mp[r] = mod + (size_t)mv * (NMOD * DM);
#pragma unroll
            for (int j = 0; j < 4; ++j) v[r][j] = ((const f32x4*)xr)[lane + 64 * j];
            if (HAS_Y) {
#pragma unroll
                for (int j = 0; j < 4; ++j) yw[r][j] = ((const v2u*)(Y + (size_t)row * DM))[lane + 64 * j];
            }
        }
        if (HAS_Y) {
            f32x4 y[2][4]; float ss[2];
#pragma unroll
            for (int r = 0; r < 2; ++r) { ss[r] = 0.f;
#pragma unroll
                for (int j = 0; j < 4; ++j) { const v2u w = yw[r][j]; y[r][j] = (f32x4){pg8::bflo(w.x), pg8::bfhi(w.x), pg8::bflo(w.y), pg8::bfhi(w.y)};
                    ss[r] += (y[r][j].x * y[r][j].x + y[r][j].y * y[r][j].y) + (y[r][j].z * y[r][j].z + y[r][j].w * y[r][j].w); } }
#pragma unroll
            for (int o = 1; o < 64; o <<= 1) { ss[0] += __shfl_xor(ss[0], o); ss[1] += __shfl_xor(ss[1], o); }
#pragma unroll
            for (int r = 0; r < 2; ++r) { const float rstd = 1.0f / sqrtf(ss[r] * (1.f / DM) + EPS);
#pragma unroll
                for (int j = 0; j < 4; ++j) { const f32x4 gp = ((const f32x4*)g_post)[lane + 64 * j], gt = ((const f32x4*)(mp[r] + k_gate * DM))[lane + 64 * j];
                    v[r][j] = v[r][j] + (mult * gt) * ((y[r][j] * rstd) * gp); }
                if (WRITE_X && !isctx[r]) {
#pragma unroll
                    for (int j = 0; j < 4; ++j) ((f32x4*)(xout + (size_t)rows[r] * DM))[lane + 64 * j] = v[r][j];
                } }
        }
        if (WRITE_H) {
            float ss[2];
#pragma unroll
            for (int r = 0; r < 2; ++r) { ss[r] = 0.f;
#pragma unroll
                for (int j = 0; j < 4; ++j) ss[r] += (v[r][j].x * v[r][j].x + v[r][j].y * v[r][j].y) + (v[r][j].z * v[r][j].z + v[r][j].w * v[r][j].w); }
#pragma unroll
            for (int o = 1; o < 64; o <<= 1) { ss[0] += __shfl_xor(ss[0], o); ss[1] += __shfl_xor(ss[1], o); }
#pragma unroll
            for (int r = 0; r < 2; ++r) { const float rstd = 1.0f / sqrtf(ss[r] * (1.f / DM) + EPS);
#pragma unroll
                for (int j = 0; j < 4; ++j) { const f32x4 gp = ((const f32x4*)g_pre)[lane + 64 * j], sh = ((const f32x4*)(mp[r] + k_in * DM))[lane + 64 * j], sc = ((const f32x4*)(mp[r] + (k_in + 1) * DM))[lane + 64 * j];
                    const f32x4 h = ((v[r][j] * rstd) * gp) * (1.0f + sc) + sh;
                    v2u w; w.x = pk2(h.x, h.y); w.y = pk2(h.z, h.w); ((v2u*)(hout + (size_t)rows[r] * DM))[lane + 64 * j] = w; } }
        }
    }
}

#define RLX_AGENT __ATOMIC_RELAXED, __HIP_MEMORY_SCOPE_AGENT
#define XB_TMO      128
#define XB_XCNT(j)  (256  + 64 * (j))
#define XB_XSUB(j)  (1280 + 64 * (j))
#define XB_XGEN(j)  (2304 + 64 * (j))
#define XB_TOP      3328
#define XB_TOPGEN   3392
#define XCD_BAR_WORDS 3456
#define XB_SPIN_CAP (1u << 22)

__device__ __forceinline__ unsigned xb_ld(unsigned* p)              { return __hip_atomic_load(p, __ATOMIC_RELAXED, __HIP_MEMORY_SCOPE_AGENT); }
__device__ __forceinline__ unsigned xb_add(unsigned* p, unsigned v) { return __hip_atomic_fetch_add(p, v, __ATOMIC_RELAXED, __HIP_MEMORY_SCOPE_AGENT); }
__device__ __forceinline__ unsigned xb_xcc_id() { return (unsigned)__builtin_amdgcn_s_getreg((3 << 11) | 20) & 0xFu; }
#define XB_SPIN(cond, bar) do { unsigned _sp = 0; while (cond) { __builtin_amdgcn_s_sleep(1); \
    if ((++_sp & 255u) == 0u) { if (xb_ld(&(bar)[XB_TMO])) break; if (_sp > XB_SPIN_CAP) { atomicAdd(&(bar)[XB_TMO], 1u); break; } } } } while (0)

struct XcdBarrier {
    unsigned* bar; unsigned x;
    volatile LAS unsigned* st;
};

__device__ __forceinline__ XcdBarrier xcd_barrier_post(unsigned* bar, volatile LAS unsigned* st) {
    XcdBarrier b; b.bar = bar; b.x = xb_xcc_id(); b.st = st;
    if (threadIdx.x == 0) (void)xb_add(&bar[XB_XCNT(b.x)], 1u);
    return b;
}
__device__ __forceinline__ void xcd_barrier_complete(unsigned* bar, unsigned x, unsigned& nloc, unsigned& nx) {
    const unsigned G = gridDim.x * gridDim.y * gridDim.z;
    unsigned sum, cnt, mine, sp = 0u;
    for (;;) {
        sum = 0u; cnt = 0u; mine = 0u;
#pragma unroll
        for (unsigned j = 0; j < 16; ++j) { const unsigned c = xb_ld(&bar[XB_XCNT(j)]); sum += c; cnt += (c > 0u) ? 1u : 0u; mine = (j == x) ? c : mine; }
        if (sum == G) break;
        __builtin_amdgcn_s_sleep(1);
        if ((++sp & 255u) == 0u) { if (xb_ld(&bar[XB_TMO])) break; if (sp > XB_SPIN_CAP) { atomicAdd(&bar[XB_TMO], 1u); break; } }
    }
    nloc = mine > 0u ? mine : 1u; nx = cnt > 0u ? cnt : 1u;
}

__device__ __forceinline__ void xcd_barrier(const XcdBarrier& b) {
    asm volatile("s_waitcnt vmcnt(0)" ::: "memory");
    __syncthreads();
    if (threadIdx.x == 0) {
        unsigned* bar = b.bar;
        __builtin_amdgcn_s_waitcnt(0);
        unsigned nloc = b.st[0], nx = b.st[1];
        if (nloc == 0u) { xcd_barrier_complete(bar, b.x, nloc, nx); b.st[0] = nloc; b.st[1] = nx; }
        const unsigned old = xb_add(&bar[XB_XSUB(b.x)], 1u);
        const unsigned gen = old / nloc;
        if (old + 1u == (gen + 1u) * nloc) {
            __builtin_amdgcn_fence(__ATOMIC_RELEASE, "agent");
            asm volatile("s_waitcnt vmcnt(0)" ::: "memory");
            const unsigned og = xb_add(&bar[XB_TOP], 1u);
            const unsigned tg = og / nx;
            if (og + 1u == (tg + 1u) * nx) xb_add(&bar[XB_TOPGEN], 1u);
            else XB_SPIN(xb_ld(&bar[XB_TOPGEN]) == tg, bar);
            __builtin_amdgcn_fence(__ATOMIC_ACQUIRE, "agent");
            xb_add(&bar[XB_XGEN(b.x)], 1u);
            asm volatile("s_waitcnt vmcnt(0)" ::: "memory");
        } else {
            XB_SPIN(xb_ld(&bar[XB_XGEN(b.x)]) == gen, bar);
            __builtin_amdgcn_fence(__ATOMIC_ACQUIRE, "agent");
            asm volatile("s_waitcnt vmcnt(0)" ::: "memory");
        }
    }
    __syncthreads();
}

__global__ void __launch_bounds__(NTHR, 2) fwd_mega(Args args) {
    extern __shared__ __attribute__((aligned(16))) unsigned char lds[];
    cg::grid_group grid = cg::this_grid();
#define GSYNC_CG() do { asm volatile("s_waitcnt vmcnt(0) lgkmcnt(0)" ::: "memory"); grid.sync(); __builtin_amdgcn_fence(__ATOMIC_ACQUIRE, "agent"); asm volatile("s_waitcnt vmcnt(0)" ::: "memory"); } while (0)
#define GSYNC() xcd_barrier(xbar)
    LAS unsigned char* L = (LAS unsigned char*)lds;
    const int tid = threadIdx.x, lane = tid & 63, wave = __builtin_amdgcn_readfirstlane(tid >> 6);
    const int G = gridDim.x, bx = blockIdx.x, vcu = (G % 8 == 0) ? (bx % 8) * (G / 8) + bx / 8 : bx;
    const int gw = vcu * NWAVES + wave, NGW = G * NWAVES;
    unsigned char* ws = args.ws;
    volatile LAS unsigned* xst = (volatile LAS unsigned*)(L + LDS_BYTES - 64);
    static_assert(attn2::PARK_OFF + attn2::PARK_BYTES <= LDS_BYTES - 64, "LDS map");
    if (tid < 2) xst[tid] = 0u;
    __syncthreads();
    XcdBarrier xbar = xcd_barrier_post((unsigned*)ws, xst);
    float* mod = (float*)(ws + WS_MOD); float* rope = (float*)(ws + WS_ROPE); float* lamp = (float*)(ws + WS_LAM);
    bf16 *W13A = (bf16*)(ws + WS_W13A), *W2A = (bf16*)(ws + WS_W2A), *W13B = (bf16*)(ws + WS_W13B), *W2B = (bf16*)(ws + WS_W2B), *WIN = (bf16*)(ws + WS_WIN), *WAP = (bf16*)(ws + WS_WAP), *WCP = (bf16*)(ws + WS_WCP), *WOUT = (bf16*)(ws + WS_WOUT);
    bf16 *H = (bf16*)(ws + WS_H), *Y = (bf16*)(ws + WS_Y), *ACT = (bf16*)(ws + WS_ACT), *Qb = (bf16*)(ws + WS_Q), *Kb = (bf16*)(ws + WS_K), *Vb = (bf16*)(ws + WS_V), *Ub = (bf16*)(ws + WS_U), *GA = (bf16*)(ws + WS_GA), *GB = (bf16*)(ws + WS_GB);
    bf16 *UC = (bf16*)(ws + WS_UC), *OSCR = (bf16*)(ws + WS_OSCR), *Zb = (bf16*)(ws + WS_Z);
    const float* x = args.in[I_X]; const float* ctx = args.in[I_CTX]; const float* normg = args.in[I_NORMG]; float* out = args.out;

    {
        LAS float* sc = (LAS float*)L;
        LAS float* red = (LAS float*)(L + 20480);
        if (bx < 144) {
            for (int i = tid; i < 5 * DM; i += NTHR) { const float c = i < 4 * DM ? args.in[I_C][i] : args.in[I_CCTX][i - 4 * DM]; sc[i] = c / (1.0f + expf(-c)); }
            __syncthreads();
            for (int it = bx; it < 144; it += G) {
                const int col = it * 64 + lane; const float* wp = args.in[I_WADA] + (size_t)(wave * 128) * (NMOD * DM) + col;
                float a0 = 0.f, a1 = 0.f, a2 = 0.f, a3 = 0.f, a4 = 0.f;
#pragma unroll 32
                for (int kk = 0; kk < 128; ++kk) { const float w = wp[(size_t)kk * (NMOD * DM)]; const int k = wave * 128 + kk;
                    a0 += sc[k] * w; a1 += sc[DM + k] * w; a2 += sc[2 * DM + k] * w; a3 += sc[3 * DM + k] * w; a4 += sc[4 * DM + k] * w; }
                red[(wave * 5 + 0) * 64 + lane] = a0; red[(wave * 5 + 1) * 64 + lane] = a1; red[(wave * 5 + 2) * 64 + lane] = a2; red[(wave * 5 + 3) * 64 + lane] = a3; red[(wave * 5 + 4) * 64 + lane] = a4;
                __syncthreads();
                if (tid < 320) { const int v = tid >> 6, cl = tid & 63; float s = 0.f;
#pragma unroll
                    for (int w8 = 0; w8 < 8; ++w8) s += red[(w8 * 5 + v) * 64 + cl];
                    mod[(size_t)v * (NMOD * DM) + it * 64 + cl] = s + args.in[I_BADA][it * 64 + cl]; }
                __syncthreads();
            }
        }
        if (bx == G - 1) {
            for (int i = tid; i < 2048; i += NTHR) { const int pos = i >> 4, f = i & 15; double inv = 1.0; for (int j = 0; j < f; ++j) inv *= 0.56234132519034908; const double ang = (double)pos * inv; rope[i] = (float)cos(ang); rope[2048 + i] = (float)sin(ang); }
        }
        if (bx == G - 2 && tid < 64) {
            const float* lq = args.in[I_LAMQK];
            const float s01 = wave_sum(lq[tid] * lq[64 + tid]), s23 = wave_sum(lq[128 + tid] * lq[192 + tid]);
            if (tid == 0) lamp[0] = expf(s01) - expf(s23) + 0.2f;
        }
        __syncthreads();
        LAS float* scr = (LAS float*)(L + wave * 16384);
        constexpr int I_13 = (DM / 64) * (2 * DFF / 32), I_2 = (DFF / 64) * (DM / 32);
        for (int it = gw; it < I_13 + I_2; it += NGW) {
            if (it < I_13) transpose_item<1>(args.in[I_F1W13], DM, 2 * DFF, W13A, scr, it, lane);
            else transpose_item<0>(args.in[I_F1W2], DFF, DM, W2A, scr, it - I_13, lane);
        }
    }
    if (args.pad0 != 0) GSYNC_CG();
    GSYNC();
    norm_rows<false, false, true>(gw, NGW, lane, 0, NROWS, x, ctx, nullptr, nullptr, H, mod, 0.f, nullptr, 0, normg + 0 * DM, 0);
    GSYNC();
    { pg8::Gemm g{H, W13A, NROWS, 2 * DFF, DM}; pg8::StaticOrder S; S.init(NROWS, 2 * DFF, G, bx); pg8::EpiSwiglu E{ACT, DFF};
      pg8::gemm_phase<pg8::EpiSwiglu, pg8::StaticOrder, PG8_ALIGN, PG8_SP2>(L, g, S, E); }
    {
        constexpr int NU = (NROWS / 256) * (2 * DFF / 256), NFULL = NU / 256, NREM = NU - NFULL * 256;
        static_assert(NREM > 0 && NREM < 256, "partial round");
        if (G == 256 ? bx >= NREM : true) {
            const int nhelp = (G == 256) ? (256 - NREM) : G, hid = (G == 256) ? bx - NREM : bx;
            LAS float* scr = (LAS float*)(L + wave * 16384);
            constexpr int I_13 = (DM / 64) * (2 * DFF / 32), I_2 = (DFF / 64) * (DM / 32), I_IN = (DM / 64) * (INW / 32), I_SQ = (DM / 64) * (DM / 32);
            constexpr int NITEMS = I_13 + I_2 + I_IN + 3 * I_SQ;
            for (int it = hid * NWAVES + wave; it < NITEMS; it += nhelp * NWAVES) {
                int r = it;
                if (r < I_IN) { transpose_item<2>(args.in[I_WIN], DM, INW, WIN, scr, r, lane); continue; } r -= I_IN;
                if (r < I_SQ) { transpose_item<0>(args.in[I_WAP], DM, DM, WAP, scr, r, lane); continue; } r -= I_SQ;
                if (r < I_SQ) { transpose_item<0>(args.in[I_WCP], DM, DM, WCP, scr, r, lane); continue; } r -= I_SQ;
                if (r < I_SQ) { transpose_item<0>(args.in[I_WOUT], DM, DM, WOUT, scr, r, lane); continue; } r -= I_SQ;
                if (r < I_13) { transpose_item<1>(args.in[I_F2W13], DM, 2 * DFF, W13B, scr, r, lane); continue; } r -= I_13;
                transpose_item<0>(args.in[I_F2W2], DFF, DM, W2B, scr, r, lane);
            }
        }
    }
    GSYNC();
    { pg8::Gemm g{ACT, W2A, NLAT, DM, DFF}; pg8::StaticOrder S; S.init(NLAT, DM, G, bx); pg8::EpiBf16<0> E{Y, DM, nullptr, 0, 0, 1.f};
      pg8::gemm_phase<pg8::EpiBf16<0>, pg8::StaticOrder, PG8_ALIGN, PG8_SP2>(L, g, S, E); }
    GSYNC();
    if (G == 256) {
        if (bx < 16) { pg8::Gemm g{ACT + (size_t)NLAT * DFF, W2A, NCTXR, DM, DFF}; pg8::StaticOrder S; S.init(NCTXR, DM, G, bx); pg8::EpiBf16<0> E{Y + (size_t)NLAT * DM, DM, nullptr, 0, 0, 1.f};
            pg8::gemm_phase<pg8::EpiBf16<0>, pg8::StaticOrder, PG8_ALIGN, PG8_SP2>(L, g, S, E); }
        else norm_rows<true, true, true>((bx - 16) * NWAVES + wave, (G - 16) * NWAVES, lane, 0, NLAT, x, ctx, Y, out, H, mod, 0.5f, normg + 1 * DM, 2, normg + 2 * DM, 3);
    } else {
        { pg8::Gemm g{ACT + (size_t)NLAT * DFF, W2A, NCTXR, DM, DFF}; pg8::StaticOrder S; S.init(NCTXR, DM, G, bx); pg8::EpiBf16<0> E{Y + (size_t)NLAT * DM, DM, nullptr, 0, 0, 1.f};
          pg8::gemm_phase<pg8::EpiBf16<0>, pg8::StaticOrder, PG8_ALIGN, PG8_SP2>(L, g, S, E); }
        norm_rows<true, true, true>(gw, NGW, lane, 0, NLAT, x, ctx, Y, out, H, mod, 0.5f, normg + 1 * DM, 2, normg + 2 * DM, 3);
    }
    GSYNC();
    norm_rows<true, true, true>(gw, NGW, lane, NLAT, NROWS, x, ctx, Y, out, H, mod, 0.5f, normg + 1 * DM, 2, normg + 2 * DM, 3);
    GSYNC();
    { pg8::Gemm g{H, WIN, NLAT, INW, DM}; pg8::StaticOrder S; S.init(NLAT, INW, G, bx);
      pg8::EpiWin E{Qb, Kb, Vb, Ub, GA, GB, rope, attn2::QSCALE};

      pg8::gemm_phase<pg8::EpiWin, pg8::StaticOrder, PG8_ALIGN, PG8_SP2>(L, g, S, E);
    }
    { pg8::Gemm g{H + (size_t)NLAT * DM, WIN + (size_t)1024 * DM, NCTXR, 2048, DM}; pg8::StaticOrder S; S.init(NCTXR, 2048, G, bx); pg8::EpiKVc E{Kb, Vb};
      pg8::gemm_phase<pg8::EpiKVc, pg8::StaticOrder, PG8_ALIGN, PG8_SP2>(L, g, S, E); }
    GSYNC();
    {
        const int c0 = 2 * tid;
        float w0[31], w1[31];
#pragma unroll
        for (int k = 0; k < 31; ++k) { const float2 w = *(const float2*)(args.in[I_CONVW] + k * DM + c0); w0[k] = w.x; w1[k] = w.y; }
        const float2 cb = *(const float2*)(args.in[I_CONVB] + c0), lg = *(const float2*)(args.in[I_CLNG] + c0), lb = *(const float2*)(args.in[I_CLNB] + c0);
        LAS float* red = (LAS float*)L;
        LAS float* stat = (LAS float*)(L + 2048);
        for (int item = vcu; item < NLAT / 16; item += G) {
            const int tg = item * 16, b = tg >> 13, t0 = tg & 8191;
            float a0[16], a1[16];
#pragma unroll
            for (int o = 0; o < 16; ++o) { a0[o] = 0.f; a1[o] = 0.f; }
#pragma unroll
            for (int i = 0; i < 46; ++i) {
                const int t = t0 - 15 + i; const bool valid = (t >= 0) && (t < SEQ); const int tt = valid ? t : t0;
                const unsigned wv = *(const unsigned*)(Ub + ((size_t)(b * SEQ + tt)) * DM + c0);
                const float x0 = valid ? pg8::bflo(wv) : 0.f, x1 = valid ? pg8::bfhi(wv) : 0.f;
#pragma unroll
                for (int o = 0; o < 16; ++o) { if (i - o >= 0 && i - o <= 30) { a0[o] += w0[i - o] * x0; a1[o] += w1[i - o] * x1; } }
            }
#pragma unroll
            for (int o = 0; o < 16; ++o) { a0[o] += cb.x; a1[o] += cb.y; const float s = wave_sum(a0[o] + a1[o]), ss = wave_sum(a0[o] * a0[o] + a1[o] * a1[o]);
                if (lane == 0) { red[wave * 32 + 2 * o] = s; red[wave * 32 + 2 * o + 1] = ss; } }
            __syncthreads();
            if (tid < 32) { float s = 0.f;
#pragma unroll
                for (int w8 = 0; w8 < 8; ++w8) s += red[w8 * 32 + tid];
                stat[tid] = s; }
            __syncthreads();
#pragma unroll
            for (int o = 0; o < 16; ++o) { const float mean = stat[2 * o] * (1.f / DM), var = stat[2 * o + 1] * (1.f / DM) - mean * mean, rstd = 1.0f / sqrtf(fmaxf(var, 0.f) + EPS);
                const float y0 = (a0[o] - mean) * rstd * lg.x + lb.x, y1 = (a1[o] - mean) * rstd * lg.y + lb.y;
                *(unsigned*)(UC + ((size_t)(tg + o)) * DM + c0) = pk2(pg8::fsilu(y0), pg8::fsilu(y1)); }
        }
    }
    __syncthreads();
    {
        const float lam = lamp[0];
#pragma unroll 1
        for (int un = vcu; un < NB * 8 * (SEQ / 256); un += G) {
            const int qb = un & 31, bh = (un >> 8) * 8 + ((un & 255) >> 5), b = bh >> 3, h = bh & 7;
            const size_t qrow0 = (size_t)b * SEQ + (size_t)qb * 256;
            const bf16* kbase = Kb + (size_t)b * NKEYS * DM; const bf16* vbase = Vb + (size_t)b * NKEYS * DM + h * 128;
            attn2::body<0>(Qb + qrow0 * DM + (2 * h) * 64, kbase + (2 * h) * 64, vbase, NKEYS, (char*)lds, lam, args.in[I_SUBLN], nullptr);
            attn2::body<1>(Qb + qrow0 * DM + (2 * h + 1) * 64, kbase + (2 * h + 1) * 64, vbase, NKEYS, (char*)lds, lam, args.in[I_SUBLN], Qb + qrow0 * DM + h * 128);
        }
    }
    GSYNC();
    { pg8::Gemm g{Qb, WAP, NLAT, DM, DM}; pg8::StaticOrder S; S.init(NLAT, DM, G, bx); pg8::EpiGate<false> E{Zb, GA};
      pg8::gemm_phase<pg8::EpiGate<false>, pg8::StaticOrder, PG8_ALIGN, PG8_SP2>(L, g, S, E); }
    asm volatile("s_waitcnt vmcnt(0)" ::: "memory");
    { pg8::Gemm g{UC, WCP, NLAT, DM, DM}; pg8::StaticOrder S; S.init(NLAT, DM, G, bx); pg8::EpiGate<true> E{Zb, GB};
      pg8::gemm_phase<pg8::EpiGate<true>, pg8::StaticOrder, PG8_ALIGN, PG8_SP2>(L, g, S, E); }
    GSYNC();
    { pg8::Gemm g{Zb, WOUT, NLAT, DM, DM}; pg8::StaticOrder S; S.init(NLAT, DM, G, bx); pg8::EpiBf16<0> E{Y, DM, nullptr, 0, 0, 1.f};
      pg8::gemm_phase<pg8::EpiBf16<0>, pg8::StaticOrder, PG8_ALIGN, PG8_SP2>(L, g, S, E);
    }
    GSYNC();
    norm_rows<true, true, true>(gw, NGW, lane, 0, NLAT, out, ctx, Y, out, H, mod, 1.0f, normg + 3 * DM, 5, normg + 4 * DM, 6);
    GSYNC();
    { pg8::Gemm g{H, W13B, NLAT, 2 * DFF, DM}; pg8::StaticOrder S; S.init(NLAT, 2 * DFF, G, bx); pg8::EpiSwiglu E{ACT, DFF};
      pg8::gemm_phase<pg8::EpiSwiglu, pg8::StaticOrder, PG8_ALIGN, PG8_SP2>(L, g, S, E);
    }
    GSYNC();
    { pg8::Gemm g{ACT, W2B, NLAT, DM, DFF}; pg8::StaticOrder S; S.init(NLAT, DM, G, bx); pg8::EpiBf16<0> E{Y, DM, nullptr, 0, 0, 1.f};
      pg8::gemm_phase<pg8::EpiBf16<0>, pg8::StaticOrder, PG8_ALIGN, PG8_SP2>(L, g, S, E);
    }
    GSYNC();
    norm_rows<true, true, false>(gw, NGW, lane, 0, NLAT, out, ctx, Y, out, nullptr, mod, 0.5f, normg + 5 * DM, 8, nullptr, 0);
}

extern "C" void kernel_launch(void* const* d_in, const int* in_sizes, int n_in, void* d_out, int out_size, void* d_ws, size_t ws_size, hipStream_t stream) {
    static int grid = 0;
    if (grid == 0) {
        if (n_in != 21 || ws_size < WS_END || out_size != NLAT * DM) { fprintf(stderr, "kernel_launch: unexpected shapes (n_in %d, out %d, ws %zu)\n", n_in, out_size, ws_size); grid = -1; return; }
        int dev = 0, cus = 0, per_cu = 0;
        if (hipGetDevice(&dev) != hipSuccess || hipDeviceGetAttribute(&cus, hipDeviceAttributeMultiprocessorCount, dev) != hipSuccess) { grid = -1; return; }
        if (hipFuncSetAttribute((const void*)fwd_mega, hipFuncAttributeMaxDynamicSharedMemorySize, LDS_BYTES) != hipSuccess) { fprintf(stderr, "kernel_launch: hipFuncSetAttribute failed\n"); grid = -1; return; }
        if (hipOccupancyMaxActiveBlocksPerMultiprocessor(&per_cu, (const void*)fwd_mega, NTHR, LDS_BYTES) != hipSuccess || per_cu < 1) fprintf(stderr, "kernel_launch: occupancy query says %d\n", per_cu);
        (void)hipGetLastError();
        grid = cus;
    }
    if (grid < 0) return;
    if (hipMemsetAsync(d_ws, 0, 16384, stream) != hipSuccess) { fprintf(stderr, "kernel_launch: memset of the barrier words failed\n"); return; }
    Args a{};
    for (int i = 0; i < 21; ++i) a.in[i] = (const float*)d_in[i];
    a.out = (float*)d_out; a.ws = (unsigned char*)d_ws;
    void* kargs[] = {&a};
    const hipError_t e = hipLaunchCooperativeKernel((const void*)fwd_mega, dim3(grid), dim3(NTHR), kargs, LDS_BYTES, stream);
    if (e != hipSuccess) fprintf(stderr, "cooperative launch failed: %s (grid %d)\n", hipGetErrorString(e), grid);
}
```

```cpp
#include <hip/hip_runtime.h>
#include <hip/hip_cooperative_groups.h>
#include <cstdio>
#include <cstdint>
namespace cg = cooperative_groups;
namespace pg8 {
#define PG8_LAS __attribute__((address_space(3)))
typedef unsigned short bf16_t;
typedef short bf16x8 __attribute__((ext_vector_type(8)));
typedef float f32x4 __attribute__((ext_vector_type(4)));
typedef unsigned u32x4 __attribute__((ext_vector_type(4)));
constexpr int BM = 256, BK = 64, HALF = 128, HTB = HALF * BK * 2  , STAGE_BYTES = 8 * HTB, NXCD = 8, WGM = 8;

__host__ __device__ __forceinline__ int lds_byte(int r, int c) { const int st = (r >> 4) * 2 + (c >> 5), rr = r & 15, cc = c & 31, ob = rr * 64 + cc * 2; return st * 1024 + (ob ^ (((ob >> 9) & 1) << 5)); }
__host__ __device__ __forceinline__ void stage_rc(int b, int& R, int& C) { const int st = b / 1024, sb = b % 1024, swz = sb ^ (((sb >> 9) & 1) << 5); R = (st >> 1) * 16 + swz / 64; C = (st & 1) * 32 + (swz % 64) / 2; }
__host__ __device__ __forceinline__ int perm32(int rho) { const int n = rho >> 4, i = rho & 15; return 8 * (i >> 2) + 4 * n + (i & 3); }

struct Unit { int pm, pn; };
struct Gemm { const bf16_t* A; const bf16_t* Bt; int M, N, K; };

struct StaticOrder {
    int nM, nN, nwg, G, c;
    __host__ __device__ void init(int M, int N, int G_, int c_) { nM = M / BM; nN = N / BM; nwg = nM * nN; G = G_; c = c_; }
    __host__ __device__ bool next(int i, Unit& u) const {
        const long L = (long)i * G + c; if (L >= nwg) return false;
        int wgid = (int)L; { const int q = nwg / NXCD, r = nwg % NXCD, xcd = wgid % NXCD, off = wgid / NXCD; wgid = (xcd < r ? xcd * (q + 1) : r * (q + 1) + (xcd - r) * q) + off; }
        const int nig = WGM * nN, gid = wgid / nig, fm = gid * WGM, gsz = (nM - fm) < WGM ? (nM - fm) : WGM;
        u.pm = fm + ((wgid % nig) % gsz); u.pn = (wgid % nig) / gsz; return true;
    }
    __device__ __forceinline__ void a_ready(const Unit&) const {}
    __device__ __forceinline__ void done(const Unit&) const {}
};

typedef float f32x2c_t __attribute__((ext_vector_type(2))); typedef __bf16 bf16x2c_t __attribute__((ext_vector_type(2)));
__device__ __forceinline__ unsigned cvt_pk_bf16(float lo, float hi) { f32x2c_t v = {lo, hi}; bf16x2c_t b = __builtin_convertvector(v, bf16x2c_t); return __builtin_bit_cast(unsigned, b); }
typedef float f32x2 __attribute__((ext_vector_type(2)));
__device__ __forceinline__ f32x2 gelu_pk(f32x2 v) {
    const f32x2 av = __builtin_elementwise_abs(v), d = av * 0.2316418882f + 1.0f;
    f32x2 t; t.x = __builtin_amdgcn_rcpf(d.x); t.y = __builtin_amdgcn_rcpf(d.y);
    f32x2 q = t * 0.5307027145f + (-0.7265760135f); q = q * t + 0.7107068705f; q = q * t + (-0.142248368f); q = q * t + 0.127414796f; q = q * t;
    const f32x2 s = (v * v) * (-0.72134752044f);
    f32x2 e; e.x = __builtin_amdgcn_exp2f(s.x); e.y = __builtin_amdgcn_exp2f(s.y);
    const f32x2 m = v * (q * e), r = v - m;
    f32x2 o; o.x = v.x < 0.f ? m.x : r.x; o.y = v.y < 0.f ? m.y : r.y; return o;
}

template <int ACT  > struct EpiBf16 {
    static constexpr bool PERM = true, AFTER_DRAIN = false; static_assert(ACT == 0 || ACT == 1, "EpiBf16: ACT is 0 (none) or 1 (gelu_pk)");
    bf16_t* O; int ldc; const float* bias; int split_cols; size_t split_stride; float scale0;
    __device__ __forceinline__ void operator()(const f32x4 (&acc)[2][2][4][2], const Unit& u, int wr, int wc, int fr, int fq) const {
        const int row0 = u.pm * BM + wr * 64 + fr; int colt = u.pn * BM; bf16_t* base = O;
        float sc = 1.f; if (split_cols) { const int t = colt / split_cols; base += (size_t)t * split_stride; colt -= t * split_cols; if (t == 0) sc = scale0; }
        const int col0 = colt + wc * 32 + 8 * fq, bcol0 = u.pn * BM + wc * 32 + 8 * fq;
        f32x4 bv[2][2];
#pragma unroll
        for (int bj = 0; bj < 2; ++bj)
#pragma unroll
            for (int n = 0; n < 2; ++n) bv[bj][n] = bias ? *(const f32x4*)(bias + bcol0 + bj * HALF + 4 * n) : (f32x4){0.f, 0.f, 0.f, 0.f};
#pragma unroll
        for (int ai = 0; ai < 2; ++ai)
#pragma unroll
            for (int m = 0; m < 4; ++m) { bf16_t* rowp = base + (size_t)(row0 + ai * HALF + m * 16) * ldc + col0;
#pragma unroll
                for (int bj = 0; bj < 2; ++bj) { f32x4 v0 = acc[ai][bj][m][0] + bv[bj][0], v1 = acc[ai][bj][m][1] + bv[bj][1];
                    if (ACT == 1) { f32x2 a = gelu_pk((f32x2){v0[0], v0[1]}), b = gelu_pk((f32x2){v0[2], v0[3]}), c = gelu_pk((f32x2){v1[0], v1[1]}), d = gelu_pk((f32x2){v1[2], v1[3]});
                        v0 = (f32x4){a.x, a.y, b.x, b.y}; v1 = (f32x4){c.x, c.y, d.x, d.y}; }
                    v0 = v0 * sc; v1 = v1 * sc; u32x4 w; w.x = cvt_pk_bf16(v0[0], v0[1]); w.y = cvt_pk_bf16(v0[2], v0[3]); w.z = cvt_pk_bf16(v1[0], v1[1]); w.w = cvt_pk_bf16(v1[2], v1[3]);
                    *(u32x4*)(rowp + bj * HALF) = w; } }
    }
};
template <class Epi, class Sched, bool ALIGN_EPI = false, bool SP2 = false>
__device__ __forceinline__ void gemm_phase(PG8_LAS unsigned char* lds, const Gemm g, const Sched& S, const Epi& E) {
    int tid_ = threadIdx.x; asm volatile("" : "+v"(tid_));
    const int tid = tid_, wid = __builtin_amdgcn_readfirstlane(tid >> 6), lane = tid & 63, wr = wid >> 2, wc = wid & 3, fr = lane & 15, fq = lane >> 4;
    const int K = g.K, nt = K / BK;
    unsigned voffA[2], voffB[2];
#pragma unroll
    for (int i = 0; i < 2; ++i) { int R, C; stage_rc(tid * 16 + i * 8192, R, C); const int Rb = Epi::PERM ? ((R & ~31) + perm32(R & 31)) : R;
        voffA[i] = (unsigned)(R * K + C) * 2u; voffB[i] = (unsigned)(Rb * K + C) * 2u; }
    const size_t kstep = (size_t)(BK * 2);
    const size_t hstep = (size_t)HALF * K * 2;
    const size_t tstep = 2 * hstep;
    const unsigned ldsw = (unsigned)wid * 1024u;
    const int aoff = lds_byte(wr * 64 + fr, fq * 8), boff = lds_byte(wc * 32 + fr, fq * 8);
#define PG8_SA(b, h) (((b) * 2 + (h)) * HTB)
#define PG8_SB(b, h) ((4 + (b) * 2 + (h)) * HTB)
#define PG8_STAGE(bufoff, gbase, voff) do { _Pragma("unroll") for (int _i = 0; _i < 2; ++_i) \
        __builtin_amdgcn_global_load_lds((const unsigned*)((const char*)(gbase) + (voff)[_i]), (PG8_LAS unsigned*)(lds + (bufoff) + ldsw + _i * 8192), 16, 0, 0); } while (0)
#define PG8_LDA(dst, b, h) do { _Pragma("unroll") for (int m = 0; m < 4; ++m) _Pragma("unroll") for (int k = 0; k < 2; ++k) dst[m][k] = *(const PG8_LAS bf16x8*)(lds + PG8_SA(b, h) + aoff + m * 2048 + k * 1024); } while (0)
#define PG8_LDB(dst, b, h) do { _Pragma("unroll") for (int n = 0; n < 2; ++n) _Pragma("unroll") for (int k = 0; k < 2; ++k) dst[n][k] = *(const PG8_LAS bf16x8*)(lds + PG8_SB(b, h) + boff + n * 2048 + k * 1024); } while (0)
#define PG8_MMA(ai, bj, At, Bt) do { __builtin_amdgcn_s_setprio(1); _Pragma("unroll") for (int m = 0; m < 4; ++m) _Pragma("unroll") for (int n = 0; n < 2; ++n) _Pragma("unroll") for (int k = 0; k < 2; ++k) \
        acc[ai][bj][m][n] = __builtin_amdgcn_mfma_f32_16x16x32_bf16(Bt[n][k], At[m][k], acc[ai][bj][m][n], 0, 0, 0); __builtin_amdgcn_s_setprio(0); } while (0)
#define PG8_WAIT_V(n) asm volatile("s_waitcnt vmcnt(" #n ")" ::: "memory")
#define PG8_WAIT_L(n) asm volatile("s_waitcnt lgkmcnt(" #n ")" ::: "memory")
#define PG8_BAR __builtin_amdgcn_s_barrier()
#define PG8_SCHED __builtin_amdgcn_sched_barrier(0)
    Unit cur, nxt; int ui = 0;
    if (!S.next(0, cur)) return;
    f32x4 acc[2][2][4][2];
#pragma unroll
    for (int a = 0; a < 2; ++a)
#pragma unroll
        for (int b = 0; b < 2; ++b)
#pragma unroll
            for (int m = 0; m < 4; ++m)
#pragma unroll
                for (int n = 0; n < 2; ++n) acc[a][b][m][n] = (f32x4){0.f, 0.f, 0.f, 0.f};
    bf16x8 At[4][2], B0[2][2], B1[2][2];
    const char* cA = (const char*)g.A + (size_t)cur.pm * tstep; const char* cB = (const char*)g.Bt + (size_t)cur.pn * tstep;
    S.a_ready(cur);
    if constexpr (SP2) {
        PG8_STAGE(PG8_SB(0, 0), cB, voffB); PG8_STAGE(PG8_SB(0, 1), cB + hstep, voffB); PG8_STAGE(PG8_SA(0, 0), cA, voffA); PG8_STAGE(PG8_SA(0, 1), cA + hstep, voffA);
        if (wr == 1) PG8_BAR;
        PG8_WAIT_V(2); PG8_BAR;
        PG8_STAGE(PG8_SB(1, 0), cB + kstep, voffB); PG8_STAGE(PG8_SA(1, 0), cA + kstep, voffA); PG8_STAGE(PG8_SB(1, 1), cB + hstep + kstep, voffB);
        PG8_WAIT_V(6); PG8_BAR;
    } else {
        PG8_STAGE(PG8_SB(0, 0), cB, voffB); PG8_STAGE(PG8_SA(0, 0), cA, voffA); PG8_STAGE(PG8_SB(0, 1), cB + hstep, voffB); PG8_STAGE(PG8_SA(0, 1), cA + hstep, voffA);
        if (wr == 1) PG8_BAR;
        PG8_WAIT_V(4); PG8_BAR;
        PG8_STAGE(PG8_SB(1, 0), cB + kstep, voffB); PG8_STAGE(PG8_SA(1, 0), cA + kstep, voffA); PG8_STAGE(PG8_SB(1, 1), cB + hstep + kstep, voffB);
        PG8_WAIT_V(6); PG8_BAR;
    }
    for (;;) {
        const bool has_next = S.next(ui + 1, nxt);
        const char* nA = has_next ? (const char*)g.A + (size_t)nxt.pm * tstep : cA; const char* nB = has_next ? (const char*)g.Bt + (size_t)nxt.pn * tstep : cB;
        for (int t = 0; t < nt; t += 2) {
            const bool last = (t == nt - 2);
            const char* a1 = cA + (size_t)(t + 1) * kstep;
            const char* a2 = last ? nA : cA + (size_t)(t + 2) * kstep; const char* b2 = last ? nB : cB + (size_t)(t + 2) * kstep;
            const char* a3 = a2 + kstep; const char* b3 = b2 + kstep;
            if (last && has_next) S.a_ready(nxt);
            if constexpr (SP2) {
            PG8_LDB(B0, 0, 0); PG8_LDB(B1, 0, 1); PG8_SCHED; PG8_LDA(At, 0, 0); PG8_STAGE(PG8_SA(1, 1), a1 + hstep, voffA);
            PG8_WAIT_V(8); PG8_WAIT_L(0); PG8_BAR; PG8_MMA(0, 0, At, B0); PG8_MMA(0, 1, At, B1); PG8_BAR; PG8_SCHED;
            PG8_LDA(At, 0, 1); PG8_STAGE(PG8_SB(0, 0), b2, voffB); PG8_STAGE(PG8_SB(0, 1), b2 + hstep, voffB); PG8_STAGE(PG8_SA(0, 0), a2, voffA);
            PG8_WAIT_V(8); PG8_WAIT_L(0); PG8_BAR; PG8_MMA(1, 0, At, B0); PG8_MMA(1, 1, At, B1); PG8_BAR; PG8_SCHED;
            PG8_LDB(B0, 1, 0); PG8_LDB(B1, 1, 1); PG8_SCHED; PG8_LDA(At, 1, 0); PG8_STAGE(PG8_SA(0, 1), a2 + hstep, voffA);
            PG8_WAIT_V(8); PG8_WAIT_L(0); PG8_BAR; PG8_MMA(0, 0, At, B0); PG8_MMA(0, 1, At, B1); PG8_BAR; PG8_SCHED;
            PG8_LDA(At, 1, 1); PG8_STAGE(PG8_SB(1, 0), b3, voffB); PG8_STAGE(PG8_SB(1, 1), b3 + hstep, voffB); PG8_STAGE(PG8_SA(1, 0), a3, voffA);
            PG8_WAIT_V(8); PG8_WAIT_L(0); PG8_BAR; PG8_MMA(1, 0, At, B0); PG8_MMA(1, 1, At, B1); PG8_BAR; PG8_SCHED;
            } else {
            PG8_LDB(B0, 0, 0); PG8_SCHED; PG8_LDA(At, 0, 0); PG8_STAGE(PG8_SA(1, 1), a1 + hstep, voffA);
            PG8_WAIT_L(8); PG8_BAR; PG8_WAIT_L(0); PG8_MMA(0, 0, At, B0); PG8_BAR; PG8_SCHED;
            PG8_LDB(B1, 0, 1); PG8_STAGE(PG8_SB(0, 0), b2, voffB);
            PG8_BAR; PG8_WAIT_L(0); PG8_MMA(0, 1, At, B1); PG8_BAR;
            PG8_LDA(At, 0, 1); PG8_STAGE(PG8_SA(0, 0), a2, voffA);
            PG8_BAR; PG8_WAIT_L(0); PG8_MMA(1, 0, At, B0); PG8_BAR; PG8_SCHED;
            PG8_STAGE(PG8_SB(0, 1), b2 + hstep, voffB);
            PG8_WAIT_V(6); PG8_BAR; PG8_MMA(1, 1, At, B1); PG8_BAR;
            PG8_LDB(B0, 1, 0); PG8_SCHED; PG8_LDA(At, 1, 0); PG8_STAGE(PG8_SA(0, 1), a2 + hstep, voffA);
            PG8_WAIT_L(8); PG8_BAR; PG8_WAIT_L(0); PG8_MMA(0, 0, At, B0); PG8_BAR; PG8_SCHED;
            PG8_LDB(B1, 1, 1); PG8_STAGE(PG8_SB(1, 0), b3, voffB);
            PG8_BAR; PG8_WAIT_L(0); PG8_MMA(0, 1, At, B1); PG8_BAR;
            PG8_LDA(At, 1, 1); PG8_STAGE(PG8_SA(1, 0), a3, voffA);
            PG8_BAR; PG8_WAIT_L(0); PG8_MMA(1, 0, At, B0); PG8_BAR; PG8_SCHED;
            PG8_STAGE(PG8_SB(1, 1), b3 + hstep, voffB);
            PG8_WAIT_V(6); PG8_BAR; PG8_MMA(1, 1, At, B1); PG8_BAR;
            }
        }
        if constexpr (ALIGN_EPI) { if (wr == 0) PG8_BAR; }
        if constexpr (!Epi::AFTER_DRAIN) { E(acc, cur, wr, wc, fr, fq); S.done(cur); }
        if (!has_next) break;
#pragma unroll
        for (int a = 0; a < 2; ++a)
#pragma unroll
            for (int b = 0; b < 2; ++b)
#pragma unroll
                for (int m = 0; m < 4; ++m)
#pragma unroll
                    for (int n = 0; n < 2; ++n) acc[a][b][m][n] = (f32x4){0.f, 0.f, 0.f, 0.f};
        cur = nxt; cA = nA; cB = nB; ++ui;
        if constexpr (ALIGN_EPI) { if (wr == 1) PG8_BAR; }
    }
    PG8_WAIT_V(0);
    if constexpr (!ALIGN_EPI) { if (wr == 0) PG8_BAR; }
    PG8_BAR;
    if constexpr (Epi::AFTER_DRAIN) { E.fused(acc, cur, wr, wc, fr, fq, lds, wid, lane); S.done(cur); }
#undef PG8_SA
#undef PG8_SB
#undef PG8_STAGE
#undef PG8_LDA
#undef PG8_LDB
#undef PG8_MMA
#undef PG8_WAIT_V
#undef PG8_WAIT_L
#undef PG8_BAR
#undef PG8_SCHED
}
}

#ifndef PG8_SP2
#define PG8_SP2 true
#endif
#ifndef PG8_ALIGN
#define PG8_ALIGN true
#endif
#include <hip/hip_bf16.h>
#include <cmath>
namespace attn2 {
using bf16x8 = __attribute__((ext_vector_type(8))) short;
using s16x4  = __attribute__((ext_vector_type(4))) short;
using f32x16 = __attribute__((ext_vector_type(16))) float;
using u32x4  = __attribute__((ext_vector_type(4))) unsigned;
typedef unsigned short bf16r;
constexpr int DQ = 64, DV = 128, NW = 8, QBLK = 32, KVBLK = 64, LD = 1024;
constexpr float SCALE = 0.125f, THR = 8.f, QSCALE = SCALE * 1.4426950408889634f;
#ifndef A2_FORCE_REF
#define A2_FORCE_REF 0
#endif
constexpr size_t SHM_V = KVBLK * DV * 2, SHM_K = KVBLK * DQ * 2, SHM_ATTN = 3 * SHM_V + 3 * SHM_K + NW * 64 * 4;
constexpr size_t PARK_OFF = SHM_ATTN, PARK_BYTES = NW * 2048 * 4;
#define A2_KSWZ(row, colB) ((row) * 128 + ((colB) ^ ((((row) >> 1) & 7) << 4)))
#define A2_SBAR() __builtin_amdgcn_sched_barrier(0)
__device__ __forceinline__ int crow(int r, int hi) { return (r & 3) + 8 * (r >> 2) + 4 * hi; }
typedef float f32x2_t __attribute__((ext_vector_type(2))); typedef __bf16 bf16x2_t __attribute__((ext_vector_type(2)));
__device__ __forceinline__ unsigned cvtpk(float lo, float hi) { f32x2_t v = {lo, hi}; bf16x2_t b = __builtin_convertvector(v, bf16x2_t); return __builtin_bit_cast(unsigned, b); }

__device__ __forceinline__ void partialSM0(f32x16& p0, f32x16& p1, float& m_reg, bool& refz) {
  float pmax = p0[0];
#pragma unroll
  for (int r = 1; r < 16; ++r) pmax = fmaxf(pmax, p0[r]);
#pragma unroll
  for (int r = 0; r < 16; ++r) pmax = fmaxf(pmax, p1[r]);
  { auto rr = __builtin_amdgcn_permlane32_swap(__float_as_uint(pmax), __float_as_uint(pmax), false, false);
    pmax = fmaxf(__uint_as_float(rr[0]), __uint_as_float(rr[1])); }
  refz = (A2_FORCE_REF == 0) && __all(fabsf(pmax) < 64.f);
  m_reg = refz ? 0.f : pmax;
  if (!refz) {
#pragma unroll
    for (int r = 0; r < 16; ++r) { p0[r] -= m_reg; p1[r] -= m_reg; }
  }
#pragma unroll
  for (int r = 0; r < 16; ++r) p0[r] = __builtin_amdgcn_exp2f(p0[r]);
}
constexpr float LAZY_BIG = 1073741824.f;
__device__ __forceinline__ void finishSM(f32x16& p0, f32x16& p1, float& m_reg, bool& refz, float& alpha, float& l_reg, bf16x8& pa0, bf16x8& pa1, bf16x8& pa2, bf16x8& pa3) {
#pragma unroll
  for (int r = 0; r < 16; ++r) p1[r] = __builtin_amdgcn_exp2f(p1[r]);
  f32x2_t sv = {p0[0], p0[1]};
#pragma unroll
  for (int i = 1; i < 8; ++i) sv += (f32x2_t){p0[2 * i], p0[2 * i + 1]};
#pragma unroll
  for (int i = 0; i < 8; ++i) sv += (f32x2_t){p1[2 * i], p1[2 * i + 1]};
  float ps = sv.x + sv.y;
  alpha = 1.f;
  if (__builtin_expect(__any(!(ps <= LAZY_BIG)), 0)) {
    auto rr = __builtin_amdgcn_permlane32_swap(__float_as_uint(ps), __float_as_uint(ps), false, false);
    const float pt = __uint_as_float(rr[0]) + __uint_as_float(rr[1]);
    const float dl = (pt > LAZY_BIG) ? floorf(__log2f(pt)) + 1.f : 0.f;
    alpha = __builtin_amdgcn_exp2f(-dl); m_reg += dl; refz = false;
#pragma unroll
    for (int r = 0; r < 16; ++r) { p0[r] *= alpha; p1[r] *= alpha; }
    ps *= alpha;
  }
  l_reg = l_reg * alpha + ps; asm volatile("" : "+v"(l_reg));
#define A2_PK8(P, BASE, OUT) do { u32x4 w = {cvtpk(P[BASE + 0], P[BASE + 1]), cvtpk(P[BASE + 2], P[BASE + 3]), cvtpk(P[BASE + 4], P[BASE + 5]), cvtpk(P[BASE + 6], P[BASE + 7])}; OUT = *reinterpret_cast<bf16x8*>(&w); } while (0)
  A2_PK8(p0, 0, pa0); A2_PK8(p0, 8, pa1); A2_PK8(p1, 0, pa2); A2_PK8(p1, 8, pa3);
#undef A2_PK8
}
__device__ __forceinline__ void qkt(f32x16& p0, f32x16& p1, const char* Ks, const bf16x8* qr, int r32, int hi) {
  p0 = f32x16{}; p1 = f32x16{};
#pragma unroll
  for (int d0 = 0; d0 < 4; ++d0) { const int cb = (d0 * 16 + hi * 8) * 2;
    const bf16x8 b0 = *reinterpret_cast<const bf16x8*>(Ks + A2_KSWZ(r32, cb));
    const bf16x8 b1 = *reinterpret_cast<const bf16x8*>(Ks + A2_KSWZ(32 + r32, cb));
    p0 = __builtin_amdgcn_mfma_f32_32x32x16_bf16(b0, qr[d0], p0, 0, 0, 0);
    p1 = __builtin_amdgcn_mfma_f32_32x32x16_bf16(b1, qr[d0], p1, 0, 0, 0); }
}
__device__ __forceinline__ int v_st(int k, int c) { const int kk = k;     return ((kk >> 3) * 4 + (c >> 5)) * 512 + ((kk & 7) * 32 + (c & 31)) * 2; }
__device__ __forceinline__ int v_rd_base(int lane) { return ((lane & 3) << 3) | (((lane >> 2) & 3) << 6) | (((lane >> 4) & 1) << 5) | (((lane >> 5) & 1) << 8); }
constexpr int v_rd_off(int d0, int ks, int half) { return d0 * 512 + ks * 4096 + half * 2048; }
template <int OFF> __device__ __forceinline__ s16x4 tr_read(int vb) {
  s16x4 r; asm volatile("ds_read_b64_tr_b16 %0, %1 offset:%2" : "=&v"(r) : "v"(vb), "i"(OFF) : "memory"); return r;
}
template <int D0> __device__ __forceinline__ void pv_one(f32x16& od, int vb, bf16x8 pa0, bf16x8 pa1, bf16x8 pa2, bf16x8 pa3) {
  const s16x4 l0 = tr_read<v_rd_off(D0, 0, 0)>(vb), h0 = tr_read<v_rd_off(D0, 0, 1)>(vb), l1 = tr_read<v_rd_off(D0, 1, 0)>(vb), h1 = tr_read<v_rd_off(D0, 1, 1)>(vb);
  const s16x4 l2 = tr_read<v_rd_off(D0, 2, 0)>(vb), h2 = tr_read<v_rd_off(D0, 2, 1)>(vb), l3 = tr_read<v_rd_off(D0, 3, 0)>(vb), h3 = tr_read<v_rd_off(D0, 3, 1)>(vb);
  asm volatile("s_waitcnt lgkmcnt(0)" ::: "memory"); A2_SBAR();
#define A2_PK(L, H) (bf16x8){L[0], L[1], L[2], L[3], H[0], H[1], H[2], H[3]}
  od = __builtin_amdgcn_mfma_f32_32x32x16_bf16(pa0, A2_PK(l0, h0), od, 0, 0, 0);
  od = __builtin_amdgcn_mfma_f32_32x32x16_bf16(pa1, A2_PK(l1, h1), od, 0, 0, 0);
  od = __builtin_amdgcn_mfma_f32_32x32x16_bf16(pa2, A2_PK(l2, h2), od, 0, 0, 0);
  od = __builtin_amdgcn_mfma_f32_32x32x16_bf16(pa3, A2_PK(l3, h3), od, 0, 0, 0);
#undef A2_PK
}
__device__ __forceinline__ void pv_d0(f32x16* o, int vb, bf16x8 pa0, bf16x8 pa1, bf16x8 pa2, bf16x8 pa3) {
  pv_one<0>(o[0], vb, pa0, pa1, pa2, pa3); pv_one<1>(o[1], vb, pa0, pa1, pa2, pa3); pv_one<2>(o[2], vb, pa0, pa1, pa2, pa3); pv_one<3>(o[3], vb, pa0, pa1, pa2, pa3);
}

struct VF { s16x4 l0, h0, l1, h1, l2, h2, l3, h3; };
template <int D0> __device__ __forceinline__ VF vread(int vb) { VF f;
  f.l0 = tr_read<v_rd_off(D0, 0, 0)>(vb); f.h0 = tr_read<v_rd_off(D0, 0, 1)>(vb); f.l1 = tr_read<v_rd_off(D0, 1, 0)>(vb); f.h1 = tr_read<v_rd_off(D0, 1, 1)>(vb);
  f.l2 = tr_read<v_rd_off(D0, 2, 0)>(vb); f.h2 = tr_read<v_rd_off(D0, 2, 1)>(vb); f.l3 = tr_read<v_rd_off(D0, 3, 0)>(vb); f.h3 = tr_read<v_rd_off(D0, 3, 1)>(vb); return f; }
__device__ __forceinline__ void mfma4(f32x16& od, const VF& f, bf16x8 pa0, bf16x8 pa1, bf16x8 pa2, bf16x8 pa3) {
#define A2_PK(L, H) (bf16x8){L[0], L[1], L[2], L[3], H[0], H[1], H[2], H[3]}
  od = __builtin_amdgcn_mfma_f32_32x32x16_bf16(pa0, A2_PK(f.l0, f.h0), od, 0, 0, 0);
  od = __builtin_amdgcn_mfma_f32_32x32x16_bf16(pa1, A2_PK(f.l1, f.h1), od, 0, 0, 0);
  od = __builtin_amdgcn_mfma_f32_32x32x16_bf16(pa2, A2_PK(f.l2, f.h2), od, 0, 0, 0);
  od = __builtin_amdgcn_mfma_f32_32x32x16_bf16(pa3, A2_PK(f.l3, f.h3), od, 0, 0, 0);
#undef A2_PK
}
#define A2_LWAIT(n) do { asm volatile("s_waitcnt lgkmcnt(" #n ")" ::: "memory"); A2_SBAR(); } while (0)
__device__ __forceinline__ void pv_psm(f32x16* o, int vb, bf16x8 pa0, bf16x8 pa1, bf16x8 pa2, bf16x8 pa3, f32x16& p0, f32x16& p1, float m_reg, bool refz) {
  const VF f0 = vread<0>(vb);
  const VF f1 = vread<1>(vb);
  if (!refz) {
#pragma unroll
    for (int r = 0; r < 16; ++r) { p0[r] -= m_reg; p1[r] -= m_reg; }
  }
#pragma unroll
  for (int r = 0; r < 8; ++r) p0[r] = __builtin_amdgcn_exp2f(p0[r]);
  asm volatile("" : "+v"(p0));
  A2_LWAIT(8); mfma4(o[0], f0, pa0, pa1, pa2, pa3);
  const VF f2 = vread<2>(vb); A2_LWAIT(8); mfma4(o[1], f1, pa0, pa1, pa2, pa3);
#pragma unroll
  for (int r = 8; r < 11; ++r) p0[r] = __builtin_amdgcn_exp2f(p0[r]);
  asm volatile("" : "+v"(p0));
  const VF f3 = vread<3>(vb); A2_LWAIT(8); mfma4(o[2], f2, pa0, pa1, pa2, pa3);
#pragma unroll
  for (int r = 11; r < 14; ++r) p0[r] = __builtin_amdgcn_exp2f(p0[r]);
  asm volatile("" : "+v"(p0));
  A2_LWAIT(0); mfma4(o[3], f3, pa0, pa1, pa2, pa3);
#pragma unroll
  for (int r = 14; r < 16; ++r) p0[r] = __builtin_amdgcn_exp2f(p0[r]);
  asm volatile("" : "+v"(p0)); A2_SBAR();
}
template <int PASS>
__device__ __forceinline__ void body(const bf16r* Qb, const bf16r* Kh, const bf16r* Vh, int seq, char* lds, float lam, const float* subln, bf16r* Ob) {
  int tid_ = threadIdx.x; asm volatile("" : "+v"(tid_));
  const int tid = tid_, wid = tid >> 6, lane = tid & 63, r32 = lane & 31, hi = lane >> 5;
  char* V_lds = lds; char* K_lds = lds + 3 * SHM_V;
  float* ws = (float*)(lds + 3 * SHM_V + 3 * SHM_K) + wid * 64; float* li_l = ws; float* al_l = ws + 32;
  float m_reg = 0.f, l_reg = 0; f32x16 o[4] = {}; bf16x8 qr[4];
  const bf16r* Qw = Qb + (long)(wid * QBLK + r32) * LD + hi * 8;
#pragma unroll
  for (int d0 = 0; d0 < 4; ++d0) qr[d0] = *reinterpret_cast<const bf16x8*>(Qw + d0 * 16);
  const int sr = tid >> 4, sc = (tid & 15) * 8, vst0 = v_st(sr, sc), vst1 = v_st(32 + sr, sc);
  const int kr = tid >> 3, kc = (tid & 7) * 8, kst = A2_KSWZ(kr, kc * 2);
  const int vb0 = (int)(uintptr_t)V_lds + v_rd_base(lane);
  struct { bf16x8 vs0, vs1, ks0; } sr_[2];
#define A2_SLOAD(i, k0) do { sr_[i].vs0 = *reinterpret_cast<const bf16x8*>(&Vh[(long)((k0) + sr) * LD + sc]); sr_[i].vs1 = *reinterpret_cast<const bf16x8*>(&Vh[(long)((k0) + 32 + sr) * LD + sc]); \
    sr_[i].ks0 = *reinterpret_cast<const bf16x8*>(&Kh[(long)((k0) + kr) * LD + kc]); } while (0)
#define A2_SWRITE(b, i) do { *(bf16x8*)(V_lds + (b) * SHM_V + vst0) = sr_[i].vs0; *(bf16x8*)(V_lds + (b) * SHM_V + vst1) = sr_[i].vs1; *(bf16x8*)(K_lds + (b) * SHM_K + kst) = sr_[i].ks0; } while (0)
#define A2_SWAIT() asm volatile("s_waitcnt vmcnt(3)" ::: "memory")
#define A2_RESC(a) do { if (__any((a) < 1.f)) { if (hi == 0) al_l[r32] = (a); asm volatile("s_waitcnt lgkmcnt(0)" ::: "memory"); \
    _Pragma("unroll") for (int d = 0; d < 4; ++d) _Pragma("unroll") for (int r = 0; r < 16; ++r) o[d][r] *= al_l[crow(r, hi)]; } } while (0)
  if (wid >= 4) __builtin_amdgcn_s_setprio(1);
  f32x16 pA0, pA1, pB0, pB1; float al; bool refz; bf16x8 pa0, pa1, pa2, pa3; const int NT = seq / KVBLK;
  A2_SLOAD(0, 0); asm volatile("s_waitcnt vmcnt(0)" ::: "memory"); A2_SWRITE(0, 0);
  A2_SLOAD(1, KVBLK); A2_SLOAD(0, 2 * KVBLK);
  __syncthreads();
  qkt(pA0, pA1, K_lds, qr, r32, hi); partialSM0(pA0, pA1, m_reg, refz);
  A2_SWAIT(); A2_SWRITE(1, 1); A2_SLOAD(1, 3 * KVBLK);
  int bp = 0, bc = 1, bn = 2;
#define A2_STEP(PC0, PC1, PP0, PP1, j_, SL) do { \
    __syncthreads(); \
    A2_SBAR(); qkt(PC0, PC1, K_lds + bc * SHM_K, qr, r32, hi); \
    finishSM(PP0, PP1, m_reg, refz, al, l_reg, pa0, pa1, pa2, pa3); A2_RESC(al); A2_SBAR(); \
    if ((j_) + 1 < NT) { A2_SWAIT(); A2_SWRITE(bn, SL); }     \
    if ((j_) + 3 < NT) A2_SLOAD(SL, ((j_) + 3) * KVBLK); A2_SBAR(); \
    pv_psm(o, vb0 + bp * (int)SHM_V, pa0, pa1, pa2, pa3, PC0, PC1, m_reg, refz); \
    { const int t_ = bp; bp = bc; bc = bn; bn = t_; } } while (0)
  for (int j = 1; j + 1 < NT; j += 2) {
    A2_STEP(pB0, pB1, pA0, pA1, j, 0);
    A2_STEP(pA0, pA1, pB0, pB1, j + 1, 1);
  }
  A2_STEP(pB0, pB1, pA0, pA1, NT - 1, 0);
#undef A2_STEP
  finishSM(pB0, pB1, m_reg, refz, al, l_reg, pa0, pa1, pa2, pa3); A2_RESC(al); A2_SBAR();
  pv_d0(o, vb0 + bp * (int)SHM_V, pa0, pa1, pa2, pa3);
  __builtin_amdgcn_s_setprio(0);
  { auto rr = __builtin_amdgcn_permlane32_swap(__float_as_uint(l_reg), __float_as_uint(l_reg), false, false); l_reg = __uint_as_float(rr[0]) + __uint_as_float(rr[1]); }
  if (hi == 0) li_l[r32] = l_reg; asm volatile("s_waitcnt lgkmcnt(0)" ::: "memory");
  float rli[16];
#pragma unroll
  for (int r = 0; r < 16; ++r) rli[r] = __builtin_amdgcn_rcpf(li_l[crow(r, hi)]);
  unsigned* sw = (unsigned*)(lds + PARK_OFF) + wid * 2048 + lane;
  if (PASS == 0) {
#pragma unroll
    for (int r = 0; r < 16; ++r)
#pragma unroll
      for (int dp = 0; dp < 2; ++dp) sw[(r * 2 + dp) * 64] = cvtpk(o[2 * dp][r] * rli[r], o[2 * dp + 1][r] * rli[r]);
  } else {
    float sg[4];
#pragma unroll
    for (int d0 = 0; d0 < 4; ++d0) sg[d0] = subln[d0 * 32 + r32];
    bf16r* Ow = Ob + (long)(wid * QBLK) * LD + r32;
#pragma unroll
    for (int r = 0; r < 16; ++r) {
      float d[4]; float ss = 0.f;
#pragma unroll
      for (int dp = 0; dp < 2; ++dp) { const unsigned w = sw[(r * 2 + dp) * 64];
        d[2 * dp] = __uint_as_float(w << 16) - lam * (o[2 * dp][r] * rli[r]); d[2 * dp + 1] = __uint_as_float(w & 0xffff0000u) - lam * (o[2 * dp + 1][r] * rli[r]); }
#pragma unroll
      for (int d0 = 0; d0 < 4; ++d0) ss += d[d0] * d[d0];
      ss += __shfl_xor(ss, 1); ss += __shfl_xor(ss, 2); ss += __shfl_xor(ss, 4); ss += __shfl_xor(ss, 8); ss += __shfl_xor(ss, 16);
      const float rstd = 0.8f / sqrtf(ss * (1.f / 128.f) + 1e-6f);
      const int orow = crow(r, hi);
#pragma unroll
      for (int d0 = 0; d0 < 4; ++d0) Ow[(long)orow * LD + d0 * 32] = (bf16r)(cvtpk(d[d0] * rstd * sg[d0], 0.f) & 0xffffu);
    }
  }
  __syncthreads();
#undef A2_SLOAD
#undef A2_SWRITE
#undef A2_SWAIT
#undef A2_RESC
}
#undef A2_KSWZ
#undef A2_LWAIT
#undef A2_SBAR
}
namespace pg8 {
typedef unsigned u32x2 __attribute__((ext_vector_type(2)));
__device__ __forceinline__ float fsigmoid(float x) { return __builtin_amdgcn_rcpf(1.0f + __builtin_amdgcn_exp2f(-1.4426950408889634f * x)); }
__device__ __forceinline__ float fsilu(float x) { return x * fsigmoid(x); }
__device__ __forceinline__ float bflo(unsigned w) { return __uint_as_float(w << 16); }
__device__ __forceinline__ float bfhi(unsigned w) { return __uint_as_float(w & 0xffff0000u); }

struct EpiSwiglu {
    static constexpr bool PERM = true, AFTER_DRAIN = false;
    bf16_t* O; int ldc;
    __device__ __forceinline__ void operator()(const f32x4 (&acc)[2][2][4][2], const Unit& u, int wr, int wc, int fr, int fq) const {
        const int row0 = u.pm * BM + wr * 64 + fr, col0 = u.pn * HALF + wc * 32 + 8 * fq;
#pragma unroll
        for (int ai = 0; ai < 2; ++ai)
#pragma unroll
            for (int m = 0; m < 4; ++m) {
                bf16_t* rowp = O + (size_t)(row0 + ai * HALF + m * 16) * ldc + col0;
                const f32x4 g0 = acc[ai][0][m][0], g1 = acc[ai][0][m][1], u0 = acc[ai][1][m][0], u1 = acc[ai][1][m][1];
                u32x4 w;
                w.x = cvt_pk_bf16(fsilu(g0[0]) * u0[0], fsilu(g0[1]) * u0[1]); w.y = cvt_pk_bf16(fsilu(g0[2]) * u0[2], fsilu(g0[3]) * u0[3]);
                w.z = cvt_pk_bf16(fsilu(g1[0]) * u1[0], fsilu(g1[1]) * u1[1]); w.w = cvt_pk_bf16(fsilu(g1[2]) * u1[2], fsilu(g1[3]) * u1[3]);
                *(u32x4*)rowp = w;
            }
    }
};

struct EpiWin {
    static constexpr bool PERM = true, AFTER_DRAIN = false;
    bf16_t *q, *k, *v, *u, *ga, *gb; const float* rope; float qscale;
    __device__ __forceinline__ void operator()(const f32x4 (&acc)[2][2][4][2], const Unit& un, int wr, int wc, int fr, int fq) const {
        const int pn = un.pn, rowt = un.pm * BM + wr * 64 + fr, bidx = un.pm >> 5;
        if (pn < 8) {
            const bool isq = pn < 4; const float sc = isq ? qscale : 1.f; bf16_t* base = isq ? q : k;
            const int colt = (pn & 3) * 256 + wc * 32 + 8 * fq, axis = wc & 1, f0 = 8 * (fq & 1);
            const float sgn = (fq < 2) ? -sc : sc;
#pragma unroll
            for (int ai = 0; ai < 2; ++ai)
#pragma unroll
                for (int m = 0; m < 4; ++m) {
                    const int r = rowt + ai * HALF + m * 16, t = r & 8191, pos = axis ? (t & 63) : (t >> 6);
                    const f32x4 cs0 = *(const f32x4*)(rope + pos * 16 + f0), cs1 = *(const f32x4*)(rope + pos * 16 + f0 + 4);
                    const f32x4 sn0 = *(const f32x4*)(rope + 2048 + pos * 16 + f0), sn1 = *(const f32x4*)(rope + 2048 + pos * 16 + f0 + 4);
                    const size_t orow = isq ? (size_t)r : (size_t)bidx * 8448 + 256 + t;
                    bf16_t* rowp = base + orow * 1024 + colt;
#pragma unroll
                    for (int bj = 0; bj < 2; ++bj) {
                        const f32x4 s0 = acc[ai][bj][m][0], s1 = acc[ai][bj][m][1]; f32x4 o0, o1;
#pragma unroll
                        for (int jj = 0; jj < 4; ++jj) { const float p0 = __shfl_xor(s0[jj], 32), p1 = __shfl_xor(s1[jj], 32);
                            o0[jj] = s0[jj] * (cs0[jj] * sc) + p0 * (sn0[jj] * sgn); o1[jj] = s1[jj] * (cs1[jj] * sc) + p1 * (sn1[jj] * sgn); }
                        u32x4 w; w.x = cvt_pk_bf16(o0[0], o0[1]); w.y = cvt_pk_bf16(o0[2], o0[3]); w.z = cvt_pk_bf16(o1[0], o1[1]); w.w = cvt_pk_bf16(o1[2], o1[3]);
                        *(u32x4*)(rowp + bj * HALF) = w;
                    }
                }
        } else if (pn < 12) {
            const int colt = (pn - 8) * 256 + wc * 32 + 8 * fq;
#pragma unroll
            for (int ai = 0; ai < 2; ++ai)
#pragma unroll
                for (int m = 0; m < 4; ++m) {
                    const int r = rowt + ai * HALF + m * 16, t = r & 8191;
                    bf16_t* rowp = v + ((size_t)bidx * 8448 + 256 + t) * 1024 + colt;
#pragma unroll
                    for (int bj = 0; bj < 2; ++bj) { const f32x4 v0 = acc[ai][bj][m][0], v1 = acc[ai][bj][m][1]; u32x4 w;
                        w.x = cvt_pk_bf16(v0[0], v0[1]); w.y = cvt_pk_bf16(v0[2], v0[3]); w.z = cvt_pk_bf16(v1[0], v1[1]); w.w = cvt_pk_bf16(v1[2], v1[3]); *(u32x4*)(rowp + bj * HALF) = w; }
                }
        } else if (pn < 20) {
            const int colt = (pn - 12) * HALF + wc * 32 + 8 * fq;
#pragma unroll
            for (int ai = 0; ai < 2; ++ai)
#pragma unroll
                for (int m = 0; m < 4; ++m) {
                    bf16_t* rowp = u + (size_t)(rowt + ai * HALF + m * 16) * 1024 + colt;
                    const f32x4 a0 = acc[ai][0][m][0], a1 = acc[ai][0][m][1], g0 = acc[ai][1][m][0], g1 = acc[ai][1][m][1]; u32x4 w;
                    w.x = cvt_pk_bf16(a0[0] * fsigmoid(g0[0]), a0[1] * fsigmoid(g0[1])); w.y = cvt_pk_bf16(a0[2] * fsigmoid(g0[2]), a0[3] * fsigmoid(g0[3]));
                    w.z = cvt_pk_bf16(a1[0] * fsigmoid(g1[0]), a1[1] * fsigmoid(g1[1])); w.w = cvt_pk_bf16(a1[2] * fsigmoid(g1[2]), a1[3] * fsigmoid(g1[3]));
                    *(u32x4*)rowp = w;
                }
        } else {
            bf16_t* base = pn < 24 ? ga : gb; const int colt = (pn & 3) * 256 + wc * 32 + 8 * fq;
#pragma unroll
            for (int ai = 0; ai < 2; ++ai)
#pragma unroll
                for (int m = 0; m < 4; ++m) {
                    bf16_t* rowp = base + (size_t)(rowt + ai * HALF + m * 16) * 1024 + colt;
#pragma unroll
                    for (int bj = 0; bj < 2; ++bj) { const f32x4 v0 = acc[ai][bj][m][0], v1 = acc[ai][bj][m][1]; u32x4 w;
                        w.x = cvt_pk_bf16(fsigmoid(v0[0]), fsigmoid(v0[1])); w.y = cvt_pk_bf16(fsigmoid(v0[2]), fsigmoid(v0[3]));
                        w.z = cvt_pk_bf16(fsigmoid(v1[0]), fsigmoid(v1[1])); w.w = cvt_pk_bf16(fsigmoid(v1[2]), fsigmoid(v1[3])); *(u32x4*)(rowp + bj * HALF) = w; }
                }
        }
    }
};

struct EpiKVc {
    static constexpr bool PERM = true, AFTER_DRAIN = false;
    bf16_t *k, *v;
    __device__ __forceinline__ void operator()(const f32x4 (&acc)[2][2][4][2], const Unit& un, int wr, int wc, int fr, int fq) const {
        bf16_t* base = un.pn < 4 ? k : v; const int colt = (un.pn & 3) * 256 + wc * 32 + 8 * fq;
#pragma unroll
        for (int ai = 0; ai < 2; ++ai)
#pragma unroll
            for (int m = 0; m < 4; ++m) {
                bf16_t* rowp = base + ((size_t)un.pm * 8448 + wr * 64 + fr + ai * HALF + m * 16) * 1024 + colt;
#pragma unroll
                for (int bj = 0; bj < 2; ++bj) { const f32x4 v0 = acc[ai][bj][m][0], v1 = acc[ai][bj][m][1]; u32x4 w;
                    w.x = cvt_pk_bf16(v0[0], v0[1]); w.y = cvt_pk_bf16(v0[2], v0[3]); w.z = cvt_pk_bf16(v1[0], v1[1]); w.w = cvt_pk_bf16(v1[2], v1[3]); *(u32x4*)(rowp + bj * HALF) = w; }
            }
    }
};

template <bool ADD> struct EpiGate {
    static constexpr bool PERM = true, AFTER_DRAIN = false;
    bf16_t* Z; const bf16_t* G;
    __device__ __forceinline__ void operator()(const f32x4 (&acc)[2][2][4][2], const Unit& un, int wr, int wc, int fr, int fq) const {
        const int row0 = un.pm * BM + wr * 64 + fr, col0 = un.pn * BM + wc * 32 + 8 * fq;
#pragma unroll
        for (int ai = 0; ai < 2; ++ai)
#pragma unroll
            for (int m = 0; m < 4; ++m) {
                const size_t off = (size_t)(row0 + ai * HALF + m * 16) * 1024 + col0;
#pragma unroll
                for (int bj = 0; bj < 2; ++bj) {
                    const u32x4 g = *(const u32x4*)(G + off + bj * HALF);
                    const f32x4 v0 = acc[ai][bj][m][0], v1 = acc[ai][bj][m][1];
                    float o[8];
                    o[0] = v0[0] * bflo(g.x); o[1] = v0[1] * bfhi(g.x); o[2] = v0[2] * bflo(g.y); o[3] = v0[3] * bfhi(g.y);
                    o[4] = v1[0] * bflo(g.z); o[5] = v1[1] * bfhi(g.z); o[6] = v1[2] * bflo(g.w); o[7] = v1[3] * bfhi(g.w);
                    if (ADD) { const u32x4 z = *(const u32x4*)(Z + off + bj * HALF);
                        o[0] += bflo(z.x); o[1] += bfhi(z.x); o[2] += bflo(z.y); o[3] += bfhi(z.y); o[4] += bflo(z.z); o[5] += bfhi(z.z); o[6] += bflo(z.w); o[7] += bfhi(z.w); }
                    u32x4 w; w.x = cvt_pk_bf16(o[0], o[1]); w.y = cvt_pk_bf16(o[2], o[3]); w.z = cvt_pk_bf16(o[4], o[5]); w.w = cvt_pk_bf16(o[6], o[7]);
                    *(u32x4*)(Z + off + bj * HALF) = w;
                }
            }
    }
};
}

constexpr int NWAVES = 8, NTHR = 512;
constexpr int DM = 1024, NB = 4, SEQ = 8192, NLAT = NB * SEQ, NCTX = 256, NCTXR = NB * NCTX, NROWS = NLAT + NCTXR, NKEYS = SEQ + NCTX;
constexpr int DFF = 2816, INW = 7168, NMOD = 9;
constexpr float EPS = 1e-6f;
constexpr size_t MiB = 1u << 20;
constexpr size_t WS_MOD = 1 * MiB, WS_ROPE = 1 * MiB + 256 * 1024, WS_LAM = 1 * MiB + 512 * 1024;
constexpr size_t WS_W13A = 2 * MiB, WS_W2A = 13 * MiB, WS_W13B = WS_W2A + 11 * MiB / 2, WS_W2B = WS_W13B + 11 * MiB, WS_WIN = 35 * MiB, WS_WAP = 49 * MiB, WS_WCP = 51 * MiB, WS_WOUT = 53 * MiB;
constexpr size_t WS_H = 56 * MiB, WS_Y = 122 * MiB, WS_BIG = 188 * MiB;
constexpr size_t WS_ACT = WS_BIG, WS_Q = WS_BIG, WS_K = WS_BIG + 64 * MiB, WS_V = WS_K + 66 * MiB, WS_U = WS_V + 66 * MiB, WS_GB = WS_U + 64 * MiB, WS_END = WS_GB + 64 * MiB;
constexpr size_t WS_GA = WS_Y, WS_UC = WS_H, WS_OSCR = WS_U, WS_Z = WS_U;
static_assert(WS_END == 512 * MiB, "ws map");
static_assert(WS_W2B + 11 * MiB / 2 <= WS_WIN, "ws map weights");
constexpr int LDS_BYTES = 147456;

#define LAS __attribute__((address_space(3)))
typedef unsigned short bf16;
typedef unsigned v4u __attribute__((ext_vector_type(4)));
typedef unsigned v2u __attribute__((ext_vector_type(2)));
typedef float f32x4 __attribute__((ext_vector_type(4)));
#define LDS_WAIT() asm volatile("s_waitcnt lgkmcnt(0)" ::: "memory")
__device__ __forceinline__ unsigned f2bf(float f) { unsigned u = __builtin_bit_cast(unsigned, f); return (u + 0x7fffu + ((u >> 16) & 1u)) >> 16; }
__device__ __forceinline__ unsigned pk2(float lo, float hi) { return f2bf(lo) | (f2bf(hi) << 16); }
__device__ __forceinline__ float wave_sum(float v) {
#pragma unroll
    for (int o = 1; o < 64; o <<= 1) v += __shfl_xor(v, o);
    return v;
}

struct Args { const float* in[21]; float* out; unsigned char* ws; int pad0, pad1; };
enum { I_X = 0, I_C, I_CTX, I_CCTX, I_WADA, I_BADA, I_NORMG, I_F1W13, I_F1W2, I_F2W13, I_F2W2, I_WIN, I_LAMQK, I_SUBLN, I_WAP, I_CONVW, I_CONVB, I_CLNG, I_CLNB, I_WCP, I_WOUT };

template <int MODE> __device__ __forceinline__ int drow(int n0) {
    if (MODE == 1) { const int bj = n0 / DFF, j = n0 % DFF; return 256 * (j / 128) + 128 * bj + (j % 128); }
    if (MODE == 2) { if (n0 >= 3072 && n0 < 5120) { const int c = n0 - 3072, bj = c / 1024, j = c % 1024; return 3072 + 256 * (j / 128) + 128 * bj + (j % 128); } return n0; }
    return n0;
}
template <int MODE> __device__ __forceinline__ void transpose_item(const float* W, int K, int N, bf16* WT, LAS float* scr, int item, int lane) {
    const int nblk = N / 32, kb = item / nblk, nb = item % nblk, k0 = 64 * kb, n0 = 32 * nb, d0 = drow<MODE>(n0);
    float tv[32];
#pragma unroll
    for (int i = 0; i < 32; ++i) tv[i] = W[(size_t)(k0 + 2 * i + (lane >> 5)) * N + n0 + (lane & 31)];
#pragma unroll
    for (int i = 0; i < 32; ++i) scr[(2 * i + (lane >> 5)) * 33 + (lane & 31)] = tv[i];
    LDS_WAIT(); asm volatile("" ::: "memory");
    const int c = lane & 7;
#pragma unroll
    for (int j = 0; j < 4; ++j) { const int n = (lane >> 3) + 8 * j; const LAS float* s = scr + (8 * c) * 33 + n;
        v4u o; o.x = pk2(s[0 * 33], s[1 * 33]); o.y = pk2(s[2 * 33], s[3 * 33]); o.z = pk2(s[4 * 33], s[5 * 33]); o.w = pk2(s[6 * 33], s[7 * 33]);
        *(v4u*)(WT + (size_t)(d0 + n) * K + k0 + 8 * c) = o; }
    LDS_WAIT(); asm volatile("" ::: "memory");
}

template <bool HAS_Y, bool WRITE_X, bool WRITE_H>
__device__ __forceinline__ void norm_rows(int gw, int NGW, int lane, int row_lo, int nrows, const float* xlat, const float* xctx, const bf16* Y, float* xout, bf16* hout, const float* mod,
                                          float mult, const float* g_post, int k_gate, const float* g_pre, int k_in) {
    for (int row0 = row_lo + gw; row0 < nrows; row0 += 2 * NGW) {
        int rows[2]; rows[0] = row0; rows[1] = (row0 + NGW < nrows) ? row0 + NGW : row0;
        f32x4 v[2][4]; v2u yw[2][4]; const float* mp[2]; bool isctx[2];
#pragma unroll
        for (int r = 0; r < 2; ++r) {
            const int row = rows[r]; isctx[r] = row >= NLAT; const int mv = isctx[r] ? 4 : (row >> 13);
            const float* xr = isctx[r] ? xctx + (size_t)(row - NLAT) * DM : xlat + (size_t)row * DM;
            mp[r] = mod + (size_t)mv * (NMOD * DM);
#pragma unroll
            for (int j = 0; j < 4; ++j) v[r][j] = ((const f32x4*)xr)[lane + 64 * j];
            if (HAS_Y) {
#pragma unroll
                for (int j = 0; j < 4; ++j) yw[r][j] = ((const v2u*)(Y + (size_t)row * DM))[lane + 64 * j];
            }
        }
        if (HAS_Y) {
            f32x4 y[2][4]; float ss[2];
#pragma unroll
            for (int r = 0; r < 2; ++r) { ss[r] = 0.f;
#pragma unroll
                for (int j = 0; j < 4; ++j) { const v2u w = yw[r][j]; y[r][j] = (f32x4){pg8::bflo(w.x), pg8::bfhi(w.x), pg8::bflo(w.y), pg8::bfhi(w.y)};
                    ss[r] += (y[r][j].x * y[r][j].x + y[r][j].y * y[r][j].y) + (y[r][j].z * y[r][j].z + y[r][j].w * y[r][j].w); } }
#pragma unroll
            for (int o = 1; o < 64; o <<= 1) { ss[0] += __shfl_xor(ss[0], o); ss[1] += __shfl_xor(ss[1], o); }
#pragma unroll
            for (int r = 0; r < 2; ++r) { const float rstd = 1.0f / sqrtf(ss[r] * (1.f / DM) + EPS);
#pragma unroll
                for (int j = 0; j < 4; ++j) { const f32x4 gp = ((const f32x4*)g_post)[lane + 64 * j], gt = ((const f32x4*)(mp[r] + k_gate * DM))[lane + 64 * j];
                    v[r][j] = v[r][j] + (mult * gt) * ((y[r][j] * rstd) * gp); }
                if (WRITE_X && !isctx[r]) {
#pragma unroll
                    for (int j = 0; j < 4; ++j) ((f32x4*)(xout + (size_t)rows[r] * DM))[lane + 64 * j] = v[r][j];
                } }
        }
        if (WRITE_H) {
            float ss[2];
#pragma unroll
            for (int r = 0; r < 2; ++r) { ss[r] = 0.f;
#pragma unroll
                for (int j = 0; j < 4; ++j) ss[r] += (v[r][j].x * v[r][j].x + v[r][j].y * v[r][j].y) + (v[r][j].z * v[r][j].z + v[r][j].w * v[r][j].w); }
#pragma unroll
            for (int o = 1; o < 64; o <<= 1) { ss[0] += __shfl_xor(ss[0], o); ss[1] += __shfl_xor(ss[1], o); }
#pragma unroll
            for (int r = 0; r < 2; ++r) { const float rstd = 1.0f / sqrtf(ss[r] * (1.f / DM) + EPS);
#pragma unroll
                for (int j = 0; j < 4; ++j) { const f32x4 gp = ((const f32x4*)g_pre)[lane + 64 * j], sh = ((const f32x4*)(mp[r] + k_in * DM))[lane + 64 * j], sc = ((const f32x4*)(mp[r] + (k_in + 1) * DM))[lane + 64 * j];
                    const f32x4 h = ((v[r][j] * rstd) * gp) * (1.0f + sc) + sh;
                    v2u w; w.x = pk2(h.x, h.y); w.y = pk2(h.z, h.w); ((v2u*)(hout + (size_t)rows[r] * DM))[lane + 64 * j] = w; } }
        }
    }
}

#define RLX_AGENT __ATOMIC_RELAXED, __HIP_MEMORY_SCOPE_AGENT
#define XB_TMO      128
#define XB_XCNT(j)  (256  + 64 * (j))
#define XB_XSUB(j)  (1280 + 64 * (j))
#define XB_XGEN(j)  (2304 + 64 * (j))
#define XB_TOP      3328
#define XB_TOPGEN   3392
#define XCD_BAR_WORDS 3456
#define XB_SPIN_CAP (1u << 22)

__device__ __forceinline__ unsigned xb_ld(unsigned* p)              { return __hip_atomic_load(p, __ATOMIC_RELAXED, __HIP_MEMORY_SCOPE_AGENT); }
__device__ __forceinline__ unsigned xb_add(unsigned* p, unsigned v) { return __hip_atomic_fetch_add(p, v, __ATOMIC_RELAXED, __HIP_MEMORY_SCOPE_AGENT); }
__device__ __forceinline__ unsigned xb_xcc_id() { return (unsigned)__builtin_amdgcn_s_getreg((3 << 11) | 20) & 0xFu; }
#define XB_SPIN(cond, bar) do { unsigned _sp = 0; while (cond) { __builtin_amdgcn_s_sleep(1); \
    if ((++_sp & 255u) == 0u) { if (xb_ld(&(bar)[XB_TMO])) break; if (_sp > XB_SPIN_CAP) { atomicAdd(&(bar)[XB_TMO], 1u); break; } } } } while (0)

struct XcdBarrier {
    unsigned* bar; unsigned x;
    volatile LAS unsigned* st;
};

__device__ __forceinline__ XcdBarrier xcd_barrier_post(unsigned* bar, volatile LAS unsigned* st) {
    XcdBarrier b; b.bar = bar; b.x = xb_xcc_id(); b.st = st;
    if (threadIdx.x == 0) (void)xb_add(&bar[XB_XCNT(b.x)], 1u);
    return b;
}
__device__ __forceinline__ void xcd_barrier_complete(unsigned* bar, unsigned x, unsigned& nloc, unsigned& nx) {
    const unsigned G = gridDim.x * gridDim.y * gridDim.z;
    unsigned sum, cnt, mine, sp = 0u;
    for (;;) {
        sum = 0u; cnt = 0u; mine = 0u;
#pragma unroll
        for (unsigned j = 0; j < 16; ++j) { const unsigned c = xb_ld(&bar[XB_XCNT(j)]); sum += c; cnt += (c > 0u) ? 1u : 0u; mine = (j == x) ? c : mine; }
        if (sum == G) break;
        __builtin_amdgcn_s_sleep(1);
        if ((++sp & 255u) == 0u) { if (xb_ld(&bar[XB_TMO])) break; if (sp > XB_SPIN_CAP) { atomicAdd(&bar[XB_TMO], 1u); break; } }
    }
    nloc = mine > 0u ? mine : 1u; nx = cnt > 0u ? cnt : 1u;
}

__device__ __forceinline__ void xcd_barrier(const XcdBarrier& b) {
    asm volatile("s_waitcnt vmcnt(0)" ::: "memory");
    __syncthreads();
    if (threadIdx.x == 0) {
        unsigned* bar = b.bar;
        __builtin_amdgcn_s_waitcnt(0);
        unsigned nloc = b.st[0], nx = b.st[1];
        if (nloc == 0u) { xcd_barrier_complete(bar, b.x, nloc, nx); b.st[0] = nloc; b.st[1] = nx; }
        const unsigned old = xb_add(&bar[XB_XSUB(b.x)], 1u);
        const unsigned gen = old / nloc;
        if (old + 1u == (gen + 1u) * nloc) {
            __builtin_amdgcn_fence(__ATOMIC_RELEASE, "agent");
            asm volatile("s_waitcnt vmcnt(0)" ::: "memory");
            const unsigned og = xb_add(&bar[XB_TOP], 1u);
            const unsigned tg = og / nx;
            if (og + 1u == (tg + 1u) * nx) xb_add(&bar[XB_TOPGEN], 1u);
            else XB_SPIN(xb_ld(&bar[XB_TOPGEN]) == tg, bar);
            __builtin_amdgcn_fence(__ATOMIC_ACQUIRE, "agent");
            xb_add(&bar[XB_XGEN(b.x)], 1u);
            asm volatile("s_waitcnt vmcnt(0)" ::: "memory");
        } else {
            XB_SPIN(xb_ld(&bar[XB_XGEN(b.x)]) == gen, bar);
            __builtin_amdgcn_fence(__ATOMIC_ACQUIRE, "agent");
            asm volatile("s_waitcnt vmcnt(0)" ::: "memory");
        }
    }
    __syncthreads();
}

__global__ void __launch_bounds__(NTHR, 2) fwd_mega(Args args) {
    extern __shared__ __attribute__((aligned(16))) unsigned char lds[];
    cg::grid_group grid = cg::this_grid();
#define GSYNC_CG() do { asm volatile("s_waitcnt vmcnt(0) lgkmcnt(0)" ::: "memory"); grid.sync(); __builtin_amdgcn_fence(__ATOMIC_ACQUIRE, "agent"); asm volatile("s_waitcnt vmcnt(0)" ::: "memory"); } while (0)
#define GSYNC() xcd_barrier(xbar)
    LAS unsigned char* L = (LAS unsigned char*)lds;
    const int tid = threadIdx.x, lane = tid & 63, wave = __builtin_amdgcn_readfirstlane(tid >> 6);
    const int G = gridDim.x, bx = blockIdx.x, vcu = (G % 8 == 0) ? (bx % 8) * (G / 8) + bx / 8 : bx;
    const int gw = vcu * NWAVES + wave, NGW = G * NWAVES;
    unsigned char* ws = args.ws;
    volatile LAS unsigned* xst = (volatile LAS unsigned*)(L + LDS_BYTES - 64);
    static_assert(attn2::PARK_OFF + attn2::PARK_BYTES <= LDS_BYTES - 64, "LDS map");
    if (tid < 2) xst[tid] = 0u;
    __syncthreads();
    XcdBarrier xbar = xcd_barrier_post((unsigned*)ws, xst);
    float* mod = (float*)(ws + WS_MOD); float* rope = (float*)(ws + WS_ROPE); float* lamp = (float*)(ws + WS_LAM);
    bf16 *W13A = (bf16*)(ws + WS_W13A), *W2A = (bf16*)(ws + WS_W2A), *W13B = (bf16*)(ws + WS_W13B), *W2B = (bf16*)(ws + WS_W2B), *WIN = (bf16*)(ws + WS_WIN), *WAP = (bf16*)(ws + WS_WAP), *WCP = (bf16*)(ws + WS_WCP), *WOUT = (bf16*)(ws + WS_WOUT);
    bf16 *H = (bf16*)(ws + WS_H), *Y = (bf16*)(ws + WS_Y), *ACT = (bf16*)(ws + WS_ACT), *Qb = (bf16*)(ws + WS_Q), *Kb = (bf16*)(ws + WS_K), *Vb = (bf16*)(ws + WS_V), *Ub = (bf16*)(ws + WS_U), *GA = (bf16*)(ws + WS_GA), *GB = (bf16*)(ws + WS_GB);
    bf16 *UC = (bf16*)(ws + WS_UC), *OSCR = (bf16*)(ws + WS_OSCR), *Zb = (bf16*)(ws + WS_Z);
    const float* x = args.in[I_X]; const float* ctx = args.in[I_CTX]; const float* normg = args.in[I_NORMG]; float* out = args.out;

    {
        LAS float* sc = (LAS float*)L;
        LAS float* red = (LAS float*)(L + 20480);
        if (bx < 144) {
            for (int i = tid; i < 5 * DM; i += NTHR) { const float c = i < 4 * DM ? args.in[I_C][i] : args.in[I_CCTX][i - 4 * DM]; sc[i] = c / (1.0f + expf(-c)); }
            __syncthreads();
            for (int it = bx; it < 144; it += G) {
                const int col = it * 64 + lane; const float* wp = args.in[I_WADA] + (size_t)(wave * 128) * (NMOD * DM) + col;
                float a0 = 0.f, a1 = 0.f, a2 = 0.f, a3 = 0.f, a4 = 0.f;
#pragma unroll 32
                for (int kk = 0; kk < 128; ++kk) { const float w = wp[(size_t)kk * (NMOD * DM)]; const int k = wave * 128 + kk;
                    a0 += sc[k] * w; a1 += sc[DM + k] * w; a2 += sc[2 * DM + k] * w; a3 += sc[3 * DM + k] * w; a4 += sc[4 * DM + k] * w; }
                red[(wave * 5 + 0) * 64 + lane] = a0; red[(wave * 5 + 1) * 64 + lane] = a1; red[(wave * 5 + 2) * 64 + lane] = a2; red[(wave * 5 + 3) * 64 + lane] = a3; red[(wave * 5 + 4) * 64 + lane] = a4;
                __syncthreads();
                if (tid < 320) { const int v = tid >> 6, cl = tid & 63; float s = 0.f;
#pragma unroll
                    for (int w8 = 0; w8 < 8; ++w8) s += red[(w8 * 5 + v) * 64 + cl];
                    mod[(size_t)v * (NMOD * DM) + it * 64 + cl] = s + args.in[I_BADA][it * 64 + cl]; }
                __syncthreads();
            }
        }
        if (bx == G - 1) {
            for (int i = tid; i < 2048; i += NTHR) { const int pos = i >> 4, f = i & 15; double inv = 1.0; for (int j = 0; j < f; ++j) inv *= 0.56234132519034908; const double ang = (double)pos * inv; rope[i] = (float)cos(ang); rope[2048 + i] = (float)sin(ang); }
        }
        if (bx == G - 2 && tid < 64) {
            const float* lq = args.in[I_LAMQK];
            const float s01 = wave_sum(lq[tid] * lq[64 + tid]), s23 = wave_sum(lq[128 + tid] * lq[192 + tid]);
            if (tid == 0) lamp[0] = expf(s01) - expf(s23) + 0.2f;
        }
        __syncthreads();
        LAS float* scr = (LAS float*)(L + wave * 16384);
        constexpr int I_13 = (DM / 64) * (2 * DFF / 32), I_2 = (DFF / 64) * (DM / 32);
        for (int it = gw; it < I_13 + I_2; it += NGW) {
            if (it < I_13) transpose_item<1>(args.in[I_F1W13], DM, 2 * DFF, W13A, scr, it, lane);
            else transpose_item<0>(args.in[I_F1W2], DFF, DM, W2A, scr, it - I_13, lane);
        }
    }
    if (args.pad0 != 0) GSYNC_CG();
    GSYNC();
    norm_rows<false, false, true>(gw, NGW, lane, 0, NROWS, x, ctx, nullptr, nullptr, H, mod, 0.f, nullptr, 0, normg + 0 * DM, 0);
    GSYNC();
    { pg8::Gemm g{H, W13A, NROWS, 2 * DFF, DM}; pg8::StaticOrder S; S.init(NROWS, 2 * DFF, G, bx); pg8::EpiSwiglu E{ACT, DFF};
      pg8::gemm_phase<pg8::EpiSwiglu, pg8::StaticOrder, PG8_ALIGN, PG8_SP2>(L, g, S, E); }
    {
        constexpr int NU = (NROWS / 256) * (2 * DFF / 256), NFULL = NU / 256, NREM = NU - NFULL * 256;
        static_assert(NREM > 0 && NREM < 256, "partial round");
        if (G == 256 ? bx >= NREM : true) {
            const int nhelp = (G == 256) ? (256 - NREM) : G, hid = (G == 256) ? bx - NREM : bx;
            LAS float* scr = (LAS float*)(L + wave * 16384);
            constexpr int I_13 = (DM / 64) * (2 * DFF / 32), I_2 = (DFF / 64) * (DM / 32), I_IN = (DM / 64) * (INW / 32), I_SQ = (DM / 64) * (DM / 32);
            constexpr int NITEMS = I_13 + I_2 + I_IN + 3 * I_SQ;
            for (int it = hid * NWAVES + wave; it < NITEMS; it += nhelp * NWAVES) {
                int r = it;
                if (r < I_IN) { transpose_item<2>(args.in[I_WIN], DM, INW, WIN, scr, r, lane); continue; } r -= I_IN;
                if (r < I_SQ) { transpose_item<0>(args.in[I_WAP], DM, DM, WAP, scr, r, lane); continue; } r -= I_SQ;
                if (r < I_SQ) { transpose_item<0>(args.in[I_WCP], DM, DM, WCP, scr, r, lane); continue; } r -= I_SQ;
                if (r < I_SQ) { transpose_item<0>(args.in[I_WOUT], DM, DM, WOUT, scr, r, lane); continue; } r -= I_SQ;
                if (r < I_13) { transpose_item<1>(args.in[I_F2W13], DM, 2 * DFF, W13B, scr, r, lane); continue; } r -= I_13;
                transpose_item<0>(args.in[I_F2W2], DFF, DM, W2B, scr, r, lane);
            }
        }
    }
    GSYNC();
    { pg8::Gemm g{ACT, W2A, NLAT, DM, DFF}; pg8::StaticOrder S; S.init(NLAT, DM, G, bx); pg8::EpiBf16<0> E{Y, DM, nullptr, 0, 0, 1.f};
      pg8::gemm_phase<pg8::EpiBf16<0>, pg8::StaticOrder, PG8_ALIGN, PG8_SP2>(L, g, S, E); }
    GSYNC();
    if (G == 256) {
        if (bx < 16) { pg8::Gemm g{ACT + (size_t)NLAT * DFF, W2A, NCTXR, DM, DFF}; pg8::StaticOrder S; S.init(NCTXR, DM, G, bx); pg8::EpiBf16<0> E{Y + (size_t)NLAT * DM, DM, nullptr, 0, 0, 1.f};
            pg8::gemm_phase<pg8::EpiBf16<0>, pg8::StaticOrder, PG8_ALIGN, PG8_SP2>(L, g, S, E); }
        else norm_rows<true, true, true>((bx - 16) * NWAVES + wave, (G - 16) * NWAVES, lane, 0, NLAT, x, ctx, Y, out, H, mod, 0.5f, normg + 1 * DM, 2, normg + 2 * DM, 3);
    } else {
        { pg8::Gemm g{ACT + (size_t)NLAT * DFF, W2A, NCTXR, DM, DFF}; pg8::StaticOrder S; S.init(NCTXR, DM, G, bx); pg8::EpiBf16<0> E{Y + (size_t)NLAT * DM, DM, nullptr, 0, 0, 1.f};
          pg8::gemm_phase<pg8::EpiBf16<0>, pg8::StaticOrder, PG8_ALIGN, PG8_SP2>(L, g, S, E); }
        norm_rows<true, true, true>(gw, NGW, lane, 0, NLAT, x, ctx, Y, out, H, mod, 0.5f, normg + 1 * DM, 2, normg + 2 * DM, 3);
    }
    GSYNC();
    norm_rows<true, true, true>(gw, NGW, lane, NLAT, NROWS, x, ctx, Y, out, H, mod, 0.5f, normg + 1 * DM, 2, normg + 2 * DM, 3);
    GSYNC();
    { pg8::Gemm g{H, WIN, NLAT, INW, DM}; pg8::StaticOrder S; S.init(NLAT, INW, G, bx);
      pg8::EpiWin E{Qb, Kb, Vb, Ub, GA, GB, rope, attn2::QSCALE};

      pg8::gemm_phase<pg8::EpiWin, pg8::StaticOrder, PG8_ALIGN, PG8_SP2>(L, g, S, E);
    }
    { pg8::Gemm g{H + (size_t)NLAT * DM, WIN + (size_t)1024 * DM, NCTXR, 2048, DM}; pg8::StaticOrder S; S.init(NCTXR, 2048, G, bx); pg8::EpiKVc E{Kb, Vb};
      pg8::gemm_phase<pg8::EpiKVc, pg8::StaticOrder, PG8_ALIGN, PG8_SP2>(L, g, S, E); }
    GSYNC();
    {
        const int c0 = 2 * tid;
        float w0[31], w1[31];
#pragma unroll
        for (int k = 0; k < 31; ++k) { const float2 w = *(const float2*)(args.in[I_CONVW] + k * DM + c0); w0[k] = w.x; w1[k] = w.y; }
        const float2 cb = *(const float2*)(args.in[I_CONVB] + c0), lg = *(const float2*)(args.in[I_CLNG] + c0), lb = *(const float2*)(args.in[I_CLNB] + c0);
        LAS float* red = (LAS float*)L;
        LAS float* stat = (LAS float*)(L + 2048);
        for (int item = vcu; item < NLAT / 16; item += G) {
            const int tg = item * 16, b = tg >> 13, t0 = tg & 8191;
            float a0[16], a1[16];
#pragma unroll
            for (int o = 0; o < 16; ++o) { a0[o] = 0.f; a1[o] = 0.f; }
#pragma unroll
            for (int i = 0; i < 46; ++i) {
                const int t = t0 - 15 + i; const bool valid = (t >= 0) && (t < SEQ); const int tt = valid ? t : t0;
                const unsigned wv = *(const unsigned*)(Ub + ((size_t)(b * SEQ + tt)) * DM + c0);
                const float x0 = valid ? pg8::bflo(wv) : 0.f, x1 = valid ? pg8::bfhi(wv) : 0.f;
#pragma unroll
                for (int o = 0; o < 16; ++o) { if (i - o >= 0 && i - o <= 30) { a0[o] += w0[i - o] * x0; a1[o] += w1[i - o] * x1; } }
            }
#pragma unroll
            for (int o = 0; o < 16; ++o) { a0[o] += cb.x; a1[o] += cb.y; const float s = wave_sum(a0[o] + a1[o]), ss = wave_sum(a0[o] * a0[o] + a1[o] * a1[o]);
                if (lane == 0) { red[wave * 32 + 2 * o] = s; red[wave * 32 + 2 * o + 1] = ss; } }
            __syncthreads();
            if (tid < 32) { float s = 0.f;
#pragma unroll
                for (int w8 = 0; w8 < 8; ++w8) s += red[w8 * 32 + tid];
                stat[tid] = s; }
            __syncthreads();
#pragma unroll
            for (int o = 0; o < 16; ++o) { const float mean = stat[2 * o] * (1.f / DM), var = stat[2 * o + 1] * (1.f / DM) - mean * mean, rstd = 1.0f / sqrtf(fmaxf(var, 0.f) + EPS);
                const float y0 = (a0[o] - mean) * rstd * lg.x + lb.x, y1 = (a1[o] - mean) * rstd * lg.y + lb.y;
                *(unsigned*)(UC + ((size_t)(tg + o)) * DM + c0) = pk2(pg8::fsilu(y0), pg8::fsilu(y1)); }
        }
    }
    __syncthreads();
    {
        const float lam = lamp[0];
#pragma unroll 1
        for (int un = vcu; un < NB * 8 * (SEQ / 256); un += G) {
            const int qb = un & 31, bh = (un >> 8) * 8 + ((un & 255) >> 5), b = bh >> 3, h = bh & 7;
            const size_t qrow0 = (size_t)b * SEQ + (size_t)qb * 256;
            const bf16* kbase = Kb + (size_t)b * NKEYS * DM; const bf16* vbase = Vb + (size_t)b * NKEYS * DM + h * 128;
            attn2::body<0>(Qb + qrow0 * DM + (2 * h) * 64, kbase + (2 * h) * 64, vbase, NKEYS, (char*)lds, lam, args.in[I_SUBLN], nullptr);
            attn2::body<1>(Qb + qrow0 * DM + (2 * h + 1) * 64, kbase + (2 * h + 1) * 64, vbase, NKEYS, (char*)lds, lam, args.in[I_SUBLN], Qb + qrow0 * DM + h * 128);
        }
    }
    GSYNC();
    { pg8::Gemm g{Qb, WAP, NLAT, DM, DM}; pg8::StaticOrder S; S.init(NLAT, DM, G, bx); pg8::EpiGate<false> E{Zb, GA};
      pg8::gemm_phase<pg8::EpiGate<false>, pg8::StaticOrder, PG8_ALIGN, PG8_SP2>(L, g, S, E); }
    asm volatile("s_waitcnt vmcnt(0)" ::: "memory");
    { pg8::Gemm g{UC, WCP, NLAT, DM, DM}; pg8::StaticOrder S; S.init(NLAT, DM, G, bx); pg8::EpiGate<true> E{Zb, GB};
      pg8::gemm_phase<pg8::EpiGate<true>, pg8::StaticOrder, PG8_ALIGN, PG8_SP2>(L, g, S, E); }
    GSYNC();
    { pg8::Gemm g{Zb, WOUT, NLAT, DM, DM}; pg8::StaticOrder S; S.init(NLAT, DM, G, bx); pg8::EpiBf16<0> E{Y, DM, nullptr, 0, 0, 1.f};
      pg8::gemm_phase<pg8::EpiBf16<0>, pg8::StaticOrder, PG8_ALIGN, PG8_SP2>(L, g, S, E);
    }
    GSYNC();
    norm_rows<true, true, true>(gw, NGW, lane, 0, NLAT, out, ctx, Y, out, H, mod, 1.0f, normg + 3 * DM, 5, normg + 4 * DM, 6);
    GSYNC();
    { pg8::Gemm g{H, W13B, NLAT, 2 * DFF, DM}; pg8::StaticOrder S; S.init(NLAT, 2 * DFF, G, bx); pg8::EpiSwiglu E{ACT, DFF};
      pg8::gemm_phase<pg8::EpiSwiglu, pg8::StaticOrder, PG8_ALIGN, PG8_SP2>(L, g, S, E);
    }
    GSYNC();
    { pg8::Gemm g{ACT, W2B, NLAT, DM, DFF}; pg8::StaticOrder S; S.init(NLAT, DM, G, bx); pg8::EpiBf16<0> E{Y, DM, nullptr, 0, 0, 1.f};
      pg8::gemm_phase<pg8::EpiBf16<0>, pg8::StaticOrder, PG8_ALIGN, PG8_SP2>(L, g, S, E);
    }
    GSYNC();
    norm_rows<true, true, false>(gw, NGW, lane, 0, NLAT, out, ctx, Y, out, nullptr, mod, 0.5f, normg + 5 * DM, 8, nullptr, 0);
}

extern "C" void kernel_launch(void* const* d_in, const int* in_sizes, int n_in, void* d_out, int out_size, void* d_ws, size_t ws_size, hipStream_t stream) {
    static int grid = 0;
    if (grid == 0) {
        if (n_in != 21 || ws_size < WS_END || out_size != NLAT * DM) { fprintf(stderr, "kernel_launch: unexpected shapes (n_in %d, out %d, ws %zu)\n", n_in, out_size, ws_size); grid = -1; return; }
        int dev = 0, cus = 0, per_cu = 0;
        if (hipGetDevice(&dev) != hipSuccess || hipDeviceGetAttribute(&cus, hipDeviceAttributeMultiprocessorCount, dev) != hipSuccess) { grid = -1; return; }
        if (hipFuncSetAttribute((const void*)fwd_mega, hipFuncAttributeMaxDynamicSharedMemorySize, LDS_BYTES) != hipSuccess) { fprintf(stderr, "kernel_launch: hipFuncSetAttribute failed\n"); grid = -1; return; }
        if (hipOccupancyMaxActiveBlocksPerMultiprocessor(&per_cu, (const void*)fwd_mega, NTHR, LDS_BYTES) != hipSuccess || per_cu < 1) fprintf(stderr, "kernel_launch: occupancy query says %d\n", per_cu);
        (void)hipGetLastError();
        grid = cus;
    }
    if (grid < 0) return;
    if (hipMemsetAsync(d_ws, 0, 16384, stream) != hipSuccess) { fprintf(stderr, "kernel_launch: memset of the barrier words failed\n"); return; }
    Args a{};
    for (int i = 0; i < 21; ++i) a.in[i] = (const float*)d_in[i];
    a.out = (float*)d_out; a.ws = (unsigned char*)d_ws;
    void* kargs[] = {&a};
    const hipError_t e = hipLaunchCooperativeKernel((const void*)fwd_mega, dim3(grid), dim3(NTHR), kargs, LDS_BYTES, stream);
    if (e != hipSuccess) fprintf(stderr, "cooperative launch failed: %s (grid %d)\n", hipGetErrorString(e), grid);
}
```

```cpp
#include <hip/hip_runtime.h>
#include <hip/hip_cooperative_groups.h>
#include <cstdio>
#include <cstdint>
namespace cg = cooperative_groups;
namespace pg8 {
#define PG8_LAS __attribute__((address_space(3)))
typedef unsigned short bf16_t;
typedef short bf16x8 __attribute__((ext_vector_type(8)));
typedef float f32x4 __attribute__((ext_vector_type(4)));
typedef unsigned u32x4 __attribute__((ext_vector_type(4)));
constexpr int BM = 256, BK = 64, HALF = 128, HTB = HALF * BK * 2  , STAGE_BYTES = 8 * HTB, NXCD = 8, WGM = 8;

__host__ __device__ __forceinline__ int lds_byte(int r, int c) { const int st = (r >> 4) * 2 + (c >> 5), rr = r & 15, cc = c & 31, ob = rr * 64 + cc * 2; return st * 1024 + (ob ^ (((ob >> 9) & 1) << 5)); }
__host__ __device__ __forceinline__ void stage_rc(int b, int& R, int& C) { const int st = b / 1024, sb = b % 1024, swz = sb ^ (((sb >> 9) & 1) << 5); R = (st >> 1) * 16 + swz / 64; C = (st & 1) * 32 + (swz % 64) / 2; }
__host__ __device__ __forceinline__ int perm32(int rho) { const int n = rho >> 4, i = rho & 15; return 8 * (i >> 2) + 4 * n + (i & 3); }

struct Unit { int pm, pn; };
struct Gemm { const bf16_t* A; const bf16_t* Bt; int M, N, K; };

struct StaticOrder {
    int nM, nN, nwg, G, c;
    __host__ __device__ void init(int M, int N, int G_, int c_) { nM = M / BM; nN = N / BM; nwg = nM * nN; G = G_; c = c_; }
    __host__ __device__ bool next(int i, Unit& u) const {
        const long L = (long)i * G + c; if (L >= nwg) return false;
        int wgid = (int)L; { const int q = nwg / NXCD, r = nwg % NXCD, xcd = wgid % NXCD, off = wgid / NXCD; wgid = (xcd < r ? xcd * (q + 1) : r * (q + 1) + (xcd - r) * q) + off; }
        const int nig = WGM * nN, gid = wgid / nig, fm = gid * WGM, gsz = (nM - fm) < WGM ? (nM - fm) : WGM;
        u.pm = fm + ((wgid % nig) % gsz); u.pn = (wgid % nig) / gsz; return true;
    }
    __device__ __forceinline__ void a_ready(const Unit&) const {}
    __device__ __forceinline__ void done(const Unit&) const {}
};

typedef float f32x2c_t __attribute__((ext_vector_type(2))); typedef __bf16 bf16x2c_t __attribute__((ext_vector_type(2)));
__device__ __forceinline__ unsigned cvt_pk_bf16(float lo, float hi) { f32x2c_t v = {lo, hi}; bf16x2c_t b = __builtin_convertvector(v, bf16x2c_t); return __builtin_bit_cast(unsigned, b); }
typedef float f32x2 __attribute__((ext_vector_type(2)));
__device__ __forceinline__ f32x2 gelu_pk(f32x2 v) {
    const f32x2 av = __builtin_elementwise_abs(v), d = av * 0.2316418882f + 1.0f;
    f32x2 t; t.x = __builtin_amdgcn_rcpf(d.x); t.y = __builtin_amdgcn_rcpf(d.y);
    f32x2 q = t * 0.5307027145f + (-0.7265760135f); q = q * t + 0.7107068705f; q = q * t + (-0.142248368f); q = q * t + 0.127414796f; q = q * t;
    const f32x2 s = (v * v) * (-0.72134752044f);
    f32x2 e; e.x = __builtin_amdgcn_exp2f(s.x); e.y = __builtin_amdgcn_exp2f(s.y);
    const f32x2 m = v * (q * e), r = v - m;
    f32x2 o; o.x = v.x < 0.f ? m.x : r.x; o.y = v.y < 0.f ? m.y : r.y; return o;
}

template <int ACT  > struct EpiBf16 {
    static constexpr bool PERM = true, AFTER_DRAIN = false; static_assert(ACT == 0 || ACT == 1, "EpiBf16: ACT is 0 (none) or 1 (gelu_pk)");
    bf16_t* O; int ldc; const float* bias; int split_cols; size_t split_stride; float scale0;
    __device__ __forceinline__ void operator()(const f32x4 (&acc)[2][2][4][2], const Unit& u, int wr, int wc, int fr, int fq) const {
        const int row0 = u.pm * BM + wr * 64 + fr; int colt = u.pn * BM; bf16_t* base = O;
        float sc = 1.f; if (split_cols) { const int t = colt / split_cols; base += (size_t)t * split_stride; colt -= t * split_cols; if (t == 0) sc = scale0; }
        const int col0 = colt + wc * 32 + 8 * fq, bcol0 = u.pn * BM + wc * 32 + 8 * fq;
        f32x4 bv[2][2];
#pragma unroll
        for (int bj = 0; bj < 2; ++bj)
#pragma unroll
            for (int n = 0; n < 2; ++n) bv[bj][n] = bias ? *(const f32x4*)(bias + bcol0 + bj * HALF + 4 * n) : (f32x4){0.f, 0.f, 0.f, 0.f};
#pragma unroll
        for (int ai = 0; ai < 2; ++ai)
#pragma unroll
            for (int m = 0; m < 4; ++m) { bf16_t* rowp = base + (size_t)(row0 + ai * HALF + m * 16) * ldc + col0;
#pragma unroll
                for (int bj = 0; bj < 2; ++bj) { f32x4 v0 = acc[ai][bj][m][0] + bv[bj][0], v1 = acc[ai][bj][m][1] + bv[bj][1];
                    if (ACT == 1) { f32x2 a = gelu_pk((f32x2){v0[0], v0[1]}), b = gelu_pk((f32x2){v0[2], v0[3]}), c = gelu_pk((f32x2){v1[0], v1[1]}), d = gelu_pk((f32x2){v1[2], v1[3]});
                        v0 = (f32x4){a.x, a.y, b.x, b.y}; v1 = (f32x4){c.x, c.y, d.x, d.y}; }
                    v0 = v0 * sc; v1 = v1 * sc; u32x4 w; w.x = cvt_pk_bf16(v0[0], v0[1]); w.y = cvt_pk_bf16(v0[2], v0[3]); w.z = cvt_pk_bf16(v1[0], v1[1]); w.w = cvt_pk_bf16(v1[2], v1[3]);
                    *(u32x4*)(rowp + bj * HALF) = w; } }
    }
};
template <class Epi, class Sched, bool ALIGN_EPI = false, bool SP2 = false>
__device__ __forceinline__ void gemm_phase(PG8_LAS unsigned char* lds, const Gemm g, const Sched& S, const Epi& E) {
    int tid_ = threadIdx.x; asm volatile("" : "+v"(tid_));
    const int tid = tid_, wid = __builtin_amdgcn_readfirstlane(tid >> 6), lane = tid & 63, wr = wid >> 2, wc = wid & 3, fr = lane & 15, fq = lane >> 4;
    const int K = g.K, nt = K / BK;
    unsigned voffA[2], voffB[2];
#pragma unroll
    for (int i = 0; i < 2; ++i) { int R, C; stage_rc(tid * 16 + i * 8192, R, C); const int Rb = Epi::PERM ? ((R & ~31) + perm32(R & 31)) : R;
        voffA[i] = (unsigned)(R * K + C) * 2u; voffB[i] = (unsigned)(Rb * K + C) * 2u; }
    const size_t kstep = (size_t)(BK * 2);
    const size_t hstep = (size_t)HALF * K * 2;
    const size_t tstep = 2 * hstep;
    const unsigned ldsw = (unsigned)wid * 1024u;
    const int aoff = lds_byte(wr * 64 + fr, fq * 8), boff = lds_byte(wc * 32 + fr, fq * 8);
#define PG8_SA(b, h) (((b) * 2 + (h)) * HTB)
#define PG8_SB(b, h) ((4 + (b) * 2 + (h)) * HTB)
#define PG8_STAGE(bufoff, gbase, voff) do { _Pragma("unroll") for (int _i = 0; _i < 2; ++_i) \
        __builtin_amdgcn_global_load_lds((const unsigned*)((const char*)(gbase) + (voff)[_i]), (PG8_LAS unsigned*)(lds + (bufoff) + ldsw + _i * 8192), 16, 0, 0); } while (0)
#define PG8_LDA(dst, b, h) do { _Pragma("unroll") for (int m = 0; m < 4; ++m) _Pragma("unroll") for (int k = 0; k < 2; ++k) dst[m][k] = *(const PG8_LAS bf16x8*)(lds + PG8_SA(b, h) + aoff + m * 2048 + k * 1024); } while (0)
#define PG8_LDB(dst, b, h) do { _Pragma("unroll") for (int n = 0; n < 2; ++n) _Pragma("unroll") for (int k = 0; k < 2; ++k) dst[n][k] = *(const PG8_LAS bf16x8*)(lds + PG8_SB(b, h) + boff + n * 2048 + k * 1024); } while (0)
#define PG8_MMA(ai, bj, At, Bt) do { __builtin_amdgcn_s_setprio(1); _Pragma("unroll") for (int m = 0; m < 4; ++m) _Pragma("unroll") for (int n = 0; n < 2; ++n) _Pragma("unroll") for (int k = 0; k < 2; ++k) \
        acc[ai][bj][m][n] = __builtin_amdgcn_mfma_f32_16x16x32_bf16(Bt[n][k], At[m][k], acc[ai][bj][m][n], 0, 0, 0); __builtin_amdgcn_s_setprio(0); } while (0)
#define PG8_WAIT_V(n) asm volatile("s_waitcnt vmcnt(" #n ")" ::: "memory")
#define PG8_WAIT_L(n) asm volatile("s_waitcnt lgkmcnt(" #n ")" ::: "memory")
#define PG8_BAR __builtin_amdgcn_s_barrier()
#define PG8_SCHED __builtin_amdgcn_sched_barrier(0)
    Unit cur, nxt; int ui = 0;
    if (!S.next(0, cur)) return;
    f32x4 acc[2][2][4][2];
#pragma unroll
    for (int a = 0; a < 2; ++a)
#pragma unroll
        for (int b = 0; b < 2; ++b)
#pragma unroll
            for (int m = 0; m < 4; ++m)
#pragma unroll
                for (int n = 0; n < 2; ++n) acc[a][b][m][n] = (f32x4){0.f, 0.f, 0.f, 0.f};
    bf16x8 At[4][2], B0[2][2], B1[2][2];
    const char* cA = (const char*)g.A + (size_t)cur.pm * tstep; const char* cB = (const char*)g.Bt + (size_t)cur.pn * tstep;
    S.a_ready(cur);
    if constexpr (SP2) {
        PG8_STAGE(PG8_SB(0, 0), cB, voffB); PG8_STAGE(PG8_SB(0, 1), cB + hstep, voffB); PG8_STAGE(PG8_SA(0, 0), cA, voffA); PG8_STAGE(PG8_SA(0, 1), cA + hstep, voffA);
        if (wr == 1) PG8_BAR;
        PG8_WAIT_V(2); PG8_BAR;
        PG8_STAGE(PG8_SB(1, 0), cB + kstep, voffB); PG8_STAGE(PG8_SA(1, 0), cA + kstep, voffA); PG8_STAGE(PG8_SB(1, 1), cB + hstep + kstep, voffB);
        PG8_WAIT_V(6); PG8_BAR;
    } else {
        PG8_STAGE(PG8_SB(0, 0), cB, voffB); PG8_STAGE(PG8_SA(0, 0), cA, voffA); PG8_STAGE(PG8_SB(0, 1), cB + hstep, voffB); PG8_STAGE(PG8_SA(0, 1), cA + hstep, voffA);
        if (wr == 1) PG8_BAR;
        PG8_WAIT_V(4); PG8_BAR;
        PG8_STAGE(PG8_SB(1, 0), cB + kstep, voffB); PG8_STAGE(PG8_SA(1, 0), cA + kstep, voffA); PG8_STAGE(PG8_SB(1, 1), cB + hstep + kstep, voffB);
        PG8_WAIT_V(6); PG8_BAR;
    }
    for (;;) {
        const bool has_next = S.next(ui + 1, nxt);
        const char* nA = has_next ? (const char*)g.A + (size_t)nxt.pm * tstep : cA; const char* nB = has_next ? (const char*)g.Bt + (size_t)nxt.pn * tstep : cB;
        for (int t = 0; t < nt; t += 2) {
            const bool last = (t == nt - 2);
            const char* a1 = cA + (size_t)(t + 1) * kstep;
            const char* a2 = last ? nA : cA + (size_t)(t + 2) * kstep; const char* b2 = last ? nB : cB + (size_t)(t + 2) * kstep;
            const char* a3 = a2 + kstep; const char* b3 = b2 + kstep;
            if (last && has_next) S.a_ready(nxt);
            if constexpr (SP2) {
            PG8_LDB(B0, 0, 0); PG8_LDB(B1, 0, 1); PG8_SCHED; PG8_LDA(At, 0, 0); PG8_STAGE(PG8_SA(1, 1), a1 + hstep, voffA);
            PG8_WAIT_V(8); PG8_WAIT_L(0); PG8_BAR; PG8_MMA(0, 0, At, B0); PG8_MMA(0, 1, At, B1); PG8_BAR; PG8_SCHED;
            PG8_LDA(At, 0, 1); PG8_STAGE(PG8_SB(0, 0), b2, voffB); PG8_STAGE(PG8_SB(0, 1), b2 + hstep, voffB); PG8_STAGE(PG8_SA(0, 0), a2, voffA);
            PG8_WAIT_V(8); PG8_WAIT_L(0); PG8_BAR; PG8_MMA(1, 0, At, B0); PG8_MMA(1, 1, At, B1); PG8_BAR; PG8_SCHED;
            PG8_LDB(B0, 1, 0); PG8_LDB(B1, 1, 1); PG8_SCHED; PG8_LDA(At, 1, 0); PG8_STAGE(PG8_SA(0, 1), a2 + hstep, voffA);
            PG8_WAIT_V(8); PG8_WAIT_L(0); PG8_BAR; PG8_MMA(0, 0, At, B0); PG8_MMA(0, 1, At, B1); PG8_BAR; PG8_SCHED;
            PG8_LDA(At, 1, 1); PG8_STAGE(PG8_SB(1, 0), b3, voffB); PG8_STAGE(PG8_SB(1, 1), b3 + hstep, voffB); PG8_STAGE(PG8_SA(1, 0), a3, voffA);
            PG8_WAIT_V(8); PG8_WAIT_L(0); PG8_BAR; PG8_MMA(1, 0, At, B0); PG8_MMA(1, 1, At, B1); PG8_BAR; PG8_SCHED;
            } else {
            PG8_LDB(B0, 0, 0); PG8_SCHED; PG8_LDA(At, 0, 0); PG8_STAGE(PG8_SA(1, 1), a1 + hstep, voffA);
            PG8_WAIT_L(8); PG8_BAR; PG8_WAIT_L(0); PG8_MMA(0, 0, At, B0); PG8_BAR; PG8_SCHED;
            PG8_LDB(B1, 0, 1); PG8_STAGE(PG8_SB(0, 0), b2, voffB);
            PG8_BAR; PG8_WAIT_L(0); PG8_MMA(0, 1, At, B1); PG8_BAR;
            PG8_LDA(At, 0, 1); PG8_STAGE(PG8_SA(0, 0), a2, voffA);
            PG8_BAR; PG8_WAIT_L(0); PG8_MMA(1, 0, At, B0); PG8_BAR; PG8_SCHED;
            PG8_STAGE(PG8_SB(0, 1), b2 + hstep, voffB);
            PG8_WAIT_V(6); PG8_BAR; PG8_MMA(1, 1, At, B1); PG8_BAR;
            PG8_LDB(B0, 1, 0); PG8_SCHED; PG8_LDA(At, 1, 0); PG8_STAGE(PG8_SA(0, 1), a2 + hstep, voffA);
            PG8_WAIT_L(8); PG8_BAR; PG8_WAIT_L(0); PG8_MMA(0, 0, At, B0); PG8_BAR; PG8_SCHED;
            PG8_LDB(B1, 1, 1); PG8_STAGE(PG8_SB(1, 0), b3, voffB);
            PG8_BAR; PG8_WAIT_L(0); PG8_MMA(0, 1, At, B1); PG8_BAR;
            PG8_LDA(At, 1, 1); PG8_STAGE(PG8_SA(1, 0), a3, voffA);
            PG8_BAR; PG8_WAIT_L(0); PG8_MMA(1, 0, At, B0); PG8_BAR; PG8_SCHED;
            PG8_STAGE(PG8_SB(1, 1), b3 + hstep, voffB);
            PG8_WAIT_V(6); PG8_BAR; PG8_MMA(1, 1, At, B1); PG8_BAR;
            }
        }
        if constexpr (ALIGN_EPI) { if (wr == 0) PG8_BAR; }
        if constexpr (!Epi::AFTER_DRAIN) { E(acc, cur, wr, wc, fr, fq); S.done(cur); }
        if (!has_next) break;
#pragma unroll
        for (int a = 0; a < 2; ++a)
#pragma unroll
            for (int b = 0; b < 2; ++b)
#pragma unroll
                for (int m = 0; m < 4; ++m)
#pragma unroll
                    for (int n = 0; n < 2; ++n) acc[a][b][m][n] = (f32x4){0.f, 0.f, 0.f, 0.f};
        cur = nxt; cA = nA; cB = nB; ++ui;
        if constexpr (ALIGN_EPI) { if (wr == 1) PG8_BAR; }
    }
    PG8_WAIT_V(0);
    if constexpr (!ALIGN_EPI) { if (wr == 0) PG8_BAR; }
    PG8_BAR;
    if constexpr (Epi::AFTER_DRAIN) { E.fused(acc, cur, wr, wc, fr, fq, lds, wid, lane); S.done(cur); }
#undef PG8_SA
#undef PG8_SB
#undef PG8_STAGE
#undef PG8_LDA
#undef PG8_LDB
#undef PG8_MMA
#undef PG8_WAIT_V
#undef PG8_WAIT_L
#undef PG8_BAR
#undef PG8_SCHED
}
}

#ifndef PG8_SP2
#define PG8_SP2 true
#endif
#ifndef PG8_ALIGN
#define PG8_ALIGN true
#endif
#include <hip/hip_bf16.h>
#include <cmath>
namespace attn2 {
using bf16x8 = __attribute__((ext_vector_type(8))) short;
using s16x4  = __attribute__((ext_vector_type(4))) short;
using f32x16 = __attribute__((ext_vector_type(16))) float;
using u32x4  = __attribute__((ext_vector_type(4))) unsigned;
typedef unsigned short bf16r;
constexpr int DQ = 64, DV = 128, NW = 8, QBLK = 32, KVBLK = 64, LD = 1024;
constexpr float SCALE = 0.125f, THR = 8.f, QSCALE = SCALE * 1.4426950408889634f;
#ifndef A2_FORCE_REF
#define A2_FORCE_REF 0
#endif
constexpr size_t SHM_V = KVBLK * DV * 2, SHM_K = KVBLK * DQ * 2, SHM_ATTN = 3 * SHM_V + 3 * SHM_K + NW * 64 * 4;
constexpr size_t PARK_OFF = SHM_ATTN, PARK_BYTES = NW * 2048 * 4;
#define A2_KSWZ(row, colB) ((row) * 128 + ((colB) ^ ((((row) >> 1) & 7) << 4)))
#define A2_SBAR() __builtin_amdgcn_sched_barrier(0)
__device__ __forceinline__ int crow(int r, int hi) { return (r & 3) + 8 * (r >> 2) + 4 * hi; }
typedef float f32x2_t __attribute__((ext_vector_type(2))); typedef __bf16 bf16x2_t __attribute__((ext_vector_type(2)));
__device__ __forceinline__ unsigned cvtpk(float lo, float hi) { f32x2_t v = {lo, hi}; bf16x2_t b = __builtin_convertvector(v, bf16x2_t); return __builtin_bit_cast(unsigned, b); }

__device__ __forceinline__ void partialSM0(f32x16& p0, f32x16& p1, float& m_reg, bool& refz) {
  float pmax = p0[0];
#pragma unroll
  for (int r = 1; r < 16; ++r) pmax = fmaxf(pmax, p0[r]);
#pragma unroll
  for (int r = 0; r < 16; ++r) pmax = fmaxf(pmax, p1[r]);
  { auto rr = __builtin_amdgcn_permlane32_swap(__float_as_uint(pmax), __float_as_uint(pmax), false, false);
    pmax = fmaxf(__uint_as_float(rr[0]), __uint_as_float(rr[1])); }
  refz = (A2_FORCE_REF == 0) && __all(fabsf(pmax) < 64.f);
  m_reg = refz ? 0.f : pmax;
  if (!refz) {
#pragma unroll
    for (int r = 0; r < 16; ++r) { p0[r] -= m_reg; p1[r] -= m_reg; }
  }
#pragma unroll
  for (int r = 0; r < 16; ++r) p0[r] = __builtin_amdgcn_exp2f(p0[r]);
}
constexpr float LAZY_BIG = 1073741824.f;
__device__ __forceinline__ void finishSM(f32x16& p0, f32x16& p1, float& m_reg, bool& refz, float& alpha, float& l_reg, bf16x8& pa0, bf16x8& pa1, bf16x8& pa2, bf16x8& pa3) {
#pragma unroll
  for (int r = 0; r < 16; ++r) p1[r] = __builtin_amdgcn_exp2f(p1[r]);
  f32x2_t sv = {p0[0], p0[1]};
#pragma unroll
  for (int i = 1; i < 8; ++i) sv += (f32x2_t){p0[2 * i], p0[2 * i + 1]};
#pragma unroll
  for (int i = 0; i < 8; ++i) sv += (f32x2_t){p1[2 * i], p1[2 * i + 1]};
  float ps = sv.x + sv.y;
  alpha = 1.f;
  if (__builtin_expect(__any(!(ps <= LAZY_BIG)), 0)) {
    auto rr = __builtin_amdgcn_permlane32_swap(__float_as_uint(ps), __float_as_uint(ps), false, false);
    const float pt = __uint_as_float(rr[0]) + __uint_as_float(rr[1]);
    const float dl = (pt > LAZY_BIG) ? floorf(__log2f(pt)) + 1.f : 0.f;
    alpha = __builtin_amdgcn_exp2f(-dl); m_reg += dl; refz = false;
#pragma unroll
    for (int r = 0; r < 16; ++r) { p0[r] *= alpha; p1[r] *= alpha; }
    ps *= alpha;
  }
  l_reg = l_reg * alpha + ps; asm volatile("" : "+v"(l_reg));
#define A2_PK8(P, BASE, OUT) do { u32x4 w = {cvtpk(P[BASE + 0], P[BASE + 1]), cvtpk(P[BASE + 2], P[BASE + 3]), cvtpk(P[BASE + 4], P[BASE + 5]), cvtpk(P[BASE + 6], P[BASE + 7])}; OUT = *reinterpret_cast<bf16x8*>(&w); } while (0)
  A2_PK8(p0, 0, pa0); A2_PK8(p0, 8, pa1); A2_PK8(p1, 0, pa2); A2_PK8(p1, 8, pa3);
#undef A2_PK8
}
__device__ __forceinline__ void qkt(f32x16& p0, f32x16& p1, const char* Ks, const bf16x8* qr, int r32, int hi) {
  p0 = f32x16{}; p1 = f32x16{};
#pragma unroll
  for (int d0 = 0; d0 < 4; ++d0) { const int cb = (d0 * 16 + hi * 8) * 2;
    const bf16x8 b0 = *reinterpret_cast<const bf16x8*>(Ks + A2_KSWZ(r32, cb));
    const bf16x8 b1 = *reinterpret_cast<const bf16x8*>(Ks + A2_KSWZ(32 + r32, cb));
    p0 = __builtin_amdgcn_mfma_f32_32x32x16_bf16(b0, qr[d0], p0, 0, 0, 0);
    p1 = __builtin_amdgcn_mfma_f32_32x32x16_bf16(b1, qr[d0], p1, 0, 0, 0); }
}
__device__ __forceinline__ int v_st(int k, int c) { const int kk = k;     return ((kk >> 3) * 4 + (c >> 5)) * 512 + ((kk & 7) * 32 + (c & 31)) * 2; }
__device__ __forceinline__ int v_rd_base(int lane) { return ((lane & 3) << 3) | (((lane >> 2) & 3) << 6) | (((lane >> 4) & 1) << 5) | (((lane >> 5) & 1) << 8); }
constexpr int v_rd_off(int d0, int ks, int half) { return d0 * 512 + ks * 4096 + half * 2048; }
template <int OFF> __device__ __forceinline__ s16x4 tr_read(int vb) {
  s16x4 r; asm volatile("ds_read_b64_tr_b16 %0, %1 offset:%2" : "=&v"(r) : "v"(vb), "i"(OFF) : "memory"); return r;
}
template <int D0> __device__ __forceinline__ void pv_one(f32x16& od, int vb, bf16x8 pa0, bf16x8 pa1, bf16x8 pa2, bf16x8 pa3) {
  const s16x4 l0 = tr_read<v_rd_off(D0, 0, 0)>(vb), h0 = tr_read<v_rd_off(D0, 0, 1)>(vb), l1 = tr_read<v_rd_off(D0, 1, 0)>(vb), h1 = tr_read<v_rd_off(D0, 1, 1)>(vb);
  const s16x4 l2 = tr_read<v_rd_off(D0, 2, 0)>(vb), h2 = tr_read<v_rd_off(D0, 2, 1)>(vb), l3 = tr_read<v_rd_off(D0, 3, 0)>(vb), h3 = tr_read<v_rd_off(D0, 3, 1)>(vb);
  asm volatile("s_waitcnt lgkmcnt(0)" ::: "memory"); A2_SBAR();
#define A2_PK(L, H) (bf16x8){L[0], L[1], L[2], L[3], H[0], H[1], H[2], H[3]}
  od = __builtin_amdgcn_mfma_f32_32x32x16_bf16(pa0, A2_PK(l0, h0), od, 0, 0, 0);
  od = __builtin_amdgcn_mfma_f32_32x32x16_bf16(pa1, A2_PK(l1, h1), od, 0, 0, 0);
  od = __builtin_amdgcn_mfma_f32_32x32x16_bf16(pa2, A2_PK(l2, h2), od, 0, 0, 0);
  od = __builtin_amdgcn_mfma_f32_32x32x16_bf16(pa3, A2_PK(l3, h3), od, 0, 0, 0);
#undef A2_PK
}
__device__ __forceinline__ void pv_d0(f32x16* o, int vb, bf16x8 pa0, bf16x8 pa1, bf16x8 pa2, bf16x8 pa3) {
  pv_one<0>(o[0], vb, pa0, pa1, pa2, pa3); pv_one<1>(o[1], vb, pa0, pa1, pa2, pa3); pv_one<2>(o[2], vb, pa0, pa1, pa2, pa3); pv_one<3>(o[3], vb, pa0, pa1, pa2, pa3);
}

struct VF { s16x4 l0, h0, l1, h1, l2, h2, l3, h3; };
template <int D0> __device__ __forceinline__ VF vread(int vb) { VF f;
  f.l0 = tr_read<v_rd_off(D0, 0, 0)>(vb); f.h0 = tr_read<v_rd_off(D0, 0, 1)>(vb); f.l1 = tr_read<v_rd_off(D0, 1, 0)>(vb); f.h1 = tr_read<v_rd_off(D0, 1, 1)>(vb);
  f.l2 = tr_read<v_rd_off(D0, 2, 0)>(vb); f.h2 = tr_read<v_rd_off(D0, 2, 1)>(vb); f.l3 = tr_read<v_rd_off(D0, 3, 0)>(vb); f.h3 = tr_read<v_rd_off(D0, 3, 1)>(vb); return f; }
__device__ __forceinline__ void mfma4(f32x16& od, const VF& f, bf16x8 pa0, bf16x8 pa1, bf16x8 pa2, bf16x8 pa3) {
#define A2_PK(L, H) (bf16x8){L[0], L[1], L[2], L[3], H[0], H[1], H[2], H[3]}
  od = __builtin_amdgcn_mfma_f32_32x32x16_bf16(pa0, A2_PK(f.l0, f.h0), od, 0, 0, 0);
  od = __builtin_amdgcn_mfma_f32_32x32x16_bf16(pa1, A2_PK(f.l1, f.h1), od, 0, 0, 0);
  od = __builtin_amdgcn_mfma_f32_32x32x16_bf16(pa2, A2_PK(f.l2, f.h2), od, 0, 0, 0);
  od = __builtin_amdgcn_mfma_f32_32x32x16_bf16(pa3, A2_PK(f.l3, f.h3), od, 0, 0, 0);
#undef A2_PK
}
#define A2_LWAIT(n) do { asm volatile("s_waitcnt lgkmcnt(" #n ")" ::: "memory"); A2_SBAR(); } while (0)
__device__ __forceinline__ void pv_psm(f32x16* o, int vb, bf16x8 pa0, bf16x8 pa1, bf16x8 pa2, bf16x8 pa3, f32x16& p0, f32x16& p1, float m_reg, bool refz) {
  if (!refz) {
#pragma unroll
    for (int r = 0; r < 16; ++r) { p0[r] -= m_reg; p1[r] -= m_reg; }
  }
  const VF f0 = vread<0>(vb);
  const VF f1 = vread<1>(vb);
#pragma unroll
  for (int r = 0; r < 8; ++r) p0[r] = __builtin_amdgcn_exp2f(p0[r]);
  asm volatile("" : "+v"(p0));
  A2_LWAIT(8); mfma4(o[0], f0, pa0, pa1, pa2, pa3);
  const VF f2 = vread<2>(vb); A2_LWAIT(8); mfma4(o[1], f1, pa0, pa1, pa2, pa3);
#pragma unroll
  for (int r = 8; r < 11; ++r) p0[r] = __builtin_amdgcn_exp2f(p0[r]);
  asm volatile("" : "+v"(p0));
  const VF f3 = vread<3>(vb); A2_LWAIT(8); mfma4(o[2], f2, pa0, pa1, pa2, pa3);
#pragma unroll
  for (int r = 11; r < 14; ++r) p0[r] = __builtin_amdgcn_exp2f(p0[r]);
  asm volatile("" : "+v"(p0));
  A2_LWAIT(0); mfma4(o[3], f3, pa0, pa1, pa2, pa3);
#pragma unroll
  for (int r = 14; r < 16; ++r) p0[r] = __builtin_amdgcn_exp2f(p0[r]);
  asm volatile("" : "+v"(p0)); A2_SBAR();
}
template <int PASS>
__device__ __forceinline__ void body(const bf16r* Qb, const bf16r* Kh, const bf16r* Vh, int seq, char* lds, float lam, const float* subln, bf16r* Ob) {
  int tid_ = threadIdx.x; asm volatile("" : "+v"(tid_));
  const int tid = tid_, wid = tid >> 6, lane = tid & 63, r32 = lane & 31, hi = lane >> 5;
  char* V_lds = lds; char* K_lds = lds + 3 * SHM_V;
  float* ws = (float*)(lds + 3 * SHM_V + 3 * SHM_K) + wid * 64; float* li_l = ws; float* al_l = ws + 32;
  float m_reg = 0.f, l_reg = 0; f32x16 o[4] = {}; bf16x8 qr[4];
  const bf16r* Qw = Qb + (long)(wid * QBLK + r32) * LD + hi * 8;
#pragma unroll
  for (int d0 = 0; d0 < 4; ++d0) qr[d0] = *reinterpret_cast<const bf16x8*>(Qw + d0 * 16);
  const int sr = tid >> 4, sc = (tid & 15) * 8, vst0 = v_st(sr, sc), vst1 = v_st(32 + sr, sc);
  const int kr = tid >> 3, kc = (tid & 7) * 8, kst = A2_KSWZ(kr, kc * 2);
  const int vb0 = (int)(uintptr_t)V_lds + v_rd_base(lane);
  struct { bf16x8 vs0, vs1, ks0; } sr_[2];
#define A2_SLOAD(i, k0) do { sr_[i].vs0 = *reinterpret_cast<const bf16x8*>(&Vh[(long)((k0) + sr) * LD + sc]); sr_[i].vs1 = *reinterpret_cast<const bf16x8*>(&Vh[(long)((k0) + 32 + sr) * LD + sc]); \
    sr_[i].ks0 = *reinterpret_cast<const bf16x8*>(&Kh[(long)((k0) + kr) * LD + kc]); } while (0)
#define A2_SWRITE(b, i) do { *(bf16x8*)(V_lds + (b) * SHM_V + vst0) = sr_[i].vs0; *(bf16x8*)(V_lds + (b) * SHM_V + vst1) = sr_[i].vs1; *(bf16x8*)(K_lds + (b) * SHM_K + kst) = sr_[i].ks0; } while (0)
#define A2_SWAIT() asm volatile("s_waitcnt vmcnt(3)" ::: "memory")
#define A2_RESC(a) do { if (__any((a) < 1.f)) { if (hi == 0) al_l[r32] = (a); asm volatile("s_waitcnt lgkmcnt(0)" ::: "memory"); \
    _Pragma("unroll") for (int d = 0; d < 4; ++d) _Pragma("unroll") for (int r = 0; r < 16; ++r) o[d][r] *= al_l[crow(r, hi)]; } } while (0)
  if (wid >= 4) __builtin_amdgcn_s_setprio(1);
  f32x16 pA0, pA1, pB0, pB1; float al; bool refz; bf16x8 pa0, pa1, pa2, pa3; const int NT = seq / KVBLK;
  A2_SLOAD(0, 0); asm volatile("s_waitcnt vmcnt(0)" ::: "memory"); A2_SWRITE(0, 0);
  A2_SLOAD(1, KVBLK); A2_SLOAD(0, 2 * KVBLK);
  __syncthreads();
  qkt(pA0, pA1, K_lds, qr, r32, hi); partialSM0(pA0, pA1, m_reg, refz);
  A2_SWAIT(); A2_SWRITE(1, 1); A2_SLOAD(1, 3 * KVBLK);
  int bp = 0, bc = 1, bn = 2;
#define A2_STEP(PC0, PC1, PP0, PP1, j_, SL) do { \
    __syncthreads(); \
    A2_SBAR(); qkt(PC0, PC1, K_lds + bc * SHM_K, qr, r32, hi); \
    finishSM(PP0, PP1, m_reg, refz, al, l_reg, pa0, pa1, pa2, pa3); A2_RESC(al); A2_SBAR(); \
    if ((j_) + 1 < NT) { A2_SWAIT(); A2_SWRITE(bn, SL); }     \
    if ((j_) + 3 < NT) A2_SLOAD(SL, ((j_) + 3) * KVBLK); A2_SBAR(); \
    pv_psm(o, vb0 + bp * (int)SHM_V, pa0, pa1, pa2, pa3, PC0, PC1, m_reg, refz); \
    { const int t_ = bp; bp = bc; bc = bn; bn = t_; } } while (0)
  for (int j = 1; j + 1 < NT; j += 2) {
    A2_STEP(pB0, pB1, pA0, pA1, j, 0);
    A2_STEP(pA0, pA1, pB0, pB1, j + 1, 1);
  }
  A2_STEP(pB0, pB1, pA0, pA1, NT - 1, 0);
#undef A2_STEP
  finishSM(pB0, pB1, m_reg, refz, al, l_reg, pa0, pa1, pa2, pa3); A2_RESC(al); A2_SBAR();
  pv_d0(o, vb0 + bp * (int)SHM_V, pa0, pa1, pa2, pa3);
  __builtin_amdgcn_s_setprio(0);
  { auto rr = __builtin_amdgcn_permlane32_swap(__float_as_uint(l_reg), __float_as_uint(l_reg), false, false); l_reg = __uint_as_float(rr[0]) + __uint_as_float(rr[1]); }
  if (hi == 0) li_l[r32] = l_reg; asm volatile("s_waitcnt lgkmcnt(0)" ::: "memory");
  float rli[16];
#pragma unroll
  for (int r = 0; r < 16; ++r) rli[r] = __builtin_amdgcn_rcpf(li_l[crow(r, hi)]);
  unsigned* sw = (unsigned*)(lds + PARK_OFF) + wid * 2048 + lane;
  if (PASS == 0) {
#pragma unroll
    for (int r = 0; r < 16; ++r)
#pragma unroll
      for (int dp = 0; dp < 2; ++dp) sw[(r * 2 + dp) * 64] = cvtpk(o[2 * dp][r] * rli[r], o[2 * dp + 1][r] * rli[r]);
  } else {
    float sg[4];
#pragma unroll
    for (int d0 = 0; d0 < 4; ++d0) sg[d0] = subln[d0 * 32 + r32];
    bf16r* Ow = Ob + (long)(wid * QBLK) * LD + r32;
#pragma unroll
    for (int r = 0; r < 16; ++r) {
      float d[4]; float ss = 0.f;
#pragma unroll
      for (int dp = 0; dp < 2; ++dp) { const unsigned w = sw[(r * 2 + dp) * 64];
        d[2 * dp] = __uint_as_float(w << 16) - lam * (o[2 * dp][r] * rli[r]); d[2 * dp + 1] = __uint_as_float(w & 0xffff0000u) - lam * (o[2 * dp + 1][r] * rli[r]); }
#pragma unroll
      for (int d0 = 0; d0 < 4; ++d0) ss += d[d0] * d[d0];
      ss += __shfl_xor(ss, 1); ss += __shfl_xor(ss, 2); ss += __shfl_xor(ss, 4); ss += __shfl_xor(ss, 8); ss += __shfl_xor(ss, 16);
      const float rstd = 0.8f / sqrtf(ss * (1.f / 128.f) + 1e-6f);
      const int orow = crow(r, hi);
#pragma unroll
      for (int d0 = 0; d0 < 4; ++d0) Ow[(long)orow * LD + d0 * 32] = (bf16r)(cvtpk(d[d0] * rstd * sg[d0], 0.f) & 0xffffu);
    }
  }
  __syncthreads();
#undef A2_SLOAD
#undef A2_SWRITE
#undef A2_SWAIT
#undef A2_RESC
}
#undef A2_KSWZ
#undef A2_LWAIT
#undef A2_SBAR
}
namespace pg8 {
typedef unsigned u32x2 __attribute__((ext_vector_type(2)));
__device__ __forceinline__ float fsigmoid(float x) { return __builtin_amdgcn_rcpf(1.0f + __builtin_amdgcn_exp2f(-1.4426950408889634f * x)); }
__device__ __forceinline__ float fsilu(float x) { return x * fsigmoid(x); }
__device__ __forceinline__ float bflo(unsigned w) { return __uint_as_float(w << 16); }
__device__ __forceinline__ float bfhi(unsigned w) { return __uint_as_float(w & 0xffff0000u); }

struct EpiSwiglu {
    static constexpr bool PERM = true, AFTER_DRAIN = false;
    bf16_t* O; int ldc;
    __device__ __forceinline__ void operator()(const f32x4 (&acc)[2][2][4][2], const Unit& u, int wr, int wc, int fr, int fq) const {
        const int row0 = u.pm * BM + wr * 64 + fr, col0 = u.pn * HALF + wc * 32 + 8 * fq;
#pragma unroll
        for (int ai = 0; ai < 2; ++ai)
#pragma unroll
            for (int m = 0; m < 4; ++m) {
                bf16_t* rowp = O + (size_t)(row0 + ai * HALF + m * 16) * ldc + col0;
                const f32x4 g0 = acc[ai][0][m][0], g1 = acc[ai][0][m][1], u0 = acc[ai][1][m][0], u1 = acc[ai][1][m][1];
                u32x4 w;
                w.x = cvt_pk_bf16(fsilu(g0[0]) * u0[0], fsilu(g0[1]) * u0[1]); w.y = cvt_pk_bf16(fsilu(g0[2]) * u0[2], fsilu(g0[3]) * u0[3]);
                w.z = cvt_pk_bf16(fsilu(g1[0]) * u1[0], fsilu(g1[1]) * u1[1]); w.w = cvt_pk_bf16(fsilu(g1[2]) * u1[2], fsilu(g1[3]) * u1[3]);
                *(u32x4*)rowp = w;
            }
    }
};

struct EpiWin {
    static constexpr bool PERM = true, AFTER_DRAIN = false;
    bf16_t *q, *k, *v, *u, *ga, *gb; const float* rope; float qscale;
    __device__ __forceinline__ void operator()(const f32x4 (&acc)[2][2][4][2], const Unit& un, int wr, int wc, int fr, int fq) const {
        const int pn = un.pn, rowt = un.pm * BM + wr * 64 + fr, bidx = un.pm >> 5;
        if (pn < 8) {
            const bool isq = pn < 4; const float sc = isq ? qscale : 1.f; bf16_t* base = isq ? q : k;
            const int colt = (pn & 3) * 256 + wc * 32 + 8 * fq, axis = wc & 1, f0 = 8 * (fq & 1);
            const float sgn = (fq < 2) ? -sc : sc;
#pragma unroll
            for (int ai = 0; ai < 2; ++ai)
#pragma unroll
                for (int m = 0; m < 4; ++m) {
                    const int r = rowt + ai * HALF + m * 16, t = r & 8191, pos = axis ? (t & 63) : (t >> 6);
                    const f32x4 cs0 = *(const f32x4*)(rope + pos * 16 + f0), cs1 = *(const f32x4*)(rope + pos * 16 + f0 + 4);
                    const f32x4 sn0 = *(const f32x4*)(rope + 2048 + pos * 16 + f0), sn1 = *(const f32x4*)(rope + 2048 + pos * 16 + f0 + 4);
                    const size_t orow = isq ? (size_t)r : (size_t)bidx * 8448 + 256 + t;
                    bf16_t* rowp = base + orow * 1024 + colt;
#pragma unroll
                    for (int bj = 0; bj < 2; ++bj) {
                        const f32x4 s0 = acc[ai][bj][m][0], s1 = acc[ai][bj][m][1]; f32x4 o0, o1;
#pragma unroll
                        for (int jj = 0; jj < 4; ++jj) { const float p0 = __shfl_xor(s0[jj], 32), p1 = __shfl_xor(s1[jj], 32);
                            o0[jj] = s0[jj] * (cs0[jj] * sc) + p0 * (sn0[jj] * sgn); o1[jj] = s1[jj] * (cs1[jj] * sc) + p1 * (sn1[jj] * sgn); }
                        u32x4 w; w.x = cvt_pk_bf16(o0[0], o0[1]); w.y = cvt_pk_bf16(o0[2], o0[3]); w.z = cvt_pk_bf16(o1[0], o1[1]); w.w = cvt_pk_bf16(o1[2], o1[3]);
                        *(u32x4*)(rowp + bj * HALF) = w;
                    }
                }
        } else if (pn < 12) {
            const int colt = (pn - 8) * 256 + wc * 32 + 8 * fq;
#pragma unroll
            for (int ai = 0; ai < 2; ++ai)
#pragma unroll
                for (int m = 0; m < 4; ++m) {
                    const int r = rowt + ai * HALF + m * 16, t = r & 8191;
                    bf16_t* rowp = v + ((size_t)bidx * 8448 + 256 + t) * 1024 + colt;
#pragma unroll
                    for (int bj = 0; bj < 2; ++bj) { const f32x4 v0 = acc[ai][bj][m][0], v1 = acc[ai][bj][m][1]; u32x4 w;
                        w.x = cvt_pk_bf16(v0[0], v0[1]); w.y = cvt_pk_bf16(v0[2], v0[3]); w.z = cvt_pk_bf16(v1[0], v1[1]); w.w = cvt_pk_bf16(v1[2], v1[3]); *(u32x4*)(rowp + bj * HALF) = w; }
                }
        } else if (pn < 20) {
            const int colt = (pn - 12) * HALF + wc * 32 + 8 * fq;
#pragma unroll
            for (int ai = 0; ai < 2; ++ai)
#pragma unroll
                for (int m = 0; m < 4; ++m) {
                    bf16_t* rowp = u + (size_t)(rowt + ai * HALF + m * 16) * 1024 + colt;
                    const f32x4 a0 = acc[ai][0][m][0], a1 = acc[ai][0][m][1], g0 = acc[ai][1][m][0], g1 = acc[ai][1][m][1]; u32x4 w;
                    w.x = cvt_pk_bf16(a0[0] * fsigmoid(g0[0]), a0[1] * fsigmoid(g0[1])); w.y = cvt_pk_bf16(a0[2] * fsigmoid(g0[2]), a0[3] * fsigmoid(g0[3]));
                    w.z = cvt_pk_bf16(a1[0] * fsigmoid(g1[0]), a1[1] * fsigmoid(g1[1])); w.w = cvt_pk_bf16(a1[2] * fsigmoid(g1[2]), a1[3] * fsigmoid(g1[3]));
                    *(u32x4*)rowp = w;
                }
        } else {
            bf16_t* base = pn < 24 ? ga : gb; const int colt = (pn & 3) * 256 + wc * 32 + 8 * fq;
#pragma unroll
            for (int ai = 0; ai < 2; ++ai)
#pragma unroll
                for (int m = 0; m < 4; ++m) {
                    bf16_t* rowp = base + (size_t)(rowt + ai * HALF + m * 16) * 1024 + colt;
#pragma unroll
                    for (int bj = 0; bj < 2; ++bj) { const f32x4 v0 = acc[ai][bj][m][0], v1 = acc[ai][bj][m][1]; u32x4 w;
                        w.x = cvt_pk_bf16(fsigmoid(v0[0]), fsigmoid(v0[1])); w.y = cvt_pk_bf16(fsigmoid(v0[2]), fsigmoid(v0[3]));
                        w.z = cvt_pk_bf16(fsigmoid(v1[0]), fsigmoid(v1[1])); w.w = cvt_pk_bf16(fsigmoid(v1[2]), fsigmoid(v1[3])); *(u32x4*)(rowp + bj * HALF) = w; }
                }
        }
    }
};

struct EpiKVc {
    static constexpr bool PERM = true, AFTER_DRAIN = false;
    bf16_t *k, *v;
    __device__ __forceinline__ void operator()(const f32x4 (&acc)[2][2][4][2], const Unit& un, int wr, int wc, int fr, int fq) const {
        bf16_t* base = un.pn < 4 ? k : v; const int colt = (un.pn & 3) * 256 + wc * 32 + 8 * fq;
#pragma unroll
        for (int ai = 0; ai < 2; ++ai)
#pragma unroll
            for (int m = 0; m < 4; ++m) {
                bf16_t* rowp = base + ((size_t)un.pm * 8448 + wr * 64 + fr + ai * HALF + m * 16) * 1024 + colt;
#pragma unroll
                for (int bj = 0; bj < 2; ++bj) { const f32x4 v0 = acc[ai][bj][m][0], v1 = acc[ai][bj][m][1]; u32x4 w;
                    w.x = cvt_pk_bf16(v0[0], v0[1]); w.y = cvt_pk_bf16(v0[2], v0[3]); w.z = cvt_pk_bf16(v1[0], v1[1]); w.w = cvt_pk_bf16(v1[2], v1[3]); *(u32x4*)(rowp + bj * HALF) = w; }
            }
    }
};

template <bool ADD> struct EpiGate {
    static constexpr bool PERM = true, AFTER_DRAIN = false;
    bf16_t* Z; const bf16_t* G;
    __device__ __forceinline__ void operator()(const f32x4 (&acc)[2][2][4][2], const Unit& un, int wr, int wc, int fr, int fq) const {
        const int row0 = un.pm * BM + wr * 64 + fr, col0 = un.pn * BM + wc * 32 + 8 * fq;
#pragma unroll
        for (int ai = 0; ai < 2; ++ai)
#pragma unroll
            for (int m = 0; m < 4; ++m) {
                const size_t off = (size_t)(row0 + ai * HALF + m * 16) * 1024 + col0;
#pragma unroll
                for (int bj = 0; bj < 2; ++bj) {
                    const u32x4 g = *(const u32x4*)(G + off + bj * HALF);
                    const f32x4 v0 = acc[ai][bj][m][0], v1 = acc[ai][bj][m][1];
                    float o[8];
                    o[0] = v0[0] * bflo(g.x); o[1] = v0[1] * bfhi(g.x); o[2] = v0[2] * bflo(g.y); o[3] = v0[3] * bfhi(g.y);
                    o[4] = v1[0] * bflo(g.z); o[5] = v1[1] * bfhi(g.z); o[6] = v1[2] * bflo(g.w); o[7] = v1[3] * bfhi(g.w);
                    if (ADD) { const u32x4 z = *(const u32x4*)(Z + off + bj * HALF);
                        o[0] += bflo(z.x); o[1] += bfhi(z.x); o[2] += bflo(z.y); o[3] += bfhi(z.y); o[4] += bflo(z.z); o[5] += bfhi(z.z); o[6] += bflo(z.w); o[7] += bfhi(z.w); }
                    u32x4 w; w.x = cvt_pk_bf16(o[0], o[1]); w.y = cvt_pk_bf16(o[2], o[3]); w.z = cvt_pk_bf16(o[4], o[5]); w.w = cvt_pk_bf16(o[6], o[7]);
                    *(u32x4*)(Z + off + bj * HALF) = w;
                }
            }
    }
};
}

constexpr int NWAVES = 8, NTHR = 512;
constexpr int DM = 1024, NB = 4, SEQ = 8192, NLAT = NB * SEQ, NCTX = 256, NCTXR = NB * NCTX, NROWS = NLAT + NCTXR, NKEYS = SEQ + NCTX;
constexpr int DFF = 2816, INW = 7168, NMOD = 9;
constexpr float EPS = 1e-6f;
constexpr size_t MiB = 1u << 20;
constexpr size_t WS_MOD = 1 * MiB, WS_ROPE = 1 * MiB + 256 * 1024, WS_LAM = 1 * MiB + 512 * 1024;
constexpr size_t WS_W13A = 2 * MiB, WS_W2A = 13 * MiB, WS_W13B = WS_W2A + 11 * MiB / 2, WS_W2B = WS_W13B + 11 * MiB, WS_WIN = 35 * MiB, WS_WAP = 49 * MiB, WS_WCP = 51 * MiB, WS_WOUT = 53 * MiB;
constexpr size_t WS_H = 56 * MiB, WS_Y = 122 * MiB, WS_BIG = 188 * MiB;
constexpr size_t WS_ACT = WS_BIG, WS_Q = WS_BIG, WS_K = WS_BIG + 64 * MiB, WS_V = WS_K + 66 * MiB, WS_U = WS_V + 66 * MiB, WS_GB = WS_U + 64 * MiB, WS_END = WS_GB + 64 * MiB;
constexpr size_t WS_GA = WS_Y, WS_UC = WS_H, WS_OSCR = WS_U, WS_Z = WS_U;
static_assert(WS_END == 512 * MiB, "ws map");
static_assert(WS_W2B + 11 * MiB / 2 <= WS_WIN, "ws map weights");
constexpr int LDS_BYTES = 147456;

#define LAS __attribute__((address_space(3)))
typedef unsigned short bf16;
typedef unsigned v4u __attribute__((ext_vector_type(4)));
typedef unsigned v2u __attribute__((ext_vector_type(2)));
typedef float f32x4 __attribute__((ext_vector_type(4)));
#define LDS_WAIT() asm volatile("s_waitcnt lgkmcnt(0)" ::: "memory")
__device__ __forceinline__ unsigned f2bf(float f) { unsigned u = __builtin_bit_cast(unsigned, f); return (u + 0x7fffu + ((u >> 16) & 1u)) >> 16; }
__device__ __forceinline__ unsigned pk2(float lo, float hi) { return f2bf(lo) | (f2bf(hi) << 16); }
__device__ __forceinline__ float wave_sum(float v) {
#pragma unroll
    for (int o = 1; o < 64; o <<= 1) v += __shfl_xor(v, o);
    return v;
}

struct Args { const float* in[21]; float* out; unsigned char* ws; int pad0, pad1; };
enum { I_X = 0, I_C, I_CTX, I_CCTX, I_WADA, I_BADA, I_NORMG, I_F1W13, I_F1W2, I_F2W13, I_F2W2, I_WIN, I_LAMQK, I_SUBLN, I_WAP, I_CONVW, I_CONVB, I_CLNG, I_CLNB, I_WCP, I_WOUT };

template <int MODE> __device__ __forceinline__ int drow(int n0) {
    if (MODE == 1) { const int bj = n0 / DFF, j = n0 % DFF; return 256 * (j / 128) + 128 * bj + (j % 128); }
    if (MODE == 2) { if (n0 >= 3072 && n0 < 5120) { const int c = n0 - 3072, bj = c / 1024, j = c % 1024; return 3072 + 256 * (j / 128) + 128 * bj + (j % 128); } return n0; }
    return n0;
}
template <int MODE> __device__ __forceinline__ void transpose_item(const float* W, int K, int N, bf16* WT, LAS float* scr, int item, int lane) {
    const int nblk = N / 32, kb = item / nblk, nb = item % nblk, k0 = 64 * kb, n0 = 32 * nb, d0 = drow<MODE>(n0);
    float tv[32];
#pragma unroll
    for (int i = 0; i < 32; ++i) tv[i] = W[(size_t)(k0 + 2 * i + (lane >> 5)) * N + n0 + (lane & 31)];
#pragma unroll
    for (int i = 0; i < 32; ++i) scr[(2 * i + (lane >> 5)) * 33 + (lane & 31)] = tv[i];
    LDS_WAIT(); asm volatile("" ::: "memory");
    const int c = lane & 7;
#pragma unroll
    for (int j = 0; j < 4; ++j) { const int n = (lane >> 3) + 8 * j; const LAS float* s = scr + (8 * c) * 33 + n;
        v4u o; o.x = pk2(s[0 * 33], s[1 * 33]); o.y = pk2(s[2 * 33], s[3 * 33]); o.z = pk2(s[4 * 33], s[5 * 33]); o.w = pk2(s[6 * 33], s[7 * 33]);
        *(v4u*)(WT + (size_t)(d0 + n) * K + k0 + 8 * c) = o; }
    LDS_WAIT(); asm volatile("" ::: "memory");
}

template <bool HAS_Y, bool WRITE_X, bool WRITE_H>
__device__ __forceinline__ void norm_rows(int gw, int NGW, int lane, int row_lo, int nrows, const float* xlat, const float* xctx, const bf16* Y, float* xout, bf16* hout, const float* mod,
                                          float mult, const float* g_post, int k_gate, const float* g_pre, int k_in) {
    for (int row0 = row_lo + gw; row0 < nrows; row0 += 2 * NGW) {
        int rows[2]; rows[0] = row0; rows[1] = (row0 + NGW < nrows) ? row0 + NGW : row0;
        f32x4 v[2][4]; v2u yw[2][4]; const float* mp[2]; bool isctx[2];
#pragma unroll
        for (int r = 0; r < 2; ++r) {
            const int row = rows[r]; isctx[r] = row >= NLAT; const int mv = isctx[r] ? 4 : (row >> 13);
            const float* xr = isctx[r] ? xctx + (size_t)(row - NLAT) * DM : xlat + (size_t)row * DM;
            mp[r] = mod + (size_t)mv * (NMOD * DM);
#pragma unroll
            for (int j = 0; j < 4; ++j) v[r][j] = ((const f32x4*)xr)[lane + 64 * j];
            if (HAS_Y) {
#pragma unroll
                for (int j = 0; j < 4; ++j) yw[r][j] = ((const v2u*)(Y + (size_t)row * DM))[lane + 64 * j];
            }
        }
        if (HAS_Y) {
            f32x4 y[2][4]; float ss[2];
#pragma unroll
            for (int r = 0; r < 2; ++r) { ss[r] = 0.f;
#pragma unroll
                for (int j = 0; j < 4; ++j) { const v2u w = yw[r][j]; y[r][j] = (f32x4){pg8::bflo(w.x), pg8::bfhi(w.x), pg8::bflo(w.y), pg8::bfhi(w.y)};
                    ss[r] += (y[r][j].x * y[r][j].x + y[r][j].y * y[r][j].y) + (y[r][j].z * y[r][j].z + y[r][j].w * y[r][j].w); } }
#pragma unroll
            for (int o = 1; o < 64; o <<= 1) { ss[0] += __shfl_xor(ss[0], o); ss[1] += __shfl_xor(ss[1], o); }
#pragma unroll
            for (int r = 0; r < 2; ++r) { const float rstd = 1.0f / sqrtf(ss[r] * (1.f / DM) + EPS);
#pragma unroll
                for (int j = 0; j < 4; ++j) { const f32x4 gp = ((const f32x4*)g_post)[lane + 64 * j], gt = ((const f32x4*)(mp[r] + k_gate * DM))[lane + 64 * j];
                    v[r][j] = v[r][j] + (mult * gt) * ((y[r][j] * rstd) * gp); }
                if (WRITE_X && !isctx[r]) {
#pragma unroll
                    for (int j = 0; j < 4; ++j) ((f32x4*)(xout + (size_t)rows[r] * DM))[lane + 64 * j] = v[r][j];
                } }
        }
        if (WRITE_H) {
            float ss[2];
#pragma unroll
            for (int r = 0; r < 2; ++r) { ss[r] = 0.f;
#pragma unroll
                for (int j = 0; j < 4; ++j) ss[r] += (v[r][j].x * v[r][j].x + v[r][j].y * v[r][j].y) + (v[r][j].z * v[r][j].z + v[r][j].w * v[r][j].w); }
#pragma unroll
            for (int o = 1; o < 64; o <<= 1) { ss[0] += __shfl_xor(ss[0], o); ss[1] += __shfl_xor(ss[1], o); }
#pragma unroll
            for (int r = 0; r < 2; ++r) { const float rstd = 1.0f / sqrtf(ss[r] * (1.f / DM) + EPS);
#pragma unroll
                for (int j = 0; j < 4; ++j) { const f32x4 gp = ((const f32x4*)g_pre)[lane + 64 * j], sh = ((const f32x4*)(mp[r] + k_in * DM))[lane + 64 * j], sc = ((const f32x4*)(mp[r] + (k_in + 1) * DM))[lane + 64 * j];
                    const f32x4 h = ((v[r][j] * rstd) * gp) * (1.0f + sc) + sh;
                    v2u w; w.x = pk2(h.x, h.y); w.y = pk2(h.z, h.w); ((v2u*)(hout + (size_t)rows[r] * DM))[lane + 64 * j] = w; } }
        }
    }
}

#define RLX_AGENT __ATOMIC_RELAXED, __HIP_MEMORY_SCOPE_AGENT
#define XB_TMO      128
#define XB_XCNT(j)  (256  + 64 * (j))
#define XB_XSUB(j)  (1280 + 64 * (j))
#define XB_XGEN(j)  (2304 + 64 * (j))
#define XB_TOP      3328
#define XB_TOPGEN   3392
#define XCD_BAR_WORDS 3456
#define XB_SPIN_CAP (1u << 22)

__device__ __forceinline__ unsigned xb_ld(unsigned* p)              { return __hip_atomic_load(p, __ATOMIC_RELAXED, __HIP_MEMORY_SCOPE_AGENT); }
__device__ __forceinline__ unsigned xb_add(unsigned* p, unsigned v) { return __hip_atomic_fetch_add(p, v, __ATOMIC_RELAXED, __HIP_MEMORY_SCOPE_AGENT); }
__device__ __forceinline__ unsigned xb_xcc_id() { return (unsigned)__builtin_amdgcn_s_getreg((3 << 11) | 20) & 0xFu; }
#define XB_SPIN(cond, bar) do { unsigned _sp = 0; while (cond) { __builtin_amdgcn_s_sleep(1); \
    if ((++_sp & 255u) == 0u) { if (xb_ld(&(bar)[XB_TMO])) break; if (_sp > XB_SPIN_CAP) { atomicAdd(&(bar)[XB_TMO], 1u); break; } } } } while (0)

struct XcdBarrier {
    unsigned* bar; unsigned x;
    volatile LAS unsigned* st;
};

__device__ __forceinline__ XcdBarrier xcd_barrier_post(unsigned* bar, volatile LAS unsigned* st) {
    XcdBarrier b; b.bar = bar; b.x = xb_xcc_id(); b.st = st;
    if (threadIdx.x == 0) (void)xb_add(&bar[XB_XCNT(b.x)], 1u);
    return b;
}
__device__ __forceinline__ void xcd_barrier_complete(unsigned* bar, unsigned x, unsigned& nloc, unsigned& nx) {
    const unsigned G = gridDim.x * gridDim.y * gridDim.z;
    unsigned sum, cnt, mine, sp = 0u;
    for (;;) {
        sum = 0u; cnt = 0u; mine = 0u;
#pragma unroll
        for (unsigned j = 0; j < 16; ++j) { const unsigned c = xb_ld(&bar[XB_XCNT(j)]); sum += c; cnt += (c > 0u) ? 1u : 0u; mine = (j == x) ? c : mine; }
        if (sum == G) break;
        __builtin_amdgcn_s_sleep(1);
        if ((++sp & 255u) == 0u) { if (xb_ld(&bar[XB_TMO])) break; if (sp > XB_SPIN_CAP) { atomicAdd(&bar[XB_TMO], 1u); break; } }
    }
    nloc = mine > 0u ? mine : 1u; nx = cnt > 0u ? cnt : 1u;
}

__device__ __forceinline__ void xcd_barrier(const XcdBarrier& b) {
    asm volatile("s_waitcnt vmcnt(0)" ::: "memory");
    __syncthreads();
    if (threadIdx.x == 0) {
        unsigned* bar = b.bar;
        __builtin_amdgcn_s_waitcnt(0);
        unsigned nloc = b.st[0], nx = b.st[1];
        if (nloc == 0u) { xcd_barrier_complete(bar, b.x, nloc, nx); b.st[0] = nloc; b.st[1] = nx; }
        const unsigned old = xb_add(&bar[XB_XSUB(b.x)], 1u);
        const unsigned gen = old / nloc;
        if (old + 1u == (gen + 1u) * nloc) {
            __builtin_amdgcn_fence(__ATOMIC_RELEASE, "agent");
            asm volatile("s_waitcnt vmcnt(0)" ::: "memory");
            const unsigned og = xb_add(&bar[XB_TOP], 1u);
            const unsigned tg = og / nx;
            if (og + 1u == (tg + 1u) * nx) xb_add(&bar[XB_TOPGEN], 1u);
            else XB_SPIN(xb_ld(&bar[XB_TOPGEN]) == tg, bar);
            __builtin_amdgcn_fence(__ATOMIC_ACQUIRE, "agent");
            xb_add(&bar[XB_XGEN(b.x)], 1u);
            asm volatile("s_waitcnt vmcnt(0)" ::: "memory");
        } else {
            XB_SPIN(xb_ld(&bar[XB_XGEN(b.x)]) == gen, bar);
            __builtin_amdgcn_fence(__ATOMIC_ACQUIRE, "agent");
            asm volatile("s_waitcnt vmcnt(0)" ::: "memory");
        }
    }
    __syncthreads();
}

__global__ void __launch_bounds__(NTHR, 2) fwd_mega(Args args) {
    extern __shared__ __attribute__((aligned(16))) unsigned char lds[];
    cg::grid_group grid = cg::this_grid();
#define GSYNC_CG() do { asm volatile("s_waitcnt vmcnt(0) lgkmcnt(0)" ::: "memory"); grid.sync(); __builtin_amdgcn_fence(__ATOMIC_ACQUIRE, "agent"); asm volatile("s_waitcnt vmcnt(0)" ::: "memory"); } while (0)
#define GSYNC() xcd_barrier(xbar)
    LAS unsigned char* L = (LAS unsigned char*)lds;
    const int tid = threadIdx.x, lane = tid & 63, wave = __builtin_amdgcn_readfirstlane(tid >> 6);
    const int G = gridDim.x, bx = blockIdx.x, vcu = (G % 8 == 0) ? (bx % 8) * (G / 8) + bx / 8 : bx;
    const int gw = vcu * NWAVES + wave, NGW = G * NWAVES;
    unsigned char* ws = args.ws;
    volatile LAS unsigned* xst = (volatile LAS unsigned*)(L + LDS_BYTES - 64);
    static_assert(attn2::PARK_OFF + attn2::PARK_BYTES <= LDS_BYTES - 64, "LDS map");
    if (tid < 2) xst[tid] = 0u;
    __syncthreads();
    XcdBarrier xbar = xcd_barrier_post((unsigned*)ws, xst);
    float* mod = (float*)(ws + WS_MOD); float* rope = (float*)(ws + WS_ROPE); float* lamp = (float*)(ws + WS_LAM);
    bf16 *W13A = (bf16*)(ws + WS_W13A), *W2A = (bf16*)(ws + WS_W2A), *W13B = (bf16*)(ws + WS_W13B), *W2B = (bf16*)(ws + WS_W2B), *WIN = (bf16*)(ws + WS_WIN), *WAP = (bf16*)(ws + WS_WAP), *WCP = (bf16*)(ws + WS_WCP), *WOUT = (bf16*)(ws + WS_WOUT);
    bf16 *H = (bf16*)(ws + WS_H), *Y = (bf16*)(ws + WS_Y), *ACT = (bf16*)(ws + WS_ACT), *Qb = (bf16*)(ws + WS_Q), *Kb = (bf16*)(ws + WS_K), *Vb = (bf16*)(ws + WS_V), *Ub = (bf16*)(ws + WS_U), *GA = (bf16*)(ws + WS_GA), *GB = (bf16*)(ws + WS_GB);
    bf16 *UC = (bf16*)(ws + WS_UC), *OSCR = (bf16*)(ws + WS_OSCR), *Zb = (bf16*)(ws + WS_Z);
    const float* x = args.in[I_X]; const float* ctx = args.in[I_CTX]; const float* normg = args.in[I_NORMG]; float* out = args.out;

    {
        LAS float* sc = (LAS float*)L;
        LAS float* red = (LAS float*)(L + 20480);
        if (bx < 144) {
            for (int i = tid; i < 5 * DM; i += NTHR) { const float c = i < 4 * DM ? args.in[I_C][i] : args.in[I_CCTX][i - 4 * DM]; sc[i] = c / (1.0f + expf(-c)); }
            __syncthreads();
            for (int it = bx; it < 144; it += G) {
                const int col = it * 64 + lane; const float* wp = args.in[I_WADA] + (size_t)(wave * 128) * (NMOD * DM) + col;
                float a0 = 0.f, a1 = 0.f, a2 = 0.f, a3 = 0.f, a4 = 0.f;
#pragma unroll 32
                for (int kk = 0; kk < 128; ++kk) { const float w = wp[(size_t)kk * (NMOD * DM)]; const int k = wave * 128 + kk;
                    a0 += sc[k] * w; a1 += sc[DM + k] * w; a2 += sc[2 * DM + k] * w; a3 += sc[3 * DM + k] * w; a4 += sc[4 * DM + k] * w; }
                red[(wave * 5 + 0) * 64 + lane] = a0; red[(wave * 5 + 1) * 64 + lane] = a1; red[(wave * 5 + 2) * 64 + lane] = a2; red[(wave * 5 + 3) * 64 + lane] = a3; red[(wave * 5 + 4) * 64 + lane] = a4;
                __syncthreads();
                if (tid < 320) { const int v = tid >> 6, cl = tid & 63; float s = 0.f;
#pragma unroll
                    for (int w8 = 0; w8 < 8; ++w8) s += red[(w8 * 5 + v) * 64 + cl];
                    mod[(size_t)v * (NMOD * DM) + it * 64 + cl] = s + args.in[I_BADA][it * 64 + cl]; }
                __syncthreads();
            }
        }
        if (bx == G - 1) {
            for (int i = tid; i < 2048; i += NTHR) { const int pos = i >> 4, f = i & 15; double inv = 1.0; for (int j = 0; j < f; ++j) inv *= 0.56234132519034908; const double ang = (double)pos * inv; rope[i] = (float)cos(ang); rope[2048 + i] = (float)sin(ang); }
        }
        if (bx == G - 2 && tid < 64) {
            const float* lq = args.in[I_LAMQK];
            const float s01 = wave_sum(lq[tid] * lq[64 + tid]), s23 = wave_sum(lq[128 + tid] * lq[192 + tid]);
            if (tid == 0) lamp[0] = expf(s01) - expf(s23) + 0.2f;
        }
        __syncthreads();
        LAS float* scr = (LAS float*)(L + wave * 16384);
        constexpr int I_13 = (DM / 64) * (2 * DFF / 32), I_2 = (DFF / 64) * (DM / 32);
        for (int it = gw; it < I_13 + I_2; it += NGW) {
            if (it < I_13) transpose_item<1>(args.in[I_F1W13], DM, 2 * DFF, W13A, scr, it, lane);
            else transpose_item<0>(args.in[I_F1W2], DFF, DM, W2A, scr, it - I_13, lane);
        }
    }
    if (args.pad0 != 0) GSYNC_CG();
    GSYNC();
    norm_rows<false, false, true>(gw, NGW, lane, 0, NROWS, x, ctx, nullptr, nullptr, H, mod, 0.f, nullptr, 0, normg + 0 * DM, 0);
    GSYNC();
    { pg8::Gemm g{H, W13A, NROWS, 2 * DFF, DM}; pg8::StaticOrder S; S.init(NROWS, 2 * DFF, G, bx); pg8::EpiSwiglu E{ACT, DFF};
      pg8::gemm_phase<pg8::EpiSwiglu, pg8::StaticOrder, PG8_ALIGN, PG8_SP2>(L, g, S, E); }
    {
        constexpr int NU = (NROWS / 256) * (2 * DFF / 256), NFULL = NU / 256, NREM = NU - NFULL * 256;
        static_assert(NREM > 0 && NREM < 256, "partial round");
        if (G == 256 ? bx >= NREM : true) {
            const int nhelp = (G == 256) ? (256 - NREM) : G, hid = (G == 256) ? bx - NREM : bx;
            LAS float* scr = (LAS float*)(L + wave * 16384);
            constexpr int I_13 = (DM / 64) * (2 * DFF / 32), I_2 = (DFF / 64) * (DM / 32), I_IN = (DM / 64) * (INW / 32), I_SQ = (DM / 64) * (DM / 32);
            constexpr int NITEMS = I_13 + I_2 + I_IN + 3 * I_SQ;
            for (int it = hid * NWAVES + wave; it < NITEMS; it += nhelp * NWAVES) {
                int r = it;
                if (r < I_IN) { transpose_item<2>(args.in[I_WIN], DM, INW, WIN, scr, r, lane); continue; } r -= I_IN;
                if (r < I_SQ) { transpose_item<0>(args.in[I_WAP], DM, DM, WAP, scr, r, lane); continue; } r -= I_SQ;
                if (r < I_SQ) { transpose_item<0>(args.in[I_WCP], DM, DM, WCP, scr, r, lane); continue; } r -= I_SQ;
                if (r < I_SQ) { transpose_item<0>(args.in[I_WOUT], DM, DM, WOUT, scr, r, lane); continue; } r -= I_SQ;
                if (r < I_13) { transpose_item<1>(args.in[I_F2W13], DM, 2 * DFF, W13B, scr, r, lane); continue; } r -= I_13;
                transpose_item<0>(args.in[I_F2W2], DFF, DM, W2B, scr, r, lane);
            }
        }
    }
    GSYNC();
    { pg8::Gemm g{ACT, W2A, NLAT, DM, DFF}; pg8::StaticOrder S; S.init(NLAT, DM, G, bx); pg8::EpiBf16<0> E{Y, DM, nullptr, 0, 0, 1.f};
      pg8::gemm_phase<pg8::EpiBf16<0>, pg8::StaticOrder, PG8_ALIGN, PG8_SP2>(L, g, S, E); }
    GSYNC();
    if (G == 256) {
        if (bx < 16) { pg8::Gemm g{ACT + (size_t)NLAT * DFF, W2A, NCTXR, DM, DFF}; pg8::StaticOrder S; S.init(NCTXR, DM, G, bx); pg8::EpiBf16<0> E{Y + (size_t)NLAT * DM, DM, nullptr, 0, 0, 1.f};
            pg8::gemm_phase<pg8::EpiBf16<0>, pg8::StaticOrder, PG8_ALIGN, PG8_SP2>(L, g, S, E); }
        else norm_rows<true, true, true>((bx - 16) * NWAVES + wave, (G - 16) * NWAVES, lane, 0, NLAT, x, ctx, Y, out, H, mod, 0.5f, normg + 1 * DM, 2, normg + 2 * DM, 3);
    } else {
        { pg8::Gemm g{ACT + (size_t)NLAT * DFF, W2A, NCTXR, DM, DFF}; pg8::StaticOrder S; S.init(NCTXR, DM, G, bx); pg8::EpiBf16<0> E{Y + (size_t)NLAT * DM, DM, nullptr, 0, 0, 1.f};
          pg8::gemm_phase<pg8::EpiBf16<0>, pg8::StaticOrder, PG8_ALIGN, PG8_SP2>(L, g, S, E); }
        norm_rows<true, true, true>(gw, NGW, lane, 0, NLAT, x, ctx, Y, out, H, mod, 0.5f, normg + 1 * DM, 2, normg + 2 * DM, 3);
    }
    GSYNC();
    norm_rows<true, true, true>(gw, NGW, lane, NLAT, NROWS, x, ctx, Y, out, H, mod, 0.5f, normg + 1 * DM, 2, normg + 2 * DM, 3);
    GSYNC();
    { pg8::Gemm g{H, WIN, NLAT, INW, DM}; pg8::StaticOrder S; S.init(NLAT, INW, G, bx);
      pg8::EpiWin E{Qb, Kb, Vb, Ub, GA, GB, rope, attn2::QSCALE};

      pg8::gemm_phase<pg8::EpiWin, pg8::StaticOrder, PG8_ALIGN, PG8_SP2>(L, g, S, E);
    }
    { pg8::Gemm g{H + (size_t)NLAT * DM, WIN + (size_t)1024 * DM, NCTXR, 2048, DM}; pg8::StaticOrder S; S.init(NCTXR, 2048, G, bx); pg8::EpiKVc E{Kb, Vb};
      pg8::gemm_phase<pg8::EpiKVc, pg8::StaticOrder, PG8_ALIGN, PG8_SP2>(L, g, S, E); }
    GSYNC();
    {
        const int c0 = 2 * tid;
        float w0[31], w1[31];
#pragma unroll
        for (int k = 0; k < 31; ++k) { const float2 w = *(const float2*)(args.in[I_CONVW] + k * DM + c0); w0[k] = w.x; w1[k] = w.y; }
        const float2 cb = *(const float2*)(args.in[I_CONVB] + c0), lg = *(const float2*)(args.in[I_CLNG] + c0), lb = *(const float2*)(args.in[I_CLNB] + c0);
        LAS float* red = (LAS float*)L;
        LAS float* stat = (LAS float*)(L + 2048);
        for (int item = vcu; item < NLAT / 16; item += G) {
            const int tg = item * 16, b = tg >> 13, t0 = tg & 8191;
            float a0[16], a1[16];
#pragma unroll
            for (int o = 0; o < 16; ++o) { a0[o] = 0.f; a1[o] = 0.f; }
#pragma unroll
            for (int i = 0; i < 46; ++i) {
                const int t = t0 - 15 + i; const bool valid = (t >= 0) && (t < SEQ); const int tt = valid ? t : t0;
                const unsigned wv = *(const unsigned*)(Ub + ((size_t)(b * SEQ + tt)) * DM + c0);
                const float x0 = valid ? pg8::bflo(wv) : 0.f, x1 = valid ? pg8::bfhi(wv) : 0.f;
#pragma unroll
                for (int o = 0; o < 16; ++o) { if (i - o >= 0 && i - o <= 30) { a0[o] += w0[i - o] * x0; a1[o] += w1[i - o] * x1; } }
            }
#pragma unroll
            for (int o = 0; o < 16; ++o) { a0[o] += cb.x; a1[o] += cb.y; const float s = wave_sum(a0[o] + a1[o]), ss = wave_sum(a0[o] * a0[o] + a1[o] * a1[o]);
                if (lane == 0) { red[wave * 32 + 2 * o] = s; red[wave * 32 + 2 * o + 1] = ss; } }
            __syncthreads();
            if (tid < 32) { float s = 0.f;
#pragma unroll
                for (int w8 = 0; w8 < 8; ++w8) s += red[w8 * 32 + tid];
                stat[tid] = s; }
            __syncthreads();
#pragma unroll
            for (int o = 0; o < 16; ++o) { const float mean = stat[2 * o] * (1.f / DM), var = stat[2 * o + 1] * (1.f / DM) - mean * mean, rstd = 1.0f / sqrtf(fmaxf(var, 0.f) + EPS);
                const float y0 = (a0[o] - mean) * rstd * lg.x + lb.x, y1 = (a1[o] - mean) * rstd * lg.y + lb.y;
                *(unsigned*)(UC + ((size_t)(tg + o)) * DM + c0) = pk2(pg8::fsilu(y0), pg8::fsilu(y1)); }
        }
    }
    __syncthreads();
    {
        const float lam = lamp[0];
#pragma unroll 1
        for (int un = vcu; un < NB * 8 * (SEQ / 256); un += G) {
            const int qb = un & 31, bh = (un >> 8) * 8 + ((un & 255) >> 5), b = bh >> 3, h = bh & 7;
            const size_t qrow0 = (size_t)b * SEQ + (size_t)qb * 256;
            const bf16* kbase = Kb + (size_t)b * NKEYS * DM; const bf16* vbase = Vb + (size_t)b * NKEYS * DM + h * 128;
            attn2::body<0>(Qb + qrow0 * DM + (2 * h) * 64, kbase + (2 * h) * 64, vbase, NKEYS, (char*)lds, lam, args.in[I_SUBLN], nullptr);
            attn2::body<1>(Qb + qrow0 * DM + (2 * h + 1) * 64, kbase + (2 * h + 1) * 64, vbase, NKEYS, (char*)lds, lam, args.in[I_SUBLN], Qb + qrow0 * DM + h * 128);
        }
    }
    GSYNC();
    { pg8::Gemm g{Qb, WAP, NLAT, DM, DM}; pg8::StaticOrder S; S.init(NLAT, DM, G, bx); pg8::EpiGate<false> E{Zb, GA};
      pg8::gemm_phase<pg8::EpiGate<false>, pg8::StaticOrder, PG8_ALIGN, PG8_SP2>(L, g, S, E); }
    asm volatile("s_waitcnt vmcnt(0)" ::: "memory");
    { pg8::Gemm g{UC, WCP, NLAT, DM, DM}; pg8::StaticOrder S; S.init(NLAT, DM, G, bx); pg8::EpiGate<true> E{Zb, GB};
      pg8::gemm_phase<pg8::EpiGate<true>, pg8::StaticOrder, PG8_ALIGN, PG8_SP2>(L, g, S, E); }
    GSYNC();
    { pg8::Gemm g{Zb, WOUT, NLAT, DM, DM}; pg8::StaticOrder S; S.init(NLAT, DM, G, bx); pg8::EpiBf16<0> E{Y, DM, nullptr, 0, 0, 1.f};
      pg8::gemm_phase<pg8::EpiBf16<0>, pg8::StaticOrder, PG8_ALIGN, PG8_SP2>(L, g, S, E);
    }
    GSYNC();
    norm_rows<true, true, true>(gw, NGW, lane, 0, NLAT, out, ctx, Y, out, H, mod, 1.0f, normg + 3 * DM, 5, normg + 4 * DM, 6);
    GSYNC();
    { pg8::Gemm g{H, W13B, NLAT, 2 * DFF, DM}; pg8::StaticOrder S; S.init(NLAT, 2 * DFF, G, bx); pg8::EpiSwiglu E{ACT, DFF};
      pg8::gemm_phase<pg8::EpiSwiglu, pg8::StaticOrder, PG8_ALIGN, PG8_SP2>(L, g, S, E);
    }
    GSYNC();
    { pg8::Gemm g{ACT, W2B, NLAT, DM, DFF}; pg8::StaticOrder S; S.init(NLAT, DM, G, bx); pg8::EpiBf16<0> E{Y, DM, nullptr, 0, 0, 1.f};
      pg8::gemm_phase<pg8::EpiBf16<0>, pg8::StaticOrder, PG8_ALIGN, PG8_SP2>(L, g, S, E);
    }
    GSYNC();
    norm_rows<true, true, false>(gw, NGW, lane, 0, NLAT, out, ctx, Y, out, nullptr, mod, 0.5f, normg + 5 * DM, 8, nullptr, 0);
}

extern "C" void kernel_launch(void* const* d_in, const int* in_sizes, int n_in, void* d_out, int out_size, void* d_ws, size_t ws_size, hipStream_t stream) {
    static int grid = 0;
    if (grid == 0) {
        if (n_in != 21 || ws_size < WS_END || out_size != NLAT * DM) { fprintf(stderr, "kernel_launch: unexpected shapes (n_in %d, out %d, ws %zu)\n", n_in, out_size, ws_size); grid = -1; return; }
        int dev = 0, cus = 0, per_cu = 0;
        if (hipGetDevice(&dev) != hipSuccess || hipDeviceGetAttribute(&cus, hipDeviceAttributeMultiprocessorCount, dev) != hipSuccess) { grid = -1; return; }
        if (hipFuncSetAttribute((const void*)fwd_mega, hipFuncAttributeMaxDynamicSharedMemorySize, LDS_BYTES) != hipSuccess) { fprintf(stderr, "kernel_launch: hipFuncSetAttribute failed\n"); grid = -1; return; }
        if (hipOccupancyMaxActiveBlocksPerMultiprocessor(&per_cu, (const void*)fwd_mega, NTHR, LDS_BYTES) != hipSuccess || per_cu < 1) fprintf(stderr, "kernel_launch: occupancy query says %d\n", per_cu);
        (void)hipGetLastError();
        grid = cus;
    }
    if (grid < 0) return;
    if (hipMemsetAsync(d_ws, 0, 16384, stream) != hipSuccess) { fprintf(stderr, "kernel_launch: memset of the barrier words failed\n"); return; }
    Args a{};
    for (int i = 0; i < 21; ++i) a.in[i] = (const float*)d_in[i];
    a.out = (float*)d_out; a.ws = (unsigned char*)d_ws;
    void* kargs[] = {&a};
    const hipError_t e = hipLaunchCooperativeKernel((const void*)fwd_mega, dim3(grid), dim3(NTHR), kargs, LDS_BYTES, stream);
    if (e != hipSuccess) fprintf(stderr, "cooperative launch failed: %s (grid %d)\n", hipGetErrorString(e), grid);
}
```
